# Optimizing an MI355X kernel written in HIP

```python
import jax
import jax.numpy as jnp
from jax import lax
import numpy as np

D_MODEL = 1024
BATCH = 8
SEQ = 4096
DEPTH = 2

HEAD_DIM = 64
RET_W = 3 * D_MODEL // 8
RET_HEADS = RET_W // HEAD_DIM
HGRN_W = 3 * D_MODEL // 8
HGRN_HEADS = HGRN_W // HEAD_DIM
HGRN_DK = HEAD_DIM
GLA_W = D_MODEL // 4
GLA_HEADS = GLA_W // HEAD_DIM
GLA_DK = HEAD_DIM // 2
GLA_QK = GLA_HEADS * GLA_DK
GLA_GATE_RANK = 16
GLA_TAU = 16.0
D_MIX = RET_W + HGRN_W + GLA_W
CHUNK = 64
ROPE_BASE = 10000.0
EPS = 1e-6
F_MIN = 1e-30
N_GROUPS = 4
EXPERTS_PER_GROUP = 8
N_EXPERTS = N_GROUPS * EXPERTS_PER_GROUP
TOP_K_INNER = 2
D_EXPERT = D_MODEL // 4
N_MOD = 6
IN_PROJ_SIZES = (RET_W,) * 4 + (HGRN_W,) * 4 + (GLA_QK, GLA_QK, GLA_W, GLA_W, GLA_GATE_RANK)
IN_PROJ_DIM = sum(IN_PROJ_SIZES)

kernel_name = "hybrid_ret_hgrn2_gla_hmoe_adaln"


def rmsnorm(x, gain):
    xf = x.astype(jnp.float32)
    y = xf * lax.rsqrt(jnp.mean(xf * xf, axis=-1, keepdims=True) + EPS)
    return y.astype(x.dtype) * gain


def split_heads(t, n_heads):
    b, s, w = t.shape
    return t.reshape(b, s, n_heads, w // n_heads).transpose(0, 2, 1, 3).astype(jnp.float32)


def head_rmsnorm(o, gain):
    b, h, s, d = o.shape
    o = o.transpose(0, 2, 1, 3)
    o = o * lax.rsqrt(jnp.mean(o * o, axis=-1, keepdims=True) + EPS)
    return o.reshape(b, s, h * d) * gain.astype(jnp.float32)


def rope_tables(positions, dim):
    inv_freq = ROPE_BASE ** (-jnp.arange(0, dim, 2, dtype=jnp.float32) / dim)
    ang = positions.astype(jnp.float32)[..., None] * inv_freq
    return jnp.cos(ang)[:, None], jnp.sin(ang)[:, None]


def apply_rope(t, cos, sin):
    t1, t2 = jnp.split(t, 2, axis=-1)
    return jnp.concatenate([t1 * cos - t2 * sin, t1 * sin + t2 * cos], axis=-1)


def retention_chunkwise(q, k, v):
    b, h, s, dk = q.shape
    dv = v.shape[-1]
    n = s // CHUNK
    log_gamma = jnp.log1p(-jnp.exp2(-5.0 - jnp.arange(h, dtype=jnp.float32)))
    idx = jnp.arange(CHUNK, dtype=jnp.float32)
    rel = idx[:, None] - idx[None, :]
    decay = jnp.where(rel >= 0, jnp.exp(log_gamma[:, None, None] * jnp.maximum(rel, 0.0)), 0.0)
    zeta = jnp.exp(log_gamma[:, None] * (CHUNK - 1 - idx))
    xi = jnp.exp(log_gamma[:, None] * (idx + 1.0))
    chunk_decay = jnp.exp(log_gamma * CHUNK)[:, None, None]
    qc = q.reshape(b, h, n, CHUNK, dk)
    kc = k.reshape(b, h, n, CHUNK, dk)
    vc = v.reshape(b, h, n, CHUNK, dv)
    scores = jnp.einsum('bhnid,bhnjd->bhnij', qc, kc) * decay[:, None]
    o_intra = jnp.einsum('bhnij,bhnje->bhnie', scores, vc)
    u = jnp.einsum('bhnjd,hj,bhnje->nbhde', kc, zeta, vc)

    def step(r, u_i):
        return r * chunk_decay + u_i, r

    _, r_prev = lax.scan(step, jnp.zeros((b, h, dk, dv), jnp.float32), u)
    o_inter = jnp.einsum('bhnid,nbhde,hi->bhnie', qc, r_prev, xi)
    return (o_intra + o_inter).reshape(b, h, s, dv)


def gated_linear_recurrence_chunkwise(q, k, v, log_a):
    b, h, s, dk = q.shape
    dv = v.shape[-1]
    n = s // CHUNK
    mask = jnp.tril(jnp.ones((CHUNK, CHUNK), dtype=bool))[:, :, None]

    def to_chunks(t):
        return jnp.moveaxis(t.reshape(b, h, n, CHUNK, t.shape[-1]), 2, 0)

    def step(state, inp):
        qc, kc, vc, lac = inp
        cum = jnp.cumsum(lac, axis=-2)
        o_inter = jnp.einsum('bhcd,bhde->bhce', qc * jnp.exp(cum), state)
        diff = cum[:, :, :, None, :] - cum[:, :, None, :, :]
        dec = jnp.where(mask, jnp.exp(jnp.where(mask, diff, 0.0)), 0.0)
        scores = jnp.einsum('bhtd,bhsd,bhtsd->bhts', qc, kc, dec)
        o = o_inter + jnp.einsum('bhts,bhse->bhte', scores, vc)
        cum_last = cum[:, :, -1:, :]
        new_state = (jnp.exp(cum_last[:, :, 0, :])[..., None] * state
                     + jnp.einsum('bhsd,bhse->bhde', kc * jnp.exp(cum_last - cum), vc))
        return new_state, o

    s0 = jnp.zeros((b, h, dk, dv), jnp.float32)
    _, o = lax.scan(step, s0, (to_chunks(q), to_chunks(k), to_chunks(v), to_chunks(log_a)))
    return jnp.moveaxis(o, 0, 2).reshape(b, h, s, dv)


def hybrid_mixer(h, cos, sin, w_in, ret_norm, hgrn_norm, hgrn_lb, gla_wa2, gla_ba, gla_norm, w_out):
    proj = h @ w_in
    splits = np.cumsum(IN_PROJ_SIZES)[:-1].tolist()
    (rq, rk, rv, rg, hq, hf, hi, hg, gq, gk, gv, gg, ga) = jnp.split(proj, splits, axis=-1)

    q = apply_rope(split_heads(rq, RET_HEADS), cos, sin)
    k = apply_rope(split_heads(rk, RET_HEADS), cos, sin) * HEAD_DIM ** -0.5
    o_ret = retention_chunkwise(q, k, split_heads(rv, RET_HEADS))
    o_ret = head_rmsnorm(o_ret, ret_norm) * jax.nn.silu(rg.astype(jnp.float32))

    lb = hgrn_lb.astype(jnp.float32).reshape(HGRN_HEADS, 1, HGRN_DK)
    z = split_heads(hf, HGRN_HEADS)
    f = lb + (1.0 - lb) * jax.nn.sigmoid(z)
    log_f = jnp.log(jnp.maximum(f, F_MIN))
    k = (1.0 - lb) * jax.nn.sigmoid(-z)
    q = jax.nn.silu(split_heads(hq, HGRN_HEADS)) * HGRN_DK ** -0.5
    o_hgrn = gated_linear_recurrence_chunkwise(q, k, split_heads(hi, HGRN_HEADS), log_f)
    o_hgrn = head_rmsnorm(o_hgrn, hgrn_norm) * jax.nn.silu(hg.astype(jnp.float32))

    log_a = jax.nn.log_sigmoid((ga @ gla_wa2 + gla_ba).astype(jnp.float32)) / GLA_TAU
    q = split_heads(gq, GLA_HEADS) * GLA_DK ** -0.5
    o_gla = gated_linear_recurrence_chunkwise(q, split_heads(gk, GLA_HEADS), split_heads(gv, GLA_HEADS),
                                              split_heads(log_a, GLA_HEADS))
    o_gla = head_rmsnorm(o_gla, gla_norm) * jax.nn.silu(gg.astype(jnp.float32))

    merged = jnp.concatenate([o_ret, o_hgrn, o_gla], axis=-1).astype(h.dtype)
    return merged @ w_out


def hierarchical_moe(h, w_rg, b_rg, w_re, b_re, w_gate, w_up, w_down):
    b, s, d = h.shape
    tok = h.reshape(b * s, d)
    g_logits = (tok @ w_rg + b_rg).astype(jnp.float32)
    g_idx = jnp.argmax(g_logits, axis=-1)
    g_w = jnp.max(jax.nn.softmax(g_logits, axis=-1), axis=-1, keepdims=True)
    e_logits = (tok @ w_re + b_re).astype(jnp.float32).reshape(-1, N_GROUPS, EXPERTS_PER_GROUP)
    e_in_group = jnp.einsum('nge,ng->ne', e_logits, jax.nn.one_hot(g_idx, N_GROUPS, dtype=jnp.float32))
    top_val, top_idx = lax.top_k(e_in_group, TOP_K_INNER)
    top_w = jax.nn.softmax(top_val, axis=-1) * g_w
    expert_ids = g_idx[:, None] * EXPERTS_PER_GROUP + top_idx
    combine = jnp.einsum('nk,nke->ne', top_w,
                         jax.nn.one_hot(expert_ids, N_EXPERTS, dtype=jnp.float32)).astype(h.dtype)
    out = jnp.zeros_like(tok)
    for e in range(N_EXPERTS):
        hid = jax.nn.silu(tok @ w_gate[e]) * (tok @ w_up[e])
        out = out + combine[:, e:e + 1] * (hid @ w_down[e])
    return out.reshape(b, s, d)


def setup_inputs(seed: int = 0) -> dict:
    key = jax.random.key(seed)
    ks = jax.random.split(key, 24)
    f32 = jnp.float32

    def nrm(k, shape, scale):
        return jax.random.normal(k, shape, f32) * scale

    x = nrm(ks[0], (BATCH, SEQ, D_MODEL), 1.0)
    c = nrm(ks[1], (BATCH, D_MODEL), 1.0)
    positions = (jax.random.randint(ks[2], (BATCH, 1), 0, 1024)
                 + jnp.arange(SEQ, dtype=jnp.int32)[None, :]).astype(jnp.int32)
    w_ada = nrm(ks[3], (DEPTH, D_MODEL, N_MOD * D_MODEL), 0.5 * D_MODEL ** -0.5)
    b_ada = nrm(ks[4], (DEPTH, N_MOD * D_MODEL), 0.02)
    norm_mix = 1.0 + nrm(ks[5], (DEPTH, D_MODEL), 0.02)
    norm_ffn = 1.0 + nrm(ks[6], (DEPTH, D_MODEL), 0.02)
    w_in = nrm(ks[7], (DEPTH, D_MODEL, IN_PROJ_DIM), D_MODEL ** -0.5)
    ret_norm = 1.0 + nrm(ks[8], (DEPTH, RET_W), 0.02)
    hgrn_norm = 1.0 + nrm(ks[9], (DEPTH, HGRN_W), 0.02)
    hgrn_lb_logits = nrm(ks[10], (DEPTH, HGRN_HEADS * HGRN_DK), 1.0)
    gla_wa2 = nrm(ks[11], (DEPTH, GLA_GATE_RANK, GLA_QK), GLA_GATE_RANK ** -0.5)
    gla_ba = nrm(ks[12], (DEPTH, GLA_QK), 0.1)
    gla_norm = 1.0 + nrm(ks[13], (DEPTH, GLA_W), 0.02)
    w_out = nrm(ks[14], (DEPTH, D_MIX, D_MODEL), D_MIX ** -0.5)
    router_group_w = nrm(ks[15], (DEPTH, D_MODEL, N_GROUPS), D_MODEL ** -0.5)
    router_group_b = nrm(ks[16], (DEPTH, N_GROUPS), 0.01)
    router_expert_w = nrm(ks[17], (DEPTH, D_MODEL, N_EXPERTS), D_MODEL ** -0.5)
    router_expert_b = nrm(ks[18], (DEPTH, N_EXPERTS), 0.01)
    expert_w_gate = nrm(ks[19], (DEPTH, N_EXPERTS, D_MODEL, D_EXPERT), D_MODEL ** -0.5)
    expert_w_up = nrm(ks[20], (DEPTH, N_EXPERTS, D_MODEL, D_EXPERT), D_MODEL ** -0.5)
    expert_w_down = nrm(ks[21], (DEPTH, N_EXPERTS, D_EXPERT, D_MODEL), D_EXPERT ** -0.5)
    norm_final = 1.0 + nrm(ks[22], (D_MODEL,), 0.02)
    return {"x": x, "c": c, "positions": positions, "w_ada": w_ada, "b_ada": b_ada,
            "norm_mix": norm_mix, "norm_ffn": norm_ffn, "w_in": w_in, "ret_norm": ret_norm,
            "hgrn_norm": hgrn_norm, "hgrn_lb_logits": hgrn_lb_logits, "gla_wa2": gla_wa2,
            "gla_ba": gla_ba, "gla_norm": gla_norm, "w_out": w_out,
            "router_group_w": router_group_w, "router_group_b": router_group_b,
            "router_expert_w": router_expert_w, "router_expert_b": router_expert_b,
            "expert_w_gate": expert_w_gate, "expert_w_up": expert_w_up,
            "expert_w_down": expert_w_down, "norm_final": norm_final}


def reference(x, c, positions, w_ada, b_ada, norm_mix, norm_ffn, w_in, ret_norm, hgrn_norm,
              hgrn_lb_logits, gla_wa2, gla_ba, gla_norm, w_out, router_group_w, router_group_b,
              router_expert_w, router_expert_b, expert_w_gate, expert_w_up, expert_w_down,
              norm_final):
    cos, sin = rope_tables(positions, HEAD_DIM)
    lb_w = jax.nn.softmax(hgrn_lb_logits.astype(jnp.float32), axis=0)
    lower_bounds = jnp.cumsum(lb_w, axis=0) - lb_w[0]
    c_act = jax.nn.silu(c)
    for layer in range(DEPTH):
        mod = c_act @ w_ada[layer] + b_ada[layer]
        shift_m, scale_m, gate_m, shift_f, scale_f, gate_f = [m[:, None, :] for m in jnp.split(mod, N_MOD, axis=-1)]
        h = rmsnorm(x, norm_mix[layer]) * (1.0 + scale_m) + shift_m
        x = x + gate_m * hybrid_mixer(h, cos, sin, w_in[layer], ret_norm[layer], hgrn_norm[layer],
                                      lower_bounds[layer], gla_wa2[layer], gla_ba[layer],
                                      gla_norm[layer], w_out[layer])
        h = rmsnorm(x, norm_ffn[layer]) * (1.0 + scale_f) + shift_f
        x = x + gate_f * hierarchical_moe(h, router_group_w[layer], router_group_b[layer],
                                          router_expert_w[layer], router_expert_b[layer],
                                          expert_w_gate[layer], expert_w_up[layer], expert_w_down[layer])
    return rmsnorm(x, norm_final)
```

```cpp
#include <hip/hip_runtime.h>
#include <cstdio>
#include <cstdint>
#include <cmath>

#define GAS __attribute__((address_space(1)))
#define LAS __attribute__((address_space(3)))
typedef unsigned short bf16;
typedef short bf16x8 __attribute__((ext_vector_type(8)));
typedef float f32x4 __attribute__((ext_vector_type(4)));
typedef float f32x2 __attribute__((ext_vector_type(2)));
typedef unsigned u32x4 __attribute__((ext_vector_type(4)));
typedef unsigned u32x2 __attribute__((ext_vector_type(2)));

#ifndef EN_P0
#define EN_P0 1
#endif
#ifndef EN_PA
#define EN_PA 1
#endif
#ifndef EN_PB
#define EN_PB 1
#endif
#ifndef EN_PC
#define EN_PC 1
#endif
#ifndef EN_PD
#define EN_PD 1
#endif
#ifndef EN_PE
#define EN_PE 1
#endif
#ifndef EN_PG
#define EN_PG 1
#endif
#ifndef EN_PH
#define EN_PH 1
#endif
#ifndef EN_PF
#define EN_PF 1
#endif
#ifndef MK_ONE_LAUNCH
#define MK_ONE_LAUNCH 0
#endif

constexpr int NB = 8, SEQ = 4096, MTOK = NB * SEQ, D = 1024, DEPTH = 2;
constexpr int NPROJ = 4096;
constexpr int INP = 3856;
constexpr int C_RQ = 0, C_RK = 384, C_RV = 768, C_RG = 1152, C_HQ = 1536, C_HF = 1920, C_HI = 2304, C_HG = 2688, C_GQ = 3072, C_GK = 3200, C_GV = 3328, C_GG = 3584, C_GA = 3840;
constexpr int NEXP = 32, DEXP = 256;
constexpr int MAXROWS = 73728;
constexpr float EPS = 1e-6f;

constexpr size_t MiB = 1u << 20;
constexpr size_t WS_CTL = 0, CTL_ZERO_BYTES = 1 * MiB;
constexpr size_t WS_MOD = 1 * MiB;
constexpr size_t WS_ROPE = 2 * MiB;
constexpr size_t WS_WIN = 10 * MiB;
constexpr size_t WS_WOUT = 26 * MiB;
constexpr size_t WS_WGU = 30 * MiB;
constexpr size_t WS_WD = 94 * MiB;
constexpr size_t WS_H = 126 * MiB;
constexpr size_t WS_PROJ = 190 * MiB;
constexpr size_t WS_HID = 190 * MiB;
constexpr size_t WS_YP = 226 * MiB;
constexpr size_t WS_STATE = 446 * MiB;
constexpr size_t WS_ROUTE = 474 * MiB;
constexpr size_t WS_IDX2 = 476 * MiB;
constexpr size_t WS_END = 480 * MiB;
constexpr int CW_CNT = 64;
constexpr int CW_BAR = 4096;

constexpr int RING_BYTES = 131072;
constexpr int LDSCTL_OFF = RING_BYTES;
constexpr int TP_OFF = RING_BYTES + 512;
constexpr int AUX_OFF = RING_BYTES + 1024;
constexpr int LDS_BYTES = 147456;

#define RLX_AGENT __ATOMIC_RELAXED, __HIP_MEMORY_SCOPE_AGENT
#define LDS_WAIT() asm volatile("s_waitcnt lgkmcnt(0)" ::: "memory")
#define VM_WAIT() asm volatile("s_waitcnt vmcnt(0)" ::: "memory")

__device__ __forceinline__ unsigned f2bf(float f) { unsigned u = __builtin_bit_cast(unsigned, f); return (u + 0x7fffu + ((u >> 16) & 1u)) >> 16; }
__device__ __forceinline__ unsigned pk2(float lo, float hi) { return f2bf(lo) | (f2bf(hi) << 16); }
__device__ __forceinline__ float bf2f(unsigned short b) { return __builtin_bit_cast(float, ((unsigned)b) << 16); }
__device__ __forceinline__ float bflo(unsigned w) { return __builtin_bit_cast(float, w << 16); }
__device__ __forceinline__ float bfhi(unsigned w) { return __builtin_bit_cast(float, w & 0xffff0000u); }
__device__ __forceinline__ float sigmoidf_(float x) { return 1.0f / (1.0f + __expf(-x)); }
__device__ __forceinline__ float siluf_(float x) { return x / (1.0f + __expf(-x)); }
__device__ __forceinline__ float wave_sum(float v) {
#pragma unroll
    for (int o = 1; o < 64; o <<= 1) v += __shfl_xor(v, o);
    return v;
}

#define XB_TMO      128
#define XB_XCNT(j)  (256  + 64 * (j))
#define XB_XSUB(j)  (1280 + 64 * (j))
#define XB_XGEN(j)  (2304 + 64 * (j))
#define XB_TOP      3328
#define XB_TOPGEN   3392
#define XCD_BAR_WORDS 3456
#define XB_SPIN_CAP (1u << 18)
__device__ __forceinline__ unsigned xb_ld(unsigned* p)              { return __hip_atomic_load(p, __ATOMIC_RELAXED, __HIP_MEMORY_SCOPE_AGENT); }
__device__ __forceinline__ unsigned xb_add(unsigned* p, unsigned v) { return __hip_atomic_fetch_add(p, v, __ATOMIC_RELAXED, __HIP_MEMORY_SCOPE_AGENT); }
__device__ __forceinline__ unsigned xb_xcc_id() { return (unsigned)__builtin_amdgcn_s_getreg((3 << 11) | 20) & 0xFu; }
#define XB_SPIN(cond, bar) do { unsigned _sp = 0; while (cond) { __builtin_amdgcn_s_sleep(1); \
    if ((++_sp & 255u) == 0u) { if (xb_ld(&(bar)[XB_TMO])) break; if (_sp > XB_SPIN_CAP) { atomicAdd(&(bar)[XB_TMO], 1u); break; } } } } while (0)
struct XcdBarrier { unsigned* bar; unsigned x; volatile LAS unsigned* st; };
__device__ __forceinline__ XcdBarrier xcd_barrier_post(unsigned* bar, volatile LAS unsigned* st) {
    XcdBarrier b; b.bar = bar; b.x = xb_xcc_id(); b.st = st;
    if (threadIdx.x == 0) (void)xb_add(&bar[XB_XCNT(b.x)], 1u);
    return b;
}
__device__ __forceinline__ void xcd_barrier_complete(unsigned* bar, unsigned x, unsigned& nloc, unsigned& nx) {
    const unsigned G = gridDim.x * gridDim.y * gridDim.z;
    unsigned sum, cnt, mine, sp = 0u;
    for (;;) {
        sum = 0u; cnt = 0u; mine = 0u;
#pragma unroll
        for (unsigned j = 0; j < 16; ++j) { const unsigned c = xb_ld(&bar[XB_XCNT(j)]); sum += c; cnt += (c > 0u) ? 1u : 0u; mine = (j == x) ? c : mine; }
        if (sum == G) break;
        __builtin_amdgcn_s_sleep(1);
        if ((++sp & 255u) == 0u) { if (xb_ld(&bar[XB_TMO])) break; if (sp > XB_SPIN_CAP) { atomicAdd(&bar[XB_TMO], 1u); break; } }
    }
    nloc = mine > 0u ? mine : 1u; nx = cnt > 0u ? cnt : 1u;
}
__device__ __forceinline__ void xcd_barrier(const XcdBarrier& b) {
    asm volatile("s_waitcnt vmcnt(0)" ::: "memory");
    __syncthreads();
    if (threadIdx.x == 0) {
        unsigned* bar = b.bar;
        __builtin_amdgcn_s_waitcnt(0);
        unsigned nloc = b.st[0], nx = b.st[1];
        if (nloc == 0u) { xcd_barrier_complete(bar, b.x, nloc, nx); b.st[0] = nloc; b.st[1] = nx; }
        const unsigned old = xb_add(&bar[XB_XSUB(b.x)], 1u);
        const unsigned gen = old / nloc;
        if (old + 1u == (gen + 1u) * nloc) {
            __builtin_amdgcn_fence(__ATOMIC_RELEASE, "agent");
            asm volatile("s_waitcnt vmcnt(0)" ::: "memory");
            const unsigned og = xb_add(&bar[XB_TOP], 1u);
            const unsigned tg = og / nx;
            if (og + 1u == (tg + 1u) * nx) xb_add(&bar[XB_TOPGEN], 1u);
            else XB_SPIN(xb_ld(&bar[XB_TOPGEN]) == tg, bar);
            __builtin_amdgcn_fence(__ATOMIC_ACQUIRE, "agent");
            xb_add(&bar[XB_XGEN(b.x)], 1u);
            asm volatile("s_waitcnt vmcnt(0)" ::: "memory");
        } else {
            XB_SPIN(xb_ld(&bar[XB_XGEN(b.x)]) == gen, bar);
            __builtin_amdgcn_fence(__ATOMIC_ACQUIRE, "agent");
            asm volatile("s_waitcnt vmcnt(0)" ::: "memory");
        }
    }
    __syncthreads();
}

namespace pg8 {
constexpr int BM = 256, BK = 64, HALF = 128, HTB = HALF * BK * 2, STAGE_BYTES = 8 * HTB, NXCD = 8, WGM = 8;
__host__ __device__ __forceinline__ int lds_byte(int r, int c) { const int st = (r >> 4) * 2 + (c >> 5), rr = r & 15, cc = c & 31, ob = rr * 64 + cc * 2; return st * 1024 + (ob ^ (((ob >> 9) & 1) << 5)); }
__host__ __device__ __forceinline__ void stage_rc(int b, int& R, int& C) { const int st = b / 1024, sb = b % 1024, swz = sb ^ (((sb >> 9) & 1) << 5); R = (st >> 1) * 16 + swz / 64; C = (st & 1) * 32 + (swz % 64) / 2; }
__host__ __device__ __forceinline__ int perm32(int rho) { const int n = rho >> 4, i = rho & 15; return 8 * (i >> 2) + 4 * n + (i & 3); }
struct Unit { int pm, pn, pc; };
struct Gemm { const bf16* A; const bf16* Bt; int K; };

struct StaticOrder {
    int nM, nN, nwg, G, c;
    __device__ void init(int M, int N, int G_, int c_) { nM = M / BM; nN = N / BM; nwg = nM * nN; G = G_; c = c_; }
    __device__ bool next(int i, Unit& u) const {
        const long L = (long)i * G + c; if (L >= nwg) return false;
        int wgid = (int)L; { const int q = nwg / NXCD, r = nwg % NXCD, xcd = wgid % NXCD, off = wgid / NXCD; wgid = (xcd < r ? xcd * (q + 1) : r * (q + 1) + (xcd - r) * q) + off; }
        const int nig = WGM * nN, gid = wgid / nig, fm = gid * WGM, gsz = (nM - fm) < WGM ? (nM - fm) : WGM;
        u.pm = fm + ((wgid % nig) % gsz); u.pn = (wgid % nig) / gsz; u.pc = u.pn; return true;
    }
};
struct MoeOrder {
    int G, c, npt, total; const LAS int* tp;
    __device__ bool next(int i, Unit& u) const {
        const int L = i * G + c; if (L >= total) return false;
        const int mt = L / npt, nl = L % npt; int e = 0;
        while (e < 31 && tp[e + 1] <= mt) ++e;
        u.pm = mt; u.pn = e * npt + nl; u.pc = nl; return true;
    }
};

__device__ __forceinline__ unsigned cvt_pk_bf16(float lo, float hi) { unsigned r; asm volatile("v_cvt_pk_bf16_f32 %0, %1, %2" : "=v"(r) : "v"(lo), "v"(hi)); return r; }

struct EpiBf16Store {
    static constexpr bool PERM = true;
    bf16* O; int ldc;
    __device__ __forceinline__ void operator()(const f32x4 (&acc)[2][2][4][2], const Unit& u, int wr, int wc, int fr, int fq) const {
        const int row0 = u.pm * BM + wr * 64 + fr, col0 = u.pc * BM + wc * 32 + 8 * fq;
#pragma unroll
        for (int ai = 0; ai < 2; ++ai)
#pragma unroll
            for (int m = 0; m < 4; ++m) { bf16* rowp = O + (size_t)(row0 + ai * HALF + m * 16) * ldc + col0;
#pragma unroll
                for (int bj = 0; bj < 2; ++bj) { const f32x4 v0 = acc[ai][bj][m][0], v1 = acc[ai][bj][m][1];
                    u32x4 w; w.x = cvt_pk_bf16(v0[0], v0[1]); w.y = cvt_pk_bf16(v0[2], v0[3]); w.z = cvt_pk_bf16(v1[0], v1[1]); w.w = cvt_pk_bf16(v1[2], v1[3]);
                    *(u32x4*)(rowp + bj * HALF) = w; } }
    }
};
struct EpiSwiGLU {
    static constexpr bool PERM = true;
    bf16* O;
    __device__ __forceinline__ void operator()(const f32x4 (&acc)[2][2][4][2], const Unit& u, int wr, int wc, int fr, int fq) const {
        const int row0 = u.pm * BM + wr * 64 + fr, col0 = u.pc * HALF + wc * 32 + 8 * fq;
#pragma unroll
        for (int ai = 0; ai < 2; ++ai)
#pragma unroll
            for (int m = 0; m < 4; ++m) { bf16* rowp = O + (size_t)(row0 + ai * HALF + m * 16) * DEXP + col0;
                float h[8];
#pragma unroll
                for (int n = 0; n < 2; ++n)
#pragma unroll
                    for (int j = 0; j < 4; ++j) { const float g = acc[ai][0][m][n][j], up = acc[ai][1][m][n][j]; h[n * 4 + j] = g / (1.0f + __expf(-g)) * up; }
                u32x4 w; w.x = cvt_pk_bf16(h[0], h[1]); w.y = cvt_pk_bf16(h[2], h[3]); w.z = cvt_pk_bf16(h[4], h[5]); w.w = cvt_pk_bf16(h[6], h[7]);
                *(u32x4*)rowp = w; }
    }
};
struct EpiResGate {
    static constexpr bool PERM = false;
    const float* res; float* out; const float* gate;
    __device__ __forceinline__ void operator()(const f32x4 (&acc)[2][2][4][2], const Unit& u, int wr, int wc, int fr, int fq) const {
        const int row0 = u.pm * BM + wr * 64 + fr, col0 = u.pc * BM + wc * 32 + 4 * fq;
        const float* gb = gate + (size_t)(u.pm >> 4) * 6144;
        f32x4 gv[2][2];
#pragma unroll
        for (int bj = 0; bj < 2; ++bj)
#pragma unroll
            for (int n = 0; n < 2; ++n) gv[bj][n] = *(const f32x4*)(gb + col0 + bj * HALF + n * 16);
#pragma unroll
        for (int ai = 0; ai < 2; ++ai)
#pragma unroll
            for (int m = 0; m < 4; ++m) { const size_t off = (size_t)(row0 + ai * HALF + m * 16) * D + col0;
#pragma unroll
                for (int bj = 0; bj < 2; ++bj)
#pragma unroll
                    for (int n = 0; n < 2; ++n) { const f32x4 r = *(const f32x4*)(res + off + bj * HALF + n * 16); *(f32x4*)(out + off + bj * HALF + n * 16) = r + gv[bj][n] * acc[ai][bj][m][n]; } }
    }
};

template <class Epi, class Sched, bool GATHER>
__device__ __forceinline__ void gemm_phase(LAS unsigned char* lds, const Gemm g, const Sched& S, const Epi& E, const LAS int* gidx) {
    const int tid = threadIdx.x, wid = __builtin_amdgcn_readfirstlane(tid >> 6), lane = tid & 63, wr = wid >> 2, wc = wid & 3, fr = lane & 15, fq = lane >> 4;
    const int K = g.K, nt = K / BK;
    unsigned voffA[2], voffB[2];
#pragma unroll
    for (int i = 0; i < 2; ++i) { int R, C; stage_rc(tid * 16 + i * 8192, R, C); const int Rb = Epi::PERM ? ((R & ~31) + perm32(R & 31)) : R;
        voffA[i] = (unsigned)(R * K + C) * 2u; voffB[i] = (unsigned)(Rb * K + C) * 2u; }
    const size_t kstep = (size_t)(BK * 2);
    const size_t hstep = (size_t)HALF * K * 2;
    const size_t tstep = 2 * hstep;
    const unsigned ldsw = (unsigned)wid * 1024u;
    const int aoff = lds_byte(wr * 64 + fr, fq * 8), boff = lds_byte(wc * 32 + fr, fq * 8);
    int nslot = 0;
#define PG8_SA(b, h) (((b) * 2 + (h)) * HTB)
#define PG8_SB(b, h) ((4 + (b) * 2 + (h)) * HTB)
#define PG8_GLDS(gp, lp) __builtin_amdgcn_global_load_lds((const unsigned*)(gp), (LAS unsigned*)(lp), 16, 0, 0)
#define PG8_STAGE(bufoff, gbase, voff) do { _Pragma("unroll") for (int _i = 0; _i < 2; ++_i) PG8_GLDS((const char*)(gbase) + (voff)[_i], lds + (bufoff) + ldsw + _i * 8192); } while (0)
#define PG8_STAGE_A(bufoff, gptr, h, nx) do { if constexpr (GATHER) { const int _slot = (nx) ? nslot : ui; _Pragma("unroll") for (int _i = 0; _i < 2; ++_i) { int _R, _C; stage_rc(tid * 16 + _i * 8192, _R, _C); \
            const unsigned _vo = (unsigned)gidx[_slot * 256 + (h) * HALF + _R] + (unsigned)_C * 2u; PG8_GLDS((const char*)(gptr) + _vo, lds + (bufoff) + ldsw + _i * 8192); } } \
        else { PG8_STAGE(bufoff, (const char*)(gptr) + (h) * hstep, voffA); } } while (0)
#define PG8_LDA(dst, b, h) do { _Pragma("unroll") for (int m = 0; m < 4; ++m) _Pragma("unroll") for (int k = 0; k < 2; ++k) dst[m][k] = *(const LAS bf16x8*)(lds + PG8_SA(b, h) + aoff + m * 2048 + k * 1024); } while (0)
#define PG8_LDB(dst, b, h) do { _Pragma("unroll") for (int n = 0; n < 2; ++n) _Pragma("unroll") for (int k = 0; k < 2; ++k) dst[n][k] = *(const LAS bf16x8*)(lds + PG8_SB(b, h) + boff + n * 2048 + k * 1024); } while (0)
#define PG8_MMA(ai, bj, At, Bt) do { __builtin_amdgcn_s_setprio(1); _Pragma("unroll") for (int m = 0; m < 4; ++m) _Pragma("unroll") for (int n = 0; n < 2; ++n) _Pragma("unroll") for (int k = 0; k < 2; ++k) \
        acc[ai][bj][m][n] = __builtin_amdgcn_mfma_f32_16x16x32_bf16(Bt[n][k], At[m][k], acc[ai][bj][m][n], 0, 0, 0); __builtin_amdgcn_s_setprio(0); } while (0)
#define PG8_WAIT_V(n) asm volatile("s_waitcnt vmcnt(" #n ")" ::: "memory")
#define PG8_WAIT_L(n) asm volatile("s_waitcnt lgkmcnt(" #n ")" ::: "memory")
#define PG8_BAR __builtin_amdgcn_s_barrier()
#define PG8_SCHED __builtin_amdgcn_sched_barrier(0)
    Unit cur, nxt; int ui = 0;
    if (!S.next(0, cur)) return;
    f32x4 acc[2][2][4][2];
#pragma unroll
    for (int a = 0; a < 2; ++a)
#pragma unroll
        for (int b = 0; b < 2; ++b)
#pragma unroll
            for (int m = 0; m < 4; ++m)
#pragma unroll
                for (int n = 0; n < 2; ++n) acc[a][b][m][n] = (f32x4){0.f, 0.f, 0.f, 0.f};
    bf16x8 At[4][2], B0[2][2], B1[2][2];
    const char* cA = (const char*)g.A + (GATHER ? (size_t)0 : (size_t)cur.pm * tstep); const char* cB = (const char*)g.Bt + (size_t)cur.pn * tstep;
    PG8_STAGE(PG8_SB(0, 0), cB, voffB); PG8_STAGE(PG8_SB(0, 1), cB + hstep, voffB); PG8_STAGE_A(PG8_SA(0, 0), cA, 0, false); PG8_STAGE_A(PG8_SA(0, 1), cA, 1, false);
    if (wr == 1) PG8_BAR;
    PG8_WAIT_V(2); PG8_BAR;
    PG8_STAGE(PG8_SB(1, 0), cB + kstep, voffB); PG8_STAGE_A(PG8_SA(1, 0), cA + kstep, 0, false); PG8_STAGE(PG8_SB(1, 1), cB + hstep + kstep, voffB);
    PG8_WAIT_V(6); PG8_BAR;
    for (;;) {
        const bool has_next = S.next(ui + 1, nxt);
        const char* nA = has_next ? (const char*)g.A + (GATHER ? (size_t)0 : (size_t)nxt.pm * tstep) : cA; const char* nB = has_next ? (const char*)g.Bt + (size_t)nxt.pn * tstep : cB;
        if constexpr (GATHER) nslot = has_next ? ui + 1 : ui;
        for (int t = 0; t < nt; t += 2) {
            const bool last = (t == nt - 2);
            const char* a1 = cA + (size_t)(t + 1) * kstep;
            const char* a2 = last ? nA : cA + (size_t)(t + 2) * kstep; const char* b2 = last ? nB : cB + (size_t)(t + 2) * kstep;
            const char* a3 = a2 + kstep; const char* b3 = b2 + kstep;
            PG8_LDB(B0, 0, 0); PG8_LDB(B1, 0, 1); PG8_SCHED; PG8_LDA(At, 0, 0); PG8_STAGE_A(PG8_SA(1, 1), a1, 1, false);
            PG8_WAIT_V(8); PG8_WAIT_L(0); PG8_BAR; PG8_MMA(0, 0, At, B0); PG8_MMA(0, 1, At, B1); PG8_BAR; PG8_SCHED;
            PG8_LDA(At, 0, 1); PG8_STAGE(PG8_SB(0, 0), b2, voffB); PG8_STAGE(PG8_SB(0, 1), b2 + hstep, voffB); PG8_STAGE_A(PG8_SA(0, 0), a2, 0, last);
            PG8_WAIT_V(8); PG8_WAIT_L(0); PG8_BAR; PG8_MMA(1, 0, At, B0); PG8_MMA(1, 1, At, B1); PG8_BAR; PG8_SCHED;
            PG8_LDB(B0, 1, 0); PG8_LDB(B1, 1, 1); PG8_SCHED; PG8_LDA(At, 1, 0); PG8_STAGE_A(PG8_SA(0, 1), a2, 1, last);
            PG8_WAIT_V(8); PG8_WAIT_L(0); PG8_BAR; PG8_MMA(0, 0, At, B0); PG8_MMA(0, 1, At, B1); PG8_BAR; PG8_SCHED;
            PG8_LDA(At, 1, 1); PG8_STAGE(PG8_SB(1, 0), b3, voffB); PG8_STAGE(PG8_SB(1, 1), b3 + hstep, voffB); PG8_STAGE_A(PG8_SA(1, 0), a3, 0, last);
            PG8_WAIT_V(8); PG8_WAIT_L(0); PG8_BAR; PG8_MMA(1, 0, At, B0); PG8_MMA(1, 1, At, B1); PG8_BAR; PG8_SCHED;
        }
        if (wr == 0) PG8_BAR;
        E(acc, cur, wr, wc, fr, fq);
        if (!has_next) break;
#pragma unroll
        for (int a = 0; a < 2; ++a)
#pragma unroll
            for (int b = 0; b < 2; ++b)
#pragma unroll
                for (int m = 0; m < 4; ++m)
#pragma unroll
                    for (int n = 0; n < 2; ++n) acc[a][b][m][n] = (f32x4){0.f, 0.f, 0.f, 0.f};
        cur = nxt; cA = nA; cB = nB; ++ui;
        if (wr == 1) PG8_BAR;
    }
    PG8_WAIT_V(0);
    PG8_BAR;
#undef PG8_SA
#undef PG8_SB
#undef PG8_GLDS
#undef PG8_STAGE
#undef PG8_STAGE_A
#undef PG8_LDA
#undef PG8_LDB
#undef PG8_MMA
#undef PG8_WAIT_V
#undef PG8_WAIT_L
#undef PG8_BAR
#undef PG8_SCHED
}
}

struct Args { const float* in[23]; float* out; unsigned char* ws; float inv_freq[32]; int ph_lo, ph_hi; };
enum { I_X = 0, I_C, I_POS, I_WADA, I_BADA, I_NMIX, I_NFFN, I_WIN, I_RETN, I_HGRNN, I_LBL, I_WA2, I_BA, I_GLAN, I_WOUT, I_RGW, I_RGB, I_REW, I_REB, I_EG, I_EU, I_ED, I_NFIN };
constexpr int PH_PER_LAYER = 7, PH_FINAL = 1 + 2 * PH_PER_LAYER, N_PHASES = PH_FINAL + 1;

__device__ __forceinline__ void transpose_item(const float* W, int ldw, int K, int k0, int n0, bf16* WT, int dst_row0, LAS float* scr, int lane) {
#pragma unroll 8
    for (int i = 0; i < 32; ++i) { const int kk = 2 * i + (lane >> 5); scr[kk * 33 + (lane & 31)] = W[(size_t)(k0 + kk) * ldw + n0 + (lane & 31)]; }
    LDS_WAIT(); asm volatile("" ::: "memory");
    const int c = lane & 7;
#pragma unroll
    for (int j = 0; j < 4; ++j) { const int n = (lane >> 3) + 8 * j; const LAS float* s = scr + (8 * c) * 33 + n;
        u32x4 o; o.x = pk2(s[0 * 33], s[1 * 33]); o.y = pk2(s[2 * 33], s[3 * 33]); o.z = pk2(s[4 * 33], s[5 * 33]); o.w = pk2(s[6 * 33], s[7 * 33]);
        *(u32x4*)(WT + (size_t)(dst_row0 + n) * K + k0 + 8 * c) = o; }
    LDS_WAIT(); asm volatile("" ::: "memory");
}
__device__ __forceinline__ void sincos_acc(float a, float& s, float& c) {
    const double ad = (double)a; const double kd = rint(ad * 0.63661977236758134308); const double rd = fma(-kd, 1.57079632679489661923, ad);
    const int q = (int)kd & 3; const float r = (float)rd, r2 = r * r;
    const float sp = r + r * r2 * (-1.6666667163e-1f + r2 * (8.3333337680e-3f + r2 * (-1.9841270114e-4f + r2 * 2.7557314297e-6f)));
    const float cp = 1.0f + r2 * (-0.5f + r2 * (4.1666667908e-2f + r2 * (-1.3888889225e-3f + r2 * (2.4801587642e-5f + r2 * -2.7557314297e-7f))));
    const float ss = (q & 1) ? cp : sp, cc = (q & 1) ? sp : cp;
    s = (q & 2) ? -ss : ss; c = ((q + 1) & 2) ? -cc : cc;
}

typedef const __attribute__((address_space(4))) Args KArgs;
#define KARGS(ap) KArgs* ap = (KArgs*)__builtin_amdgcn_kernarg_segment_ptr(); asm volatile("" : "+s"(ap))
#define PHASE_IDS() int tid = threadIdx.x; asm volatile("" : "+v"(tid)); const int lane = tid & 63, wave = __builtin_amdgcn_readfirstlane(tid >> 6); \
    const int G = gridDim.x, bid = blockIdx.x, gw = bid * 8 + wave, NGW = G * 8; (void)lane; (void)wave; (void)gw; (void)NGW; (void)G; (void)bid

template <int TYPE>
__device__ __forceinline__ void naive_mixer_item(LAS unsigned char* lds, KArgs* ap, int layer, int b, int hh  , int tid) {
    constexpr int DK = (TYPE == 2) ? 32 : 64, DKW = DK / 8;
    LAS float* Qs = (LAS float*)lds; LAS float* Ks = Qs + 4096; LAS float* As = Ks + 4096; LAS float* Vs = As + 4096; LAS float* Os = Vs + 4096; LAS float* Ps = Os + 4096;
    unsigned char* ws = ap->ws;
    const bf16* PROJ = (const bf16*)(ws + WS_PROJ); bf16* H = (bf16*)(ws + WS_H);
    const f32x2* ROPE = (const f32x2*)(ws + WS_ROPE);
    const float* lbl = ap->in[I_LBL]; const float* gba = ap->in[I_BA];
    const int e = tid & 63, w = tid >> 6;
    const int qc = (TYPE == 0 ? C_RQ + hh * 64 : TYPE == 1 ? C_HQ + hh * 64 : C_GQ + hh * 32);
    const int kc = (TYPE == 0 ? C_RK + hh * 64 : TYPE == 1 ? C_HF + hh * 64 : C_GK + hh * 32);
    const int vc = (TYPE == 0 ? C_RV : TYPE == 1 ? C_HI : C_GV) + hh * 64;
    const int gc = (TYPE == 0 ? C_RG : TYPE == 1 ? C_HG : C_GG) + hh * 64;
    const int mc = (TYPE == 0 ? 0 : TYPE == 1 ? 384 : 768) + hh * 64;
    const float* gain = ap->in[TYPE == 0 ? I_RETN : TYPE == 1 ? I_HGRNN : I_GLAN] + layer * (TYPE == 2 ? 256 : 384) + hh * 64;
    float S[DKW];
#pragma unroll
    for (int i = 0; i < DKW; ++i) S[i] = 0.f;
    for (int n = 0; n < 64; ++n) {
        __syncthreads();
        const size_t row0 = (size_t)b * SEQ + (size_t)n * 64;
        for (int idx = tid; idx < 4096; idx += 512) {
            const int t = idx >> 6, d = idx & 63; const bf16* p = PROJ + (row0 + t) * NPROJ;
            Vs[idx] = bf2f(p[vc + d]);
            if (TYPE == 0) {
                const int j = d & 31; const f32x2 cs = ROPE[(row0 + t) * 32 + j];
                const float q1 = bf2f(p[qc + j]), q2 = bf2f(p[qc + 32 + j]), k1 = bf2f(p[kc + j]), k2 = bf2f(p[kc + 32 + j]);
                Qs[idx] = d < 32 ? q1 * cs.x - q2 * cs.y : q1 * cs.y + q2 * cs.x;
                Ks[idx] = (d < 32 ? k1 * cs.x - k2 * cs.y : k1 * cs.y + k2 * cs.x) * 0.125f;
                As[idx] = 1.0f - exp2f(-5.0f - (float)hh);
            } else if (TYPE == 1) {
                const float l0 = lbl[hh * 64 + d], l1 = lbl[384 + hh * 64 + d]; const float mx = fmaxf(l0, l1), e0 = expf(l0 - mx), e1 = expf(l1 - mx);
                const float lb = layer == 0 ? 0.f : e1 / (e0 + e1);
                const float z = bf2f(p[kc + d]); const float f = lb + (1.0f - lb) * sigmoidf_(z);
                As[idx] = fmaxf(f, 1e-30f); Ks[idx] = (1.0f - lb) * sigmoidf_(-z); Qs[idx] = siluf_(bf2f(p[qc + d])) * 0.125f;
            } else {
                if (d < 32) { const float pre = bf2f(p[C_GA + hh * 32 + d]) + gba[layer * 128 + hh * 32 + d];
                    const float ls = fminf(pre, 0.f) - log1pf(expf(-fabsf(pre)));
                    As[t * 64 + d] = expf(ls * (1.0f / 16.0f)); Ks[t * 64 + d] = bf2f(p[kc + d]); Qs[t * 64 + d] = bf2f(p[qc + d]) * 0.17677669529663687f; }
            }
        }
        __syncthreads();
        for (int t0 = 0; t0 < 64; t0 += 16) {
            for (int tt = 0; tt < 16; ++tt) { const int t = t0 + tt; const float v = Vs[t * 64 + e]; float part = 0.f;
#pragma unroll
                for (int i = 0; i < DKW; ++i) { const int d = w * DKW + i; S[i] = As[t * 64 + d] * S[i] + Ks[t * 64 + d] * v; part += Qs[t * 64 + d] * S[i]; }
                Ps[(tt * 8 + w) * 64 + e] = part; }
            __syncthreads();
            for (int idx = tid; idx < 1024; idx += 512) { const int tt = idx >> 6, ee = idx & 63; float o = 0.f;
#pragma unroll
                for (int ww = 0; ww < 8; ++ww) o += Ps[(tt * 8 + ww) * 64 + ee];
                Os[(t0 + tt) * 64 + ee] = o; }
            __syncthreads();
        }
        for (int tt = 0; tt < 8; ++tt) { const int t = w * 8 + tt; const float o = Os[t * 64 + e]; const float ss = wave_sum(o * o); const float r = rsqrtf(ss * (1.0f / 64.0f) + EPS);
            const float g = bf2f(PROJ[(row0 + t) * NPROJ + gc + e]);
            H[(row0 + t) * D + mc + e] = (bf16)f2bf(o * r * gain[e] * siluf_(g)); }
    }
}

__device__ __forceinline__ void build_tp(LAS int* TP, const unsigned* cnt, int tid) {
    if (tid == 0) { int s = 0; for (int e = 0; e < 32; ++e) { TP[e] = s; s += ((int)cnt[e] + 255) >> 8; } TP[32] = s; }
    __syncthreads();
}

__device__ __forceinline__ void phase_prologue(LAS unsigned char* lds) {
    KARGS(ap); PHASE_IDS();
    unsigned char* ws = ap->ws;
    if (bid < 192) {
        float* MOD = (float*)(ws + WS_MOD);
        const float* cin = ap->in[I_C]; const float* wada = ap->in[I_WADA]; const float* bada = ap->in[I_BADA];
        LAS float* cact = (LAS float*)lds;
        for (int i = tid; i < 8192; i += 512) { const int b = i >> 10, k = i & 1023; cact[k * 8 + b] = siluf_(cin[i]); }
        __syncthreads();
        LAS float* red = (LAS float*)(lds + 32768);
        for (int it = bid; it < 192; it += G) {
            const int l = it / 96, j0 = (it % 96) * 64; const float* W = wada + (size_t)l * D * 6144 + j0 + lane;
            float acc[8];
#pragma unroll
            for (int b = 0; b < 8; ++b) acc[b] = 0.f;
#pragma unroll 8
            for (int kk = 0; kk < 128; ++kk) { const int k = wave * 128 + kk; const float wv = W[(size_t)k * 6144];
                const f32x4 c0 = *(const LAS f32x4*)(cact + k * 8), c1 = *(const LAS f32x4*)(cact + k * 8 + 4);
                acc[0] += c0[0] * wv; acc[1] += c0[1] * wv; acc[2] += c0[2] * wv; acc[3] += c0[3] * wv; acc[4] += c1[0] * wv; acc[5] += c1[1] * wv; acc[6] += c1[2] * wv; acc[7] += c1[3] * wv; }
#pragma unroll
            for (int b = 0; b < 8; ++b) red[(wave * 8 + b) * 64 + lane] = acc[b];
            __syncthreads();
            { const int b = tid >> 6, col = tid & 63; float s = 0.f;
#pragma unroll
              for (int ww = 0; ww < 8; ++ww) s += red[(ww * 8 + b) * 64 + col];
              MOD[((size_t)l * 8 + b) * 6144 + j0 + col] = s + bada[l * 6144 + j0 + col]; }
            __syncthreads();
        }
    }
    __syncthreads();
    {
        bf16* WIN_T = (bf16*)(ws + WS_WIN); bf16* WOUT_T = (bf16*)(ws + WS_WOUT); bf16* WGU_T = (bf16*)(ws + WS_WGU); bf16* WD_T = (bf16*)(ws + WS_WD);
        LAS float* scr = (LAS float*)(lds + wave * 16384);
        constexpr int I_IN = 16 * 120, I_OUT = 16 * 32, I_G = 16 * 8, I_D = 4 * 32;
        constexpr int PER_L = I_IN + I_OUT + 32 * I_G * 2 + 32 * I_D;
        for (int it = gw; it < 2 * PER_L; it += NGW) {
            const int l = it / PER_L; int r = it % PER_L;
            if (r < I_IN) { const int kb = r / 120, nb = r % 120; transpose_item(ap->in[I_WIN] + (size_t)l * D * INP, INP, D, kb * 64, nb * 32, WIN_T + (size_t)l * NPROJ * D, nb * 32, scr, lane); continue; } r -= I_IN;
            if (r < I_OUT) { const int kb = r / 32, nb = r % 32; transpose_item(ap->in[I_WOUT] + (size_t)l * D * D, D, D, kb * 64, nb * 32, WOUT_T + (size_t)l * D * D, nb * 32, scr, lane); continue; } r -= I_OUT;
            if (r < 32 * I_G * 2) { const int up = r / (32 * I_G); r %= 32 * I_G; const int e = r / I_G; r %= I_G; const int kb = r / 8, nb = r % 8, n0 = nb * 32;
                transpose_item(ap->in[up ? I_EU : I_EG] + ((size_t)l * NEXP + e) * D * DEXP, DEXP, D, kb * 64, n0, WGU_T + ((size_t)l * NEXP + e) * 512 * D, (n0 >> 7) * 256 + (n0 & 127) + up * 128, scr, lane); continue; } r -= 32 * I_G * 2;
            { const int e = r / I_D; r %= I_D; const int kb = r / 32, nb = r % 32;
                transpose_item(ap->in[I_ED] + ((size_t)l * NEXP + e) * DEXP * D, D, DEXP, kb * 64, nb * 32, WD_T + ((size_t)l * NEXP + e) * D * DEXP, nb * 32, scr, lane); }
        }
        const float* win = ap->in[I_WIN]; const float* wa2 = ap->in[I_WA2];
        for (int it = bid * 512 + tid; it < 2 * 256 * 128; it += G * 512) {
            const int l = it / (256 * 128), r = it % (256 * 128), n = r / 128, k0 = (r % 128) * 8;
            float o[8];
#pragma unroll
            for (int j = 0; j < 8; ++j) o[j] = 0.f;
            if (n < 128) {
#pragma unroll
                for (int j = 0; j < 8; ++j) { const float* wr_ = win + (size_t)l * D * INP + (size_t)(k0 + j) * INP + 3840; float s = 0.f;
#pragma unroll
                    for (int rr = 0; rr < 16; ++rr) s += wr_[rr] * wa2[l * 16 * 128 + rr * 128 + n];
                    o[j] = s; } }
            u32x4 w; w.x = pk2(o[0], o[1]); w.y = pk2(o[2], o[3]); w.z = pk2(o[4], o[5]); w.w = pk2(o[6], o[7]);
            *(u32x4*)(WIN_T + (size_t)l * NPROJ * D + (size_t)(3840 + n) * D + k0) = w;
        }
    }
    {
        f32x2* ROPE = (f32x2*)(ws + WS_ROPE); const int* posp = (const int*)ap->in[I_POS];
        for (int it = bid * 512 + tid; it < MTOK * 32; it += G * 512) {
            const int row = it >> 5, j = it & 31; const int pos = posp[row];
            const float ang = (float)pos * ap->inv_freq[j]; float s, c; sincos_acc(ang, s, c); ROPE[it] = (f32x2){c, s};
        }
    }
}

template <int MODE>
__device__ __forceinline__ void phase_norm1(LAS unsigned char* lds, int layer) {
    KARGS(ap); PHASE_IDS();
    unsigned char* ws = ap->ws; float* outp = ap->out;
    const float* MOD = (const float*)(ws + WS_MOD); bf16* H = (bf16*)(ws + WS_H); const bf16* YP = (const bf16*)(ws + WS_YP);
    const int* ROUTE_I = (const int*)(ws + WS_ROUTE); const float* ROUTE_W = (const float*)(ws + WS_ROUTE + 4 * MTOK * 4);
    LAS int* TP = (LAS int*)(lds + TP_OFF);
    const int pl = (MODE == 2) ? DEPTH - 1 : layer - 1;
    if (MODE != 0) build_tp(TP, (const unsigned*)(ws + WS_CTL) + CW_CNT + pl * 64, tid);
    const float* xin = MODE == 0 ? ap->in[I_X] : outp;
    const float* gn = MODE == 2 ? ap->in[I_NFIN] : ap->in[I_NMIX] + layer * D;
    for (int m = gw; m < MTOK; m += NGW) {
        const int b = m >> 12;
        f32x4 v[4];
#pragma unroll
        for (int j = 0; j < 4; ++j) v[j] = *(const f32x4*)(xin + (size_t)m * D + 4 * lane + 256 * j);
        if (MODE != 0) {
            const int e0 = ROUTE_I[m], e1 = ROUTE_I[MTOK + m], r0 = ROUTE_I[2 * MTOK + m], r1 = ROUTE_I[3 * MTOK + m]; const float w0 = ROUTE_W[m], w1 = ROUTE_W[MTOK + m];
            const bf16* y0 = YP + (size_t)(TP[e0] * 256 + r0) * D; const bf16* y1 = YP + (size_t)(TP[e1] * 256 + r1) * D;
            const float* gf = MOD + (size_t)pl * 8 * 6144 + (size_t)b * 6144 + 5 * D;
#pragma unroll
            for (int j = 0; j < 4; ++j) { const u32x2 a0 = *(const u32x2*)(y0 + 4 * lane + 256 * j), a1 = *(const u32x2*)(y1 + 4 * lane + 256 * j); const f32x4 g4 = *(const f32x4*)(gf + 4 * lane + 256 * j);
                v[j][0] += g4[0] * (w0 * bflo(a0.x) + w1 * bflo(a1.x)); v[j][1] += g4[1] * (w0 * bfhi(a0.x) + w1 * bfhi(a1.x));
                v[j][2] += g4[2] * (w0 * bflo(a0.y) + w1 * bflo(a1.y)); v[j][3] += g4[3] * (w0 * bfhi(a0.y) + w1 * bfhi(a1.y));
                if (MODE == 1) *(f32x4*)(outp + (size_t)m * D + 4 * lane + 256 * j) = v[j]; }
        }
        float ss = 0.f;
#pragma unroll
        for (int j = 0; j < 4; ++j) ss += (v[j][0] * v[j][0] + v[j][1] * v[j][1]) + (v[j][2] * v[j][2] + v[j][3] * v[j][3]);
        const float rstd = rsqrtf(wave_sum(ss) * (1.0f / D) + EPS);
        if (MODE == 2) {
#pragma unroll
            for (int j = 0; j < 4; ++j) { const int c0 = 4 * lane + 256 * j; const f32x4 g4 = *(const f32x4*)(gn + c0);
                f32x4 y;
#pragma unroll
                for (int q = 0; q < 4; ++q) y[q] = v[j][q] * rstd * g4[q];
                *(f32x4*)(outp + (size_t)m * D + c0) = y; }
        } else {
            const float* mb = MOD + (size_t)layer * 8 * 6144 + (size_t)b * 6144;
#pragma unroll
            for (int j = 0; j < 4; ++j) { const int c0 = 4 * lane + 256 * j; const f32x4 g4 = *(const f32x4*)(gn + c0), sh = *(const f32x4*)(mb + c0), sc = *(const f32x4*)(mb + D + c0);
                f32x4 y;
#pragma unroll
                for (int q = 0; q < 4; ++q) y[q] = (v[j][q] * rstd * g4[q]) * (1.0f + sc[q]) + sh[q];
                u32x2 o; o.x = pk2(y[0], y[1]); o.y = pk2(y[2], y[3]); *(u32x2*)(H + (size_t)m * D + c0) = o; }
        }
    }
}

__device__ __forceinline__ void phase_inproj(LAS unsigned char* lds, int layer) {
    KARGS(ap); unsigned char* ws = ap->ws;
    pg8::Gemm g{(const bf16*)(ws + WS_H), (const bf16*)(ws + WS_WIN) + (size_t)layer * NPROJ * D, D}; pg8::StaticOrder S; S.init(MTOK, NPROJ, gridDim.x, blockIdx.x);
    pg8::EpiBf16Store E{(bf16*)(ws + WS_PROJ), NPROJ};
    pg8::gemm_phase<pg8::EpiBf16Store, pg8::StaticOrder, false>(lds, g, S, E, nullptr);
}
__device__ __forceinline__ void phase_mixer_naive(LAS unsigned char* lds, int layer) {
    KARGS(ap); PHASE_IDS();
    for (int it = bid; it < NB * 16; it += G) {
        const int b = it >> 4, hd = it & 15;
        if (hd < 6) naive_mixer_item<0>(lds, ap, layer, b, hd, tid);
        else if (hd < 12) naive_mixer_item<1>(lds, ap, layer, b, hd - 6, tid);
        else naive_mixer_item<2>(lds, ap, layer, b, hd - 12, tid);
        __syncthreads();
    }
}
__device__ __forceinline__ void phase_outproj(LAS unsigned char* lds, int layer) {
    KARGS(ap); unsigned char* ws = ap->ws; float* outp = ap->out;
    pg8::Gemm g{(const bf16*)(ws + WS_H), (const bf16*)(ws + WS_WOUT) + (size_t)layer * D * D, D}; pg8::StaticOrder S; S.init(MTOK, D, gridDim.x, blockIdx.x);
    pg8::EpiResGate E{layer == 0 ? ap->in[I_X] : outp, outp, (const float*)(ws + WS_MOD) + (size_t)layer * 8 * 6144 + 2 * D};
    pg8::gemm_phase<pg8::EpiResGate, pg8::StaticOrder, false>(lds, g, S, E, nullptr);
}
__device__ __forceinline__ void phase_norm2_router(LAS unsigned char* lds, int layer) {
    KARGS(ap); PHASE_IDS();
    unsigned char* ws = ap->ws; const float* xres = ap->out;
    bf16* H = (bf16*)(ws + WS_H);
    int* ROUTE_I = (int*)(ws + WS_ROUTE); float* ROUTE_W = (float*)(ws + WS_ROUTE + 4 * MTOK * 4); int* IDX2 = (int*)(ws + WS_IDX2);
    unsigned* cntl = (unsigned*)(ws + WS_CTL) + CW_CNT + layer * 64;
    LAS bf16* Wr = (LAS bf16*)lds;
    { const float* rgw = ap->in[I_RGW] + (size_t)layer * D * 4; const float* rew = ap->in[I_REW] + (size_t)layer * D * 32;
      for (int i = tid; i < 36 * 1024; i += 512) { const int n = i >> 10, k = i & 1023; const float wv = n < 4 ? rgw[k * 4 + n] : rew[k * 32 + (n - 4)]; Wr[i] = (bf16)f2bf(wv); } }
    __syncthreads();
    const float* gn = ap->in[I_NFFN] + layer * D; const float* rgb = ap->in[I_RGB] + layer * 4; const float* reb = ap->in[I_REB] + layer * 32;
    const float* modl = (const float*)(ws + WS_MOD) + (size_t)layer * 8 * 6144;
    for (int m = gw; m < MTOK; m += NGW) {
        const int b = m >> 12; const float* mb = modl + (size_t)b * 6144 + 3 * D;
        f32x4 v[4];
#pragma unroll
        for (int j = 0; j < 4; ++j) v[j] = *(const f32x4*)(xres + (size_t)m * D + 4 * lane + 256 * j);
        float ss = 0.f;
#pragma unroll
        for (int j = 0; j < 4; ++j) ss += (v[j][0] * v[j][0] + v[j][1] * v[j][1]) + (v[j][2] * v[j][2] + v[j][3] * v[j][3]);
        const float rstd = rsqrtf(wave_sum(ss) * (1.0f / D) + EPS);
#pragma unroll
        for (int j = 0; j < 4; ++j) { const int c0 = 4 * lane + 256 * j; const f32x4 g4 = *(const f32x4*)(gn + c0), sh = *(const f32x4*)(mb + c0), sc = *(const f32x4*)(mb + D + c0);
#pragma unroll
            for (int q = 0; q < 4; ++q) v[j][q] = (v[j][q] * rstd * g4[q]) * (1.0f + sc[q]) + sh[q];
            u32x2 o; o.x = pk2(v[j][0], v[j][1]); o.y = pk2(v[j][2], v[j][3]); *(u32x2*)(H + (size_t)m * D + c0) = o; }
        float lgv = 0.f;
#pragma unroll 2
        for (int n = 0; n < 36; ++n) { float p = 0.f;
#pragma unroll
            for (int j = 0; j < 4; ++j) { const u32x2 wv = *(const LAS u32x2*)(Wr + n * 1024 + 4 * lane + 256 * j);
                p += v[j][0] * bflo(wv.x) + v[j][1] * bfhi(wv.x) + v[j][2] * bflo(wv.y) + v[j][3] * bfhi(wv.y); }
            const float s = wave_sum(p); lgv = (lane == n) ? s : lgv; }
        float gl[4];
#pragma unroll
        for (int q = 0; q < 4; ++q) gl[q] = __shfl(lgv, q) + rgb[q];
        int gi = 0; float gm = gl[0];
#pragma unroll
        for (int q = 1; q < 4; ++q) if (gl[q] > gm) { gm = gl[q]; gi = q; }
        float gs = 0.f;
#pragma unroll
        for (int q = 0; q < 4; ++q) gs += __expf(gl[q] - gm);
        const float gwt = 1.0f / gs;
        float el[8];
#pragma unroll
        for (int q = 0; q < 8; ++q) el[q] = __shfl(lgv, 4 + gi * 8 + q) + reb[gi * 8 + q];
        int i0 = 0; float m0 = el[0];
#pragma unroll
        for (int q = 1; q < 8; ++q) if (el[q] > m0) { m0 = el[q]; i0 = q; }
        int i1 = -1; float m1 = -3.0e38f;
#pragma unroll
        for (int q = 0; q < 8; ++q) if (q != i0 && el[q] > m1) { m1 = el[q]; i1 = q; }
        const float ex = __expf(m1 - m0); const float w0 = gwt / (1.0f + ex), w1 = gwt * ex / (1.0f + ex);
        if (lane == 0) {
            const int e0 = gi * 8 + i0, e1 = gi * 8 + i1;
            const int r0 = (int)atomicAdd(cntl + e0, 1u), r1 = (int)atomicAdd(cntl + e1, 1u);
            IDX2[e0 * MTOK + r0] = m; IDX2[e1 * MTOK + r1] = m;
            ROUTE_I[m] = e0; ROUTE_I[MTOK + m] = e1; ROUTE_I[2 * MTOK + m] = r0; ROUTE_I[3 * MTOK + m] = r1; ROUTE_W[m] = w0; ROUTE_W[MTOK + m] = w1;
        }
    }
}
__device__ __forceinline__ void phase_moe_up(LAS unsigned char* lds, int layer) {
    KARGS(ap); unsigned char* ws = ap->ws;
    LAS int* TP = (LAS int*)(lds + TP_OFF); LAS int* AUX = (LAS int*)(lds + AUX_OFF);
    const unsigned* cntl = (const unsigned*)(ws + WS_CTL) + CW_CNT + layer * 64;
    { int tid = threadIdx.x; build_tp(TP, cntl, tid);
      pg8::MoeOrder S0; S0.G = gridDim.x; S0.c = blockIdx.x; S0.npt = 2; S0.total = TP[32] * 2; S0.tp = TP;
      const int* IDX2 = (const int*)(ws + WS_IDX2);
      pg8::Unit u; for (int i = 0; i < 8; ++i) { if (!S0.next(i, u)) break; const int e = u.pn >> 1, j = u.pm - TP[e], cnt = (int)cntl[e];
          if (tid < 256) { const int rank = j * 256 + tid; AUX[i * 256 + tid] = (rank < cnt ? IDX2[e * MTOK + rank] : 0) * (D * 2); } }
      __syncthreads(); }
    pg8::MoeOrder S; S.G = gridDim.x; S.c = blockIdx.x; S.npt = 2; S.total = TP[32] * 2; S.tp = TP;
    pg8::Gemm g{(const bf16*)(ws + WS_H), (const bf16*)(ws + WS_WGU) + (size_t)layer * NEXP * 512 * D, D};
    pg8::EpiSwiGLU E{(bf16*)(ws + WS_HID)};
    pg8::gemm_phase<pg8::EpiSwiGLU, pg8::MoeOrder, true>(lds, g, S, E, AUX);
}
__device__ __forceinline__ void phase_moe_down(LAS unsigned char* lds, int layer) {
    KARGS(ap); unsigned char* ws = ap->ws;
    LAS int* TP = (LAS int*)(lds + TP_OFF);
    build_tp(TP, (const unsigned*)(ws + WS_CTL) + CW_CNT + layer * 64, threadIdx.x);
    pg8::MoeOrder S; S.G = gridDim.x; S.c = blockIdx.x; S.npt = 4; S.total = TP[32] * 4; S.tp = TP;
    pg8::Gemm g{(const bf16*)(ws + WS_HID), (const bf16*)(ws + WS_WD) + (size_t)layer * NEXP * D * DEXP, DEXP};
    pg8::EpiBf16Store E{(bf16*)(ws + WS_YP), D};
    pg8::gemm_phase<pg8::EpiBf16Store, pg8::MoeOrder, false>(lds, g, S, E, nullptr);
}

__global__ void __launch_bounds__(512, 2) fwd(Args a) {
    extern __shared__ __attribute__((aligned(16))) unsigned char lds_raw[];
    LAS unsigned char* lds = (LAS unsigned char*)lds_raw;
    volatile LAS unsigned* MISC = (volatile LAS unsigned*)(lds + LDSCTL_OFF);
    for (int u = threadIdx.x; u < (LDS_BYTES - LDSCTL_OFF) / 4; u += 512) ((LAS unsigned*)(lds + LDSCTL_OFF))[u] = 0u;
    __syncthreads();
    unsigned* ctl = (unsigned*)(a.ws + WS_CTL);
    XcdBarrier bar; bar.bar = ctl + CW_BAR; bar.x = 0; bar.st = nullptr;
    if (MK_ONE_LAUNCH) bar = xcd_barrier_post(ctl + CW_BAR, MISC + 8);
    const int lo = a.ph_lo, hi = a.ph_hi;
#define IN(k) (lo <= (k) && (k) < hi)
#define SEAM(k) do { if (MK_ONE_LAUNCH) { if ((k) + 1 < hi) xcd_barrier(bar); } } while (0)
    if (EN_P0 && IN(0)) { phase_prologue(lds); SEAM(0); }
    for (int layer = 0; layer < DEPTH; ++layer) {
        const int pb = 1 + PH_PER_LAYER * layer;
        if (EN_PA && IN(pb + 0)) { if (layer == 0) phase_norm1<0>(lds, layer); else phase_norm1<1>(lds, layer); SEAM(pb + 0); }
        if (EN_PB && IN(pb + 1)) { phase_inproj(lds, layer); SEAM(pb + 1); }
        if (EN_PC && IN(pb + 2)) { phase_mixer_naive(lds, layer); SEAM(pb + 2); }
        if (EN_PD && IN(pb + 3)) { phase_outproj(lds, layer); SEAM(pb + 3); }
        if (EN_PE && IN(pb + 4)) { phase_norm2_router(lds, layer); SEAM(pb + 4); }
        if (EN_PG && IN(pb + 5)) { phase_moe_up(lds, layer); SEAM(pb + 5); }
        if (EN_PH && IN(pb + 6)) { phase_moe_down(lds, layer); SEAM(pb + 6); }
    }
    if (EN_PF && IN(PH_FINAL)) phase_norm1<2>(lds, 0);
#undef IN
#undef SEAM
}

extern "C" void kernel_launch(void* const* d_in, const int* in_sizes, int n_in, void* d_out, int out_size, void* d_ws, size_t ws_size, hipStream_t stream) {
    static int grid = 0;
    if (grid == 0) {
        if (n_in != 23 || out_size != MTOK * D || ws_size < WS_END) { fprintf(stderr, "kernel_launch: unexpected shapes (n_in %d out %d ws %zu)\n", n_in, out_size, ws_size); grid = -1; return; }
        int dev = 0, cus = 0;
        if (hipGetDevice(&dev) != hipSuccess || hipDeviceGetAttribute(&cus, hipDeviceAttributeMultiprocessorCount, dev) != hipSuccess) { grid = -1; return; }
        if (hipFuncSetAttribute((const void*)fwd, hipFuncAttributeMaxDynamicSharedMemorySize, LDS_BYTES) != hipSuccess) { fprintf(stderr, "kernel_launch: hipFuncSetAttribute failed\n"); grid = -1; return; }
        int per_cu = 0;
        if (hipOccupancyMaxActiveBlocksPerMultiprocessor(&per_cu, (const void*)fwd, 512, LDS_BYTES) != hipSuccess || per_cu < 1) fprintf(stderr, "kernel_launch: occupancy query reports %d\n", per_cu);
        (void)hipGetLastError();
        grid = cus;
    }
    if (grid < 0) return;
    (void)hipMemsetAsync((char*)d_ws + WS_CTL, 0, CTL_ZERO_BYTES, stream);
    Args a{};
    for (int i = 0; i < 23; ++i) a.in[i] = (const float*)d_in[i];
    a.out = (float*)d_out; a.ws = (unsigned char*)d_ws;
    for (int j = 0; j < 32; ++j) a.inv_freq[j] = (float)std::pow(10000.0, -(double)j / 32.0);
#if MK_ONE_LAUNCH
    a.ph_lo = 0; a.ph_hi = N_PHASES;
    hipLaunchKernelGGL(fwd, dim3(grid), dim3(512), LDS_BYTES, stream, a);
#else
    for (int p = 0; p < N_PHASES; ++p) { a.ph_lo = p; a.ph_hi = p + 1; hipLaunchKernelGGL(fwd, dim3(grid), dim3(512), LDS_BYTES, stream, a); }
#endif
}
```

```cpp
#include <hip/hip_runtime.h>
#include <cstdio>
#include <cstdint>
#include <cmath>

#define GAS __attribute__((address_space(1)))
#define LAS __attribute__((address_space(3)))
typedef unsigned short bf16;
typedef short bf16x8 __attribute__((ext_vector_type(8)));
typedef float f32x4 __attribute__((ext_vector_type(4)));
typedef float f32x2 __attribute__((ext_vector_type(2)));
typedef unsigned u32x4 __attribute__((ext_vector_type(4)));
typedef unsigned u32x2 __attribute__((ext_vector_type(2)));

#ifndef EN_P0
#define EN_P0 1
#endif
#ifndef EN_PA
#define EN_PA 1
#endif
#ifndef EN_PB
#define EN_PB 1
#endif
#ifndef EN_PC
#define EN_PC 1
#endif
#ifndef EN_PD
#define EN_PD 1
#endif
#ifndef EN_PE
#define EN_PE 1
#endif
#ifndef EN_PG
#define EN_PG 1
#endif
#ifndef EN_PH
#define EN_PH 1
#endif
#ifndef EN_PF
#define EN_PF 1
#endif
#ifndef MK_ONE_LAUNCH
#define MK_ONE_LAUNCH 1
#endif

constexpr int NB = 8, SEQ = 4096, MTOK = NB * SEQ, D = 1024, DEPTH = 2;
constexpr int NPROJ = 4096;
constexpr int INP = 3856;
constexpr int C_RQ = 0, C_RK = 384, C_RV = 768, C_RG = 1152, C_HQ = 1536, C_HF = 1920, C_HI = 2304, C_HG = 2688, C_GQ = 3072, C_GK = 3200, C_GV = 3328, C_GG = 3584, C_GA = 3840;
constexpr int NEXP = 32, DEXP = 256;
constexpr int MAXROWS = 73728;
constexpr float EPS = 1e-6f;

constexpr size_t MiB = 1u << 20;
constexpr size_t WS_CTL = 0, CTL_ZERO_BYTES = 1 * MiB;
constexpr size_t WS_MOD = 1 * MiB;
constexpr size_t WS_ROPE = 2 * MiB;
constexpr size_t WS_WIN = 10 * MiB;
constexpr size_t WS_WOUT = 26 * MiB;
constexpr size_t WS_WGU = 30 * MiB;
constexpr size_t WS_WD = 94 * MiB;
constexpr size_t WS_H = 126 * MiB;
constexpr size_t WS_PROJ = 190 * MiB;
constexpr size_t WS_HID = 190 * MiB;
constexpr size_t WS_YP = 226 * MiB;
constexpr size_t WS_STATE = 446 * MiB;
constexpr size_t WS_ROUTE = 474 * MiB;
constexpr size_t WS_IDX2 = 476 * MiB;
constexpr size_t WS_END = 480 * MiB;
constexpr int CW_CNT = 64;
constexpr int CW_BAR = 4096;

constexpr int RING_BYTES = 131072;
constexpr int LDSCTL_OFF = RING_BYTES;
constexpr int TP_OFF = RING_BYTES + 512;
constexpr int AUX_OFF = RING_BYTES + 1024;
constexpr int LDS_BYTES = 147456;

#define RLX_AGENT __ATOMIC_RELAXED, __HIP_MEMORY_SCOPE_AGENT
#define LDS_WAIT() asm volatile("s_waitcnt lgkmcnt(0)" ::: "memory")
#define VM_WAIT() asm volatile("s_waitcnt vmcnt(0)" ::: "memory")

__device__ __forceinline__ unsigned f2bf(float f) { unsigned u = __builtin_bit_cast(unsigned, f); return (u + 0x7fffu + ((u >> 16) & 1u)) >> 16; }
__device__ __forceinline__ unsigned pk2(float lo, float hi) { return f2bf(lo) | (f2bf(hi) << 16); }
__device__ __forceinline__ float bf2f(unsigned short b) { return __builtin_bit_cast(float, ((unsigned)b) << 16); }
__device__ __forceinline__ float bflo(unsigned w) { return __builtin_bit_cast(float, w << 16); }
__device__ __forceinline__ float bfhi(unsigned w) { return __builtin_bit_cast(float, w & 0xffff0000u); }
__device__ __forceinline__ float sigmoidf_(float x) { return 1.0f / (1.0f + __expf(-x)); }
__device__ __forceinline__ float siluf_(float x) { return x / (1.0f + __expf(-x)); }
__device__ __forceinline__ float wave_sum(float v) {
#pragma unroll
    for (int o = 1; o < 64; o <<= 1) v += __shfl_xor(v, o);
    return v;
}

#define XB_TMO      128
#define XB_XCNT(j)  (256  + 64 * (j))
#define XB_XSUB(j)  (1280 + 64 * (j))
#define XB_XGEN(j)  (2304 + 64 * (j))
#define XB_TOP      3328
#define XB_TOPGEN   3392
#define XCD_BAR_WORDS 3456
#define XB_SPIN_CAP (1u << 18)
__device__ __forceinline__ unsigned xb_ld(unsigned* p)              { return __hip_atomic_load(p, __ATOMIC_RELAXED, __HIP_MEMORY_SCOPE_AGENT); }
__device__ __forceinline__ unsigned xb_add(unsigned* p, unsigned v) { return __hip_atomic_fetch_add(p, v, __ATOMIC_RELAXED, __HIP_MEMORY_SCOPE_AGENT); }
__device__ __forceinline__ unsigned xb_xcc_id() { return (unsigned)__builtin_amdgcn_s_getreg((3 << 11) | 20) & 0xFu; }
#define XB_SPIN(cond, bar) do { unsigned _sp = 0; while (cond) { __builtin_amdgcn_s_sleep(1); \
    if ((++_sp & 255u) == 0u) { if (xb_ld(&(bar)[XB_TMO])) break; if (_sp > XB_SPIN_CAP) { atomicAdd(&(bar)[XB_TMO], 1u); break; } } } } while (0)
struct XcdBarrier { unsigned* bar; unsigned x; volatile LAS unsigned* st; };
__device__ __forceinline__ XcdBarrier xcd_barrier_post(unsigned* bar, volatile LAS unsigned* st) {
    XcdBarrier b; b.bar = bar; b.x = xb_xcc_id(); b.st = st;
    if (threadIdx.x == 0) (void)xb_add(&bar[XB_XCNT(b.x)], 1u);
    return b;
}
__device__ __forceinline__ void xcd_barrier_complete(unsigned* bar, unsigned x, unsigned& nloc, unsigned& nx) {
    const unsigned G = gridDim.x * gridDim.y * gridDim.z;
    unsigned sum, cnt, mine, sp = 0u;
    for (;;) {
        sum = 0u; cnt = 0u; mine = 0u;
#pragma unroll
        for (unsigned j = 0; j < 16; ++j) { const unsigned c = xb_ld(&bar[XB_XCNT(j)]); sum += c; cnt += (c > 0u) ? 1u : 0u; mine = (j == x) ? c : mine; }
        if (sum == G) break;
        __builtin_amdgcn_s_sleep(1);
        if ((++sp & 255u) == 0u) { if (xb_ld(&bar[XB_TMO])) break; if (sp > XB_SPIN_CAP) { atomicAdd(&bar[XB_TMO], 1u); break; } }
    }
    nloc = mine > 0u ? mine : 1u; nx = cnt > 0u ? cnt : 1u;
}
__device__ __forceinline__ void xcd_barrier(const XcdBarrier& b) {
    asm volatile("s_waitcnt vmcnt(0)" ::: "memory");
    __syncthreads();
    if (threadIdx.x == 0) {
        unsigned* bar = b.bar;
        __builtin_amdgcn_s_waitcnt(0);
        unsigned nloc = b.st[0], nx = b.st[1];
        if (nloc == 0u) { xcd_barrier_complete(bar, b.x, nloc, nx); b.st[0] = nloc; b.st[1] = nx; }
        const unsigned old = xb_add(&bar[XB_XSUB(b.x)], 1u);
        const unsigned gen = old / nloc;
        if (old + 1u == (gen + 1u) * nloc) {
            __builtin_amdgcn_fence(__ATOMIC_RELEASE, "agent");
            asm volatile("s_waitcnt vmcnt(0)" ::: "memory");
            const unsigned og = xb_add(&bar[XB_TOP], 1u);
            const unsigned tg = og / nx;
            if (og + 1u == (tg + 1u) * nx) xb_add(&bar[XB_TOPGEN], 1u);
            else XB_SPIN(xb_ld(&bar[XB_TOPGEN]) == tg, bar);
            __builtin_amdgcn_fence(__ATOMIC_ACQUIRE, "agent");
            xb_add(&bar[XB_XGEN(b.x)], 1u);
            asm volatile("s_waitcnt vmcnt(0)" ::: "memory");
        } else {
            XB_SPIN(xb_ld(&bar[XB_XGEN(b.x)]) == gen, bar);
            __builtin_amdgcn_fence(__ATOMIC_ACQUIRE, "agent");
            asm volatile("s_waitcnt vmcnt(0)" ::: "memory");
        }
    }
    __syncthreads();
}

namespace pg8 {
constexpr int BM = 256, BK = 64, HALF = 128, HTB = HALF * BK * 2, STAGE_BYTES = 8 * HTB, NXCD = 8, WGM = 8;
__host__ __device__ __forceinline__ int lds_byte(int r, int c) { const int st = (r >> 4) * 2 + (c >> 5), rr = r & 15, cc = c & 31, ob = rr * 64 + cc * 2; return st * 1024 + (ob ^ (((ob >> 9) & 1) << 5)); }
__host__ __device__ __forceinline__ void stage_rc(int b, int& R, int& C) { const int st = b / 1024, sb = b % 1024, swz = sb ^ (((sb >> 9) & 1) << 5); R = (st >> 1) * 16 + swz / 64; C = (st & 1) * 32 + (swz % 64) / 2; }
__host__ __device__ __forceinline__ int perm32(int rho) { const int n = rho >> 4, i = rho & 15; return 8 * (i >> 2) + 4 * n + (i & 3); }
struct Unit { int pm, pn, pc; };
struct Gemm { const bf16* A; const bf16* Bt; int K; };

struct StaticOrder {
    int nM, nN, nwg, G, c;
    __device__ void init(int M, int N, int G_, int c_) { nM = M / BM; nN = N / BM; nwg = nM * nN; G = G_; c = c_; }
    __device__ bool next(int i, Unit& u) const {
        const long L = (long)i * G + c; if (L >= nwg) return false;
        int wgid = (int)L; { const int q = nwg / NXCD, r = nwg % NXCD, xcd = wgid % NXCD, off = wgid / NXCD; wgid = (xcd < r ? xcd * (q + 1) : r * (q + 1) + (xcd - r) * q) + off; }
        const int nig = WGM * nN, gid = wgid / nig, fm = gid * WGM, gsz = (nM - fm) < WGM ? (nM - fm) : WGM;
        u.pm = fm + ((wgid % nig) % gsz); u.pn = (wgid % nig) / gsz; u.pc = u.pn; return true;
    }
};
struct MoeOrder {
    int G, c, npt, total; const LAS int* tp;
    __device__ bool next(int i, Unit& u) const {
        const int L = i * G + c; if (L >= total) return false;
        const int mt = L / npt, nl = L % npt; int e = 0;
        while (e < 31 && tp[e + 1] <= mt) ++e;
        u.pm = mt; u.pn = e * npt + nl; u.pc = nl; return true;
    }
};

__device__ __forceinline__ unsigned cvt_pk_bf16(float lo, float hi) { unsigned r; asm volatile("v_cvt_pk_bf16_f32 %0, %1, %2" : "=v"(r) : "v"(lo), "v"(hi)); return r; }

struct EpiBf16Store {
    static constexpr bool PERM = true;
    bf16* O; int ldc;
    __device__ __forceinline__ void operator()(const f32x4 (&acc)[2][2][4][2], const Unit& u, int wr, int wc, int fr, int fq) const {
        const int row0 = u.pm * BM + wr * 64 + fr, col0 = u.pc * BM + wc * 32 + 8 * fq;
#pragma unroll
        for (int ai = 0; ai < 2; ++ai)
#pragma unroll
            for (int m = 0; m < 4; ++m) { bf16* rowp = O + (size_t)(row0 + ai * HALF + m * 16) * ldc + col0;
#pragma unroll
                for (int bj = 0; bj < 2; ++bj) { const f32x4 v0 = acc[ai][bj][m][0], v1 = acc[ai][bj][m][1];
                    u32x4 w; w.x = cvt_pk_bf16(v0[0], v0[1]); w.y = cvt_pk_bf16(v0[2], v0[3]); w.z = cvt_pk_bf16(v1[0], v1[1]); w.w = cvt_pk_bf16(v1[2], v1[3]);
                    *(u32x4*)(rowp + bj * HALF) = w; } }
    }
};
struct EpiSwiGLU {
    static constexpr bool PERM = true;
    bf16* O;
    __device__ __forceinline__ void operator()(const f32x4 (&acc)[2][2][4][2], const Unit& u, int wr, int wc, int fr, int fq) const {
        const int row0 = u.pm * BM + wr * 64 + fr, col0 = u.pc * HALF + wc * 32 + 8 * fq;
#pragma unroll
        for (int ai = 0; ai < 2; ++ai)
#pragma unroll
            for (int m = 0; m < 4; ++m) { bf16* rowp = O + (size_t)(row0 + ai * HALF + m * 16) * DEXP + col0;
                float h[8];
#pragma unroll
                for (int n = 0; n < 2; ++n)
#pragma unroll
                    for (int j = 0; j < 4; ++j) { const float g = acc[ai][0][m][n][j], up = acc[ai][1][m][n][j]; h[n * 4 + j] = g / (1.0f + __expf(-g)) * up; }
                u32x4 w; w.x = cvt_pk_bf16(h[0], h[1]); w.y = cvt_pk_bf16(h[2], h[3]); w.z = cvt_pk_bf16(h[4], h[5]); w.w = cvt_pk_bf16(h[6], h[7]);
                *(u32x4*)rowp = w; }
    }
};
struct EpiResGate {
    static constexpr bool PERM = false;
    const float* res; float* out; const float* gate;
    __device__ __forceinline__ void operator()(const f32x4 (&acc)[2][2][4][2], const Unit& u, int wr, int wc, int fr, int fq) const {
        const int row0 = u.pm * BM + wr * 64 + fr, col0 = u.pc * BM + wc * 32 + 4 * fq;
        const float* gb = gate + (size_t)(u.pm >> 4) * 6144;
        f32x4 gv[2][2];
#pragma unroll
        for (int bj = 0; bj < 2; ++bj)
#pragma unroll
            for (int n = 0; n < 2; ++n) gv[bj][n] = *(const f32x4*)(gb + col0 + bj * HALF + n * 16);
#pragma unroll
        for (int ai = 0; ai < 2; ++ai)
#pragma unroll
            for (int m = 0; m < 4; ++m) { const size_t off = (size_t)(row0 + ai * HALF + m * 16) * D + col0;
#pragma unroll
                for (int bj = 0; bj < 2; ++bj)
#pragma unroll
                    for (int n = 0; n < 2; ++n) { const f32x4 r = *(const f32x4*)(res + off + bj * HALF + n * 16); *(f32x4*)(out + off + bj * HALF + n * 16) = r + gv[bj][n] * acc[ai][bj][m][n]; } }
    }
};

template <class Epi, class Sched, bool GATHER>
__device__ __forceinline__ void gemm_phase(LAS unsigned char* lds, const Gemm g, const Sched& S, const Epi& E, const LAS int* gidx) {
    const int tid = threadIdx.x, wid = __builtin_amdgcn_readfirstlane(tid >> 6), lane = tid & 63, wr = wid >> 2, wc = wid & 3, fr = lane & 15, fq = lane >> 4;
    const int K = g.K, nt = K / BK;
    unsigned voffA[2], voffB[2];
#pragma unroll
    for (int i = 0; i < 2; ++i) { int R, C; stage_rc(tid * 16 + i * 8192, R, C); const int Rb = Epi::PERM ? ((R & ~31) + perm32(R & 31)) : R;
        voffA[i] = (unsigned)(R * K + C) * 2u; voffB[i] = (unsigned)(Rb * K + C) * 2u; }
    const size_t kstep = (size_t)(BK * 2);
    const size_t hstep = (size_t)HALF * K * 2;
    const size_t tstep = 2 * hstep;
    const unsigned ldsw = (unsigned)wid * 1024u;
    const int aoff = lds_byte(wr * 64 + fr, fq * 8), boff = lds_byte(wc * 32 + fr, fq * 8);
    int nslot = 0;
#define PG8_SA(b, h) (((b) * 2 + (h)) * HTB)
#define PG8_SB(b, h) ((4 + (b) * 2 + (h)) * HTB)
#define PG8_GLDS(gp, lp) __builtin_amdgcn_global_load_lds((const unsigned*)(gp), (LAS unsigned*)(lp), 16, 0, 0)
#define PG8_STAGE(bufoff, gbase, voff) do { _Pragma("unroll") for (int _i = 0; _i < 2; ++_i) PG8_GLDS((const char*)(gbase) + (voff)[_i], lds + (bufoff) + ldsw + _i * 8192); } while (0)
#define PG8_STAGE_A(bufoff, gptr, h, nx) do { if constexpr (GATHER) { const int _slot = (nx) ? nslot : ui; _Pragma("unroll") for (int _i = 0; _i < 2; ++_i) { int _R, _C; stage_rc(tid * 16 + _i * 8192, _R, _C); \
            const unsigned _vo = (unsigned)gidx[_slot * 256 + (h) * HALF + _R] + (unsigned)_C * 2u; PG8_GLDS((const char*)(gptr) + _vo, lds + (bufoff) + ldsw + _i * 8192); } } \
        else { PG8_STAGE(bufoff, (const char*)(gptr) + (h) * hstep, voffA); } } while (0)
#define PG8_LDA(dst, b, h) do { _Pragma("unroll") for (int m = 0; m < 4; ++m) _Pragma("unroll") for (int k = 0; k < 2; ++k) dst[m][k] = *(const LAS bf16x8*)(lds + PG8_SA(b, h) + aoff + m * 2048 + k * 1024); } while (0)
#define PG8_LDB(dst, b, h) do { _Pragma("unroll") for (int n = 0; n < 2; ++n) _Pragma("unroll") for (int k = 0; k < 2; ++k) dst[n][k] = *(const LAS bf16x8*)(lds + PG8_SB(b, h) + boff + n * 2048 + k * 1024); } while (0)
#define PG8_MMA(ai, bj, At, Bt) do { __builtin_amdgcn_s_setprio(1); _Pragma("unroll") for (int m = 0; m < 4; ++m) _Pragma("unroll") for (int n = 0; n < 2; ++n) _Pragma("unroll") for (int k = 0; k < 2; ++k) \
        acc[ai][bj][m][n] = __builtin_amdgcn_mfma_f32_16x16x32_bf16(Bt[n][k], At[m][k], acc[ai][bj][m][n], 0, 0, 0); __builtin_amdgcn_s_setprio(0); } while (0)
#define PG8_WAIT_V(n) asm volatile("s_waitcnt vmcnt(" #n ")" ::: "memory")
#define PG8_WAIT_L(n) asm volatile("s_waitcnt lgkmcnt(" #n ")" ::: "memory")
#define PG8_BAR __builtin_amdgcn_s_barrier()
#define PG8_SCHED __builtin_amdgcn_sched_barrier(0)
    Unit cur, nxt; int ui = 0;
    if (!S.next(0, cur)) return;
    f32x4 acc[2][2][4][2];
#pragma unroll
    for (int a = 0; a < 2; ++a)
#pragma unroll
        for (int b = 0; b < 2; ++b)
#pragma unroll
            for (int m = 0; m < 4; ++m)
#pragma unroll
                for (int n = 0; n < 2; ++n) acc[a][b][m][n] = (f32x4){0.f, 0.f, 0.f, 0.f};
    bf16x8 At[4][2], B0[2][2], B1[2][2];
    const char* cA = (const char*)g.A + (GATHER ? (size_t)0 : (size_t)cur.pm * tstep); const char* cB = (const char*)g.Bt + (size_t)cur.pn * tstep;
    PG8_STAGE(PG8_SB(0, 0), cB, voffB); PG8_STAGE(PG8_SB(0, 1), cB + hstep, voffB); PG8_STAGE_A(PG8_SA(0, 0), cA, 0, false); PG8_STAGE_A(PG8_SA(0, 1), cA, 1, false);
    if (wr == 1) PG8_BAR;
    PG8_WAIT_V(2); PG8_BAR;
    PG8_STAGE(PG8_SB(1, 0), cB + kstep, voffB); PG8_STAGE_A(PG8_SA(1, 0), cA + kstep, 0, false); PG8_STAGE(PG8_SB(1, 1), cB + hstep + kstep, voffB);
    PG8_WAIT_V(6); PG8_BAR;
    for (;;) {
        const bool has_next = S.next(ui + 1, nxt);
        const char* nA = has_next ? (const char*)g.A + (GATHER ? (size_t)0 : (size_t)nxt.pm * tstep) : cA; const char* nB = has_next ? (const char*)g.Bt + (size_t)nxt.pn * tstep : cB;
        if constexpr (GATHER) nslot = has_next ? ui + 1 : ui;
        for (int t = 0; t < nt; t += 2) {
            const bool last = (t == nt - 2);
            const char* a1 = cA + (size_t)(t + 1) * kstep;
            const char* a2 = last ? nA : cA + (size_t)(t + 2) * kstep; const char* b2 = last ? nB : cB + (size_t)(t + 2) * kstep;
            const char* a3 = a2 + kstep; const char* b3 = b2 + kstep;
            PG8_LDB(B0, 0, 0); PG8_LDB(B1, 0, 1); PG8_SCHED; PG8_LDA(At, 0, 0); PG8_STAGE_A(PG8_SA(1, 1), a1, 1, false);
            PG8_WAIT_V(8); PG8_WAIT_L(0); PG8_BAR; PG8_MMA(0, 0, At, B0); PG8_MMA(0, 1, At, B1); PG8_BAR; PG8_SCHED;
            PG8_LDA(At, 0, 1); PG8_STAGE(PG8_SB(0, 0), b2, voffB); PG8_STAGE(PG8_SB(0, 1), b2 + hstep, voffB); PG8_STAGE_A(PG8_SA(0, 0), a2, 0, last);
            PG8_WAIT_V(8); PG8_WAIT_L(0); PG8_BAR; PG8_MMA(1, 0, At, B0); PG8_MMA(1, 1, At, B1); PG8_BAR; PG8_SCHED;
            PG8_LDB(B0, 1, 0); PG8_LDB(B1, 1, 1); PG8_SCHED; PG8_LDA(At, 1, 0); PG8_STAGE_A(PG8_SA(0, 1), a2, 1, last);
            PG8_WAIT_V(8); PG8_WAIT_L(0); PG8_BAR; PG8_MMA(0, 0, At, B0); PG8_MMA(0, 1, At, B1); PG8_BAR; PG8_SCHED;
            PG8_LDA(At, 1, 1); PG8_STAGE(PG8_SB(1, 0), b3, voffB); PG8_STAGE(PG8_SB(1, 1), b3 + hstep, voffB); PG8_STAGE_A(PG8_SA(1, 0), a3, 0, last);
            PG8_WAIT_V(8); PG8_WAIT_L(0); PG8_BAR; PG8_MMA(1, 0, At, B0); PG8_MMA(1, 1, At, B1); PG8_BAR; PG8_SCHED;
        }
        if (wr == 0) PG8_BAR;
        E(acc, cur, wr, wc, fr, fq);
        if (!has_next) break;
#pragma unroll
        for (int a = 0; a < 2; ++a)
#pragma unroll
            for (int b = 0; b < 2; ++b)
#pragma unroll
                for (int m = 0; m < 4; ++m)
#pragma unroll
                    for (int n = 0; n < 2; ++n) acc[a][b][m][n] = (f32x4){0.f, 0.f, 0.f, 0.f};
        cur = nxt; cA = nA; cB = nB; ++ui;
        if (wr == 1) PG8_BAR;
    }
    PG8_WAIT_V(0);
    PG8_BAR;
#undef PG8_SA
#undef PG8_SB
#undef PG8_GLDS
#undef PG8_STAGE
#undef PG8_STAGE_A
#undef PG8_LDA
#undef PG8_LDB
#undef PG8_MMA
#undef PG8_WAIT_V
#undef PG8_WAIT_L
#undef PG8_BAR
#undef PG8_SCHED
}
}

struct Args { const float* in[23]; float* out; unsigned char* ws; float inv_freq[32]; int ph_lo, ph_hi; };
enum { I_X = 0, I_C, I_POS, I_WADA, I_BADA, I_NMIX, I_NFFN, I_WIN, I_RETN, I_HGRNN, I_LBL, I_WA2, I_BA, I_GLAN, I_WOUT, I_RGW, I_RGB, I_REW, I_REB, I_EG, I_EU, I_ED, I_NFIN };
constexpr int PH_PER_LAYER = 7, PH_FINAL = 1 + 2 * PH_PER_LAYER, N_PHASES = PH_FINAL + 1;

__device__ __forceinline__ void transpose_item(const float* W, int ldw, int K, int k0, int n0, bf16* WT, int dst_row0, LAS float* scr, int lane) {
#pragma unroll 8
    for (int i = 0; i < 32; ++i) { const int kk = 2 * i + (lane >> 5); scr[kk * 33 + (lane & 31)] = W[(size_t)(k0 + kk) * ldw + n0 + (lane & 31)]; }
    LDS_WAIT(); asm volatile("" ::: "memory");
    const int c = lane & 7;
#pragma unroll
    for (int j = 0; j < 4; ++j) { const int n = (lane >> 3) + 8 * j; const LAS float* s = scr + (8 * c) * 33 + n;
        u32x4 o; o.x = pk2(s[0 * 33], s[1 * 33]); o.y = pk2(s[2 * 33], s[3 * 33]); o.z = pk2(s[4 * 33], s[5 * 33]); o.w = pk2(s[6 * 33], s[7 * 33]);
        *(u32x4*)(WT + (size_t)(dst_row0 + n) * K + k0 + 8 * c) = o; }
    LDS_WAIT(); asm volatile("" ::: "memory");
}
__device__ __forceinline__ void sincos_acc(float a, float& s, float& c) {
    const double ad = (double)a; const double kd = rint(ad * 0.63661977236758134308); const double rd = fma(-kd, 1.57079632679489661923, ad);
    const int q = (int)kd & 3; const float r = (float)rd, r2 = r * r;
    const float sp = r + r * r2 * (-1.6666667163e-1f + r2 * (8.3333337680e-3f + r2 * (-1.9841270114e-4f + r2 * 2.7557314297e-6f)));
    const float cp = 1.0f + r2 * (-0.5f + r2 * (4.1666667908e-2f + r2 * (-1.3888889225e-3f + r2 * (2.4801587642e-5f + r2 * -2.7557314297e-7f))));
    const float ss = (q & 1) ? cp : sp, cc = (q & 1) ? sp : cp;
    s = (q & 2) ? -ss : ss; c = ((q + 1) & 2) ? -cc : cc;
}

typedef const __attribute__((address_space(4))) Args KArgs;
#define KARGS(ap) KArgs* ap = (KArgs*)__builtin_amdgcn_kernarg_segment_ptr(); asm volatile("" : "+s"(ap))
#define PHASE_IDS() int tid = threadIdx.x; asm volatile("" : "+v"(tid)); const int lane = tid & 63, wave = __builtin_amdgcn_readfirstlane(tid >> 6); \
    const int G = gridDim.x, bid = blockIdx.x, gw = bid * 8 + wave, NGW = G * 8; (void)lane; (void)wave; (void)gw; (void)NGW; (void)G; (void)bid

template <int TYPE>
__device__ __forceinline__ void naive_mixer_item(LAS unsigned char* lds, KArgs* ap, int layer, int b, int hh  , int tid) {
    constexpr int DK = (TYPE == 2) ? 32 : 64, DKW = DK / 8;
    LAS float* Qs = (LAS float*)lds; LAS float* Ks = Qs + 4096; LAS float* As = Ks + 4096; LAS float* Vs = As + 4096; LAS float* Os = Vs + 4096; LAS float* Ps = Os + 4096;
    unsigned char* ws = ap->ws;
    const bf16* PROJ = (const bf16*)(ws + WS_PROJ); bf16* H = (bf16*)(ws + WS_H);
    const f32x2* ROPE = (const f32x2*)(ws + WS_ROPE);
    const float* lbl = ap->in[I_LBL]; const float* gba = ap->in[I_BA];
    const int e = tid & 63, w = tid >> 6;
    const int qc = (TYPE == 0 ? C_RQ + hh * 64 : TYPE == 1 ? C_HQ + hh * 64 : C_GQ + hh * 32);
    const int kc = (TYPE == 0 ? C_RK + hh * 64 : TYPE == 1 ? C_HF + hh * 64 : C_GK + hh * 32);
    const int vc = (TYPE == 0 ? C_RV : TYPE == 1 ? C_HI : C_GV) + hh * 64;
    const int gc = (TYPE == 0 ? C_RG : TYPE == 1 ? C_HG : C_GG) + hh * 64;
    const int mc = (TYPE == 0 ? 0 : TYPE == 1 ? 384 : 768) + hh * 64;
    const float* gain = ap->in[TYPE == 0 ? I_RETN : TYPE == 1 ? I_HGRNN : I_GLAN] + layer * (TYPE == 2 ? 256 : 384) + hh * 64;
    float S[DKW];
#pragma unroll
    for (int i = 0; i < DKW; ++i) S[i] = 0.f;
    for (int n = 0; n < 64; ++n) {
        __syncthreads();
        const size_t row0 = (size_t)b * SEQ + (size_t)n * 64;
        for (int idx = tid; idx < 4096; idx += 512) {
            const int t = idx >> 6, d = idx & 63; const bf16* p = PROJ + (row0 + t) * NPROJ;
            Vs[idx] = bf2f(p[vc + d]);
            if (TYPE == 0) {
                const int j = d & 31; const f32x2 cs = ROPE[(row0 + t) * 32 + j];
                const float q1 = bf2f(p[qc + j]), q2 = bf2f(p[qc + 32 + j]), k1 = bf2f(p[kc + j]), k2 = bf2f(p[kc + 32 + j]);
                Qs[idx] = d < 32 ? q1 * cs.x - q2 * cs.y : q1 * cs.y + q2 * cs.x;
                Ks[idx] = (d < 32 ? k1 * cs.x - k2 * cs.y : k1 * cs.y + k2 * cs.x) * 0.125f;
                As[idx] = 1.0f - exp2f(-5.0f - (float)hh);
            } else if (TYPE == 1) {
                const float l0 = lbl[hh * 64 + d], l1 = lbl[384 + hh * 64 + d]; const float mx = fmaxf(l0, l1), e0 = expf(l0 - mx), e1 = expf(l1 - mx);
                const float lb = layer == 0 ? 0.f : e1 / (e0 + e1);
                const float z = bf2f(p[kc + d]); const float f = lb + (1.0f - lb) * sigmoidf_(z);
                As[idx] = fmaxf(f, 1e-30f); Ks[idx] = (1.0f - lb) * sigmoidf_(-z); Qs[idx] = siluf_(bf2f(p[qc + d])) * 0.125f;
            } else {
                if (d < 32) { const float pre = bf2f(p[C_GA + hh * 32 + d]) + gba[layer * 128 + hh * 32 + d];
                    const float ls = fminf(pre, 0.f) - log1pf(expf(-fabsf(pre)));
                    As[t * 64 + d] = expf(ls * (1.0f / 16.0f)); Ks[t * 64 + d] = bf2f(p[kc + d]); Qs[t * 64 + d] = bf2f(p[qc + d]) * 0.17677669529663687f; }
            }
        }
        __syncthreads();
        for (int t0 = 0; t0 < 64; t0 += 16) {
            for (int tt = 0; tt < 16; ++tt) { const int t = t0 + tt; const float v = Vs[t * 64 + e]; float part = 0.f;
#pragma unroll
                for (int i = 0; i < DKW; ++i) { const int d = w * DKW + i; S[i] = As[t * 64 + d] * S[i] + Ks[t * 64 + d] * v; part += Qs[t * 64 + d] * S[i]; }
                Ps[(tt * 8 + w) * 64 + e] = part; }
            __syncthreads();
            for (int idx = tid; idx < 1024; idx += 512) { const int tt = idx >> 6, ee = idx & 63; float o = 0.f;
#pragma unroll
                for (int ww = 0; ww < 8; ++ww) o += Ps[(tt * 8 + ww) * 64 + ee];
                Os[(t0 + tt) * 64 + ee] = o; }
            __syncthreads();
        }
        for (int tt = 0; tt < 8; ++tt) { const int t = w * 8 + tt; const float o = Os[t * 64 + e]; const float ss = wave_sum(o * o); const float r = rsqrtf(ss * (1.0f / 64.0f) + EPS);
            const float g = bf2f(PROJ[(row0 + t) * NPROJ + gc + e]);
            H[(row0 + t) * D + mc + e] = (bf16)f2bf(o * r * gain[e] * siluf_(g)); }
    }
}

__device__ __forceinline__ void build_tp(LAS int* TP, const unsigned* cnt, int tid) {
    if (tid == 0) { int s = 0; for (int e = 0; e < 32; ++e) { TP[e] = s; s += ((int)cnt[e] + 255) >> 8; } TP[32] = s; }
    __syncthreads();
}

__device__ __forceinline__ void phase_prologue(LAS unsigned char* lds) {
    KARGS(ap); PHASE_IDS();
    unsigned char* ws = ap->ws;
    if (bid < 192) {
        float* MOD = (float*)(ws + WS_MOD);
        const float* cin = ap->in[I_C]; const float* wada = ap->in[I_WADA]; const float* bada = ap->in[I_BADA];
        LAS float* cact = (LAS float*)lds;
        for (int i = tid; i < 8192; i += 512) { const int b = i >> 10, k = i & 1023; cact[k * 8 + b] = siluf_(cin[i]); }
        __syncthreads();
        LAS float* red = (LAS float*)(lds + 32768);
        for (int it = bid; it < 192; it += G) {
            const int l = it / 96, j0 = (it % 96) * 64; const float* W = wada + (size_t)l * D * 6144 + j0 + lane;
            float acc[8];
#pragma unroll
            for (int b = 0; b < 8; ++b) acc[b] = 0.f;
#pragma unroll 8
            for (int kk = 0; kk < 128; ++kk) { const int k = wave * 128 + kk; const float wv = W[(size_t)k * 6144];
                const f32x4 c0 = *(const LAS f32x4*)(cact + k * 8), c1 = *(const LAS f32x4*)(cact + k * 8 + 4);
                acc[0] += c0[0] * wv; acc[1] += c0[1] * wv; acc[2] += c0[2] * wv; acc[3] += c0[3] * wv; acc[4] += c1[0] * wv; acc[5] += c1[1] * wv; acc[6] += c1[2] * wv; acc[7] += c1[3] * wv; }
#pragma unroll
            for (int b = 0; b < 8; ++b) red[(wave * 8 + b) * 64 + lane] = acc[b];
            __syncthreads();
            { const int b = tid >> 6, col = tid & 63; float s = 0.f;
#pragma unroll
              for (int ww = 0; ww < 8; ++ww) s += red[(ww * 8 + b) * 64 + col];
              MOD[((size_t)l * 8 + b) * 6144 + j0 + col] = s + bada[l * 6144 + j0 + col]; }
            __syncthreads();
        }
    }
    __syncthreads();
    {
        bf16* WIN_T = (bf16*)(ws + WS_WIN); bf16* WOUT_T = (bf16*)(ws + WS_WOUT); bf16* WGU_T = (bf16*)(ws + WS_WGU); bf16* WD_T = (bf16*)(ws + WS_WD);
        LAS float* scr = (LAS float*)(lds + wave * 16384);
        constexpr int I_IN = 16 * 120, I_OUT = 16 * 32, I_G = 16 * 8, I_D = 4 * 32;
        constexpr int PER_L = I_IN + I_OUT + 32 * I_G * 2 + 32 * I_D;
        for (int it = gw; it < 2 * PER_L; it += NGW) {
            const int l = it / PER_L; int r = it % PER_L;
            if (r < I_IN) { const int kb = r / 120, nb = r % 120; transpose_item(ap->in[I_WIN] + (size_t)l * D * INP, INP, D, kb * 64, nb * 32, WIN_T + (size_t)l * NPROJ * D, nb * 32, scr, lane); continue; } r -= I_IN;
            if (r < I_OUT) { const int kb = r / 32, nb = r % 32; transpose_item(ap->in[I_WOUT] + (size_t)l * D * D, D, D, kb * 64, nb * 32, WOUT_T + (size_t)l * D * D, nb * 32, scr, lane); continue; } r -= I_OUT;
            if (r < 32 * I_G * 2) { const int up = r / (32 * I_G); r %= 32 * I_G; const int e = r / I_G; r %= I_G; const int kb = r / 8, nb = r % 8, n0 = nb * 32;
                transpose_item(ap->in[up ? I_EU : I_EG] + ((size_t)l * NEXP + e) * D * DEXP, DEXP, D, kb * 64, n0, WGU_T + ((size_t)l * NEXP + e) * 512 * D, (n0 >> 7) * 256 + (n0 & 127) + up * 128, scr, lane); continue; } r -= 32 * I_G * 2;
            { const int e = r / I_D; r %= I_D; const int kb = r / 32, nb = r % 32;
                transpose_item(ap->in[I_ED] + ((size_t)l * NEXP + e) * DEXP * D, D, DEXP, kb * 64, nb * 32, WD_T + ((size_t)l * NEXP + e) * D * DEXP, nb * 32, scr, lane); }
        }
        const float* win = ap->in[I_WIN]; const float* wa2 = ap->in[I_WA2];
        for (int it = bid * 512 + tid; it < 2 * 256 * 128; it += G * 512) {
            const int l = it / (256 * 128), r = it % (256 * 128), n = r / 128, k0 = (r % 128) * 8;
            float o[8];
#pragma unroll
            for (int j = 0; j < 8; ++j) o[j] = 0.f;
            if (n < 128) {
#pragma unroll
                for (int j = 0; j < 8; ++j) { const float* wr_ = win + (size_t)l * D * INP + (size_t)(k0 + j) * INP + 3840; float s = 0.f;
#pragma unroll
                    for (int rr = 0; rr < 16; ++rr) s += wr_[rr] * wa2[l * 16 * 128 + rr * 128 + n];
                    o[j] = s; } }
            u32x4 w; w.x = pk2(o[0], o[1]); w.y = pk2(o[2], o[3]); w.z = pk2(o[4], o[5]); w.w = pk2(o[6], o[7]);
            *(u32x4*)(WIN_T + (size_t)l * NPROJ * D + (size_t)(3840 + n) * D + k0) = w;
        }
    }
    {
        f32x2* ROPE = (f32x2*)(ws + WS_ROPE); const int* posp = (const int*)ap->in[I_POS];
        for (int it = bid * 512 + tid; it < MTOK * 32; it += G * 512) {
            const int row = it >> 5, j = it & 31; const int pos = posp[row];
            const float ang = (float)pos * ap->inv_freq[j]; float s, c; sincos_acc(ang, s, c); ROPE[it] = (f32x2){c, s};
        }
    }
}

template <int MODE>
__device__ __forceinline__ void phase_norm1(LAS unsigned char* lds, int layer) {
    KARGS(ap); PHASE_IDS();
    unsigned char* ws = ap->ws; float* outp = ap->out;
    const float* MOD = (const float*)(ws + WS_MOD); bf16* H = (bf16*)(ws + WS_H); const bf16* YP = (const bf16*)(ws + WS_YP);
    const int* ROUTE_I = (const int*)(ws + WS_ROUTE); const float* ROUTE_W = (const float*)(ws + WS_ROUTE + 4 * MTOK * 4);
    LAS int* TP = (LAS int*)(lds + TP_OFF);
    const int pl = (MODE == 2) ? DEPTH - 1 : layer - 1;
    if (MODE != 0) build_tp(TP, (const unsigned*)(ws + WS_CTL) + CW_CNT + pl * 64, tid);
    const float* xin = MODE == 0 ? ap->in[I_X] : outp;
    const float* gn = MODE == 2 ? ap->in[I_NFIN] : ap->in[I_NMIX] + layer * D;
    for (int m = gw; m < MTOK; m += NGW) {
        const int b = m >> 12;
        f32x4 v[4];
#pragma unroll
        for (int j = 0; j < 4; ++j) v[j] = *(const f32x4*)(xin + (size_t)m * D + 4 * lane + 256 * j);
        if (MODE != 0) {
            const int e0 = ROUTE_I[m], e1 = ROUTE_I[MTOK + m], r0 = ROUTE_I[2 * MTOK + m], r1 = ROUTE_I[3 * MTOK + m]; const float w0 = ROUTE_W[m], w1 = ROUTE_W[MTOK + m];
            const bf16* y0 = YP + (size_t)(TP[e0] * 256 + r0) * D; const bf16* y1 = YP + (size_t)(TP[e1] * 256 + r1) * D;
            const float* gf = MOD + (size_t)pl * 8 * 6144 + (size_t)b * 6144 + 5 * D;
#pragma unroll
            for (int j = 0; j < 4; ++j) { const u32x2 a0 = *(const u32x2*)(y0 + 4 * lane + 256 * j), a1 = *(const u32x2*)(y1 + 4 * lane + 256 * j); const f32x4 g4 = *(const f32x4*)(gf + 4 * lane + 256 * j);
                v[j][0] += g4[0] * (w0 * bflo(a0.x) + w1 * bflo(a1.x)); v[j][1] += g4[1] * (w0 * bfhi(a0.x) + w1 * bfhi(a1.x));
                v[j][2] += g4[2] * (w0 * bflo(a0.y) + w1 * bflo(a1.y)); v[j][3] += g4[3] * (w0 * bfhi(a0.y) + w1 * bfhi(a1.y));
                if (MODE == 1) *(f32x4*)(outp + (size_t)m * D + 4 * lane + 256 * j) = v[j]; }
        }
        float ss = 0.f;
#pragma unroll
        for (int j = 0; j < 4; ++j) ss += (v[j][0] * v[j][0] + v[j][1] * v[j][1]) + (v[j][2] * v[j][2] + v[j][3] * v[j][3]);
        const float rstd = rsqrtf(wave_sum(ss) * (1.0f / D) + EPS);
        if (MODE == 2) {
#pragma unroll
            for (int j = 0; j < 4; ++j) { const int c0 = 4 * lane + 256 * j; const f32x4 g4 = *(const f32x4*)(gn + c0);
                f32x4 y;
#pragma unroll
                for (int q = 0; q < 4; ++q) y[q] = v[j][q] * rstd * g4[q];
                *(f32x4*)(outp + (size_t)m * D + c0) = y; }
        } else {
            const float* mb = MOD + (size_t)layer * 8 * 6144 + (size_t)b * 6144;
#pragma unroll
            for (int j = 0; j < 4; ++j) { const int c0 = 4 * lane + 256 * j; const f32x4 g4 = *(const f32x4*)(gn + c0), sh = *(const f32x4*)(mb + c0), sc = *(const f32x4*)(mb + D + c0);
                f32x4 y;
#pragma unroll
                for (int q = 0; q < 4; ++q) y[q] = (v[j][q] * rstd * g4[q]) * (1.0f + sc[q]) + sh[q];
                u32x2 o; o.x = pk2(y[0], y[1]); o.y = pk2(y[2], y[3]); *(u32x2*)(H + (size_t)m * D + c0) = o; }
        }
    }
}

__device__ __forceinline__ void phase_inproj(LAS unsigned char* lds, int layer) {
    KARGS(ap); unsigned char* ws = ap->ws;
    pg8::Gemm g{(const bf16*)(ws + WS_H), (const bf16*)(ws + WS_WIN) + (size_t)layer * NPROJ * D, D}; pg8::StaticOrder S; S.init(MTOK, NPROJ, gridDim.x, blockIdx.x);
    pg8::EpiBf16Store E{(bf16*)(ws + WS_PROJ), NPROJ};
    pg8::gemm_phase<pg8::EpiBf16Store, pg8::StaticOrder, false>(lds, g, S, E, nullptr);
}
__device__ __forceinline__ void phase_mixer_naive(LAS unsigned char* lds, int layer) {
    KARGS(ap); PHASE_IDS();
    for (int it = bid; it < NB * 16; it += G) {
        const int b = it >> 4, hd = it & 15;
        if (hd < 6) naive_mixer_item<0>(lds, ap, layer, b, hd, tid);
        else if (hd < 12) naive_mixer_item<1>(lds, ap, layer, b, hd - 6, tid);
        else naive_mixer_item<2>(lds, ap, layer, b, hd - 12, tid);
        __syncthreads();
    }
}
__device__ __forceinline__ void phase_outproj(LAS unsigned char* lds, int layer) {
    KARGS(ap); unsigned char* ws = ap->ws; float* outp = ap->out;
    pg8::Gemm g{(const bf16*)(ws + WS_H), (const bf16*)(ws + WS_WOUT) + (size_t)layer * D * D, D}; pg8::StaticOrder S; S.init(MTOK, D, gridDim.x, blockIdx.x);
    pg8::EpiResGate E{layer == 0 ? ap->in[I_X] : outp, outp, (const float*)(ws + WS_MOD) + (size_t)layer * 8 * 6144 + 2 * D};
    pg8::gemm_phase<pg8::EpiResGate, pg8::StaticOrder, false>(lds, g, S, E, nullptr);
}
__device__ __forceinline__ void phase_norm2_router(LAS unsigned char* lds, int layer) {
    KARGS(ap); PHASE_IDS();
    unsigned char* ws = ap->ws; const float* xres = ap->out;
    bf16* H = (bf16*)(ws + WS_H);
    int* ROUTE_I = (int*)(ws + WS_ROUTE); float* ROUTE_W = (float*)(ws + WS_ROUTE + 4 * MTOK * 4); int* IDX2 = (int*)(ws + WS_IDX2);
    unsigned* cntl = (unsigned*)(ws + WS_CTL) + CW_CNT + layer * 64;
    LAS bf16* Wr = (LAS bf16*)lds;
    { const float* rgw = ap->in[I_RGW] + (size_t)layer * D * 4; const float* rew = ap->in[I_REW] + (size_t)layer * D * 32;
      for (int i = tid; i < 36 * 1024; i += 512) { const int n = i >> 10, k = i & 1023; const float wv = n < 4 ? rgw[k * 4 + n] : rew[k * 32 + (n - 4)]; Wr[i] = (bf16)f2bf(wv); } }
    __syncthreads();
    const float* gn = ap->in[I_NFFN] + layer * D; const float* rgb = ap->in[I_RGB] + layer * 4; const float* reb = ap->in[I_REB] + layer * 32;
    const float* modl = (const float*)(ws + WS_MOD) + (size_t)layer * 8 * 6144;
    for (int m = gw; m < MTOK; m += NGW) {
        const int b = m >> 12; const float* mb = modl + (size_t)b * 6144 + 3 * D;
        f32x4 v[4];
#pragma unroll
        for (int j = 0; j < 4; ++j) v[j] = *(const f32x4*)(xres + (size_t)m * D + 4 * lane + 256 * j);
        float ss = 0.f;
#pragma unroll
        for (int j = 0; j < 4; ++j) ss += (v[j][0] * v[j][0] + v[j][1] * v[j][1]) + (v[j][2] * v[j][2] + v[j][3] * v[j][3]);
        const float rstd = rsqrtf(wave_sum(ss) * (1.0f / D) + EPS);
#pragma unroll
        for (int j = 0; j < 4; ++j) { const int c0 = 4 * lane + 256 * j; const f32x4 g4 = *(const f32x4*)(gn + c0), sh = *(const f32x4*)(mb + c0), sc = *(const f32x4*)(mb + D + c0);
#pragma unroll
            for (int q = 0; q < 4; ++q) v[j][q] = (v[j][q] * rstd * g4[q]) * (1.0f + sc[q]) + sh[q];
            u32x2 o; o.x = pk2(v[j][0], v[j][1]); o.y = pk2(v[j][2], v[j][3]); *(u32x2*)(H + (size_t)m * D + c0) = o; }
        float lgv = 0.f;
#pragma unroll 2
        for (int n = 0; n < 36; ++n) { float p = 0.f;
#pragma unroll
            for (int j = 0; j < 4; ++j) { const u32x2 wv = *(const LAS u32x2*)(Wr + n * 1024 + 4 * lane + 256 * j);
                p += v[j][0] * bflo(wv.x) + v[j][1] * bfhi(wv.x) + v[j][2] * bflo(wv.y) + v[j][3] * bfhi(wv.y); }
            const float s = wave_sum(p); lgv = (lane == n) ? s : lgv; }
        float gl[4];
#pragma unroll
        for (int q = 0; q < 4; ++q) gl[q] = __shfl(lgv, q) + rgb[q];
        int gi = 0; float gm = gl[0];
#pragma unroll
        for (int q = 1; q < 4; ++q) if (gl[q] > gm) { gm = gl[q]; gi = q; }
        float gs = 0.f;
#pragma unroll
        for (int q = 0; q < 4; ++q) gs += __expf(gl[q] - gm);
        const float gwt = 1.0f / gs;
        float el[8];
#pragma unroll
        for (int q = 0; q < 8; ++q) el[q] = __shfl(lgv, 4 + gi * 8 + q) + reb[gi * 8 + q];
        int i0 = 0; float m0 = el[0];
#pragma unroll
        for (int q = 1; q < 8; ++q) if (el[q] > m0) { m0 = el[q]; i0 = q; }
        int i1 = -1; float m1 = -3.0e38f;
#pragma unroll
        for (int q = 0; q < 8; ++q) if (q != i0 && el[q] > m1) { m1 = el[q]; i1 = q; }
        const float ex = __expf(m1 - m0); const float w0 = gwt / (1.0f + ex), w1 = gwt * ex / (1.0f + ex);
        if (lane == 0) {
            const int e0 = gi * 8 + i0, e1 = gi * 8 + i1;
            const int r0 = (int)atomicAdd(cntl + e0, 1u), r1 = (int)atomicAdd(cntl + e1, 1u);
            IDX2[e0 * MTOK + r0] = m; IDX2[e1 * MTOK + r1] = m;
            ROUTE_I[m] = e0; ROUTE_I[MTOK + m] = e1; ROUTE_I[2 * MTOK + m] = r0; ROUTE_I[3 * MTOK + m] = r1; ROUTE_W[m] = w0; ROUTE_W[MTOK + m] = w1;
        }
    }
}
__device__ __forceinline__ void phase_moe_up(LAS unsigned char* lds, int layer) {
    KARGS(ap); unsigned char* ws = ap->ws;
    LAS int* TP = (LAS int*)(lds + TP_OFF); LAS int* AUX = (LAS int*)(lds + AUX_OFF);
    const unsigned* cntl = (const unsigned*)(ws + WS_CTL) + CW_CNT + layer * 64;
    { int tid = threadIdx.x; build_tp(TP, cntl, tid);
      pg8::MoeOrder S0; S0.G = gridDim.x; S0.c = blockIdx.x; S0.npt = 2; S0.total = TP[32] * 2; S0.tp = TP;
      const int* IDX2 = (const int*)(ws + WS_IDX2);
      pg8::Unit u; for (int i = 0; i < 8; ++i) { if (!S0.next(i, u)) break; const int e = u.pn >> 1, j = u.pm - TP[e], cnt = (int)cntl[e];
          if (tid < 256) { const int rank = j * 256 + tid; AUX[i * 256 + tid] = (rank < cnt ? IDX2[e * MTOK + rank] : 0) * (D * 2); } }
      __syncthreads(); }
    pg8::MoeOrder S; S.G = gridDim.x; S.c = blockIdx.x; S.npt = 2; S.total = TP[32] * 2; S.tp = TP;
    pg8::Gemm g{(const bf16*)(ws + WS_H), (const bf16*)(ws + WS_WGU) + (size_t)layer * NEXP * 512 * D, D};
    pg8::EpiSwiGLU E{(bf16*)(ws + WS_HID)};
    pg8::gemm_phase<pg8::EpiSwiGLU, pg8::MoeOrder, true>(lds, g, S, E, AUX);
}
__device__ __forceinline__ void phase_moe_down(LAS unsigned char* lds, int layer) {
    KARGS(ap); unsigned char* ws = ap->ws;
    LAS int* TP = (LAS int*)(lds + TP_OFF);
    build_tp(TP, (const unsigned*)(ws + WS_CTL) + CW_CNT + layer * 64, threadIdx.x);
    pg8::MoeOrder S; S.G = gridDim.x; S.c = blockIdx.x; S.npt = 4; S.total = TP[32] * 4; S.tp = TP;
    pg8::Gemm g{(const bf16*)(ws + WS_HID), (const bf16*)(ws + WS_WD) + (size_t)layer * NEXP * D * DEXP, DEXP};
    pg8::EpiBf16Store E{(bf16*)(ws + WS_YP), D};
    pg8::gemm_phase<pg8::EpiBf16Store, pg8::MoeOrder, false>(lds, g, S, E, nullptr);
}

__global__ void __launch_bounds__(512, 2) fwd(Args a) {
    extern __shared__ __attribute__((aligned(16))) unsigned char lds_raw[];
    LAS unsigned char* lds = (LAS unsigned char*)lds_raw;
    volatile LAS unsigned* MISC = (volatile LAS unsigned*)(lds + LDSCTL_OFF);
    for (int u = threadIdx.x; u < (LDS_BYTES - LDSCTL_OFF) / 4; u += 512) ((LAS unsigned*)(lds + LDSCTL_OFF))[u] = 0u;
    __syncthreads();
#if MK_ONE_LAUNCH
    { unsigned* ctl0 = (unsigned*)(a.ws + WS_CTL); (void)xcd_barrier_post(ctl0 + CW_BAR, MISC + 8); }
    constexpr int lo = 0, hi = N_PHASES;
#define SEAM(k) do { if ((k) + 1 < hi) { KARGS(_ap); XcdBarrier _b; _b.bar = (unsigned*)(_ap->ws + WS_CTL) + CW_BAR; _b.x = xb_xcc_id(); _b.st = (volatile LAS unsigned*)(lds + LDSCTL_OFF) + 8; xcd_barrier(_b); } } while (0)
#else
    (void)MISC;
    const int lo = a.ph_lo, hi = a.ph_hi;
#define SEAM(k) do { } while (0)
#endif
#define IN(k) (lo <= (k) && (k) < hi)
    if (EN_P0 && IN(0)) { phase_prologue(lds); SEAM(0); }
    for (int layer = 0; layer < DEPTH; ++layer) {
        const int pb = 1 + PH_PER_LAYER * layer;
        if (EN_PA && IN(pb + 0)) { if (layer == 0) phase_norm1<0>(lds, layer); else phase_norm1<1>(lds, layer); SEAM(pb + 0); }
        if (EN_PB && IN(pb + 1)) { phase_inproj(lds, layer); SEAM(pb + 1); }
        if (EN_PC && IN(pb + 2)) { phase_mixer_naive(lds, layer); SEAM(pb + 2); }
        if (EN_PD && IN(pb + 3)) { phase_outproj(lds, layer); SEAM(pb + 3); }
        if (EN_PE && IN(pb + 4)) { phase_norm2_router(lds, layer); SEAM(pb + 4); }
        if (EN_PG && IN(pb + 5)) { phase_moe_up(lds, layer); SEAM(pb + 5); }
        if (EN_PH && IN(pb + 6)) { phase_moe_down(lds, layer); SEAM(pb + 6); }
    }
    if (EN_PF && IN(PH_FINAL)) phase_norm1<2>(lds, 0);
#undef IN
#undef SEAM
}

extern "C" void kernel_launch(void* const* d_in, const int* in_sizes, int n_in, void* d_out, int out_size, void* d_ws, size_t ws_size, hipStream_t stream) {
    static int grid = 0;
    if (grid == 0) {
        if (n_in != 23 || out_size != MTOK * D || ws_size < WS_END) { fprintf(stderr, "kernel_launch: unexpected shapes (n_in %d out %d ws %zu)\n", n_in, out_size, ws_size); grid = -1; return; }
        int dev = 0, cus = 0;
        if (hipGetDevice(&dev) != hipSuccess || hipDeviceGetAttribute(&cus, hipDeviceAttributeMultiprocessorCount, dev) != hipSuccess) { grid = -1; return; }
        if (hipFuncSetAttribute((const void*)fwd, hipFuncAttributeMaxDynamicSharedMemorySize, LDS_BYTES) != hipSuccess) { fprintf(stderr, "kernel_launch: hipFuncSetAttribute failed\n"); grid = -1; return; }
        int per_cu = 0;
        if (hipOccupancyMaxActiveBlocksPerMultiprocessor(&per_cu, (const void*)fwd, 512, LDS_BYTES) != hipSuccess || per_cu < 1) fprintf(stderr, "kernel_launch: occupancy query reports %d\n", per_cu);
        (void)hipGetLastError();
        grid = cus;
    }
    if (grid < 0) return;
    (void)hipMemsetAsync((char*)d_ws + WS_CTL, 0, CTL_ZERO_BYTES, stream);
    Args a{};
    for (int i = 0; i < 23; ++i) a.in[i] = (const float*)d_in[i];
    a.out = (float*)d_out; a.ws = (unsigned char*)d_ws;
    for (int j = 0; j < 32; ++j) a.inv_freq[j] = (float)std::pow(10000.0, -(double)j / 32.0);
#if MK_ONE_LAUNCH
    a.ph_lo = 0; a.ph_hi = N_PHASES;
    hipLaunchKernelGGL(fwd, dim3(grid), dim3(512), LDS_BYTES, stream, a);
#else
    for (int p = 0; p < N_PHASES; ++p) { a.ph_lo = p; a.ph_hi = p + 1; hipLaunchKernelGGL(fwd, dim3(grid), dim3(512), LDS_BYTES, stream, a); }
#endif
}
```

```cpp
#include <hip/hip_runtime.h>
#include <cstdio>
#include <cstdint>
#include <cmath>

#define GAS __attribute__((address_space(1)))
#define LAS __attribute__((address_space(3)))
typedef unsigned short bf16;
typedef short bf16x8 __attribute__((ext_vector_type(8)));
typedef float f32x4 __attribute__((ext_vector_type(4)));
typedef float f32x2 __attribute__((ext_vector_type(2)));
typedef unsigned u32x4 __attribute__((ext_vector_type(4)));
typedef unsigned u32x2 __attribute__((ext_vector_type(2)));

#ifndef EN_P0
#define EN_P0 1
#endif
#ifndef EN_PA
#define EN_PA 1
#endif
#ifndef EN_PB
#define EN_PB 1
#endif
#ifndef EN_PC
#define EN_PC 1
#endif
#ifndef EN_PD
#define EN_PD 1
#endif
#ifndef EN_PE
#define EN_PE 1
#endif
#ifndef EN_PG
#define EN_PG 1
#endif
#ifndef EN_PH
#define EN_PH 1
#endif
#ifndef EN_PF
#define EN_PF 1
#endif
#ifndef MK_NAIVE_MIXER
#define MK_NAIVE_MIXER 0
#endif
#ifndef MK_ONE_LAUNCH
#define MK_ONE_LAUNCH 1
#endif

constexpr int NB = 8, SEQ = 4096, MTOK = NB * SEQ, D = 1024, DEPTH = 2;
constexpr int NPROJ = 4096;
constexpr int INP = 3856;
constexpr int C_RQ = 0, C_RK = 384, C_RV = 768, C_RG = 1152, C_HQ = 1536, C_HF = 1920, C_HI = 2304, C_HG = 2688, C_GQ = 3072, C_GK = 3200, C_GV = 3328, C_GG = 3584, C_GA = 3840;
constexpr int NEXP = 32, DEXP = 256;
constexpr int MAXROWS = 73728;
constexpr float EPS = 1e-6f;

constexpr size_t MiB = 1u << 20;
constexpr size_t WS_CTL = 0, CTL_ZERO_BYTES = 1 * MiB;
constexpr size_t WS_MOD = 1 * MiB;
constexpr size_t WS_ROPE = 2 * MiB;
constexpr size_t WS_WIN = 10 * MiB;
constexpr size_t WS_WOUT = 26 * MiB;
constexpr size_t WS_WGU = 30 * MiB;
constexpr size_t WS_WD = 94 * MiB;
constexpr size_t WS_H = 126 * MiB;
constexpr size_t WS_PROJ = 190 * MiB;
constexpr size_t WS_HID = 190 * MiB;
constexpr size_t WS_YP = 226 * MiB;
constexpr size_t WS_STATE = 446 * MiB;
constexpr size_t WS_ROUTE = 474 * MiB;
constexpr size_t WS_IDX2 = 476 * MiB;
constexpr size_t WS_END = 480 * MiB;
constexpr int CW_CNT = 64;
constexpr int CW_BAR = 4096;

constexpr int RING_BYTES = 131072;
constexpr int LDSCTL_OFF = RING_BYTES;
constexpr int TP_OFF = RING_BYTES + 512;
constexpr int AUX_OFF = RING_BYTES + 1024;
constexpr int LDS_BYTES = 147456;

#define RLX_AGENT __ATOMIC_RELAXED, __HIP_MEMORY_SCOPE_AGENT
#define LDS_WAIT() asm volatile("s_waitcnt lgkmcnt(0)" ::: "memory")
#define VM_WAIT() asm volatile("s_waitcnt vmcnt(0)" ::: "memory")

__device__ __forceinline__ unsigned f2bf(float f) { unsigned u = __builtin_bit_cast(unsigned, f); return (u + 0x7fffu + ((u >> 16) & 1u)) >> 16; }
__device__ __forceinline__ unsigned pk2(float lo, float hi) { return f2bf(lo) | (f2bf(hi) << 16); }
__device__ __forceinline__ float bf2f(unsigned short b) { return __builtin_bit_cast(float, ((unsigned)b) << 16); }
__device__ __forceinline__ float bflo(unsigned w) { return __builtin_bit_cast(float, w << 16); }
__device__ __forceinline__ float bfhi(unsigned w) { return __builtin_bit_cast(float, w & 0xffff0000u); }
__device__ __forceinline__ float sigmoidf_(float x) { return 1.0f / (1.0f + __expf(-x)); }
__device__ __forceinline__ float siluf_(float x) { return x / (1.0f + __expf(-x)); }
__device__ __forceinline__ float wave_sum(float v) {
#pragma unroll
    for (int o = 1; o < 64; o <<= 1) v += __shfl_xor(v, o);
    return v;
}

#define XB_TMO      128
#define XB_XCNT(j)  (256  + 64 * (j))
#define XB_XSUB(j)  (1280 + 64 * (j))
#define XB_XGEN(j)  (2304 + 64 * (j))
#define XB_TOP      3328
#define XB_TOPGEN   3392
#define XCD_BAR_WORDS 3456
#define XB_SPIN_CAP (1u << 18)
__device__ __forceinline__ unsigned xb_ld(unsigned* p)              { return __hip_atomic_load(p, __ATOMIC_RELAXED, __HIP_MEMORY_SCOPE_AGENT); }
__device__ __forceinline__ unsigned xb_add(unsigned* p, unsigned v) { return __hip_atomic_fetch_add(p, v, __ATOMIC_RELAXED, __HIP_MEMORY_SCOPE_AGENT); }
__device__ __forceinline__ unsigned xb_xcc_id() { return (unsigned)__builtin_amdgcn_s_getreg((3 << 11) | 20) & 0xFu; }
#define XB_SPIN(cond, bar) do { unsigned _sp = 0; while (cond) { __builtin_amdgcn_s_sleep(1); \
    if ((++_sp & 255u) == 0u) { if (xb_ld(&(bar)[XB_TMO])) break; if (_sp > XB_SPIN_CAP) { atomicAdd(&(bar)[XB_TMO], 1u); break; } } } } while (0)
struct XcdBarrier { unsigned* bar; unsigned x; volatile LAS unsigned* st; };
__device__ __forceinline__ XcdBarrier xcd_barrier_post(unsigned* bar, volatile LAS unsigned* st) {
    XcdBarrier b; b.bar = bar; b.x = xb_xcc_id(); b.st = st;
    if (threadIdx.x == 0) (void)xb_add(&bar[XB_XCNT(b.x)], 1u);
    return b;
}
__device__ __forceinline__ void xcd_barrier_complete(unsigned* bar, unsigned x, unsigned& nloc, unsigned& nx) {
    const unsigned G = gridDim.x * gridDim.y * gridDim.z;
    unsigned sum, cnt, mine, sp = 0u;
    for (;;) {
        sum = 0u; cnt = 0u; mine = 0u;
#pragma unroll
        for (unsigned j = 0; j < 16; ++j) { const unsigned c = xb_ld(&bar[XB_XCNT(j)]); sum += c; cnt += (c > 0u) ? 1u : 0u; mine = (j == x) ? c : mine; }
        if (sum == G) break;
        __builtin_amdgcn_s_sleep(1);
        if ((++sp & 255u) == 0u) { if (xb_ld(&bar[XB_TMO])) break; if (sp > XB_SPIN_CAP) { atomicAdd(&bar[XB_TMO], 1u); break; } }
    }
    nloc = mine > 0u ? mine : 1u; nx = cnt > 0u ? cnt : 1u;
}
__device__ __forceinline__ void xcd_barrier(const XcdBarrier& b) {
    asm volatile("s_waitcnt vmcnt(0)" ::: "memory");
    __syncthreads();
    if (threadIdx.x == 0) {
        unsigned* bar = b.bar;
        __builtin_amdgcn_s_waitcnt(0);
        unsigned nloc = b.st[0], nx = b.st[1];
        if (nloc == 0u) { xcd_barrier_complete(bar, b.x, nloc, nx); b.st[0] = nloc; b.st[1] = nx; }
        const unsigned old = xb_add(&bar[XB_XSUB(b.x)], 1u);
        const unsigned gen = old / nloc;
        if (old + 1u == (gen + 1u) * nloc) {
            __builtin_amdgcn_fence(__ATOMIC_RELEASE, "agent");
            asm volatile("s_waitcnt vmcnt(0)" ::: "memory");
            const unsigned og = xb_add(&bar[XB_TOP], 1u);
            const unsigned tg = og / nx;
            if (og + 1u == (tg + 1u) * nx) xb_add(&bar[XB_TOPGEN], 1u);
            else XB_SPIN(xb_ld(&bar[XB_TOPGEN]) == tg, bar);
            __builtin_amdgcn_fence(__ATOMIC_ACQUIRE, "agent");
            xb_add(&bar[XB_XGEN(b.x)], 1u);
            asm volatile("s_waitcnt vmcnt(0)" ::: "memory");
        } else {
            XB_SPIN(xb_ld(&bar[XB_XGEN(b.x)]) == gen, bar);
            __builtin_amdgcn_fence(__ATOMIC_ACQUIRE, "agent");
            asm volatile("s_waitcnt vmcnt(0)" ::: "memory");
        }
    }
    __syncthreads();
}

namespace pg8 {
constexpr int BM = 256, BK = 64, HALF = 128, HTB = HALF * BK * 2, STAGE_BYTES = 8 * HTB, NXCD = 8, WGM = 8;
__host__ __device__ __forceinline__ int lds_byte(int r, int c) { const int st = (r >> 4) * 2 + (c >> 5), rr = r & 15, cc = c & 31, ob = rr * 64 + cc * 2; return st * 1024 + (ob ^ (((ob >> 9) & 1) << 5)); }
__host__ __device__ __forceinline__ void stage_rc(int b, int& R, int& C) { const int st = b / 1024, sb = b % 1024, swz = sb ^ (((sb >> 9) & 1) << 5); R = (st >> 1) * 16 + swz / 64; C = (st & 1) * 32 + (swz % 64) / 2; }
__host__ __device__ __forceinline__ int perm32(int rho) { const int n = rho >> 4, i = rho & 15; return 8 * (i >> 2) + 4 * n + (i & 3); }
struct Unit { int pm, pn, pc; };
struct Gemm { const bf16* A; const bf16* Bt; int K; };

struct StaticOrder {
    int nM, nN, nwg, G, c;
    __device__ void init(int M, int N, int G_, int c_) { nM = M / BM; nN = N / BM; nwg = nM * nN; G = G_; c = c_; }
    __device__ bool next(int i, Unit& u) const {
        const long L = (long)i * G + c; if (L >= nwg) return false;
        int wgid = (int)L; { const int q = nwg / NXCD, r = nwg % NXCD, xcd = wgid % NXCD, off = wgid / NXCD; wgid = (xcd < r ? xcd * (q + 1) : r * (q + 1) + (xcd - r) * q) + off; }
        const int nig = WGM * nN, gid = wgid / nig, fm = gid * WGM, gsz = (nM - fm) < WGM ? (nM - fm) : WGM;
        u.pm = fm + ((wgid % nig) % gsz); u.pn = (wgid % nig) / gsz; u.pc = u.pn; return true;
    }
};
struct MoeOrder {
    int G, c, npt, total; const LAS int* tp;
    __device__ bool next(int i, Unit& u) const {
        const int L = i * G + c; if (L >= total) return false;
        const int mt = L / npt, nl = L % npt; int e = 0;
        while (e < 31 && tp[e + 1] <= mt) ++e;
        u.pm = mt; u.pn = e * npt + nl; u.pc = nl; return true;
    }
};

__device__ __forceinline__ unsigned cvt_pk_bf16(float lo, float hi) { unsigned r; asm volatile("v_cvt_pk_bf16_f32 %0, %1, %2" : "=v"(r) : "v"(lo), "v"(hi)); return r; }

struct EpiBf16Store {
    static constexpr bool PERM = true;
    bf16* O; int ldc;
    __device__ __forceinline__ void operator()(const f32x4 (&acc)[2][2][4][2], const Unit& u, int wr, int wc, int fr, int fq) const {
        const int row0 = u.pm * BM + wr * 64 + fr, col0 = u.pc * BM + wc * 32 + 8 * fq;
#pragma unroll
        for (int ai = 0; ai < 2; ++ai)
#pragma unroll
            for (int m = 0; m < 4; ++m) { bf16* rowp = O + (size_t)(row0 + ai * HALF + m * 16) * ldc + col0;
#pragma unroll
                for (int bj = 0; bj < 2; ++bj) { const f32x4 v0 = acc[ai][bj][m][0], v1 = acc[ai][bj][m][1];
                    u32x4 w; w.x = cvt_pk_bf16(v0[0], v0[1]); w.y = cvt_pk_bf16(v0[2], v0[3]); w.z = cvt_pk_bf16(v1[0], v1[1]); w.w = cvt_pk_bf16(v1[2], v1[3]);
                    *(u32x4*)(rowp + bj * HALF) = w; } }
    }
};
struct EpiSwiGLU {
    static constexpr bool PERM = true;
    bf16* O;
    __device__ __forceinline__ void operator()(const f32x4 (&acc)[2][2][4][2], const Unit& u, int wr, int wc, int fr, int fq) const {
        const int row0 = u.pm * BM + wr * 64 + fr, col0 = u.pc * HALF + wc * 32 + 8 * fq;
#pragma unroll
        for (int ai = 0; ai < 2; ++ai)
#pragma unroll
            for (int m = 0; m < 4; ++m) { bf16* rowp = O + (size_t)(row0 + ai * HALF + m * 16) * DEXP + col0;
                float h[8];
#pragma unroll
                for (int n = 0; n < 2; ++n)
#pragma unroll
                    for (int j = 0; j < 4; ++j) { const float g = acc[ai][0][m][n][j], up = acc[ai][1][m][n][j]; h[n * 4 + j] = g / (1.0f + __expf(-g)) * up; }
                u32x4 w; w.x = cvt_pk_bf16(h[0], h[1]); w.y = cvt_pk_bf16(h[2], h[3]); w.z = cvt_pk_bf16(h[4], h[5]); w.w = cvt_pk_bf16(h[6], h[7]);
                *(u32x4*)rowp = w; }
    }
};
struct EpiResGate {
    static constexpr bool PERM = false;
    const float* res; float* out; const float* gate;
    __device__ __forceinline__ void operator()(const f32x4 (&acc)[2][2][4][2], const Unit& u, int wr, int wc, int fr, int fq) const {
        const int row0 = u.pm * BM + wr * 64 + fr, col0 = u.pc * BM + wc * 32 + 4 * fq;
        const float* gb = gate + (size_t)(u.pm >> 4) * 6144;
        f32x4 gv[2][2];
#pragma unroll
        for (int bj = 0; bj < 2; ++bj)
#pragma unroll
            for (int n = 0; n < 2; ++n) gv[bj][n] = *(const f32x4*)(gb + col0 + bj * HALF + n * 16);
#pragma unroll
        for (int ai = 0; ai < 2; ++ai)
#pragma unroll
            for (int m = 0; m < 4; ++m) { const size_t off = (size_t)(row0 + ai * HALF + m * 16) * D + col0;
#pragma unroll
                for (int bj = 0; bj < 2; ++bj)
#pragma unroll
                    for (int n = 0; n < 2; ++n) { const f32x4 r = *(const f32x4*)(res + off + bj * HALF + n * 16); *(f32x4*)(out + off + bj * HALF + n * 16) = r + gv[bj][n] * acc[ai][bj][m][n]; } }
    }
};

template <class Epi, class Sched, bool GATHER>
__device__ __forceinline__ void gemm_phase(LAS unsigned char* lds, const Gemm g, const Sched& S, const Epi& E, const LAS int* gidx) {
    const int tid = threadIdx.x, wid = __builtin_amdgcn_readfirstlane(tid >> 6), lane = tid & 63, wr = wid >> 2, wc = wid & 3, fr = lane & 15, fq = lane >> 4;
    const int K = g.K, nt = K / BK;
    unsigned voffA[2], voffB[2];
#pragma unroll
    for (int i = 0; i < 2; ++i) { int R, C; stage_rc(tid * 16 + i * 8192, R, C); const int Rb = Epi::PERM ? ((R & ~31) + perm32(R & 31)) : R;
        voffA[i] = (unsigned)(R * K + C) * 2u; voffB[i] = (unsigned)(Rb * K + C) * 2u; }
    const size_t kstep = (size_t)(BK * 2);
    const size_t hstep = (size_t)HALF * K * 2;
    const size_t tstep = 2 * hstep;
    const unsigned ldsw = (unsigned)wid * 1024u;
    const int aoff = lds_byte(wr * 64 + fr, fq * 8), boff = lds_byte(wc * 32 + fr, fq * 8);
    int nslot = 0;
#define PG8_SA(b, h) (((b) * 2 + (h)) * HTB)
#define PG8_SB(b, h) ((4 + (b) * 2 + (h)) * HTB)
#define PG8_GLDS(gp, lp) __builtin_amdgcn_global_load_lds((const unsigned*)(gp), (LAS unsigned*)(lp), 16, 0, 0)
#define PG8_STAGE(bufoff, gbase, voff) do { _Pragma("unroll") for (int _i = 0; _i < 2; ++_i) PG8_GLDS((const char*)(gbase) + (voff)[_i], lds + (bufoff) + ldsw + _i * 8192); } while (0)
#define PG8_STAGE_A(bufoff, gptr, h, nx) do { if constexpr (GATHER) { const int _slot = (nx) ? nslot : ui; _Pragma("unroll") for (int _i = 0; _i < 2; ++_i) { int _R, _C; stage_rc(tid * 16 + _i * 8192, _R, _C); \
            const unsigned _vo = (unsigned)gidx[_slot * 256 + (h) * HALF + _R] + (unsigned)_C * 2u; PG8_GLDS((const char*)(gptr) + _vo, lds + (bufoff) + ldsw + _i * 8192); } } \
        else { PG8_STAGE(bufoff, (const char*)(gptr) + (h) * hstep, voffA); } } while (0)
#define PG8_LDA(dst, b, h) do { _Pragma("unroll") for (int m = 0; m < 4; ++m) _Pragma("unroll") for (int k = 0; k < 2; ++k) dst[m][k] = *(const LAS bf16x8*)(lds + PG8_SA(b, h) + aoff + m * 2048 + k * 1024); } while (0)
#define PG8_LDB(dst, b, h) do { _Pragma("unroll") for (int n = 0; n < 2; ++n) _Pragma("unroll") for (int k = 0; k < 2; ++k) dst[n][k] = *(const LAS bf16x8*)(lds + PG8_SB(b, h) + boff + n * 2048 + k * 1024); } while (0)
#define PG8_MMA(ai, bj, At, Bt) do { __builtin_amdgcn_s_setprio(1); _Pragma("unroll") for (int m = 0; m < 4; ++m) _Pragma("unroll") for (int n = 0; n < 2; ++n) _Pragma("unroll") for (int k = 0; k < 2; ++k) \
        acc[ai][bj][m][n] = __builtin_amdgcn_mfma_f32_16x16x32_bf16(Bt[n][k], At[m][k], acc[ai][bj][m][n], 0, 0, 0); __builtin_amdgcn_s_setprio(0); } while (0)
#define PG8_WAIT_V(n) asm volatile("s_waitcnt vmcnt(" #n ")" ::: "memory")
#define PG8_WAIT_L(n) asm volatile("s_waitcnt lgkmcnt(" #n ")" ::: "memory")
#define PG8_BAR __builtin_amdgcn_s_barrier()
#define PG8_SCHED __builtin_amdgcn_sched_barrier(0)
    Unit cur, nxt; int ui = 0;
    if (!S.next(0, cur)) return;
    f32x4 acc[2][2][4][2];
#pragma unroll
    for (int a = 0; a < 2; ++a)
#pragma unroll
        for (int b = 0; b < 2; ++b)
#pragma unroll
            for (int m = 0; m < 4; ++m)
#pragma unroll
                for (int n = 0; n < 2; ++n) acc[a][b][m][n] = (f32x4){0.f, 0.f, 0.f, 0.f};
    bf16x8 At[4][2], B0[2][2], B1[2][2];
    const char* cA = (const char*)g.A + (GATHER ? (size_t)0 : (size_t)cur.pm * tstep); const char* cB = (const char*)g.Bt + (size_t)cur.pn * tstep;
    PG8_STAGE(PG8_SB(0, 0), cB, voffB); PG8_STAGE(PG8_SB(0, 1), cB + hstep, voffB); PG8_STAGE_A(PG8_SA(0, 0), cA, 0, false); PG8_STAGE_A(PG8_SA(0, 1), cA, 1, false);
    if (wr == 1) PG8_BAR;
    PG8_WAIT_V(2); PG8_BAR;
    PG8_STAGE(PG8_SB(1, 0), cB + kstep, voffB); PG8_STAGE_A(PG8_SA(1, 0), cA + kstep, 0, false); PG8_STAGE(PG8_SB(1, 1), cB + hstep + kstep, voffB);
    PG8_WAIT_V(6); PG8_BAR;
    for (;;) {
        const bool has_next = S.next(ui + 1, nxt);
        const char* nA = has_next ? (const char*)g.A + (GATHER ? (size_t)0 : (size_t)nxt.pm * tstep) : cA; const char* nB = has_next ? (const char*)g.Bt + (size_t)nxt.pn * tstep : cB;
        if constexpr (GATHER) nslot = has_next ? ui + 1 : ui;
        for (int t = 0; t < nt; t += 2) {
            const bool last = (t == nt - 2);
            const char* a1 = cA + (size_t)(t + 1) * kstep;
            const char* a2 = last ? nA : cA + (size_t)(t + 2) * kstep; const char* b2 = last ? nB : cB + (size_t)(t + 2) * kstep;
            const char* a3 = a2 + kstep; const char* b3 = b2 + kstep;
            PG8_LDB(B0, 0, 0); PG8_LDB(B1, 0, 1); PG8_SCHED; PG8_LDA(At, 0, 0); PG8_STAGE_A(PG8_SA(1, 1), a1, 1, false);
            PG8_WAIT_V(8); PG8_WAIT_L(0); PG8_BAR; PG8_MMA(0, 0, At, B0); PG8_MMA(0, 1, At, B1); PG8_BAR; PG8_SCHED;
            PG8_LDA(At, 0, 1); PG8_STAGE(PG8_SB(0, 0), b2, voffB); PG8_STAGE(PG8_SB(0, 1), b2 + hstep, voffB); PG8_STAGE_A(PG8_SA(0, 0), a2, 0, last);
            PG8_WAIT_V(8); PG8_WAIT_L(0); PG8_BAR; PG8_MMA(1, 0, At, B0); PG8_MMA(1, 1, At, B1); PG8_BAR; PG8_SCHED;
            PG8_LDB(B0, 1, 0); PG8_LDB(B1, 1, 1); PG8_SCHED; PG8_LDA(At, 1, 0); PG8_STAGE_A(PG8_SA(0, 1), a2, 1, last);
            PG8_WAIT_V(8); PG8_WAIT_L(0); PG8_BAR; PG8_MMA(0, 0, At, B0); PG8_MMA(0, 1, At, B1); PG8_BAR; PG8_SCHED;
            PG8_LDA(At, 1, 1); PG8_STAGE(PG8_SB(1, 0), b3, voffB); PG8_STAGE(PG8_SB(1, 1), b3 + hstep, voffB); PG8_STAGE_A(PG8_SA(1, 0), a3, 0, last);
            PG8_WAIT_V(8); PG8_WAIT_L(0); PG8_BAR; PG8_MMA(1, 0, At, B0); PG8_MMA(1, 1, At, B1); PG8_BAR; PG8_SCHED;
        }
        if (wr == 0) PG8_BAR;
        E(acc, cur, wr, wc, fr, fq);
        if (!has_next) break;
#pragma unroll
        for (int a = 0; a < 2; ++a)
#pragma unroll
            for (int b = 0; b < 2; ++b)
#pragma unroll
                for (int m = 0; m < 4; ++m)
#pragma unroll
                    for (int n = 0; n < 2; ++n) acc[a][b][m][n] = (f32x4){0.f, 0.f, 0.f, 0.f};
        cur = nxt; cA = nA; cB = nB; ++ui;
        if (wr == 1) PG8_BAR;
    }
    PG8_WAIT_V(0);
    PG8_BAR;
#undef PG8_SA
#undef PG8_SB
#undef PG8_GLDS
#undef PG8_STAGE
#undef PG8_STAGE_A
#undef PG8_LDA
#undef PG8_LDB
#undef PG8_MMA
#undef PG8_WAIT_V
#undef PG8_WAIT_L
#undef PG8_BAR
#undef PG8_SCHED
}
}

struct Args { const float* in[23]; float* out; unsigned char* ws; float inv_freq[32]; int ph_lo, ph_hi; };
enum { I_X = 0, I_C, I_POS, I_WADA, I_BADA, I_NMIX, I_NFFN, I_WIN, I_RETN, I_HGRNN, I_LBL, I_WA2, I_BA, I_GLAN, I_WOUT, I_RGW, I_RGB, I_REW, I_REB, I_EG, I_EU, I_ED, I_NFIN };
constexpr int PH_PER_LAYER = 7, PH_FINAL = 1 + 2 * PH_PER_LAYER, N_PHASES = PH_FINAL + 1;

__device__ __forceinline__ void transpose_item(const float* W, int ldw, int K, int k0, int n0, bf16* WT, int dst_row0, LAS float* scr, int lane) {
#pragma unroll 8
    for (int i = 0; i < 32; ++i) { const int kk = 2 * i + (lane >> 5); scr[kk * 33 + (lane & 31)] = W[(size_t)(k0 + kk) * ldw + n0 + (lane & 31)]; }
    LDS_WAIT(); asm volatile("" ::: "memory");
    const int c = lane & 7;
#pragma unroll
    for (int j = 0; j < 4; ++j) { const int n = (lane >> 3) + 8 * j; const LAS float* s = scr + (8 * c) * 33 + n;
        u32x4 o; o.x = pk2(s[0 * 33], s[1 * 33]); o.y = pk2(s[2 * 33], s[3 * 33]); o.z = pk2(s[4 * 33], s[5 * 33]); o.w = pk2(s[6 * 33], s[7 * 33]);
        *(u32x4*)(WT + (size_t)(dst_row0 + n) * K + k0 + 8 * c) = o; }
    LDS_WAIT(); asm volatile("" ::: "memory");
}
__device__ __forceinline__ void sincos_acc(float a, float& s, float& c) {
    const double ad = (double)a; const double kd = rint(ad * 0.63661977236758134308); const double rd = fma(-kd, 1.57079632679489661923, ad);
    const int q = (int)kd & 3; const float r = (float)rd, r2 = r * r;
    const float sp = r + r * r2 * (-1.6666667163e-1f + r2 * (8.3333337680e-3f + r2 * (-1.9841270114e-4f + r2 * 2.7557314297e-6f)));
    const float cp = 1.0f + r2 * (-0.5f + r2 * (4.1666667908e-2f + r2 * (-1.3888889225e-3f + r2 * (2.4801587642e-5f + r2 * -2.7557314297e-7f))));
    const float ss = (q & 1) ? cp : sp, cc = (q & 1) ? sp : cp;
    s = (q & 2) ? -ss : ss; c = ((q + 1) & 2) ? -cc : cc;
}

typedef const __attribute__((address_space(4))) Args KArgs;
#define KARGS(ap) KArgs* ap = (KArgs*)__builtin_amdgcn_kernarg_segment_ptr(); asm volatile("" : "+s"(ap))
#define PHASE_IDS() int tid = threadIdx.x; asm volatile("" : "+v"(tid)); const int lane = tid & 63, wave = __builtin_amdgcn_readfirstlane(tid >> 6); \
    const int G = gridDim.x, bid = blockIdx.x, gw = bid * 8 + wave, NGW = G * 8; (void)lane; (void)wave; (void)gw; (void)NGW; (void)G; (void)bid

template <int TYPE>
__device__ __forceinline__ void naive_mixer_item(LAS unsigned char* lds, KArgs* ap, int layer, int b, int hh  , int tid) {
    constexpr int DK = (TYPE == 2) ? 32 : 64, DKW = DK / 8;
    LAS float* Qs = (LAS float*)lds; LAS float* Ks = Qs + 4096; LAS float* As = Ks + 4096; LAS float* Vs = As + 4096; LAS float* Os = Vs + 4096; LAS float* Ps = Os + 4096;
    unsigned char* ws = ap->ws;
    const bf16* PROJ = (const bf16*)(ws + WS_PROJ); bf16* H = (bf16*)(ws + WS_H);
    const f32x2* ROPE = (const f32x2*)(ws + WS_ROPE);
    const float* lbl = ap->in[I_LBL]; const float* gba = ap->in[I_BA];
    const int e = tid & 63, w = tid >> 6;
    const int qc = (TYPE == 0 ? C_RQ + hh * 64 : TYPE == 1 ? C_HQ + hh * 64 : C_GQ + hh * 32);
    const int kc = (TYPE == 0 ? C_RK + hh * 64 : TYPE == 1 ? C_HF + hh * 64 : C_GK + hh * 32);
    const int vc = (TYPE == 0 ? C_RV : TYPE == 1 ? C_HI : C_GV) + hh * 64;
    const int gc = (TYPE == 0 ? C_RG : TYPE == 1 ? C_HG : C_GG) + hh * 64;
    const int mc = (TYPE == 0 ? 0 : TYPE == 1 ? 384 : 768) + hh * 64;
    const float* gain = ap->in[TYPE == 0 ? I_RETN : TYPE == 1 ? I_HGRNN : I_GLAN] + layer * (TYPE == 2 ? 256 : 384) + hh * 64;
    float S[DKW];
#pragma unroll
    for (int i = 0; i < DKW; ++i) S[i] = 0.f;
    for (int n = 0; n < 64; ++n) {
        __syncthreads();
        const size_t row0 = (size_t)b * SEQ + (size_t)n * 64;
        for (int idx = tid; idx < 4096; idx += 512) {
            const int t = idx >> 6, d = idx & 63; const bf16* p = PROJ + (row0 + t) * NPROJ;
            Vs[idx] = bf2f(p[vc + d]);
            if (TYPE == 0) {
                const int j = d & 31; const f32x2 cs = ROPE[(row0 + t) * 32 + j];
                const float q1 = bf2f(p[qc + j]), q2 = bf2f(p[qc + 32 + j]), k1 = bf2f(p[kc + j]), k2 = bf2f(p[kc + 32 + j]);
                Qs[idx] = d < 32 ? q1 * cs.x - q2 * cs.y : q1 * cs.y + q2 * cs.x;
                Ks[idx] = (d < 32 ? k1 * cs.x - k2 * cs.y : k1 * cs.y + k2 * cs.x) * 0.125f;
                As[idx] = 1.0f - exp2f(-5.0f - (float)hh);
            } else if (TYPE == 1) {
                const float l0 = lbl[hh * 64 + d], l1 = lbl[384 + hh * 64 + d]; const float mx = fmaxf(l0, l1), e0 = expf(l0 - mx), e1 = expf(l1 - mx);
                const float lb = layer == 0 ? 0.f : e1 / (e0 + e1);
                const float z = bf2f(p[kc + d]); const float f = lb + (1.0f - lb) * sigmoidf_(z);
                As[idx] = fmaxf(f, 1e-30f); Ks[idx] = (1.0f - lb) * sigmoidf_(-z); Qs[idx] = siluf_(bf2f(p[qc + d])) * 0.125f;
            } else {
                if (d < 32) { const float pre = bf2f(p[C_GA + hh * 32 + d]) + gba[layer * 128 + hh * 32 + d];
                    const float ls = fminf(pre, 0.f) - log1pf(expf(-fabsf(pre)));
                    As[t * 64 + d] = expf(ls * (1.0f / 16.0f)); Ks[t * 64 + d] = bf2f(p[kc + d]); Qs[t * 64 + d] = bf2f(p[qc + d]) * 0.17677669529663687f; }
            }
        }
        __syncthreads();
        for (int t0 = 0; t0 < 64; t0 += 16) {
            for (int tt = 0; tt < 16; ++tt) { const int t = t0 + tt; const float v = Vs[t * 64 + e]; float part = 0.f;
#pragma unroll
                for (int i = 0; i < DKW; ++i) { const int d = w * DKW + i; S[i] = As[t * 64 + d] * S[i] + Ks[t * 64 + d] * v; part += Qs[t * 64 + d] * S[i]; }
                Ps[(tt * 8 + w) * 64 + e] = part; }
            __syncthreads();
            for (int idx = tid; idx < 1024; idx += 512) { const int tt = idx >> 6, ee = idx & 63; float o = 0.f;
#pragma unroll
                for (int ww = 0; ww < 8; ++ww) o += Ps[(tt * 8 + ww) * 64 + ee];
                Os[(t0 + tt) * 64 + ee] = o; }
            __syncthreads();
        }
        for (int tt = 0; tt < 8; ++tt) { const int t = w * 8 + tt; const float o = Os[t * 64 + e]; const float ss = wave_sum(o * o); const float r = rsqrtf(ss * (1.0f / 64.0f) + EPS);
            const float g = bf2f(PROJ[(row0 + t) * NPROJ + gc + e]);
            H[(row0 + t) * D + mc + e] = (bf16)f2bf(o * r * gain[e] * siluf_(g)); }
    }
}

constexpr int MX_PITCH = 72;
constexpr int MX_ARR = 64 * MX_PITCH * 2;
constexpr int MX_GROUP_BYTES = 5 * MX_ARR + 5 * 256 + 256;
__device__ __forceinline__ float wave_incl_scan(float v, int lane) {
#pragma unroll
    for (int off = 1; off < 64; off <<= 1) { const float u = __shfl_up(v, off); v += (lane >= off) ? u : 0.f; }
    return v;
}
__device__ __forceinline__ float rdlane(float v, int l) { return __builtin_bit_cast(float, __builtin_amdgcn_readlane(__builtin_bit_cast(int, v), l)); }
__device__ __forceinline__ float bfx(const u32x4& r, int i) { const unsigned w = r[i >> 1]; return (i & 1) ? bfhi(w) : bflo(w); }
__device__ __forceinline__ unsigned short bfbits(const u32x4& r, int i) { const unsigned w = r[i >> 1]; return (unsigned short)((i & 1) ? (w >> 16) : (w & 0xffffu)); }

template <int TYPE>
__device__ __forceinline__ void mixer_chunked(LAS unsigned char* lds, KArgs* ap, int layer, int b, int hh, int tid, int chunk0, int nchunks) {
    constexpr int DK = (TYPE == 2) ? 32 : 64, NKS = DK / 32;
    const int lane = tid & 63, wv = __builtin_amdgcn_readfirstlane(tid >> 6), gid = wv >> 2, w = wv & 3, col = lane & 15, rg = lane >> 4;
    LAS unsigned char* gb = lds + gid * MX_GROUP_BYTES;
    LAS bf16* Qt = (LAS bf16*)gb; LAS bf16* Kt = Qt + 64 * MX_PITCH; LAS bf16* KT = Kt + 64 * MX_PITCH; LAS bf16* VT = KT + 64 * MX_PITCH; LAS bf16* ST = VT + 64 * MX_PITCH;
    LAS float* EM = (LAS float*)(gb + 5 * MX_ARR); LAS float* EL = EM + 64; LAS float* ELM = EL + 64; LAS float* LBt = ELM + 64; LAS float* OMLt = LBt + 64;
    unsigned char* ws = ap->ws;
    const bf16* PROJ = (const bf16*)(ws + WS_PROJ); bf16* H = (bf16*)(ws + WS_H);
    const int qc = (TYPE == 0 ? C_RQ + hh * 64 : TYPE == 1 ? C_HQ + hh * 64 : C_GQ + hh * 32);
    const int kc = (TYPE == 0 ? C_RK + hh * 64 : TYPE == 1 ? C_HF + hh * 64 : C_GK + hh * 32);
    const int vc = (TYPE == 0 ? C_RV : TYPE == 1 ? C_HI : C_GV) + hh * 64;
    const int gc = (TYPE == 0 ? C_RG : TYPE == 1 ? C_HG : C_GG) + hh * 64;
    const int mc = (TYPE == 0 ? 0 : TYPE == 1 ? 384 : 768) + hh * 64;
    const float* gain = ap->in[TYPE == 0 ? I_RETN : TYPE == 1 ? I_HGRNN : I_GLAN] + layer * (TYPE == 2 ? 256 : 384) + hh * 64;
    const float lgam = (TYPE == 0) ? log1pf(-exp2f(-5.0f - (float)hh)) : 0.f;
    float gba[16];
    if constexpr (TYPE == 2) { int zl = 0; asm volatile("" : "+v"(zl)); const float* gbap = ap->in[I_BA] + layer * 128 + hh * 32 + 16 * (w & 1) + zl;
#pragma unroll
        for (int p = 0; p < 16; ++p) gba[p] = gbap[p]; }
    if constexpr (TYPE == 1) {
        if (w == 0) { const float* lbl = ap->in[I_LBL]; const float l0 = lbl[hh * 64 + lane], l1 = lbl[384 + hh * 64 + lane]; const float mx = fmaxf(l0, l1), e0 = expf(l0 - mx), e1 = expf(l1 - mx);
            const float lb = layer == 0 ? 0.f : e1 / (e0 + e1); LBt[lane] = lb; OMLt[lane] = 1.0f - lb; }
    }
    f32x4 S[4];
#pragma unroll
    for (int et = 0; et < 4; ++et) S[et] = (f32x4){0.f, 0.f, 0.f, 0.f};
    const bool owner = (w < DK / 16);
    const size_t rowbase = (size_t)b * SEQ + (size_t)chunk0 * 64;
    u32x4 rq[2], rk[2], rv[2], rr[4], rq2[2], rk2[2]; const f32x2* ropep = nullptr;
#define MX_LOAD_RAW(n) do { const bf16* p_ = PROJ + (rowbase + (size_t)(n) * 64 + lane) * NPROJ; \
        if constexpr (TYPE == 0) { rq[0] = *(const u32x4*)(p_ + qc + 16 * w); rq[1] = *(const u32x4*)(p_ + qc + 16 * w + 8); rk[0] = *(const u32x4*)(p_ + kc + 16 * w); rk[1] = *(const u32x4*)(p_ + kc + 16 * w + 8); \
            rq2[0] = *(const u32x4*)(p_ + qc + 16 * (w ^ 2)); rq2[1] = *(const u32x4*)(p_ + qc + 16 * (w ^ 2) + 8); rk2[0] = *(const u32x4*)(p_ + kc + 16 * (w ^ 2)); rk2[1] = *(const u32x4*)(p_ + kc + 16 * (w ^ 2) + 8); \
            ropep = (const f32x2*)(ws + WS_ROPE) + (rowbase + (size_t)(n) * 64 + lane) * 32 + 16 * (w & 1); } \
        else if constexpr (TYPE == 1) { rq[0] = *(const u32x4*)(p_ + qc + 16 * w); rq[1] = *(const u32x4*)(p_ + qc + 16 * w + 8); rk[0] = *(const u32x4*)(p_ + kc + 16 * w); rk[1] = *(const u32x4*)(p_ + kc + 16 * w + 8); } \
        else { if (w < 2) { rq[0] = *(const u32x4*)(p_ + qc + 16 * w); rq[1] = *(const u32x4*)(p_ + qc + 16 * w + 8); rk[0] = *(const u32x4*)(p_ + kc + 16 * w); rk[1] = *(const u32x4*)(p_ + kc + 16 * w + 8); \
                            rr[0] = *(const u32x4*)(p_ + C_GA + hh * 32 + 16 * w); rr[1] = *(const u32x4*)(p_ + C_GA + hh * 32 + 16 * w + 8); } } \
        rv[0] = *(const u32x4*)(p_ + vc + 16 * w); rv[1] = *(const u32x4*)(p_ + vc + 16 * w + 8); } while (0)
    MX_LOAD_RAW(0);
    __syncthreads();
    for (int n = 0; n < nchunks; ++n) {
        float em4[4];
        {
            float Qr[16], Kr[16];
            if (TYPE != 2 || w < 2) {
                float c[16]; float myM = 0.f, myL = 0.f;
                if constexpr (TYPE == 0) {
#pragma unroll
                    for (int p = 0; p < 16; ++p) { const f32x2 cs2 = ropep[p]; const float cs = cs2.x, sn = cs2.y;
                        const float qs = bfx(rq[p >> 3], p & 7), qp = bfx(rq2[p >> 3], p & 7), ks_ = bfx(rk[p >> 3], p & 7), kp = bfx(rk2[p >> 3], p & 7);
                        if (w < 2) { Qr[p] = qs * cs - qp * sn; Kr[p] = (ks_ * cs - kp * sn) * 0.125f; } else { Qr[p] = qp * sn + qs * cs; Kr[p] = (kp * sn + ks_ * cs) * 0.125f; } }
#pragma unroll
                    for (int p = 0; p < 16; ++p) c[p] = (float)(lane + 1) * lgam;
                } else if constexpr (TYPE == 1) {
                    const f32x4 lb0 = *(const LAS f32x4*)(LBt + 16 * w), lb1 = *(const LAS f32x4*)(LBt + 16 * w + 4), lb2 = *(const LAS f32x4*)(LBt + 16 * w + 8), lb3 = *(const LAS f32x4*)(LBt + 16 * w + 12);
                    const f32x4 om0 = *(const LAS f32x4*)(OMLt + 16 * w), om1 = *(const LAS f32x4*)(OMLt + 16 * w + 4), om2 = *(const LAS f32x4*)(OMLt + 16 * w + 8), om3 = *(const LAS f32x4*)(OMLt + 16 * w + 12);
#pragma unroll
                    for (int p = 0; p < 16; ++p) { const float lb = (p < 4 ? lb0 : p < 8 ? lb1 : p < 12 ? lb2 : lb3)[p & 3], om = (p < 4 ? om0 : p < 8 ? om1 : p < 12 ? om2 : om3)[p & 3];
                        const float z = bfx(rk[p >> 3], p & 7), qv = bfx(rq[p >> 3], p & 7); const float sg = 1.0f / (1.0f + __expf(-z));
                        const float f = lb + om * sg; c[p] = __logf(fmaxf(f, 1e-30f)); Kr[p] = om * (1.0f - sg); Qr[p] = qv / (1.0f + __expf(-qv)) * 0.125f; }
#pragma unroll
                    for (int p = 0; p < 16; ++p) c[p] = wave_incl_scan(c[p], lane);
                } else {
#pragma unroll
                    for (int p = 0; p < 16; ++p) { const float pre = bfx(rr[p >> 3], p & 7) + gba[p];
                        c[p] = (fminf(pre, 0.f) - __logf(1.0f + __expf(-fabsf(pre)))) * (1.0f / 16.0f); Kr[p] = bfx(rk[p >> 3], p & 7); Qr[p] = bfx(rq[p >> 3], p & 7) * 0.17677669529663687f; }
#pragma unroll
                    for (int p = 0; p < 16; ++p) c[p] = wave_incl_scan(c[p], lane);
                }
#pragma unroll
                for (int p = 0; p < 16; ++p) { const float m = rdlane(c[p], 31), cl = rdlane(c[p], 63); Qr[p] *= __expf(c[p] - m); Kr[p] *= __expf(m - c[p]);
                    myM = (lane == p) ? m : myM; myL = (lane == p) ? cl : myL; }
                if (lane < 16) { EM[16 * w + lane] = __expf(myM); EL[16 * w + lane] = __expf(myL); ELM[16 * w + lane] = __expf(myL - myM); }
                LDS_WAIT();
                const f32x4 e4 = *(const LAS f32x4*)(EM + 16 * w + 4 * rg);
#pragma unroll
                for (int i = 0; i < 4; ++i) em4[i] = e4[i];
            } else {
#pragma unroll
                for (int i = 0; i < 4; ++i) em4[i] = 0.f;
            }
            if (TYPE != 2 || w < 2) {
                u32x4 q0, q1, k0, k1;
                q0.x = pg8::cvt_pk_bf16(Qr[0], Qr[1]); q0.y = pg8::cvt_pk_bf16(Qr[2], Qr[3]); q0.z = pg8::cvt_pk_bf16(Qr[4], Qr[5]); q0.w = pg8::cvt_pk_bf16(Qr[6], Qr[7]);
                q1.x = pg8::cvt_pk_bf16(Qr[8], Qr[9]); q1.y = pg8::cvt_pk_bf16(Qr[10], Qr[11]); q1.z = pg8::cvt_pk_bf16(Qr[12], Qr[13]); q1.w = pg8::cvt_pk_bf16(Qr[14], Qr[15]);
                k0.x = pg8::cvt_pk_bf16(Kr[0], Kr[1]); k0.y = pg8::cvt_pk_bf16(Kr[2], Kr[3]); k0.z = pg8::cvt_pk_bf16(Kr[4], Kr[5]); k0.w = pg8::cvt_pk_bf16(Kr[6], Kr[7]);
                k1.x = pg8::cvt_pk_bf16(Kr[8], Kr[9]); k1.y = pg8::cvt_pk_bf16(Kr[10], Kr[11]); k1.z = pg8::cvt_pk_bf16(Kr[12], Kr[13]); k1.w = pg8::cvt_pk_bf16(Kr[14], Kr[15]);
                *(LAS u32x4*)(Qt + lane * MX_PITCH + 16 * w) = q0; *(LAS u32x4*)(Qt + lane * MX_PITCH + 16 * w + 8) = q1;
                *(LAS u32x4*)(Kt + lane * MX_PITCH + 16 * w) = k0; *(LAS u32x4*)(Kt + lane * MX_PITCH + 16 * w + 8) = k1;
#pragma unroll
                for (int p = 0; p < 16; ++p) KT[(16 * w + p) * MX_PITCH + lane] = bfbits(p < 8 ? k0 : k1, p & 7);
            }
#pragma unroll
            for (int p = 0; p < 16; ++p) VT[(16 * w + p) * MX_PITCH + lane] = bfbits(rv[p >> 3], p & 7);
            if (owner) {
#pragma unroll
                for (int et = 0; et < 4; ++et) { u32x2 o; o.x = pg8::cvt_pk_bf16(S[et][0] * em4[0], S[et][1] * em4[1]); o.y = pg8::cvt_pk_bf16(S[et][2] * em4[2], S[et][3] * em4[3]);
                    *(LAS u32x2*)(ST + (16 * et + col) * MX_PITCH + 16 * w + 4 * rg) = o; }
            }
        }
        __syncthreads();
        const size_t trow = rowbase + (size_t)n * 64 + 16 * w + col;
        u32x2 gt[4];
#pragma unroll
        for (int et = 0; et < 4; ++et) gt[et] = *(const u32x2*)(PROJ + trow * NPROJ + gc + 16 * et + 4 * rg);
        if (n + 1 < nchunks) { MX_LOAD_RAW(n + 1); }
        bf16x8 Bq[NKS];
#pragma unroll
        for (int ks = 0; ks < NKS; ++ks) Bq[ks] = *(const LAS bf16x8*)(Qt + (16 * w + col) * MX_PITCH + 32 * ks + 8 * rg);
        f32x4 PT[4];
#pragma unroll
        for (int st = 0; st < 4; ++st) { PT[st] = (f32x4){0.f, 0.f, 0.f, 0.f};
            if (st <= w) {
#pragma unroll
                for (int ks = 0; ks < NKS; ++ks) { const bf16x8 af = *(const LAS bf16x8*)(Kt + (16 * st + col) * MX_PITCH + 32 * ks + 8 * rg); PT[st] = __builtin_amdgcn_mfma_f32_16x16x32_bf16(af, Bq[ks], PT[st], 0, 0, 0); }
                if (st == w) {
#pragma unroll
                    for (int i = 0; i < 4; ++i) PT[st][i] = (4 * rg + i > col) ? 0.f : PT[st][i]; }
            } }
        u32x4 pb0, pb1;
        pb0.x = pg8::cvt_pk_bf16(PT[0][0], PT[0][1]); pb0.y = pg8::cvt_pk_bf16(PT[0][2], PT[0][3]); pb0.z = pg8::cvt_pk_bf16(PT[1][0], PT[1][1]); pb0.w = pg8::cvt_pk_bf16(PT[1][2], PT[1][3]);
        pb1.x = pg8::cvt_pk_bf16(PT[2][0], PT[2][1]); pb1.y = pg8::cvt_pk_bf16(PT[2][2], PT[2][3]); pb1.z = pg8::cvt_pk_bf16(PT[3][0], PT[3][1]); pb1.w = pg8::cvt_pk_bf16(PT[3][2], PT[3][3]);
        f32x4 OT[4];
#pragma unroll
        for (int et = 0; et < 4; ++et) { OT[et] = (f32x4){0.f, 0.f, 0.f, 0.f};
#pragma unroll
            for (int ks = 0; ks < NKS; ++ks) { const bf16x8 af = *(const LAS bf16x8*)(ST + (16 * et + col) * MX_PITCH + 32 * ks + 8 * rg); OT[et] = __builtin_amdgcn_mfma_f32_16x16x32_bf16(af, Bq[ks], OT[et], 0, 0, 0); }
            { const u32x2 a0 = *(const LAS u32x2*)(VT + (16 * et + col) * MX_PITCH + 4 * rg), a1 = *(const LAS u32x2*)(VT + (16 * et + col) * MX_PITCH + 16 + 4 * rg);
              u32x4 av; av.x = a0.x; av.y = a0.y; av.z = a1.x; av.w = a1.y;
              OT[et] = __builtin_amdgcn_mfma_f32_16x16x32_bf16(__builtin_bit_cast(bf16x8, av), __builtin_bit_cast(bf16x8, pb0), OT[et], 0, 0, 0); }
            if (w >= 2) { const u32x2 a0 = *(const LAS u32x2*)(VT + (16 * et + col) * MX_PITCH + 32 + 4 * rg), a1 = *(const LAS u32x2*)(VT + (16 * et + col) * MX_PITCH + 48 + 4 * rg);
              u32x4 av; av.x = a0.x; av.y = a0.y; av.z = a1.x; av.w = a1.y;
              OT[et] = __builtin_amdgcn_mfma_f32_16x16x32_bf16(__builtin_bit_cast(bf16x8, av), __builtin_bit_cast(bf16x8, pb1), OT[et], 0, 0, 0); }
        }
        if (owner) {
            const f32x4 el = *(const LAS f32x4*)(EL + 16 * w + 4 * rg), elm = *(const LAS f32x4*)(ELM + 16 * w + 4 * rg);
#pragma unroll
            for (int et = 0; et < 4; ++et) { f32x4 W = (f32x4){0.f, 0.f, 0.f, 0.f};
#pragma unroll
                for (int ks = 0; ks < 2; ++ks) { const bf16x8 af = *(const LAS bf16x8*)(KT + (16 * w + col) * MX_PITCH + 32 * ks + 8 * rg), bfr = *(const LAS bf16x8*)(VT + (16 * et + col) * MX_PITCH + 32 * ks + 8 * rg);
                    W = __builtin_amdgcn_mfma_f32_16x16x32_bf16(af, bfr, W, 0, 0, 0); }
                S[et] = el * S[et] + elm * W; }
        }
        { float ss = 0.f;
#pragma unroll
          for (int et = 0; et < 4; ++et) ss += (OT[et][0] * OT[et][0] + OT[et][1] * OT[et][1]) + (OT[et][2] * OT[et][2] + OT[et][3] * OT[et][3]);
          ss += __shfl_xor(ss, 16); ss += __shfl_xor(ss, 32);
          const float r = rsqrtf(ss * (1.0f / 64.0f) + EPS);
#pragma unroll
          for (int et = 0; et < 4; ++et) { const f32x4 g4 = *(const f32x4*)(gain + 16 * et + 4 * rg);
              const float g0 = bflo(gt[et].x), g1 = bfhi(gt[et].x), g2 = bflo(gt[et].y), g3 = bfhi(gt[et].y);
              const float o0 = OT[et][0] * r * g4[0] * (g0 / (1.0f + __expf(-g0))), o1 = OT[et][1] * r * g4[1] * (g1 / (1.0f + __expf(-g1)));
              const float o2 = OT[et][2] * r * g4[2] * (g2 / (1.0f + __expf(-g2))), o3 = OT[et][3] * r * g4[3] * (g3 / (1.0f + __expf(-g3)));
              u32x2 o; o.x = pg8::cvt_pk_bf16(o0, o1); o.y = pg8::cvt_pk_bf16(o2, o3);
              *(u32x2*)(H + trow * D + mc + 16 * et + 4 * rg) = o; } }
        __syncthreads();
    }
#undef MX_LOAD_RAW
}

#ifndef MK_MIX_MASK
#define MK_MIX_MASK 7
#endif
__device__ __forceinline__ void phase_mixer(LAS unsigned char* lds, int layer) {
    KARGS(ap); PHASE_IDS();
    for (int pr = bid; pr < NB * 8; pr += G) {
        const int b = pr >> 3, hp = pr & 7, hd = 2 * hp + (wave >> 2);
        if (hp < 3) { if (MK_MIX_MASK & 1) mixer_chunked<0>(lds, ap, layer, b, hd, tid, 0, 64); }
        else if (hp < 6) { if (MK_MIX_MASK & 2) mixer_chunked<1>(lds, ap, layer, b, hd - 6, tid, 0, 64); }
        else { if (MK_MIX_MASK & 4) mixer_chunked<2>(lds, ap, layer, b, hd - 12, tid, 0, 64); }
        __syncthreads();
    }
    if (MK_MIX_MASK != 7) {
        for (int it = bid; it < NB * 16; it += G) {
            const int b = it >> 4, hd = it & 15;
            if (hd < 6) { if (!(MK_MIX_MASK & 1)) naive_mixer_item<0>(lds, ap, layer, b, hd, tid); }
            else if (hd < 12) { if (!(MK_MIX_MASK & 2)) naive_mixer_item<1>(lds, ap, layer, b, hd - 6, tid); }
            else { if (!(MK_MIX_MASK & 4)) naive_mixer_item<2>(lds, ap, layer, b, hd - 12, tid); }
            __syncthreads();
        }
    }
}
__device__ __forceinline__ void build_tp(LAS int* TP, const unsigned* cnt, int tid) {
    if (tid == 0) { int s = 0; for (int e = 0; e < 32; ++e) { TP[e] = s; s += ((int)cnt[e] + 255) >> 8; } TP[32] = s; }
    __syncthreads();
}

__device__ __forceinline__ void phase_prologue(LAS unsigned char* lds) {
    KARGS(ap); PHASE_IDS();
    unsigned char* ws = ap->ws;
    if (bid < 192) {
        float* MOD = (float*)(ws + WS_MOD);
        const float* cin = ap->in[I_C]; const float* wada = ap->in[I_WADA]; const float* bada = ap->in[I_BADA];
        LAS float* cact = (LAS float*)lds;
        for (int i = tid; i < 8192; i += 512) { const int b = i >> 10, k = i & 1023; cact[k * 8 + b] = siluf_(cin[i]); }
        __syncthreads();
        LAS float* red = (LAS float*)(lds + 32768);
        for (int it = bid; it < 192; it += G) {
            const int l = it / 96, j0 = (it % 96) * 64; const float* W = wada + (size_t)l * D * 6144 + j0 + lane;
            float acc[8];
#pragma unroll
            for (int b = 0; b < 8; ++b) acc[b] = 0.f;
#pragma unroll 8
            for (int kk = 0; kk < 128; ++kk) { const int k = wave * 128 + kk; const float wv = W[(size_t)k * 6144];
                const f32x4 c0 = *(const LAS f32x4*)(cact + k * 8), c1 = *(const LAS f32x4*)(cact + k * 8 + 4);
                acc[0] += c0[0] * wv; acc[1] += c0[1] * wv; acc[2] += c0[2] * wv; acc[3] += c0[3] * wv; acc[4] += c1[0] * wv; acc[5] += c1[1] * wv; acc[6] += c1[2] * wv; acc[7] += c1[3] * wv; }
#pragma unroll
            for (int b = 0; b < 8; ++b) red[(wave * 8 + b) * 64 + lane] = acc[b];
            __syncthreads();
            { const int b = tid >> 6, col = tid & 63; float s = 0.f;
#pragma unroll
              for (int ww = 0; ww < 8; ++ww) s += red[(ww * 8 + b) * 64 + col];
              MOD[((size_t)l * 8 + b) * 6144 + j0 + col] = s + bada[l * 6144 + j0 + col]; }
            __syncthreads();
        }
    }
    __syncthreads();
    {
        bf16* WIN_T = (bf16*)(ws + WS_WIN); bf16* WOUT_T = (bf16*)(ws + WS_WOUT); bf16* WGU_T = (bf16*)(ws + WS_WGU); bf16* WD_T = (bf16*)(ws + WS_WD);
        LAS float* scr = (LAS float*)(lds + wave * 16384);
        constexpr int I_IN = 16 * 120, I_OUT = 16 * 32, I_G = 16 * 8, I_D = 4 * 32;
        constexpr int PER_L = I_IN + I_OUT + 32 * I_G * 2 + 32 * I_D;
        for (int it = gw; it < 2 * PER_L; it += NGW) {
            const int l = it / PER_L; int r = it % PER_L;
            if (r < I_IN) { const int kb = r / 120, nb = r % 120; transpose_item(ap->in[I_WIN] + (size_t)l * D * INP, INP, D, kb * 64, nb * 32, WIN_T + (size_t)l * NPROJ * D, nb * 32, scr, lane); continue; } r -= I_IN;
            if (r < I_OUT) { const int kb = r / 32, nb = r % 32; transpose_item(ap->in[I_WOUT] + (size_t)l * D * D, D, D, kb * 64, nb * 32, WOUT_T + (size_t)l * D * D, nb * 32, scr, lane); continue; } r -= I_OUT;
            if (r < 32 * I_G * 2) { const int up = r / (32 * I_G); r %= 32 * I_G; const int e = r / I_G; r %= I_G; const int kb = r / 8, nb = r % 8, n0 = nb * 32;
                transpose_item(ap->in[up ? I_EU : I_EG] + ((size_t)l * NEXP + e) * D * DEXP, DEXP, D, kb * 64, n0, WGU_T + ((size_t)l * NEXP + e) * 512 * D, (n0 >> 7) * 256 + (n0 & 127) + up * 128, scr, lane); continue; } r -= 32 * I_G * 2;
            { const int e = r / I_D; r %= I_D; const int kb = r / 32, nb = r % 32;
                transpose_item(ap->in[I_ED] + ((size_t)l * NEXP + e) * DEXP * D, D, DEXP, kb * 64, nb * 32, WD_T + ((size_t)l * NEXP + e) * D * DEXP, nb * 32, scr, lane); }
        }
        const float* win = ap->in[I_WIN]; const float* wa2 = ap->in[I_WA2];
        for (int it = bid * 512 + tid; it < 2 * 256 * 128; it += G * 512) {
            const int l = it / (256 * 128), r = it % (256 * 128), n = r / 128, k0 = (r % 128) * 8;
            float o[8];
#pragma unroll
            for (int j = 0; j < 8; ++j) o[j] = 0.f;
            if (n < 128) {
#pragma unroll
                for (int j = 0; j < 8; ++j) { const float* wr_ = win + (size_t)l * D * INP + (size_t)(k0 + j) * INP + 3840; float s = 0.f;
#pragma unroll
                    for (int rr = 0; rr < 16; ++rr) s += wr_[rr] * wa2[l * 16 * 128 + rr * 128 + n];
                    o[j] = s; } }
            u32x4 w; w.x = pk2(o[0], o[1]); w.y = pk2(o[2], o[3]); w.z = pk2(o[4], o[5]); w.w = pk2(o[6], o[7]);
            *(u32x4*)(WIN_T + (size_t)l * NPROJ * D + (size_t)(3840 + n) * D + k0) = w;
        }
    }
    {
        f32x2* ROPE = (f32x2*)(ws + WS_ROPE); const int* posp = (const int*)ap->in[I_POS];
        for (int it = bid * 512 + tid; it < MTOK * 32; it += G * 512) {
            const int row = it >> 5, j = it & 31; const int pos = posp[row];
            const float ang = (float)pos * ap->inv_freq[j]; float s, c; sincos_acc(ang, s, c); ROPE[it] = (f32x2){c, s};
        }
    }
}

template <int MODE>
__device__ __forceinline__ void phase_norm1(LAS unsigned char* lds, int layer) {
    KARGS(ap); PHASE_IDS();
    unsigned char* ws = ap->ws; float* outp = ap->out;
    const float* MOD = (const float*)(ws + WS_MOD); bf16* H = (bf16*)(ws + WS_H); const bf16* YP = (const bf16*)(ws + WS_YP);
    const int* ROUTE_I = (const int*)(ws + WS_ROUTE); const float* ROUTE_W = (const float*)(ws + WS_ROUTE + 4 * MTOK * 4);
    LAS int* TP = (LAS int*)(lds + TP_OFF);
    const int pl = (MODE == 2) ? DEPTH - 1 : layer - 1;
    if (MODE != 0) build_tp(TP, (const unsigned*)(ws + WS_CTL) + CW_CNT + pl * 64, tid);
    const float* xin = MODE == 0 ? ap->in[I_X] : outp;
    const float* gn = MODE == 2 ? ap->in[I_NFIN] : ap->in[I_NMIX] + layer * D;
    for (int m = gw; m < MTOK; m += NGW) {
        const int b = m >> 12;
        f32x4 v[4];
#pragma unroll
        for (int j = 0; j < 4; ++j) v[j] = *(const f32x4*)(xin + (size_t)m * D + 4 * lane + 256 * j);
        if (MODE != 0) {
            const int e0 = ROUTE_I[m], e1 = ROUTE_I[MTOK + m], r0 = ROUTE_I[2 * MTOK + m], r1 = ROUTE_I[3 * MTOK + m]; const float w0 = ROUTE_W[m], w1 = ROUTE_W[MTOK + m];
            const bf16* y0 = YP + (size_t)(TP[e0] * 256 + r0) * D; const bf16* y1 = YP + (size_t)(TP[e1] * 256 + r1) * D;
            const float* gf = MOD + (size_t)pl * 8 * 6144 + (size_t)b * 6144 + 5 * D;
#pragma unroll
            for (int j = 0; j < 4; ++j) { const u32x2 a0 = *(const u32x2*)(y0 + 4 * lane + 256 * j), a1 = *(const u32x2*)(y1 + 4 * lane + 256 * j); const f32x4 g4 = *(const f32x4*)(gf + 4 * lane + 256 * j);
                v[j][0] += g4[0] * (w0 * bflo(a0.x) + w1 * bflo(a1.x)); v[j][1] += g4[1] * (w0 * bfhi(a0.x) + w1 * bfhi(a1.x));
                v[j][2] += g4[2] * (w0 * bflo(a0.y) + w1 * bflo(a1.y)); v[j][3] += g4[3] * (w0 * bfhi(a0.y) + w1 * bfhi(a1.y));
                if (MODE == 1) *(f32x4*)(outp + (size_t)m * D + 4 * lane + 256 * j) = v[j]; }
        }
        float ss = 0.f;
#pragma unroll
        for (int j = 0; j < 4; ++j) ss += (v[j][0] * v[j][0] + v[j][1] * v[j][1]) + (v[j][2] * v[j][2] + v[j][3] * v[j][3]);
        const float rstd = rsqrtf(wave_sum(ss) * (1.0f / D) + EPS);
        if (MODE == 2) {
#pragma unroll
            for (int j = 0; j < 4; ++j) { const int c0 = 4 * lane + 256 * j; const f32x4 g4 = *(const f32x4*)(gn + c0);
                f32x4 y;
#pragma unroll
                for (int q = 0; q < 4; ++q) y[q] = v[j][q] * rstd * g4[q];
                *(f32x4*)(outp + (size_t)m * D + c0) = y; }
        } else {
            const float* mb = MOD + (size_t)layer * 8 * 6144 + (size_t)b * 6144;
#pragma unroll
            for (int j = 0; j < 4; ++j) { const int c0 = 4 * lane + 256 * j; const f32x4 g4 = *(const f32x4*)(gn + c0), sh = *(const f32x4*)(mb + c0), sc = *(const f32x4*)(mb + D + c0);
                f32x4 y;
#pragma unroll
                for (int q = 0; q < 4; ++q) y[q] = (v[j][q] * rstd * g4[q]) * (1.0f + sc[q]) + sh[q];
                u32x2 o; o.x = pk2(y[0], y[1]); o.y = pk2(y[2], y[3]); *(u32x2*)(H + (size_t)m * D + c0) = o; }
        }
    }
}

__device__ __forceinline__ void phase_inproj(LAS unsigned char* lds, int layer) {
    KARGS(ap); unsigned char* ws = ap->ws;
    pg8::Gemm g{(const bf16*)(ws + WS_H), (const bf16*)(ws + WS_WIN) + (size_t)layer * NPROJ * D, D}; pg8::StaticOrder S; S.init(MTOK, NPROJ, gridDim.x, blockIdx.x);
    pg8::EpiBf16Store E{(bf16*)(ws + WS_PROJ), NPROJ};
    pg8::gemm_phase<pg8::EpiBf16Store, pg8::StaticOrder, false>(lds, g, S, E, nullptr);
}
__device__ __forceinline__ void phase_mixer_naive(LAS unsigned char* lds, int layer) {
    KARGS(ap); PHASE_IDS();
    for (int it = bid; it < NB * 16; it += G) {
        const int b = it >> 4, hd = it & 15;
        if (hd < 6) naive_mixer_item<0>(lds, ap, layer, b, hd, tid);
        else if (hd < 12) naive_mixer_item<1>(lds, ap, layer, b, hd - 6, tid);
        else naive_mixer_item<2>(lds, ap, layer, b, hd - 12, tid);
        __syncthreads();
    }
}
__device__ __forceinline__ void phase_outproj(LAS unsigned char* lds, int layer) {
    KARGS(ap); unsigned char* ws = ap->ws; float* outp = ap->out;
    pg8::Gemm g{(const bf16*)(ws + WS_H), (const bf16*)(ws + WS_WOUT) + (size_t)layer * D * D, D}; pg8::StaticOrder S; S.init(MTOK, D, gridDim.x, blockIdx.x);
    pg8::EpiResGate E{layer == 0 ? ap->in[I_X] : outp, outp, (const float*)(ws + WS_MOD) + (size_t)layer * 8 * 6144 + 2 * D};
    pg8::gemm_phase<pg8::EpiResGate, pg8::StaticOrder, false>(lds, g, S, E, nullptr);
}
__device__ __forceinline__ void phase_norm2_router(LAS unsigned char* lds, int layer) {
    KARGS(ap); PHASE_IDS();
    unsigned char* ws = ap->ws; const float* xres = ap->out;
    bf16* H = (bf16*)(ws + WS_H);
    int* ROUTE_I = (int*)(ws + WS_ROUTE); float* ROUTE_W = (float*)(ws + WS_ROUTE + 4 * MTOK * 4); int* IDX2 = (int*)(ws + WS_IDX2);
    unsigned* cntl = (unsigned*)(ws + WS_CTL) + CW_CNT + layer * 64;
    LAS bf16* Wr = (LAS bf16*)lds;
    { const float* rgw = ap->in[I_RGW] + (size_t)layer * D * 4; const float* rew = ap->in[I_REW] + (size_t)layer * D * 32;
      for (int i = tid; i < 36 * 1024; i += 512) { const int n = i >> 10, k = i & 1023; const float wv = n < 4 ? rgw[k * 4 + n] : rew[k * 32 + (n - 4)]; Wr[i] = (bf16)f2bf(wv); } }
    __syncthreads();
    const float* gn = ap->in[I_NFFN] + layer * D; const float* rgb = ap->in[I_RGB] + layer * 4; const float* reb = ap->in[I_REB] + layer * 32;
    const float* modl = (const float*)(ws + WS_MOD) + (size_t)layer * 8 * 6144;
    for (int m = gw; m < MTOK; m += NGW) {
        const int b = m >> 12; const float* mb = modl + (size_t)b * 6144 + 3 * D;
        f32x4 v[4];
#pragma unroll
        for (int j = 0; j < 4; ++j) v[j] = *(const f32x4*)(xres + (size_t)m * D + 4 * lane + 256 * j);
        float ss = 0.f;
#pragma unroll
        for (int j = 0; j < 4; ++j) ss += (v[j][0] * v[j][0] + v[j][1] * v[j][1]) + (v[j][2] * v[j][2] + v[j][3] * v[j][3]);
        const float rstd = rsqrtf(wave_sum(ss) * (1.0f / D) + EPS);
#pragma unroll
        for (int j = 0; j < 4; ++j) { const int c0 = 4 * lane + 256 * j; const f32x4 g4 = *(const f32x4*)(gn + c0), sh = *(const f32x4*)(mb + c0), sc = *(const f32x4*)(mb + D + c0);
#pragma unroll
            for (int q = 0; q < 4; ++q) v[j][q] = (v[j][q] * rstd * g4[q]) * (1.0f + sc[q]) + sh[q];
            u32x2 o; o.x = pk2(v[j][0], v[j][1]); o.y = pk2(v[j][2], v[j][3]); *(u32x2*)(H + (size_t)m * D + c0) = o; }
        float lgv = 0.f;
#pragma unroll 2
        for (int n = 0; n < 36; ++n) { float p = 0.f;
#pragma unroll
            for (int j = 0; j < 4; ++j) { const u32x2 wv = *(const LAS u32x2*)(Wr + n * 1024 + 4 * lane + 256 * j);
                p += v[j][0] * bflo(wv.x) + v[j][1] * bfhi(wv.x) + v[j][2] * bflo(wv.y) + v[j][3] * bfhi(wv.y); }
            const float s = wave_sum(p); lgv = (lane == n) ? s : lgv; }
        float gl[4];
#pragma unroll
        for (int q = 0; q < 4; ++q) gl[q] = __shfl(lgv, q) + rgb[q];
        int gi = 0; float gm = gl[0];
#pragma unroll
        for (int q = 1; q < 4; ++q) if (gl[q] > gm) { gm = gl[q]; gi = q; }
        float gs = 0.f;
#pragma unroll
        for (int q = 0; q < 4; ++q) gs += __expf(gl[q] - gm);
        const float gwt = 1.0f / gs;
        float el[8];
#pragma unroll
        for (int q = 0; q < 8; ++q) el[q] = __shfl(lgv, 4 + gi * 8 + q) + reb[gi * 8 + q];
        int i0 = 0; float m0 = el[0];
#pragma unroll
        for (int q = 1; q < 8; ++q) if (el[q] > m0) { m0 = el[q]; i0 = q; }
        int i1 = -1; float m1 = -3.0e38f;
#pragma unroll
        for (int q = 0; q < 8; ++q) if (q != i0 && el[q] > m1) { m1 = el[q]; i1 = q; }
        const float ex = __expf(m1 - m0); const float w0 = gwt / (1.0f + ex), w1 = gwt * ex / (1.0f + ex);
        if (lane == 0) {
            const int e0 = gi * 8 + i0, e1 = gi * 8 + i1;
            const int r0 = (int)atomicAdd(cntl + e0, 1u), r1 = (int)atomicAdd(cntl + e1, 1u);
            IDX2[e0 * MTOK + r0] = m; IDX2[e1 * MTOK + r1] = m;
            ROUTE_I[m] = e0; ROUTE_I[MTOK + m] = e1; ROUTE_I[2 * MTOK + m] = r0; ROUTE_I[3 * MTOK + m] = r1; ROUTE_W[m] = w0; ROUTE_W[MTOK + m] = w1;
        }
    }
}
__device__ __forceinline__ void phase_moe_up(LAS unsigned char* lds, int layer) {
    KARGS(ap); unsigned char* ws = ap->ws;
    LAS int* TP = (LAS int*)(lds + TP_OFF); LAS int* AUX = (LAS int*)(lds + AUX_OFF);
    const unsigned* cntl = (const unsigned*)(ws + WS_CTL) + CW_CNT + layer * 64;
    { int tid = threadIdx.x; build_tp(TP, cntl, tid);
      pg8::MoeOrder S0; S0.G = gridDim.x; S0.c = blockIdx.x; S0.npt = 2; S0.total = TP[32] * 2; S0.tp = TP;
      const int* IDX2 = (const int*)(ws + WS_IDX2);
      pg8::Unit u; for (int i = 0; i < 8; ++i) { if (!S0.next(i, u)) break; const int e = u.pn >> 1, j = u.pm - TP[e], cnt = (int)cntl[e];
          if (tid < 256) { const int rank = j * 256 + tid; AUX[i * 256 + tid] = (rank < cnt ? IDX2[e * MTOK + rank] : 0) * (D * 2); } }
      __syncthreads(); }
    pg8::MoeOrder S; S.G = gridDim.x; S.c = blockIdx.x; S.npt = 2; S.total = TP[32] * 2; S.tp = TP;
    pg8::Gemm g{(const bf16*)(ws + WS_H), (const bf16*)(ws + WS_WGU) + (size_t)layer * NEXP * 512 * D, D};
    pg8::EpiSwiGLU E{(bf16*)(ws + WS_HID)};
    pg8::gemm_phase<pg8::EpiSwiGLU, pg8::MoeOrder, true>(lds, g, S, E, AUX);
}
__device__ __forceinline__ void phase_moe_down(LAS unsigned char* lds, int layer) {
    KARGS(ap); unsigned char* ws = ap->ws;
    LAS int* TP = (LAS int*)(lds + TP_OFF);
    build_tp(TP, (const unsigned*)(ws + WS_CTL) + CW_CNT + layer * 64, threadIdx.x);
    pg8::MoeOrder S; S.G = gridDim.x; S.c = blockIdx.x; S.npt = 4; S.total = TP[32] * 4; S.tp = TP;
    pg8::Gemm g{(const bf16*)(ws + WS_HID), (const bf16*)(ws + WS_WD) + (size_t)layer * NEXP * D * DEXP, DEXP};
    pg8::EpiBf16Store E{(bf16*)(ws + WS_YP), D};
    pg8::gemm_phase<pg8::EpiBf16Store, pg8::MoeOrder, false>(lds, g, S, E, nullptr);
}

__global__ void __launch_bounds__(512, 2) fwd(Args a) {
    extern __shared__ __attribute__((aligned(16))) unsigned char lds_raw[];
    LAS unsigned char* lds = (LAS unsigned char*)lds_raw;
    volatile LAS unsigned* MISC = (volatile LAS unsigned*)(lds + LDSCTL_OFF);
    for (int u = threadIdx.x; u < (LDS_BYTES - LDSCTL_OFF) / 4; u += 512) ((LAS unsigned*)(lds + LDSCTL_OFF))[u] = 0u;
    __syncthreads();
#if MK_ONE_LAUNCH
    { unsigned* ctl0 = (unsigned*)(a.ws + WS_CTL); (void)xcd_barrier_post(ctl0 + CW_BAR, MISC + 8); }
    constexpr int lo = 0, hi = N_PHASES;
#define SEAM(k) do { if ((k) + 1 < hi) { KARGS(_ap); XcdBarrier _b; _b.bar = (unsigned*)(_ap->ws + WS_CTL) + CW_BAR; _b.x = xb_xcc_id(); _b.st = (volatile LAS unsigned*)(lds + LDSCTL_OFF) + 8; xcd_barrier(_b); } } while (0)
#else
    (void)MISC;
    const int lo = a.ph_lo, hi = a.ph_hi;
#define SEAM(k) do { } while (0)
#endif
#define IN(k) (lo <= (k) && (k) < hi)
    if (EN_P0 && IN(0)) { phase_prologue(lds); SEAM(0); }
#define LAYER_PHASES(layer) do { constexpr int pb = 1 + PH_PER_LAYER * (layer); \
        if (EN_PA && IN(pb + 0)) { if ((layer) == 0) phase_norm1<0>(lds, (layer)); else phase_norm1<1>(lds, (layer)); SEAM(pb + 0); } \
        if (EN_PB && IN(pb + 1)) { phase_inproj(lds, (layer)); SEAM(pb + 1); } \
        if (EN_PC && IN(pb + 2)) { if (MK_NAIVE_MIXER) phase_mixer_naive(lds, (layer)); else phase_mixer(lds, (layer)); SEAM(pb + 2); } \
        if (EN_PD && IN(pb + 3)) { phase_outproj(lds, (layer)); SEAM(pb + 3); } \
        if (EN_PE && IN(pb + 4)) { phase_norm2_router(lds, (layer)); SEAM(pb + 4); } \
        if (EN_PG && IN(pb + 5)) { phase_moe_up(lds, (layer)); SEAM(pb + 5); } \
        if (EN_PH && IN(pb + 6)) { phase_moe_down(lds, (layer)); SEAM(pb + 6); } } while (0)
    LAYER_PHASES(0);
    LAYER_PHASES(1);
#undef LAYER_PHASES
    if (EN_PF && IN(PH_FINAL)) phase_norm1<2>(lds, 0);
#undef IN
#undef SEAM
}

extern "C" void kernel_launch(void* const* d_in, const int* in_sizes, int n_in, void* d_out, int out_size, void* d_ws, size_t ws_size, hipStream_t stream) {
    static int grid = 0;
    if (grid == 0) {
        if (n_in != 23 || out_size != MTOK * D || ws_size < WS_END) { fprintf(stderr, "kernel_launch: unexpected shapes (n_in %d out %d ws %zu)\n", n_in, out_size, ws_size); grid = -1; return; }
        int dev = 0, cus = 0;
        if (hipGetDevice(&dev) != hipSuccess || hipDeviceGetAttribute(&cus, hipDeviceAttributeMultiprocessorCount, dev) != hipSuccess) { grid = -1; return; }
        if (hipFuncSetAttribute((const void*)fwd, hipFuncAttributeMaxDynamicSharedMemorySize, LDS_BYTES) != hipSuccess) { fprintf(stderr, "kernel_launch: hipFuncSetAttribute failed\n"); grid = -1; return; }
        int per_cu = 0;
        if (hipOccupancyMaxActiveBlocksPerMultiprocessor(&per_cu, (const void*)fwd, 512, LDS_BYTES) != hipSuccess || per_cu < 1) fprintf(stderr, "kernel_launch: occupancy query reports %d\n", per_cu);
        (void)hipGetLastError();
        grid = cus;
    }
    if (grid < 0) return;
    (void)hipMemsetAsync((char*)d_ws + WS_CTL, 0, CTL_ZERO_BYTES, stream);
    Args a{};
    for (int i = 0; i < 23; ++i) a.in[i] = (const float*)d_in[i];
    a.out = (float*)d_out; a.ws = (unsigned char*)d_ws;
    for (int j = 0; j < 32; ++j) a.inv_freq[j] = (float)std::pow(10000.0, -(double)j / 32.0);
#if MK_ONE_LAUNCH
    a.ph_lo = 0; a.ph_hi = N_PHASES;
    hipLaunchKernelGGL(fwd, dim3(grid), dim3(512), LDS_BYTES, stream, a);
#else
    for (int p = 0; p < N_PHASES; ++p) { a.ph_lo = p; a.ph_hi = p + 1; hipLaunchKernelGGL(fwd, dim3(grid), dim3(512), LDS_BYTES, stream, a); }
#endif
}
```

```cpp
#include <hip/hip_runtime.h>
#include <cstdio>
#include <cstdint>
#include <cmath>

#define GAS __attribute__((address_space(1)))
#define LAS __attribute__((address_space(3)))
typedef unsigned short bf16;
typedef short bf16x8 __attribute__((ext_vector_type(8)));
typedef float f32x4 __attribute__((ext_vector_type(4)));
typedef float f32x2 __attribute__((ext_vector_type(2)));
typedef unsigned u32x4 __attribute__((ext_vector_type(4)));
typedef unsigned u32x2 __attribute__((ext_vector_type(2)));

#ifndef EN_P0
#define EN_P0 1
#endif
#ifndef EN_PA
#define EN_PA 1
#endif
#ifndef EN_PB
#define EN_PB 1
#endif
#ifndef EN_PC
#define EN_PC 1
#endif
#ifndef EN_PD
#define EN_PD 1
#endif
#ifndef EN_PE
#define EN_PE 1
#endif
#ifndef EN_PG
#define EN_PG 1
#endif
#ifndef EN_PH
#define EN_PH 1
#endif
#ifndef EN_PF
#define EN_PF 1
#endif
#ifndef PROBE_B
#define PROBE_B 0
#endif
#ifndef PROBE_C
#define PROBE_C 0
#endif
#ifndef PROBE_D
#define PROBE_D 0
#endif
#ifndef MK_NAIVE_MIXER
#define MK_NAIVE_MIXER 0
#endif
#ifndef MK_ONE_LAUNCH
#define MK_ONE_LAUNCH 1
#endif

constexpr int NB = 8, SEQ = 4096, MTOK = NB * SEQ, D = 1024, DEPTH = 2;
constexpr int NPROJ = 4096;
constexpr int INP = 3856;
constexpr int C_RQ = 0, C_RK = 384, C_RV = 768, C_RG = 1152, C_HQ = 1536, C_HF = 1920, C_HI = 2304, C_HG = 2688, C_GQ = 3072, C_GK = 3200, C_GV = 3328, C_GG = 3584, C_GA = 3840;
constexpr int NEXP = 32, DEXP = 256;
constexpr int MAXROWS = 73728;
constexpr float EPS = 1e-6f;

constexpr size_t MiB = 1u << 20;
constexpr size_t WS_CTL = 0, CTL_ZERO_BYTES = 1 * MiB;
constexpr size_t WS_MOD = 1 * MiB;
constexpr size_t WS_ROPE = 2 * MiB;
constexpr size_t WS_WIN = 10 * MiB;
constexpr size_t WS_WOUT = 26 * MiB;
constexpr size_t WS_WGU = 30 * MiB;
constexpr size_t WS_WD = 94 * MiB;
constexpr size_t WS_H = 126 * MiB;
constexpr size_t WS_PROJ = 190 * MiB;
constexpr size_t WS_HID = 190 * MiB;
constexpr size_t WS_YP = 226 * MiB;
constexpr size_t WS_STATE = 446 * MiB;
constexpr size_t WS_ROUTE = 474 * MiB;
constexpr size_t WS_IDX2 = 476 * MiB;
constexpr size_t WS_END = 480 * MiB;
constexpr int CW_CNT = 64;
constexpr int CW_BAR = 4096;

constexpr int RING_BYTES = 131072;
constexpr int LDSCTL_OFF = RING_BYTES;
constexpr int TP_OFF = RING_BYTES + 512;
constexpr int AUX_OFF = RING_BYTES + 1024;
constexpr int LDS_BYTES = 147456;

#define RLX_AGENT __ATOMIC_RELAXED, __HIP_MEMORY_SCOPE_AGENT
#define LDS_WAIT() asm volatile("s_waitcnt lgkmcnt(0)" ::: "memory")
#define VM_WAIT() asm volatile("s_waitcnt vmcnt(0)" ::: "memory")

__device__ __forceinline__ unsigned f2bf(float f) { unsigned u = __builtin_bit_cast(unsigned, f); return (u + 0x7fffu + ((u >> 16) & 1u)) >> 16; }
__device__ __forceinline__ unsigned pk2(float lo, float hi) { return f2bf(lo) | (f2bf(hi) << 16); }
__device__ __forceinline__ float bf2f(unsigned short b) { return __builtin_bit_cast(float, ((unsigned)b) << 16); }
__device__ __forceinline__ float bflo(unsigned w) { return __builtin_bit_cast(float, w << 16); }
__device__ __forceinline__ float bfhi(unsigned w) { return __builtin_bit_cast(float, w & 0xffff0000u); }
__device__ __forceinline__ float sigmoidf_(float x) { return 1.0f / (1.0f + __expf(-x)); }
__device__ __forceinline__ float siluf_(float x) { return x / (1.0f + __expf(-x)); }
template <int CTRL, int RMASK, bool BC> __device__ __forceinline__ float dpp_f(float v) {
    return __builtin_bit_cast(float, __builtin_amdgcn_update_dpp(0, __builtin_bit_cast(int, v), CTRL, RMASK, 0xf, BC)); }
__device__ __forceinline__ float rdlane(float v, int l) { return __builtin_bit_cast(float, __builtin_amdgcn_readlane(__builtin_bit_cast(int, v), l)); }
__device__ __forceinline__ float wave_sum(float v) {
    v += dpp_f<0x128, 0xf, false>(v); v += dpp_f<0x124, 0xf, false>(v); v += dpp_f<0x122, 0xf, false>(v); v += dpp_f<0x121, 0xf, false>(v);
    v += dpp_f<0x142, 0xa, false>(v); v += dpp_f<0x143, 0xc, false>(v);
    return rdlane(v, 63);
}
__device__ __forceinline__ float wave_incl_scan(float v) {
    v += dpp_f<0x111, 0xf, true>(v); v += dpp_f<0x112, 0xf, true>(v); v += dpp_f<0x114, 0xf, true>(v); v += dpp_f<0x118, 0xf, true>(v);
    v += dpp_f<0x142, 0xa, false>(v); v += dpp_f<0x143, 0xc, false>(v);
    return v;
}
#define XB_TMO      128
#define XB_XCNT(j)  (256  + 64 * (j))
#define XB_XSUB(j)  (1280 + 64 * (j))
#define XB_XGEN(j)  (2304 + 64 * (j))
#define XB_TOP      3328
#define XB_TOPGEN   3392
#define XCD_BAR_WORDS 3456
#define XB_SPIN_CAP (1u << 18)
__device__ __forceinline__ unsigned xb_ld(unsigned* p)              { return __hip_atomic_load(p, __ATOMIC_RELAXED, __HIP_MEMORY_SCOPE_AGENT); }
__device__ __forceinline__ unsigned xb_add(unsigned* p, unsigned v) { return __hip_atomic_fetch_add(p, v, __ATOMIC_RELAXED, __HIP_MEMORY_SCOPE_AGENT); }
__device__ __forceinline__ unsigned xb_xcc_id() { return (unsigned)__builtin_amdgcn_s_getreg((3 << 11) | 20) & 0xFu; }
#define XB_SPIN(cond, bar) do { unsigned _sp = 0; while (cond) { __builtin_amdgcn_s_sleep(1); \
    if ((++_sp & 255u) == 0u) { if (xb_ld(&(bar)[XB_TMO])) break; if (_sp > XB_SPIN_CAP) { atomicAdd(&(bar)[XB_TMO], 1u); break; } } } } while (0)
struct XcdBarrier { unsigned* bar; unsigned x; volatile LAS unsigned* st; };
__device__ __forceinline__ XcdBarrier xcd_barrier_post(unsigned* bar, volatile LAS unsigned* st) {
    XcdBarrier b; b.bar = bar; b.x = xb_xcc_id(); b.st = st;
    if (threadIdx.x == 0) (void)xb_add(&bar[XB_XCNT(b.x)], 1u);
    return b;
}
__device__ __forceinline__ void xcd_barrier_complete(unsigned* bar, unsigned x, unsigned& nloc, unsigned& nx) {
    const unsigned G = gridDim.x * gridDim.y * gridDim.z;
    unsigned sum, cnt, mine, sp = 0u;
    for (;;) {
        sum = 0u; cnt = 0u; mine = 0u;
#pragma unroll
        for (unsigned j = 0; j < 16; ++j) { const unsigned c = xb_ld(&bar[XB_XCNT(j)]); sum += c; cnt += (c > 0u) ? 1u : 0u; mine = (j == x) ? c : mine; }
        if (sum == G) break;
        __builtin_amdgcn_s_sleep(1);
        if ((++sp & 255u) == 0u) { if (xb_ld(&bar[XB_TMO])) break; if (sp > XB_SPIN_CAP) { atomicAdd(&bar[XB_TMO], 1u); break; } }
    }
    nloc = mine > 0u ? mine : 1u; nx = cnt > 0u ? cnt : 1u;
}
__device__ __forceinline__ void xcd_barrier(const XcdBarrier& b) {
    asm volatile("s_waitcnt vmcnt(0)" ::: "memory");
    __syncthreads();
    if (threadIdx.x == 0) {
        unsigned* bar = b.bar;
        __builtin_amdgcn_s_waitcnt(0);
        unsigned nloc = b.st[0], nx = b.st[1];
        if (nloc == 0u) { xcd_barrier_complete(bar, b.x, nloc, nx); b.st[0] = nloc; b.st[1] = nx; }
        const unsigned old = xb_add(&bar[XB_XSUB(b.x)], 1u);
        const unsigned gen = old / nloc;
        if (old + 1u == (gen + 1u) * nloc) {
            __builtin_amdgcn_fence(__ATOMIC_RELEASE, "agent");
            asm volatile("s_waitcnt vmcnt(0)" ::: "memory");
            const unsigned og = xb_add(&bar[XB_TOP], 1u);
            const unsigned tg = og / nx;
            if (og + 1u == (tg + 1u) * nx) xb_add(&bar[XB_TOPGEN], 1u);
            else XB_SPIN(xb_ld(&bar[XB_TOPGEN]) == tg, bar);
            __builtin_amdgcn_fence(__ATOMIC_ACQUIRE, "agent");
            xb_add(&bar[XB_XGEN(b.x)], 1u);
            asm volatile("s_waitcnt vmcnt(0)" ::: "memory");
        } else {
            XB_SPIN(xb_ld(&bar[XB_XGEN(b.x)]) == gen, bar);
            __builtin_amdgcn_fence(__ATOMIC_ACQUIRE, "agent");
            asm volatile("s_waitcnt vmcnt(0)" ::: "memory");
        }
    }
    __syncthreads();
}

namespace pg8 {
constexpr int BM = 256, BK = 64, HALF = 128, HTB = HALF * BK * 2, STAGE_BYTES = 8 * HTB, NXCD = 8, WGM = 8;
__host__ __device__ __forceinline__ int lds_byte(int r, int c) { const int st = (r >> 4) * 2 + (c >> 5), rr = r & 15, cc = c & 31, ob = rr * 64 + cc * 2; return st * 1024 + (ob ^ (((ob >> 9) & 1) << 5)); }
__host__ __device__ __forceinline__ void stage_rc(int b, int& R, int& C) { const int st = b / 1024, sb = b % 1024, swz = sb ^ (((sb >> 9) & 1) << 5); R = (st >> 1) * 16 + swz / 64; C = (st & 1) * 32 + (swz % 64) / 2; }
__host__ __device__ __forceinline__ int perm32(int rho) { const int n = rho >> 4, i = rho & 15; return 8 * (i >> 2) + 4 * n + (i & 3); }
struct Unit { int pm, pn, pc; };
struct Gemm { const bf16* A; const bf16* Bt; int K; };

struct StaticOrder {
    int nM, nN, nwg, G, c;
    __device__ void init(int M, int N, int G_, int c_) { nM = M / BM; nN = N / BM; nwg = nM * nN; G = G_; c = c_; }
    __device__ bool next(int i, Unit& u) const {
        const long L = (long)i * G + c; if (L >= nwg) return false;
        int wgid = (int)L; { const int q = nwg / NXCD, r = nwg % NXCD, xcd = wgid % NXCD, off = wgid / NXCD; wgid = (xcd < r ? xcd * (q + 1) : r * (q + 1) + (xcd - r) * q) + off; }
        const int nig = WGM * nN, gid = wgid / nig, fm = gid * WGM, gsz = (nM - fm) < WGM ? (nM - fm) : WGM;
        u.pm = fm + ((wgid % nig) % gsz); u.pn = (wgid % nig) / gsz; u.pc = u.pn; return true;
    }
};
struct MoeOrder {
    int G, c, npt, total; const LAS int* tp;
    __device__ bool next(int i, Unit& u) const {
        const int L = i * G + c; if (L >= total) return false;
        const int mt = L / npt, nl = L % npt; int e = 0;
        while (e < 31 && tp[e + 1] <= mt) ++e;
        u.pm = mt; u.pn = e * npt + nl; u.pc = nl; return true;
    }
};

__device__ __forceinline__ unsigned cvt_pk_bf16(float lo, float hi) { unsigned r; asm volatile("v_cvt_pk_bf16_f32 %0, %1, %2" : "=v"(r) : "v"(lo), "v"(hi)); return r; }

struct EpiBf16Store {
    static constexpr bool PERM = true;
    bf16* O; int ldc;
    __device__ __forceinline__ void operator()(const f32x4 (&acc)[2][2][4][2], const Unit& u, int wr, int wc, int fr, int fq) const {
        const int row0 = u.pm * BM + wr * 64 + fr, col0 = u.pc * BM + wc * 32 + 8 * fq;
#pragma unroll
        for (int ai = 0; ai < 2; ++ai)
#pragma unroll
            for (int m = 0; m < 4; ++m) { bf16* rowp = O + (size_t)(row0 + ai * HALF + m * 16) * ldc + col0;
#pragma unroll
                for (int bj = 0; bj < 2; ++bj) { const f32x4 v0 = acc[ai][bj][m][0], v1 = acc[ai][bj][m][1];
                    u32x4 w; w.x = cvt_pk_bf16(v0[0], v0[1]); w.y = cvt_pk_bf16(v0[2], v0[3]); w.z = cvt_pk_bf16(v1[0], v1[1]); w.w = cvt_pk_bf16(v1[2], v1[3]);
                    *(u32x4*)(rowp + bj * HALF) = w; } }
    }
};
struct EpiSwiGLU {
    static constexpr bool PERM = true;
    bf16* O;
    __device__ __forceinline__ void operator()(const f32x4 (&acc)[2][2][4][2], const Unit& u, int wr, int wc, int fr, int fq) const {
        const int row0 = u.pm * BM + wr * 64 + fr, col0 = u.pc * HALF + wc * 32 + 8 * fq;
#pragma unroll
        for (int ai = 0; ai < 2; ++ai)
#pragma unroll
            for (int m = 0; m < 4; ++m) { bf16* rowp = O + (size_t)(row0 + ai * HALF + m * 16) * DEXP + col0;
                float h[8];
#pragma unroll
                for (int n = 0; n < 2; ++n)
#pragma unroll
                    for (int j = 0; j < 4; ++j) { const float g = acc[ai][0][m][n][j], up = acc[ai][1][m][n][j]; h[n * 4 + j] = g / (1.0f + __expf(-g)) * up; }
                u32x4 w; w.x = cvt_pk_bf16(h[0], h[1]); w.y = cvt_pk_bf16(h[2], h[3]); w.z = cvt_pk_bf16(h[4], h[5]); w.w = cvt_pk_bf16(h[6], h[7]);
                *(u32x4*)rowp = w; }
    }
};
struct EpiResGate {
    static constexpr bool PERM = false;
    const float* res; float* out; const float* gate;
    __device__ __forceinline__ void operator()(const f32x4 (&acc)[2][2][4][2], const Unit& u, int wr, int wc, int fr, int fq) const {
        const int row0 = u.pm * BM + wr * 64 + fr, col0 = u.pc * BM + wc * 32 + 4 * fq;
        const float* gb = gate + (size_t)(u.pm >> 4) * 6144;
        f32x4 gv[2][2];
#pragma unroll
        for (int bj = 0; bj < 2; ++bj)
#pragma unroll
            for (int n = 0; n < 2; ++n) gv[bj][n] = *(const f32x4*)(gb + col0 + bj * HALF + n * 16);
#pragma unroll
        for (int ai = 0; ai < 2; ++ai)
#pragma unroll
            for (int m = 0; m < 4; ++m) { const size_t off = (size_t)(row0 + ai * HALF + m * 16) * D + col0;
#pragma unroll
                for (int bj = 0; bj < 2; ++bj)
#pragma unroll
                    for (int n = 0; n < 2; ++n) { const f32x4 r = *(const f32x4*)(res + off + bj * HALF + n * 16); *(f32x4*)(out + off + bj * HALF + n * 16) = r + gv[bj][n] * acc[ai][bj][m][n]; } }
    }
};

template <class Epi, class Sched, bool GATHER>
__device__ __forceinline__ void gemm_phase(LAS unsigned char* lds, const Gemm g, const Sched& S, const Epi& E, const LAS int* gidx) {
    const int tid = threadIdx.x, wid = __builtin_amdgcn_readfirstlane(tid >> 6), lane = tid & 63, wr = wid >> 2, wc = wid & 3, fr = lane & 15, fq = lane >> 4;
    const int K = g.K, nt = K / BK;
    unsigned voffA[2], voffB[2];
#pragma unroll
    for (int i = 0; i < 2; ++i) { int R, C; stage_rc(tid * 16 + i * 8192, R, C); const int Rb = Epi::PERM ? ((R & ~31) + perm32(R & 31)) : R;
        voffA[i] = (unsigned)(R * K + C) * 2u; voffB[i] = (unsigned)(Rb * K + C) * 2u; }
    const size_t kstep = (size_t)(BK * 2);
    const size_t hstep = (size_t)HALF * K * 2;
    const size_t tstep = 2 * hstep;
    const unsigned ldsw = (unsigned)wid * 1024u;
    const int aoff = lds_byte(wr * 64 + fr, fq * 8), boff = lds_byte(wc * 32 + fr, fq * 8);
    int nslot = 0;
#define PG8_SA(b, h) (((b) * 2 + (h)) * HTB)
#define PG8_SB(b, h) ((4 + (b) * 2 + (h)) * HTB)
#define PG8_GLDS(gp, lp) __builtin_amdgcn_global_load_lds((const unsigned*)(gp), (LAS unsigned*)(lp), 16, 0, 0)
#define PG8_STAGE(bufoff, gbase, voff) do { _Pragma("unroll") for (int _i = 0; _i < 2; ++_i) PG8_GLDS((const char*)(gbase) + (voff)[_i], lds + (bufoff) + ldsw + _i * 8192); } while (0)
#define PG8_STAGE_A(bufoff, gptr, h, nx) do { if constexpr (GATHER) { const int _slot = (nx) ? nslot : ui; _Pragma("unroll") for (int _i = 0; _i < 2; ++_i) { int _R, _C; stage_rc(tid * 16 + _i * 8192, _R, _C); \
            const unsigned _vo = (unsigned)gidx[_slot * 256 + (h) * HALF + _R] + (unsigned)_C * 2u; PG8_GLDS((const char*)(gptr) + _vo, lds + (bufoff) + ldsw + _i * 8192); } } \
        else { PG8_STAGE(bufoff, (const char*)(gptr) + (h) * hstep, voffA); } } while (0)
#define PG8_LDA(dst, b, h) do { _Pragma("unroll") for (int m = 0; m < 4; ++m) _Pragma("unroll") for (int k = 0; k < 2; ++k) dst[m][k] = *(const LAS bf16x8*)(lds + PG8_SA(b, h) + aoff + m * 2048 + k * 1024); } while (0)
#define PG8_LDB(dst, b, h) do { _Pragma("unroll") for (int n = 0; n < 2; ++n) _Pragma("unroll") for (int k = 0; k < 2; ++k) dst[n][k] = *(const LAS bf16x8*)(lds + PG8_SB(b, h) + boff + n * 2048 + k * 1024); } while (0)
#define PG8_MMA(ai, bj, At, Bt) do { __builtin_amdgcn_s_setprio(1); _Pragma("unroll") for (int m = 0; m < 4; ++m) _Pragma("unroll") for (int n = 0; n < 2; ++n) _Pragma("unroll") for (int k = 0; k < 2; ++k) \
        acc[ai][bj][m][n] = __builtin_amdgcn_mfma_f32_16x16x32_bf16(Bt[n][k], At[m][k], acc[ai][bj][m][n], 0, 0, 0); __builtin_amdgcn_s_setprio(0); } while (0)
#define PG8_WAIT_V(n) asm volatile("s_waitcnt vmcnt(" #n ")" ::: "memory")
#define PG8_WAIT_L(n) asm volatile("s_waitcnt lgkmcnt(" #n ")" ::: "memory")
#define PG8_BAR __builtin_amdgcn_s_barrier()
#define PG8_SCHED __builtin_amdgcn_sched_barrier(0)
    Unit cur, nxt; int ui = 0;
    if (!S.next(0, cur)) return;
    f32x4 acc[2][2][4][2];
#pragma unroll
    for (int a = 0; a < 2; ++a)
#pragma unroll
        for (int b = 0; b < 2; ++b)
#pragma unroll
            for (int m = 0; m < 4; ++m)
#pragma unroll
                for (int n = 0; n < 2; ++n) acc[a][b][m][n] = (f32x4){0.f, 0.f, 0.f, 0.f};
    bf16x8 At[4][2], B0[2][2], B1[2][2];
    const char* cA = (const char*)g.A + (GATHER ? (size_t)0 : (size_t)cur.pm * tstep); const char* cB = (const char*)g.Bt + (size_t)cur.pn * tstep;
    PG8_STAGE(PG8_SB(0, 0), cB, voffB); PG8_STAGE(PG8_SB(0, 1), cB + hstep, voffB); PG8_STAGE_A(PG8_SA(0, 0), cA, 0, false); PG8_STAGE_A(PG8_SA(0, 1), cA, 1, false);
    if (wr == 1) PG8_BAR;
    PG8_WAIT_V(2); PG8_BAR;
    PG8_STAGE(PG8_SB(1, 0), cB + kstep, voffB); PG8_STAGE_A(PG8_SA(1, 0), cA + kstep, 0, false); PG8_STAGE(PG8_SB(1, 1), cB + hstep + kstep, voffB);
    PG8_WAIT_V(6); PG8_BAR;
    for (;;) {
        const bool has_next = S.next(ui + 1, nxt);
        const char* nA = has_next ? (const char*)g.A + (GATHER ? (size_t)0 : (size_t)nxt.pm * tstep) : cA; const char* nB = has_next ? (const char*)g.Bt + (size_t)nxt.pn * tstep : cB;
        if constexpr (GATHER) nslot = has_next ? ui + 1 : ui;
        for (int t = 0; t < nt; t += 2) {
            const bool last = (t == nt - 2);
            const char* a1 = cA + (size_t)(t + 1) * kstep;
            const char* a2 = last ? nA : cA + (size_t)(t + 2) * kstep; const char* b2 = last ? nB : cB + (size_t)(t + 2) * kstep;
            const char* a3 = a2 + kstep; const char* b3 = b2 + kstep;
            PG8_LDB(B0, 0, 0); PG8_LDB(B1, 0, 1); PG8_SCHED; PG8_LDA(At, 0, 0); PG8_STAGE_A(PG8_SA(1, 1), a1, 1, false);
            PG8_WAIT_V(8); PG8_WAIT_L(0); PG8_BAR; PG8_MMA(0, 0, At, B0); PG8_MMA(0, 1, At, B1); PG8_BAR; PG8_SCHED;
            PG8_LDA(At, 0, 1); PG8_STAGE(PG8_SB(0, 0), b2, voffB); PG8_STAGE(PG8_SB(0, 1), b2 + hstep, voffB); PG8_STAGE_A(PG8_SA(0, 0), a2, 0, last);
            PG8_WAIT_V(8); PG8_WAIT_L(0); PG8_BAR; PG8_MMA(1, 0, At, B0); PG8_MMA(1, 1, At, B1); PG8_BAR; PG8_SCHED;
            PG8_LDB(B0, 1, 0); PG8_LDB(B1, 1, 1); PG8_SCHED; PG8_LDA(At, 1, 0); PG8_STAGE_A(PG8_SA(0, 1), a2, 1, last);
            PG8_WAIT_V(8); PG8_WAIT_L(0); PG8_BAR; PG8_MMA(0, 0, At, B0); PG8_MMA(0, 1, At, B1); PG8_BAR; PG8_SCHED;
            PG8_LDA(At, 1, 1); PG8_STAGE(PG8_SB(1, 0), b3, voffB); PG8_STAGE(PG8_SB(1, 1), b3 + hstep, voffB); PG8_STAGE_A(PG8_SA(1, 0), a3, 0, last);
            PG8_WAIT_V(8); PG8_WAIT_L(0); PG8_BAR; PG8_MMA(1, 0, At, B0); PG8_MMA(1, 1, At, B1); PG8_BAR; PG8_SCHED;
        }
        if (wr == 0) PG8_BAR;
        E(acc, cur, wr, wc, fr, fq);
        if (!has_next) break;
#pragma unroll
        for (int a = 0; a < 2; ++a)
#pragma unroll
            for (int b = 0; b < 2; ++b)
#pragma unroll
                for (int m = 0; m < 4; ++m)
#pragma unroll
                    for (int n = 0; n < 2; ++n) acc[a][b][m][n] = (f32x4){0.f, 0.f, 0.f, 0.f};
        cur = nxt; cA = nA; cB = nB; ++ui;
        if (wr == 1) PG8_BAR;
    }
    PG8_WAIT_V(0);
    PG8_BAR;
#undef PG8_SA
#undef PG8_SB
#undef PG8_GLDS
#undef PG8_STAGE
#undef PG8_STAGE_A
#undef PG8_LDA
#undef PG8_LDB
#undef PG8_MMA
#undef PG8_WAIT_V
#undef PG8_WAIT_L
#undef PG8_BAR
#undef PG8_SCHED
}
}

struct Args { const float* in[23]; float* out; unsigned char* ws; float inv_freq[32]; int ph_lo, ph_hi; };
enum { I_X = 0, I_C, I_POS, I_WADA, I_BADA, I_NMIX, I_NFFN, I_WIN, I_RETN, I_HGRNN, I_LBL, I_WA2, I_BA, I_GLAN, I_WOUT, I_RGW, I_RGB, I_REW, I_REB, I_EG, I_EU, I_ED, I_NFIN };
constexpr int PH_PER_LAYER = 7, PH_FINAL = 1 + 2 * PH_PER_LAYER, N_PHASES = PH_FINAL + 1;

__device__ __forceinline__ void transpose_item(const float* W, int ldw, int K, int k0, int n0, bf16* WT, int dst_row0, LAS float* scr, int lane) {
#pragma unroll 8
    for (int i = 0; i < 32; ++i) { const int kk = 2 * i + (lane >> 5); scr[kk * 33 + (lane & 31)] = W[(size_t)(k0 + kk) * ldw + n0 + (lane & 31)]; }
    LDS_WAIT(); asm volatile("" ::: "memory");
    const int c = lane & 7;
#pragma unroll
    for (int j = 0; j < 4; ++j) { const int n = (lane >> 3) + 8 * j; const LAS float* s = scr + (8 * c) * 33 + n;
        u32x4 o; o.x = pk2(s[0 * 33], s[1 * 33]); o.y = pk2(s[2 * 33], s[3 * 33]); o.z = pk2(s[4 * 33], s[5 * 33]); o.w = pk2(s[6 * 33], s[7 * 33]);
        *(u32x4*)(WT + (size_t)(dst_row0 + n) * K + k0 + 8 * c) = o; }
    LDS_WAIT(); asm volatile("" ::: "memory");
}
__device__ __forceinline__ void sincos_acc(float a, float& s, float& c) {
    const double ad = (double)a; const double kd = rint(ad * 0.63661977236758134308); const double rd = fma(-kd, 1.57079632679489661923, ad);
    const int q = (int)kd & 3; const float r = (float)rd, r2 = r * r;
    const float sp = r + r * r2 * (-1.6666667163e-1f + r2 * (8.3333337680e-3f + r2 * (-1.9841270114e-4f + r2 * 2.7557314297e-6f)));
    const float cp = 1.0f + r2 * (-0.5f + r2 * (4.1666667908e-2f + r2 * (-1.3888889225e-3f + r2 * (2.4801587642e-5f + r2 * -2.7557314297e-7f))));
    const float ss = (q & 1) ? cp : sp, cc = (q & 1) ? sp : cp;
    s = (q & 2) ? -ss : ss; c = ((q + 1) & 2) ? -cc : cc;
}

typedef const __attribute__((address_space(4))) Args KArgs;
#define KARGS(ap) KArgs* ap = (KArgs*)__builtin_amdgcn_kernarg_segment_ptr(); asm volatile("" : "+s"(ap))
#define PHASE_IDS() int tid = threadIdx.x; asm volatile("" : "+v"(tid)); const int lane = tid & 63, wave = __builtin_amdgcn_readfirstlane(tid >> 6); \
    const int G = gridDim.x, bid = blockIdx.x, gw = bid * 8 + wave, NGW = G * 8; (void)lane; (void)wave; (void)gw; (void)NGW; (void)G; (void)bid

template <int TYPE>
__device__ __forceinline__ void naive_mixer_item(LAS unsigned char* lds, KArgs* ap, int layer, int b, int hh  , int tid) {
    constexpr int DK = (TYPE == 2) ? 32 : 64, DKW = DK / 8;
    LAS float* Qs = (LAS float*)lds; LAS float* Ks = Qs + 4096; LAS float* As = Ks + 4096; LAS float* Vs = As + 4096; LAS float* Os = Vs + 4096; LAS float* Ps = Os + 4096;
    unsigned char* ws = ap->ws;
    const bf16* PROJ = (const bf16*)(ws + WS_PROJ); bf16* H = (bf16*)(ws + WS_H);
    const f32x2* ROPE = (const f32x2*)(ws + WS_ROPE);
    const float* lbl = ap->in[I_LBL]; const float* gba = ap->in[I_BA];
    const int e = tid & 63, w = tid >> 6;
    const int qc = (TYPE == 0 ? C_RQ + hh * 64 : TYPE == 1 ? C_HQ + hh * 64 : C_GQ + hh * 32);
    const int kc = (TYPE == 0 ? C_RK + hh * 64 : TYPE == 1 ? C_HF + hh * 64 : C_GK + hh * 32);
    const int vc = (TYPE == 0 ? C_RV : TYPE == 1 ? C_HI : C_GV) + hh * 64;
    const int gc = (TYPE == 0 ? C_RG : TYPE == 1 ? C_HG : C_GG) + hh * 64;
    const int mc = (TYPE == 0 ? 0 : TYPE == 1 ? 384 : 768) + hh * 64;
    const float* gain = ap->in[TYPE == 0 ? I_RETN : TYPE == 1 ? I_HGRNN : I_GLAN] + layer * (TYPE == 2 ? 256 : 384) + hh * 64;
    float S[DKW];
#pragma unroll
    for (int i = 0; i < DKW; ++i) S[i] = 0.f;
    for (int n = 0; n < 64; ++n) {
        __syncthreads();
        const size_t row0 = (size_t)b * SEQ + (size_t)n * 64;
        for (int idx = tid; idx < 4096; idx += 512) {
            const int t = idx >> 6, d = idx & 63; const bf16* p = PROJ + (row0 + t) * NPROJ;
            Vs[idx] = bf2f(p[vc + d]);
            if (TYPE == 0) {
                const int j = d & 31; const f32x2 cs = ROPE[(row0 + t) * 32 + j];
                const float q1 = bf2f(p[qc + j]), q2 = bf2f(p[qc + 32 + j]), k1 = bf2f(p[kc + j]), k2 = bf2f(p[kc + 32 + j]);
                Qs[idx] = d < 32 ? q1 * cs.x - q2 * cs.y : q1 * cs.y + q2 * cs.x;
                Ks[idx] = (d < 32 ? k1 * cs.x - k2 * cs.y : k1 * cs.y + k2 * cs.x) * 0.125f;
                As[idx] = 1.0f - exp2f(-5.0f - (float)hh);
            } else if (TYPE == 1) {
                const float l0 = lbl[hh * 64 + d], l1 = lbl[384 + hh * 64 + d]; const float mx = fmaxf(l0, l1), e0 = expf(l0 - mx), e1 = expf(l1 - mx);
                const float lb = layer == 0 ? 0.f : e1 / (e0 + e1);
                const float z = bf2f(p[kc + d]); const float f = lb + (1.0f - lb) * sigmoidf_(z);
                As[idx] = fmaxf(f, 1e-30f); Ks[idx] = (1.0f - lb) * sigmoidf_(-z); Qs[idx] = siluf_(bf2f(p[qc + d])) * 0.125f;
            } else {
                if (d < 32) { const float pre = bf2f(p[C_GA + hh * 32 + d]) + gba[layer * 128 + hh * 32 + d];
                    const float ls = fminf(pre, 0.f) - log1pf(expf(-fabsf(pre)));
                    As[t * 64 + d] = expf(ls * (1.0f / 16.0f)); Ks[t * 64 + d] = bf2f(p[kc + d]); Qs[t * 64 + d] = bf2f(p[qc + d]) * 0.17677669529663687f; }
            }
        }
        __syncthreads();
        for (int t0 = 0; t0 < 64; t0 += 16) {
            for (int tt = 0; tt < 16; ++tt) { const int t = t0 + tt; const float v = Vs[t * 64 + e]; float part = 0.f;
#pragma unroll
                for (int i = 0; i < DKW; ++i) { const int d = w * DKW + i; S[i] = As[t * 64 + d] * S[i] + Ks[t * 64 + d] * v; part += Qs[t * 64 + d] * S[i]; }
                Ps[(tt * 8 + w) * 64 + e] = part; }
            __syncthreads();
            for (int idx = tid; idx < 1024; idx += 512) { const int tt = idx >> 6, ee = idx & 63; float o = 0.f;
#pragma unroll
                for (int ww = 0; ww < 8; ++ww) o += Ps[(tt * 8 + ww) * 64 + ee];
                Os[(t0 + tt) * 64 + ee] = o; }
            __syncthreads();
        }
        for (int tt = 0; tt < 8; ++tt) { const int t = w * 8 + tt; const float o = Os[t * 64 + e]; const float ss = wave_sum(o * o); const float r = rsqrtf(ss * (1.0f / 64.0f) + EPS);
            const float g = bf2f(PROJ[(row0 + t) * NPROJ + gc + e]);
            H[(row0 + t) * D + mc + e] = (bf16)f2bf(o * r * gain[e] * siluf_(g)); }
    }
}

constexpr int MX_PITCH = 72;
constexpr int MX_ARR = 64 * MX_PITCH * 2;
constexpr int MX_GROUP_BYTES = 5 * MX_ARR + 5 * 256 + 256;
__device__ __forceinline__ float bfx(const u32x4& r, int i) { const unsigned w = r[i >> 1]; return (i & 1) ? bfhi(w) : bflo(w); }
__device__ __forceinline__ unsigned short bfbits(const u32x4& r, int i) { const unsigned w = r[i >> 1]; return (unsigned short)((i & 1) ? (w >> 16) : (w & 0xffffu)); }

template <int TYPE>
__device__ __forceinline__ void mixer_chunked(LAS unsigned char* lds, KArgs* ap, int layer, int b, int hh, int tid, int chunk0, int nchunks) {
    constexpr int DK = (TYPE == 2) ? 32 : 64, NKS = DK / 32;
    const int lane = tid & 63, wv = __builtin_amdgcn_readfirstlane(tid >> 6), gid = wv >> 2, w = wv & 3, col = lane & 15, rg = lane >> 4;
    LAS unsigned char* gb = lds + gid * MX_GROUP_BYTES;
    LAS bf16* Qt = (LAS bf16*)gb; LAS bf16* Kt = Qt + 64 * MX_PITCH; LAS bf16* KT = Kt + 64 * MX_PITCH; LAS bf16* VT = KT + 64 * MX_PITCH; LAS bf16* ST = VT + 64 * MX_PITCH;
    LAS float* EM = (LAS float*)(gb + 5 * MX_ARR); LAS float* EL = EM + 64; LAS float* ELM = EL + 64; LAS float* LBt = ELM + 64; LAS float* OMLt = LBt + 64;
    unsigned char* ws = ap->ws;
    const bf16* PROJ = (const bf16*)(ws + WS_PROJ); bf16* H = (bf16*)(ws + WS_H);
    const int qc = (TYPE == 0 ? C_RQ + hh * 64 : TYPE == 1 ? C_HQ + hh * 64 : C_GQ + hh * 32);
    const int kc = (TYPE == 0 ? C_RK + hh * 64 : TYPE == 1 ? C_HF + hh * 64 : C_GK + hh * 32);
    const int vc = (TYPE == 0 ? C_RV : TYPE == 1 ? C_HI : C_GV) + hh * 64;
    const int gc = (TYPE == 0 ? C_RG : TYPE == 1 ? C_HG : C_GG) + hh * 64;
    const int mc = (TYPE == 0 ? 0 : TYPE == 1 ? 384 : 768) + hh * 64;
    const float* gain = ap->in[TYPE == 0 ? I_RETN : TYPE == 1 ? I_HGRNN : I_GLAN] + layer * (TYPE == 2 ? 256 : 384) + hh * 64;
    const float lgam = (TYPE == 0) ? log1pf(-exp2f(-5.0f - (float)hh)) : 0.f;
    float gba[16];
    if constexpr (TYPE == 2) { int zl = 0; asm volatile("" : "+v"(zl)); const float* gbap = ap->in[I_BA] + layer * 128 + hh * 32 + 16 * (w & 1) + zl;
#pragma unroll
        for (int p = 0; p < 16; ++p) gba[p] = gbap[p]; }
    if constexpr (TYPE == 1) {
        if (w == 0) { const float* lbl = ap->in[I_LBL]; const float l0 = lbl[hh * 64 + lane], l1 = lbl[384 + hh * 64 + lane]; const float mx = fmaxf(l0, l1), e0 = expf(l0 - mx), e1 = expf(l1 - mx);
            const float lb = layer == 0 ? 0.f : e1 / (e0 + e1); LBt[lane] = lb; OMLt[lane] = 1.0f - lb; }
    }
    f32x4 S[4];
#pragma unroll
    for (int et = 0; et < 4; ++et) S[et] = (f32x4){0.f, 0.f, 0.f, 0.f};
    const bool owner = (w < DK / 16);
    const size_t rowbase = (size_t)b * SEQ + (size_t)chunk0 * 64;
    u32x4 rq[2], rk[2], rv[2], rr[4], rq2[2], rk2[2]; const f32x2* ropep = nullptr;
#define MX_LOAD_RAW(n) do { const bf16* p_ = PROJ + (rowbase + (size_t)(n) * 64 + lane) * NPROJ; \
        if constexpr (TYPE == 0) { rq[0] = *(const u32x4*)(p_ + qc + 16 * w); rq[1] = *(const u32x4*)(p_ + qc + 16 * w + 8); rk[0] = *(const u32x4*)(p_ + kc + 16 * w); rk[1] = *(const u32x4*)(p_ + kc + 16 * w + 8); \
            rq2[0] = *(const u32x4*)(p_ + qc + 16 * (w ^ 2)); rq2[1] = *(const u32x4*)(p_ + qc + 16 * (w ^ 2) + 8); rk2[0] = *(const u32x4*)(p_ + kc + 16 * (w ^ 2)); rk2[1] = *(const u32x4*)(p_ + kc + 16 * (w ^ 2) + 8); \
            ropep = (const f32x2*)(ws + WS_ROPE) + (rowbase + (size_t)(n) * 64 + lane) * 32 + 16 * (w & 1); } \
        else if constexpr (TYPE == 1) { rq[0] = *(const u32x4*)(p_ + qc + 16 * w); rq[1] = *(const u32x4*)(p_ + qc + 16 * w + 8); rk[0] = *(const u32x4*)(p_ + kc + 16 * w); rk[1] = *(const u32x4*)(p_ + kc + 16 * w + 8); } \
        else { if (w < 2) { rq[0] = *(const u32x4*)(p_ + qc + 16 * w); rq[1] = *(const u32x4*)(p_ + qc + 16 * w + 8); rk[0] = *(const u32x4*)(p_ + kc + 16 * w); rk[1] = *(const u32x4*)(p_ + kc + 16 * w + 8); \
                            rr[0] = *(const u32x4*)(p_ + C_GA + hh * 32 + 16 * w); rr[1] = *(const u32x4*)(p_ + C_GA + hh * 32 + 16 * w + 8); } } \
        rv[0] = *(const u32x4*)(p_ + vc + 16 * w); rv[1] = *(const u32x4*)(p_ + vc + 16 * w + 8); } while (0)
    MX_LOAD_RAW(0);
    __syncthreads();
    for (int n = 0; n < nchunks; ++n) {
        float em4[4];
        {
            float Qr[16], Kr[16];
            if (TYPE != 2 || w < 2) {
                float c[16]; float myM = 0.f, myL = 0.f;
                if constexpr (TYPE == 0) {
#pragma unroll
                    for (int p = 0; p < 16; ++p) { const f32x2 cs2 = ropep[p]; const float cs = cs2.x, sn = cs2.y;
                        const float qs = bfx(rq[p >> 3], p & 7), qp = bfx(rq2[p >> 3], p & 7), ks_ = bfx(rk[p >> 3], p & 7), kp = bfx(rk2[p >> 3], p & 7);
                        if (w < 2) { Qr[p] = qs * cs - qp * sn; Kr[p] = (ks_ * cs - kp * sn) * 0.125f; } else { Qr[p] = qp * sn + qs * cs; Kr[p] = (kp * sn + ks_ * cs) * 0.125f; } }
#pragma unroll
                    for (int p = 0; p < 16; ++p) c[p] = (float)(lane + 1) * lgam;
                } else if constexpr (TYPE == 1) {
                    const f32x4 lb0 = *(const LAS f32x4*)(LBt + 16 * w), lb1 = *(const LAS f32x4*)(LBt + 16 * w + 4), lb2 = *(const LAS f32x4*)(LBt + 16 * w + 8), lb3 = *(const LAS f32x4*)(LBt + 16 * w + 12);
                    const f32x4 om0 = *(const LAS f32x4*)(OMLt + 16 * w), om1 = *(const LAS f32x4*)(OMLt + 16 * w + 4), om2 = *(const LAS f32x4*)(OMLt + 16 * w + 8), om3 = *(const LAS f32x4*)(OMLt + 16 * w + 12);
#pragma unroll
                    for (int p = 0; p < 16; ++p) { const float lb = (p < 4 ? lb0 : p < 8 ? lb1 : p < 12 ? lb2 : lb3)[p & 3], om = (p < 4 ? om0 : p < 8 ? om1 : p < 12 ? om2 : om3)[p & 3];
                        const float z = bfx(rk[p >> 3], p & 7), qv = bfx(rq[p >> 3], p & 7); const float sg = 1.0f / (1.0f + __expf(-z));
                        const float f = lb + om * sg; c[p] = __logf(fmaxf(f, 1e-30f)); Kr[p] = om * (1.0f - sg); Qr[p] = qv / (1.0f + __expf(-qv)) * 0.125f; }
#pragma unroll
                    for (int p = 0; p < 16; ++p) c[p] = wave_incl_scan(c[p]);
                } else {
#pragma unroll
                    for (int p = 0; p < 16; ++p) { const float pre = bfx(rr[p >> 3], p & 7) + gba[p];
                        c[p] = (fminf(pre, 0.f) - __logf(1.0f + __expf(-fabsf(pre)))) * (1.0f / 16.0f); Kr[p] = bfx(rk[p >> 3], p & 7); Qr[p] = bfx(rq[p >> 3], p & 7) * 0.17677669529663687f; }
#pragma unroll
                    for (int p = 0; p < 16; ++p) c[p] = wave_incl_scan(c[p]);
                }
#pragma unroll
                for (int p = 0; p < 16; ++p) { const float m = rdlane(c[p], 31), cl = rdlane(c[p], 63); Qr[p] *= __expf(c[p] - m); Kr[p] *= __expf(m - c[p]);
                    myM = (lane == p) ? m : myM; myL = (lane == p) ? cl : myL; }
                if (lane < 16) { EM[16 * w + lane] = __expf(myM); EL[16 * w + lane] = __expf(myL); ELM[16 * w + lane] = __expf(myL - myM); }
                LDS_WAIT();
                const f32x4 e4 = *(const LAS f32x4*)(EM + 16 * w + 4 * rg);
#pragma unroll
                for (int i = 0; i < 4; ++i) em4[i] = e4[i];
            } else {
#pragma unroll
                for (int i = 0; i < 4; ++i) em4[i] = 0.f;
            }
            if (TYPE != 2 || w < 2) {
                u32x4 q0, q1, k0, k1;
                q0.x = pg8::cvt_pk_bf16(Qr[0], Qr[1]); q0.y = pg8::cvt_pk_bf16(Qr[2], Qr[3]); q0.z = pg8::cvt_pk_bf16(Qr[4], Qr[5]); q0.w = pg8::cvt_pk_bf16(Qr[6], Qr[7]);
                q1.x = pg8::cvt_pk_bf16(Qr[8], Qr[9]); q1.y = pg8::cvt_pk_bf16(Qr[10], Qr[11]); q1.z = pg8::cvt_pk_bf16(Qr[12], Qr[13]); q1.w = pg8::cvt_pk_bf16(Qr[14], Qr[15]);
                k0.x = pg8::cvt_pk_bf16(Kr[0], Kr[1]); k0.y = pg8::cvt_pk_bf16(Kr[2], Kr[3]); k0.z = pg8::cvt_pk_bf16(Kr[4], Kr[5]); k0.w = pg8::cvt_pk_bf16(Kr[6], Kr[7]);
                k1.x = pg8::cvt_pk_bf16(Kr[8], Kr[9]); k1.y = pg8::cvt_pk_bf16(Kr[10], Kr[11]); k1.z = pg8::cvt_pk_bf16(Kr[12], Kr[13]); k1.w = pg8::cvt_pk_bf16(Kr[14], Kr[15]);
                *(LAS u32x4*)(Qt + lane * MX_PITCH + 16 * w) = q0; *(LAS u32x4*)(Qt + lane * MX_PITCH + 16 * w + 8) = q1;
                *(LAS u32x4*)(Kt + lane * MX_PITCH + 16 * w) = k0; *(LAS u32x4*)(Kt + lane * MX_PITCH + 16 * w + 8) = k1;
#pragma unroll
                for (int p = 0; p < 16; ++p) KT[(16 * w + p) * MX_PITCH + lane] = bfbits(p < 8 ? k0 : k1, p & 7);
            }
#pragma unroll
            for (int p = 0; p < 16; ++p) VT[(16 * w + p) * MX_PITCH + lane] = bfbits(rv[p >> 3], p & 7);
            if (owner) {
#pragma unroll
                for (int et = 0; et < 4; ++et) { u32x2 o; o.x = pg8::cvt_pk_bf16(S[et][0] * em4[0], S[et][1] * em4[1]); o.y = pg8::cvt_pk_bf16(S[et][2] * em4[2], S[et][3] * em4[3]);
                    *(LAS u32x2*)(ST + (16 * et + col) * MX_PITCH + 16 * w + 4 * rg) = o; }
            }
        }
        __syncthreads();
        const size_t trow = rowbase + (size_t)n * 64 + 16 * w + col;
        u32x2 gt[4];
#pragma unroll
        for (int et = 0; et < 4; ++et) gt[et] = *(const u32x2*)(PROJ + trow * NPROJ + gc + 16 * et + 4 * rg);
        if (n + 1 < nchunks) { MX_LOAD_RAW(n + 1); }
        bf16x8 Bq[NKS];
#pragma unroll
        for (int ks = 0; ks < NKS; ++ks) Bq[ks] = *(const LAS bf16x8*)(Qt + (16 * w + col) * MX_PITCH + 32 * ks + 8 * rg);
        f32x4 PT[4];
#pragma unroll
        for (int st = 0; st < 4; ++st) { PT[st] = (f32x4){0.f, 0.f, 0.f, 0.f};
            if (st <= w) {
#pragma unroll
                for (int ks = 0; ks < NKS; ++ks) { const bf16x8 af = *(const LAS bf16x8*)(Kt + (16 * st + col) * MX_PITCH + 32 * ks + 8 * rg); PT[st] = __builtin_amdgcn_mfma_f32_16x16x32_bf16(af, Bq[ks], PT[st], 0, 0, 0); }
                if (st == w) {
#pragma unroll
                    for (int i = 0; i < 4; ++i) PT[st][i] = (4 * rg + i > col) ? 0.f : PT[st][i]; }
            } }
        u32x4 pb0, pb1;
        pb0.x = pg8::cvt_pk_bf16(PT[0][0], PT[0][1]); pb0.y = pg8::cvt_pk_bf16(PT[0][2], PT[0][3]); pb0.z = pg8::cvt_pk_bf16(PT[1][0], PT[1][1]); pb0.w = pg8::cvt_pk_bf16(PT[1][2], PT[1][3]);
        pb1.x = pg8::cvt_pk_bf16(PT[2][0], PT[2][1]); pb1.y = pg8::cvt_pk_bf16(PT[2][2], PT[2][3]); pb1.z = pg8::cvt_pk_bf16(PT[3][0], PT[3][1]); pb1.w = pg8::cvt_pk_bf16(PT[3][2], PT[3][3]);
        f32x4 OT[4];
#pragma unroll
        for (int et = 0; et < 4; ++et) { OT[et] = (f32x4){0.f, 0.f, 0.f, 0.f};
#pragma unroll
            for (int ks = 0; ks < NKS; ++ks) { const bf16x8 af = *(const LAS bf16x8*)(ST + (16 * et + col) * MX_PITCH + 32 * ks + 8 * rg); OT[et] = __builtin_amdgcn_mfma_f32_16x16x32_bf16(af, Bq[ks], OT[et], 0, 0, 0); }
            { const u32x2 a0 = *(const LAS u32x2*)(VT + (16 * et + col) * MX_PITCH + 4 * rg), a1 = *(const LAS u32x2*)(VT + (16 * et + col) * MX_PITCH + 16 + 4 * rg);
              u32x4 av; av.x = a0.x; av.y = a0.y; av.z = a1.x; av.w = a1.y;
              OT[et] = __builtin_amdgcn_mfma_f32_16x16x32_bf16(__builtin_bit_cast(bf16x8, av), __builtin_bit_cast(bf16x8, pb0), OT[et], 0, 0, 0); }
            if (w >= 2) { const u32x2 a0 = *(const LAS u32x2*)(VT + (16 * et + col) * MX_PITCH + 32 + 4 * rg), a1 = *(const LAS u32x2*)(VT + (16 * et + col) * MX_PITCH + 48 + 4 * rg);
              u32x4 av; av.x = a0.x; av.y = a0.y; av.z = a1.x; av.w = a1.y;
              OT[et] = __builtin_amdgcn_mfma_f32_16x16x32_bf16(__builtin_bit_cast(bf16x8, av), __builtin_bit_cast(bf16x8, pb1), OT[et], 0, 0, 0); }
        }
        if (owner) {
            const f32x4 el = *(const LAS f32x4*)(EL + 16 * w + 4 * rg), elm = *(const LAS f32x4*)(ELM + 16 * w + 4 * rg);
#pragma unroll
            for (int et = 0; et < 4; ++et) { f32x4 W = (f32x4){0.f, 0.f, 0.f, 0.f};
#pragma unroll
                for (int ks = 0; ks < 2; ++ks) { const bf16x8 af = *(const LAS bf16x8*)(KT + (16 * w + col) * MX_PITCH + 32 * ks + 8 * rg), bfr = *(const LAS bf16x8*)(VT + (16 * et + col) * MX_PITCH + 32 * ks + 8 * rg);
                    W = __builtin_amdgcn_mfma_f32_16x16x32_bf16(af, bfr, W, 0, 0, 0); }
                S[et] = el * S[et] + elm * W; }
        }
        { float ss = 0.f;
#pragma unroll
          for (int et = 0; et < 4; ++et) ss += (OT[et][0] * OT[et][0] + OT[et][1] * OT[et][1]) + (OT[et][2] * OT[et][2] + OT[et][3] * OT[et][3]);
          ss += __shfl_xor(ss, 16); ss += __shfl_xor(ss, 32);
          const float r = rsqrtf(ss * (1.0f / 64.0f) + EPS);
#pragma unroll
          for (int et = 0; et < 4; ++et) { const f32x4 g4 = *(const f32x4*)(gain + 16 * et + 4 * rg);
              const float g0 = bflo(gt[et].x), g1 = bfhi(gt[et].x), g2 = bflo(gt[et].y), g3 = bfhi(gt[et].y);
              const float o0 = OT[et][0] * r * g4[0] * (g0 / (1.0f + __expf(-g0))), o1 = OT[et][1] * r * g4[1] * (g1 / (1.0f + __expf(-g1)));
              const float o2 = OT[et][2] * r * g4[2] * (g2 / (1.0f + __expf(-g2))), o3 = OT[et][3] * r * g4[3] * (g3 / (1.0f + __expf(-g3)));
              u32x2 o; o.x = pg8::cvt_pk_bf16(o0, o1); o.y = pg8::cvt_pk_bf16(o2, o3);
              *(u32x2*)(H + trow * D + mc + 16 * et + 4 * rg) = o; } }
        __syncthreads();
    }
#undef MX_LOAD_RAW
}

#ifndef MK_MIX_MASK
#define MK_MIX_MASK 7
#endif
__device__ __forceinline__ void phase_mixer(LAS unsigned char* lds, int layer) {
    KARGS(ap); PHASE_IDS();
    for (int pr = bid; pr < NB * 8; pr += G) {
        const int b = pr >> 3, hp = pr & 7, hd = 2 * hp + (wave >> 2);
        if (hp < 3) { if (MK_MIX_MASK & 1) mixer_chunked<0>(lds, ap, layer, b, hd, tid, 0, 64); }
        else if (hp < 6) { if (MK_MIX_MASK & 2) mixer_chunked<1>(lds, ap, layer, b, hd - 6, tid, 0, 64); }
        else { if (MK_MIX_MASK & 4) mixer_chunked<2>(lds, ap, layer, b, hd - 12, tid, 0, 64); }
        __syncthreads();
    }
    if (MK_MIX_MASK != 7) {
        for (int it = bid; it < NB * 16; it += G) {
            const int b = it >> 4, hd = it & 15;
            if (hd < 6) { if (!(MK_MIX_MASK & 1)) naive_mixer_item<0>(lds, ap, layer, b, hd, tid); }
            else if (hd < 12) { if (!(MK_MIX_MASK & 2)) naive_mixer_item<1>(lds, ap, layer, b, hd - 6, tid); }
            else { if (!(MK_MIX_MASK & 4)) naive_mixer_item<2>(lds, ap, layer, b, hd - 12, tid); }
            __syncthreads();
        }
    }
}
__device__ __forceinline__ void build_tp(LAS int* TP, const unsigned* cnt, int tid) {
    if (tid == 0) { int s = 0; for (int e = 0; e < 32; ++e) { TP[e] = s; s += ((int)cnt[e] + 255) >> 8; } TP[32] = s; }
    __syncthreads();
}

__device__ __forceinline__ void phase_prologue(LAS unsigned char* lds) {
    KARGS(ap); PHASE_IDS();
    unsigned char* ws = ap->ws;
    if (bid < 192) {
        float* MOD = (float*)(ws + WS_MOD);
        const float* cin = ap->in[I_C]; const float* wada = ap->in[I_WADA]; const float* bada = ap->in[I_BADA];
        LAS float* cact = (LAS float*)lds;
        for (int i = tid; i < 8192; i += 512) { const int b = i >> 10, k = i & 1023; cact[k * 8 + b] = siluf_(cin[i]); }
        __syncthreads();
        LAS float* red = (LAS float*)(lds + 32768);
        for (int it = bid; it < 192; it += G) {
            const int l = it / 96, j0 = (it % 96) * 64; const float* W = wada + (size_t)l * D * 6144 + j0 + lane;
            float acc[8];
#pragma unroll
            for (int b = 0; b < 8; ++b) acc[b] = 0.f;
#pragma unroll 8
            for (int kk = 0; kk < 128; ++kk) { const int k = wave * 128 + kk; const float wv = W[(size_t)k * 6144];
                const f32x4 c0 = *(const LAS f32x4*)(cact + k * 8), c1 = *(const LAS f32x4*)(cact + k * 8 + 4);
                acc[0] += c0[0] * wv; acc[1] += c0[1] * wv; acc[2] += c0[2] * wv; acc[3] += c0[3] * wv; acc[4] += c1[0] * wv; acc[5] += c1[1] * wv; acc[6] += c1[2] * wv; acc[7] += c1[3] * wv; }
#pragma unroll
            for (int b = 0; b < 8; ++b) red[(wave * 8 + b) * 64 + lane] = acc[b];
            __syncthreads();
            { const int b = tid >> 6, col = tid & 63; float s = 0.f;
#pragma unroll
              for (int ww = 0; ww < 8; ++ww) s += red[(ww * 8 + b) * 64 + col];
              MOD[((size_t)l * 8 + b) * 6144 + j0 + col] = s + bada[l * 6144 + j0 + col]; }
            __syncthreads();
        }
    }
    __syncthreads();
    {
        bf16* WIN_T = (bf16*)(ws + WS_WIN); bf16* WOUT_T = (bf16*)(ws + WS_WOUT); bf16* WGU_T = (bf16*)(ws + WS_WGU); bf16* WD_T = (bf16*)(ws + WS_WD);
        LAS float* scr = (LAS float*)(lds + wave * 16384);
        constexpr int I_IN = 16 * 120, I_OUT = 16 * 32, I_G = 16 * 8, I_D = 4 * 32;
        constexpr int PER_L = I_IN + I_OUT + 32 * I_G * 2 + 32 * I_D;
        for (int it = gw; it < 2 * PER_L; it += NGW) {
            const int l = it / PER_L; int r = it % PER_L;
            if (r < I_IN) { const int kb = r / 120, nb = r % 120; transpose_item(ap->in[I_WIN] + (size_t)l * D * INP, INP, D, kb * 64, nb * 32, WIN_T + (size_t)l * NPROJ * D, nb * 32, scr, lane); continue; } r -= I_IN;
            if (r < I_OUT) { const int kb = r / 32, nb = r % 32; transpose_item(ap->in[I_WOUT] + (size_t)l * D * D, D, D, kb * 64, nb * 32, WOUT_T + (size_t)l * D * D, nb * 32, scr, lane); continue; } r -= I_OUT;
            if (r < 32 * I_G * 2) { const int up = r / (32 * I_G); r %= 32 * I_G; const int e = r / I_G; r %= I_G; const int kb = r / 8, nb = r % 8, n0 = nb * 32;
                transpose_item(ap->in[up ? I_EU : I_EG] + ((size_t)l * NEXP + e) * D * DEXP, DEXP, D, kb * 64, n0, WGU_T + ((size_t)l * NEXP + e) * 512 * D, (n0 >> 7) * 256 + (n0 & 127) + up * 128, scr, lane); continue; } r -= 32 * I_G * 2;
            { const int e = r / I_D; r %= I_D; const int kb = r / 32, nb = r % 32;
                transpose_item(ap->in[I_ED] + ((size_t)l * NEXP + e) * DEXP * D, D, DEXP, kb * 64, nb * 32, WD_T + ((size_t)l * NEXP + e) * D * DEXP, nb * 32, scr, lane); }
        }
        const float* win = ap->in[I_WIN]; const float* wa2 = ap->in[I_WA2];
        for (int it = bid * 512 + tid; it < 2 * 256 * 128; it += G * 512) {
            const int l = it / (256 * 128), r = it % (256 * 128), n = r / 128, k0 = (r % 128) * 8;
            float o[8];
#pragma unroll
            for (int j = 0; j < 8; ++j) o[j] = 0.f;
            if (n < 128) {
#pragma unroll
                for (int j = 0; j < 8; ++j) { const float* wr_ = win + (size_t)l * D * INP + (size_t)(k0 + j) * INP + 3840; float s = 0.f;
#pragma unroll
                    for (int rr = 0; rr < 16; ++rr) s += wr_[rr] * wa2[l * 16 * 128 + rr * 128 + n];
                    o[j] = s; } }
            u32x4 w; w.x = pk2(o[0], o[1]); w.y = pk2(o[2], o[3]); w.z = pk2(o[4], o[5]); w.w = pk2(o[6], o[7]);
            *(u32x4*)(WIN_T + (size_t)l * NPROJ * D + (size_t)(3840 + n) * D + k0) = w;
        }
    }
    {
        f32x2* ROPE = (f32x2*)(ws + WS_ROPE); const int* posp = (const int*)ap->in[I_POS];
        for (int it = bid * 512 + tid; it < MTOK * 32; it += G * 512) {
            const int row = it >> 5, j = it & 31; const int pos = posp[row];
            const float ang = (float)pos * ap->inv_freq[j]; float s, c; sincos_acc(ang, s, c); ROPE[it] = (f32x2){c, s};
        }
    }
}

template <int MODE>
__device__ __forceinline__ void phase_norm1(LAS unsigned char* lds, int layer) {
    KARGS(ap); PHASE_IDS();
    unsigned char* ws = ap->ws; float* outp = ap->out;
    const float* MOD = (const float*)(ws + WS_MOD); bf16* H = (bf16*)(ws + WS_H); const bf16* YP = (const bf16*)(ws + WS_YP);
    const int* ROUTE_I = (const int*)(ws + WS_ROUTE); const float* ROUTE_W = (const float*)(ws + WS_ROUTE + 4 * MTOK * 4);
    LAS int* TP = (LAS int*)(lds + TP_OFF);
    const int pl = (MODE == 2) ? DEPTH - 1 : layer - 1;
    if (MODE != 0) build_tp(TP, (const unsigned*)(ws + WS_CTL) + CW_CNT + pl * 64, tid);
    const float* xin = MODE == 0 ? ap->in[I_X] : outp;
    const float* gn = MODE == 2 ? ap->in[I_NFIN] : ap->in[I_NMIX] + layer * D;
    for (int rb = bid; rb < MTOK / 128; rb += G) {
        const int row0 = rb * 128 + wave * 16, b = row0 >> 12;
        f32x4 Av[4], Bv[4], Gf[4];
#pragma unroll
        for (int j = 0; j < 4; ++j) { const int c0 = 4 * lane + 256 * j; Av[j] = *(const f32x4*)(gn + c0);
            if (MODE != 2) { const float* mb = MOD + (size_t)layer * 8 * 6144 + (size_t)b * 6144; const f32x4 sc = *(const f32x4*)(mb + D + c0); Bv[j] = *(const f32x4*)(mb + c0); Av[j] = Av[j] * (1.0f + sc); }
            if (MODE != 0) Gf[j] = *(const f32x4*)(MOD + (size_t)pl * 8 * 6144 + (size_t)b * 6144 + 5 * D + c0); }
        for (int r = 0; r < 16; r += 2) {
            f32x4 v[2][4];
#pragma unroll
            for (int q = 0; q < 2; ++q)
#pragma unroll
                for (int j = 0; j < 4; ++j) v[q][j] = *(const f32x4*)(xin + (size_t)(row0 + r + q) * D + 4 * lane + 256 * j);
            if (MODE != 0) {
                u32x2 y0[2][4], y1[2][4]; float w0[2], w1[2];
#pragma unroll
                for (int q = 0; q < 2; ++q) { const int m = row0 + r + q; const int e0 = ROUTE_I[m], e1 = ROUTE_I[MTOK + m], r0 = ROUTE_I[2 * MTOK + m], r1 = ROUTE_I[3 * MTOK + m]; w0[q] = ROUTE_W[m]; w1[q] = ROUTE_W[MTOK + m];
                    const bf16* p0 = YP + (size_t)(TP[e0] * 256 + r0) * D; const bf16* p1 = YP + (size_t)(TP[e1] * 256 + r1) * D;
#pragma unroll
                    for (int j = 0; j < 4; ++j) { y0[q][j] = *(const u32x2*)(p0 + 4 * lane + 256 * j); y1[q][j] = *(const u32x2*)(p1 + 4 * lane + 256 * j); } }
#pragma unroll
                for (int q = 0; q < 2; ++q)
#pragma unroll
                    for (int j = 0; j < 4; ++j) { const u32x2 a0 = y0[q][j], a1 = y1[q][j];
                        v[q][j][0] += Gf[j][0] * (w0[q] * bflo(a0.x) + w1[q] * bflo(a1.x)); v[q][j][1] += Gf[j][1] * (w0[q] * bfhi(a0.x) + w1[q] * bfhi(a1.x));
                        v[q][j][2] += Gf[j][2] * (w0[q] * bflo(a0.y) + w1[q] * bflo(a1.y)); v[q][j][3] += Gf[j][3] * (w0[q] * bfhi(a0.y) + w1[q] * bfhi(a1.y));
                        if (MODE == 1) *(f32x4*)(outp + (size_t)(row0 + r + q) * D + 4 * lane + 256 * j) = v[q][j]; }
            }
            float ss[2];
#pragma unroll
            for (int q = 0; q < 2; ++q) { float s = 0.f;
#pragma unroll
                for (int j = 0; j < 4; ++j) s += (v[q][j][0] * v[q][j][0] + v[q][j][1] * v[q][j][1]) + (v[q][j][2] * v[q][j][2] + v[q][j][3] * v[q][j][3]);
                ss[q] = s; }
            ss[0] = wave_sum(ss[0]); ss[1] = wave_sum(ss[1]);
#pragma unroll
            for (int q = 0; q < 2; ++q) { const float rstd = rsqrtf(ss[q] * (1.0f / D) + EPS); const size_t m = (size_t)(row0 + r + q);
#pragma unroll
                for (int j = 0; j < 4; ++j) { const int c0 = 4 * lane + 256 * j;
                    if (MODE == 2) { *(f32x4*)(outp + m * D + c0) = v[q][j] * rstd * Av[j]; }
                    else { const f32x4 y = (v[q][j] * rstd) * Av[j] + Bv[j]; u32x2 o; o.x = pk2(y[0], y[1]); o.y = pk2(y[2], y[3]); *(u32x2*)(H + m * D + c0) = o; } } }
        }
    }
}

__device__ __forceinline__ void phase_inproj(LAS unsigned char* lds, int layer) {
    KARGS(ap); unsigned char* ws = ap->ws;
    pg8::Gemm g{(const bf16*)(ws + WS_H), (const bf16*)(ws + WS_WIN) + (size_t)layer * NPROJ * D, D}; pg8::StaticOrder S; S.init(MTOK, NPROJ, gridDim.x, blockIdx.x);
    pg8::EpiBf16Store E{(bf16*)(ws + WS_PROJ), NPROJ};
    pg8::gemm_phase<pg8::EpiBf16Store, pg8::StaticOrder, false>(lds, g, S, E, nullptr);
}
__device__ __forceinline__ void phase_mixer_naive(LAS unsigned char* lds, int layer) {
    KARGS(ap); PHASE_IDS();
    for (int it = bid; it < NB * 16; it += G) {
        const int b = it >> 4, hd = it & 15;
        if (hd < 6) naive_mixer_item<0>(lds, ap, layer, b, hd, tid);
        else if (hd < 12) naive_mixer_item<1>(lds, ap, layer, b, hd - 6, tid);
        else naive_mixer_item<2>(lds, ap, layer, b, hd - 12, tid);
        __syncthreads();
    }
}
__device__ __forceinline__ void phase_outproj(LAS unsigned char* lds, int layer) {
    KARGS(ap); unsigned char* ws = ap->ws; float* outp = ap->out;
    pg8::Gemm g{(const bf16*)(ws + WS_H), (const bf16*)(ws + WS_WOUT) + (size_t)layer * D * D, D}; pg8::StaticOrder S; S.init(MTOK, D, gridDim.x, blockIdx.x);
    pg8::EpiResGate E{layer == 0 ? ap->in[I_X] : outp, outp, (const float*)(ws + WS_MOD) + (size_t)layer * 8 * 6144 + 2 * D};
    pg8::gemm_phase<pg8::EpiResGate, pg8::StaticOrder, false>(lds, g, S, E, nullptr);
}
__device__ __forceinline__ void phase_norm2_router(LAS unsigned char* lds, int layer) {
    KARGS(ap); PHASE_IDS();
    unsigned char* ws = ap->ws; const float* xres = ap->out;
    bf16* H = (bf16*)(ws + WS_H);
    int* ROUTE_I = (int*)(ws + WS_ROUTE); float* ROUTE_W = (float*)(ws + WS_ROUTE + 4 * MTOK * 4); int* IDX2 = (int*)(ws + WS_IDX2);
    unsigned* cntl = (unsigned*)(ws + WS_CTL) + CW_CNT + layer * 64;
    LAS bf16* Wr = (LAS bf16*)lds;
    { const float* rgw = ap->in[I_RGW] + (size_t)layer * D * 4; const float* rew = ap->in[I_REW] + (size_t)layer * D * 32;
      for (int i = tid; i < 36 * 1024; i += 512) { const int n = i >> 10, k = i & 1023; const float wv = n < 4 ? rgw[k * 4 + n] : rew[k * 32 + (n - 4)]; Wr[i] = (bf16)f2bf(wv); } }
    __syncthreads();
    const float* gn = ap->in[I_NFFN] + layer * D; const float* rgb = ap->in[I_RGB] + layer * 4; const float* reb = ap->in[I_REB] + layer * 32;
    const float* modl = (const float*)(ws + WS_MOD) + (size_t)layer * 8 * 6144;
    for (int rb = bid; rb < MTOK / 128; rb += G) {
        const int row0 = rb * 128 + wave * 16, b = row0 >> 12; const float* mb = modl + (size_t)b * 6144 + 3 * D;
        f32x4 Av[4], Bv[4];
#pragma unroll
        for (int j = 0; j < 4; ++j) { const int c0 = 4 * lane + 256 * j; const f32x4 sc = *(const f32x4*)(mb + D + c0); Bv[j] = *(const f32x4*)(mb + c0); Av[j] = *(const f32x4*)(gn + c0) * (1.0f + sc); }
        for (int r = 0; r < 16; r += 2) {
            f32x4 v[2][4];
#pragma unroll
            for (int q = 0; q < 2; ++q)
#pragma unroll
                for (int j = 0; j < 4; ++j) v[q][j] = *(const f32x4*)(xres + (size_t)(row0 + r + q) * D + 4 * lane + 256 * j);
            float ss[2];
#pragma unroll
            for (int q = 0; q < 2; ++q) { float s = 0.f;
#pragma unroll
                for (int j = 0; j < 4; ++j) s += (v[q][j][0] * v[q][j][0] + v[q][j][1] * v[q][j][1]) + (v[q][j][2] * v[q][j][2] + v[q][j][3] * v[q][j][3]);
                ss[q] = s; }
            ss[0] = wave_sum(ss[0]); ss[1] = wave_sum(ss[1]);
#pragma unroll
            for (int q = 0; q < 2; ++q) { const float rstd = rsqrtf(ss[q] * (1.0f / D) + EPS);
#pragma unroll
                for (int j = 0; j < 4; ++j) { v[q][j] = (v[q][j] * rstd) * Av[j] + Bv[j]; u32x2 o; o.x = pk2(v[q][j][0], v[q][j][1]); o.y = pk2(v[q][j][2], v[q][j][3]);
                    *(u32x2*)(H + (size_t)(row0 + r + q) * D + 4 * lane + 256 * j) = o; } }
            float lgv[2] = {0.f, 0.f};
#pragma unroll 3
            for (int n0 = 0; n0 < 36; n0 += 2) {
                float p[2][2];
#pragma unroll
                for (int nn = 0; nn < 2; ++nn) { float a0 = 0.f, a1 = 0.f;
#pragma unroll
                    for (int j = 0; j < 4; ++j) { const u32x2 wv = *(const LAS u32x2*)(Wr + (n0 + nn) * 1024 + 4 * lane + 256 * j); const float w0 = bflo(wv.x), w1 = bfhi(wv.x), w2 = bflo(wv.y), w3 = bfhi(wv.y);
                        a0 += v[0][j][0] * w0 + v[0][j][1] * w1 + v[0][j][2] * w2 + v[0][j][3] * w3; a1 += v[1][j][0] * w0 + v[1][j][1] * w1 + v[1][j][2] * w2 + v[1][j][3] * w3; }
                    p[0][nn] = a0; p[1][nn] = a1; }
#pragma unroll
                for (int nn = 0; nn < 2; ++nn) { const float s0 = wave_sum(p[0][nn]), s1 = wave_sum(p[1][nn]); lgv[0] = (lane == n0 + nn) ? s0 : lgv[0]; lgv[1] = (lane == n0 + nn) ? s1 : lgv[1]; }
            }
#pragma unroll
            for (int q = 0; q < 2; ++q) {
                const int m = row0 + r + q;
                float gl[4];
#pragma unroll
                for (int t = 0; t < 4; ++t) gl[t] = rdlane(lgv[q], t) + rgb[t];
                int gi = 0; float gm = gl[0];
#pragma unroll
                for (int t = 1; t < 4; ++t) if (gl[t] > gm) { gm = gl[t]; gi = t; }
                float gs = 0.f;
#pragma unroll
                for (int t = 0; t < 4; ++t) gs += __expf(gl[t] - gm);
                const float gwt = 1.0f / gs;
                gi = __builtin_amdgcn_readfirstlane(gi);
                float el[8];
#pragma unroll
                for (int t = 0; t < 8; ++t) el[t] = rdlane(lgv[q], 4 + gi * 8 + t) + reb[gi * 8 + t];
                int i0 = 0; float m0 = el[0];
#pragma unroll
                for (int t = 1; t < 8; ++t) if (el[t] > m0) { m0 = el[t]; i0 = t; }
                int i1 = -1; float m1 = -3.0e38f;
#pragma unroll
                for (int t = 0; t < 8; ++t) if (t != i0 && el[t] > m1) { m1 = el[t]; i1 = t; }
                const float ex = __expf(m1 - m0); const float w0 = gwt / (1.0f + ex), w1 = gwt * ex / (1.0f + ex);
                if (lane == 0) {
                    const int e0 = gi * 8 + i0, e1 = gi * 8 + i1;
                    const int r0 = (int)atomicAdd(cntl + e0, 1u), r1 = (int)atomicAdd(cntl + e1, 1u);
                    IDX2[e0 * MTOK + r0] = m; IDX2[e1 * MTOK + r1] = m;
                    ROUTE_I[m] = e0; ROUTE_I[MTOK + m] = e1; ROUTE_I[2 * MTOK + m] = r0; ROUTE_I[3 * MTOK + m] = r1; ROUTE_W[m] = w0; ROUTE_W[MTOK + m] = w1;
                }
            }
        }
    }
}
__device__ __forceinline__ void phase_moe_up(LAS unsigned char* lds, int layer) {
    KARGS(ap); unsigned char* ws = ap->ws;
    LAS int* TP = (LAS int*)(lds + TP_OFF); LAS int* AUX = (LAS int*)(lds + AUX_OFF);
    const unsigned* cntl = (const unsigned*)(ws + WS_CTL) + CW_CNT + layer * 64;
    { int tid = threadIdx.x; build_tp(TP, cntl, tid);
      pg8::MoeOrder S0; S0.G = gridDim.x; S0.c = blockIdx.x; S0.npt = 2; S0.total = TP[32] * 2; S0.tp = TP;
      const int* IDX2 = (const int*)(ws + WS_IDX2);
      pg8::Unit u; for (int i = 0; i < 8; ++i) { if (!S0.next(i, u)) break; const int e = u.pn >> 1, j = u.pm - TP[e], cnt = (int)cntl[e];
          if (tid < 256) { const int rank = j * 256 + tid; AUX[i * 256 + tid] = (rank < cnt ? IDX2[e * MTOK + rank] : 0) * (D * 2); } }
      __syncthreads(); }
    pg8::MoeOrder S; S.G = gridDim.x; S.c = blockIdx.x; S.npt = 2; S.total = TP[32] * 2; S.tp = TP;
    pg8::Gemm g{(const bf16*)(ws + WS_H), (const bf16*)(ws + WS_WGU) + (size_t)layer * NEXP * 512 * D, D};
    pg8::EpiSwiGLU E{(bf16*)(ws + WS_HID)};
    pg8::gemm_phase<pg8::EpiSwiGLU, pg8::MoeOrder, true>(lds, g, S, E, AUX);
}
__device__ __forceinline__ void phase_moe_down(LAS unsigned char* lds, int layer) {
    KARGS(ap); unsigned char* ws = ap->ws;
    LAS int* TP = (LAS int*)(lds + TP_OFF);
    build_tp(TP, (const unsigned*)(ws + WS_CTL) + CW_CNT + layer * 64, threadIdx.x);
    pg8::MoeOrder S; S.G = gridDim.x; S.c = blockIdx.x; S.npt = 4; S.total = TP[32] * 4; S.tp = TP;
    pg8::Gemm g{(const bf16*)(ws + WS_HID), (const bf16*)(ws + WS_WD) + (size_t)layer * NEXP * D * DEXP, DEXP};
    pg8::EpiBf16Store E{(bf16*)(ws + WS_YP), D};
    pg8::gemm_phase<pg8::EpiBf16Store, pg8::MoeOrder, false>(lds, g, S, E, nullptr);
}

__global__ void __launch_bounds__(512, 2) fwd(Args a) {
    extern __shared__ __attribute__((aligned(16))) unsigned char lds_raw[];
    LAS unsigned char* lds = (LAS unsigned char*)lds_raw;
    volatile LAS unsigned* MISC = (volatile LAS unsigned*)(lds + LDSCTL_OFF);
    for (int u = threadIdx.x; u < (LDS_BYTES - LDSCTL_OFF) / 4; u += 512) ((LAS unsigned*)(lds + LDSCTL_OFF))[u] = 0u;
    __syncthreads();
#if MK_ONE_LAUNCH
    { unsigned* ctl0 = (unsigned*)(a.ws + WS_CTL); (void)xcd_barrier_post(ctl0 + CW_BAR, MISC + 8); }
    constexpr int lo = 0, hi = N_PHASES;
#define SEAM(k) do { if ((k) + 1 < hi) { KARGS(_ap); XcdBarrier _b; _b.bar = (unsigned*)(_ap->ws + WS_CTL) + CW_BAR; _b.x = xb_xcc_id(); _b.st = (volatile LAS unsigned*)(lds + LDSCTL_OFF) + 8; xcd_barrier(_b); } } while (0)
#else
    (void)MISC;
    const int lo = a.ph_lo, hi = a.ph_hi;
#define SEAM(k) do { } while (0)
#endif
#define IN(k) (lo <= (k) && (k) < hi)
    if (EN_P0 && IN(0)) { phase_prologue(lds); SEAM(0); if (PROBE_D) { phase_prologue(lds); SEAM(0); } }
#define LAYER_PHASES(layer) do { constexpr int pb = 1 + PH_PER_LAYER * (layer); \
        if (EN_PA && IN(pb + 0)) { if ((layer) == 0) phase_norm1<0>(lds, (layer)); else phase_norm1<1>(lds, (layer)); SEAM(pb + 0); } \
        if (EN_PB && IN(pb + 1)) { phase_inproj(lds, (layer)); SEAM(pb + 1); if (PROBE_B) { phase_inproj(lds, (layer)); SEAM(pb + 1); } } \
        if (EN_PC && IN(pb + 2)) { if (MK_NAIVE_MIXER) phase_mixer_naive(lds, (layer)); else phase_mixer(lds, (layer)); SEAM(pb + 2); } \
        if (EN_PD && IN(pb + 3)) { phase_outproj(lds, (layer)); SEAM(pb + 3); } \
        if (EN_PE && IN(pb + 4)) { phase_norm2_router(lds, (layer)); SEAM(pb + 4); } \
        if (EN_PG && IN(pb + 5)) { phase_moe_up(lds, (layer)); SEAM(pb + 5); if (PROBE_C) { phase_moe_up(lds, (layer)); SEAM(pb + 5); } } \
        if (EN_PH && IN(pb + 6)) { phase_moe_down(lds, (layer)); SEAM(pb + 6); if (PROBE_C) { phase_moe_down(lds, (layer)); SEAM(pb + 6); } } } while (0)
    LAYER_PHASES(0);
    LAYER_PHASES(1);
#undef LAYER_PHASES
    if (EN_PF && IN(PH_FINAL)) phase_norm1<2>(lds, 0);
#undef IN
#undef SEAM
}

extern "C" void kernel_launch(void* const* d_in, const int* in_sizes, int n_in, void* d_out, int out_size, void* d_ws, size_t ws_size, hipStream_t stream) {
    static int grid = 0;
    if (grid == 0) {
        if (n_in != 23 || out_size != MTOK * D || ws_size < WS_END) { fprintf(stderr, "kernel_launch: unexpected shapes (n_in %d out %d ws %zu)\n", n_in, out_size, ws_size); grid = -1; return; }
        int dev = 0, cus = 0;
        if (hipGetDevice(&dev) != hipSuccess || hipDeviceGetAttribute(&cus, hipDeviceAttributeMultiprocessorCount, dev) != hipSuccess) { grid = -1; return; }
        if (hipFuncSetAttribute((const void*)fwd, hipFuncAttributeMaxDynamicSharedMemorySize, LDS_BYTES) != hipSuccess) { fprintf(stderr, "kernel_launch: hipFuncSetAttribute failed\n"); grid = -1; return; }
        int per_cu = 0;
        if (hipOccupancyMaxActiveBlocksPerMultiprocessor(&per_cu, (const void*)fwd, 512, LDS_BYTES) != hipSuccess || per_cu < 1) fprintf(stderr, "kernel_launch: occupancy query reports %d\n", per_cu);
        (void)hipGetLastError();
        grid = cus;
    }
    if (grid < 0) return;
    (void)hipMemsetAsync((char*)d_ws + WS_CTL, 0, CTL_ZERO_BYTES, stream);
    Args a{};
    for (int i = 0; i < 23; ++i) a.in[i] = (const float*)d_in[i];
    a.out = (float*)d_out; a.ws = (unsigned char*)d_ws;
    for (int j = 0; j < 32; ++j) a.inv_freq[j] = (float)std::pow(10000.0, -(double)j / 32.0);
#if MK_ONE_LAUNCH
    a.ph_lo = 0; a.ph_hi = N_PHASES;
    hipLaunchKernelGGL(fwd, dim3(grid), dim3(512), LDS_BYTES, stream, a);
#else
    for (int p = 0; p < N_PHASES; ++p) { a.ph_lo = p; a.ph_hi = p + 1; hipLaunchKernelGGL(fwd, dim3(grid), dim3(512), LDS_BYTES, stream, a); }
#endif
}
```

```cpp
#include <hip/hip_runtime.h>
#include <cstdio>
#include <cstdint>
#include <cmath>

#define GAS __attribute__((address_space(1)))
#define LAS __attribute__((address_space(3)))
typedef unsigned short bf16;
typedef short bf16x8 __attribute__((ext_vector_type(8)));
typedef float f32x4 __attribute__((ext_vector_type(4)));
typedef float f32x2 __attribute__((ext_vector_type(2)));
typedef unsigned u32x4 __attribute__((ext_vector_type(4)));
typedef unsigned u32x2 __attribute__((ext_vector_type(2)));

#ifndef EN_P0
#define EN_P0 1
#endif
#ifndef EN_PA
#define EN_PA 1
#endif
#ifndef EN_PB
#define EN_PB 1
#endif
#ifndef EN_PC
#define EN_PC 1
#endif
#ifndef EN_PD
#define EN_PD 1
#endif
#ifndef EN_PE
#define EN_PE 1
#endif
#ifndef EN_PG
#define EN_PG 1
#endif
#ifndef EN_PH
#define EN_PH 1
#endif
#ifndef EN_PF
#define EN_PF 1
#endif
#ifndef PROBE_B
#define PROBE_B 0
#endif
#ifndef PROBE_C
#define PROBE_C 0
#endif
#ifndef PROBE_D
#define PROBE_D 0
#endif
#ifndef MK_NAIVE_MIXER
#define MK_NAIVE_MIXER 0
#endif
#ifndef MK_ONE_LAUNCH
#define MK_ONE_LAUNCH 1
#endif

constexpr int NB = 8, SEQ = 4096, MTOK = NB * SEQ, D = 1024, DEPTH = 2;
constexpr int NPROJ = 4096;
constexpr int INP = 3856;
constexpr int C_RQ = 0, C_RK = 384, C_RV = 768, C_RG = 1152, C_HQ = 1536, C_HF = 1920, C_HI = 2304, C_HG = 2688, C_GQ = 3072, C_GK = 3200, C_GV = 3328, C_GG = 3584, C_GA = 3840;
constexpr int NEXP = 32, DEXP = 256;
constexpr int MAXROWS = 73728;
constexpr float EPS = 1e-6f;

constexpr size_t MiB = 1u << 20;
constexpr size_t WS_CTL = 0, CTL_ZERO_BYTES = 1 * MiB;
constexpr size_t WS_MOD = 1 * MiB;
constexpr size_t WS_ROPE = 2 * MiB;
constexpr size_t WS_WIN = 10 * MiB;
constexpr size_t WS_WOUT = 26 * MiB;
constexpr size_t WS_WGU = 30 * MiB;
constexpr size_t WS_WD = 94 * MiB;
constexpr size_t WS_H = 126 * MiB;
constexpr size_t WS_PROJ = 190 * MiB;
constexpr size_t WS_HID = 190 * MiB;
constexpr size_t WS_YP = 226 * MiB;
constexpr size_t WS_STATE = 446 * MiB;
constexpr size_t WS_ROUTE = 474 * MiB;
constexpr size_t WS_IDX2 = 476 * MiB;
constexpr size_t WS_END = 480 * MiB;
constexpr int CW_CNT = 64;
constexpr int CW_BAR = 4096;

constexpr int RING_BYTES = 131072;
constexpr int LDSCTL_OFF = RING_BYTES;
constexpr int TP_OFF = RING_BYTES + 512;
constexpr int AUX_OFF = RING_BYTES + 1024;
constexpr int LDS_BYTES = 147456;

#define RLX_AGENT __ATOMIC_RELAXED, __HIP_MEMORY_SCOPE_AGENT
#define LDS_WAIT() asm volatile("s_waitcnt lgkmcnt(0)" ::: "memory")
#define VM_WAIT() asm volatile("s_waitcnt vmcnt(0)" ::: "memory")

__device__ __forceinline__ unsigned f2bf(float f) { unsigned u = __builtin_bit_cast(unsigned, f); return (u + 0x7fffu + ((u >> 16) & 1u)) >> 16; }
__device__ __forceinline__ unsigned pk2(float lo, float hi) { return f2bf(lo) | (f2bf(hi) << 16); }
__device__ __forceinline__ float bf2f(unsigned short b) { return __builtin_bit_cast(float, ((unsigned)b) << 16); }
__device__ __forceinline__ float bflo(unsigned w) { return __builtin_bit_cast(float, w << 16); }
__device__ __forceinline__ float bfhi(unsigned w) { return __builtin_bit_cast(float, w & 0xffff0000u); }
__device__ __forceinline__ float sigmoidf_(float x) { return 1.0f / (1.0f + __expf(-x)); }
__device__ __forceinline__ float siluf_(float x) { return x / (1.0f + __expf(-x)); }
template <int CTRL, int RMASK, bool BC> __device__ __forceinline__ float dpp_f(float v) {
    return __builtin_bit_cast(float, __builtin_amdgcn_update_dpp(0, __builtin_bit_cast(int, v), CTRL, RMASK, 0xf, BC)); }
__device__ __forceinline__ float rdlane(float v, int l) { return __builtin_bit_cast(float, __builtin_amdgcn_readlane(__builtin_bit_cast(int, v), l)); }
__device__ __forceinline__ float wave_sum(float v) {
    v += dpp_f<0x128, 0xf, false>(v); v += dpp_f<0x124, 0xf, false>(v); v += dpp_f<0x122, 0xf, false>(v); v += dpp_f<0x121, 0xf, false>(v);
    v += dpp_f<0x142, 0xa, false>(v); v += dpp_f<0x143, 0xc, false>(v);
    return rdlane(v, 63);
}
__device__ __forceinline__ float wave_incl_scan(float v) {
    v += dpp_f<0x111, 0xf, true>(v); v += dpp_f<0x112, 0xf, true>(v); v += dpp_f<0x114, 0xf, true>(v); v += dpp_f<0x118, 0xf, true>(v);
    v += dpp_f<0x142, 0xa, false>(v); v += dpp_f<0x143, 0xc, false>(v);
    return v;
}
#define XB_TMO      128
#define XB_XCNT(j)  (256  + 64 * (j))
#define XB_XSUB(j)  (1280 + 64 * (j))
#define XB_XGEN(j)  (2304 + 64 * (j))
#define XB_TOP      3328
#define XB_TOPGEN   3392
#define XCD_BAR_WORDS 3456
#define XB_SPIN_CAP (1u << 18)
__device__ __forceinline__ unsigned xb_ld(unsigned* p)              { return __hip_atomic_load(p, __ATOMIC_RELAXED, __HIP_MEMORY_SCOPE_AGENT); }
__device__ __forceinline__ unsigned xb_add(unsigned* p, unsigned v) { return __hip_atomic_fetch_add(p, v, __ATOMIC_RELAXED, __HIP_MEMORY_SCOPE_AGENT); }
__device__ __forceinline__ unsigned xb_xcc_id() { return (unsigned)__builtin_amdgcn_s_getreg((3 << 11) | 20) & 0xFu; }
#define XB_SPIN(cond, bar) do { unsigned _sp = 0; while (cond) { __builtin_amdgcn_s_sleep(1); \
    if ((++_sp & 255u) == 0u) { if (xb_ld(&(bar)[XB_TMO])) break; if (_sp > XB_SPIN_CAP) { atomicAdd(&(bar)[XB_TMO], 1u); break; } } } } while (0)
struct XcdBarrier { unsigned* bar; unsigned x; volatile LAS unsigned* st; };
__device__ __forceinline__ XcdBarrier xcd_barrier_post(unsigned* bar, volatile LAS unsigned* st) {
    XcdBarrier b; b.bar = bar; b.x = xb_xcc_id(); b.st = st;
    if (threadIdx.x == 0) (void)xb_add(&bar[XB_XCNT(b.x)], 1u);
    return b;
}
__device__ __forceinline__ void xcd_barrier_complete(unsigned* bar, unsigned x, unsigned& nloc, unsigned& nx) {
    const unsigned G = gridDim.x * gridDim.y * gridDim.z;
    unsigned sum, cnt, mine, sp = 0u;
    for (;;) {
        sum = 0u; cnt = 0u; mine = 0u;
#pragma unroll
        for (unsigned j = 0; j < 16; ++j) { const unsigned c = xb_ld(&bar[XB_XCNT(j)]); sum += c; cnt += (c > 0u) ? 1u : 0u; mine = (j == x) ? c : mine; }
        if (sum == G) break;
        __builtin_amdgcn_s_sleep(1);
        if ((++sp & 255u) == 0u) { if (xb_ld(&bar[XB_TMO])) break; if (sp > XB_SPIN_CAP) { atomicAdd(&bar[XB_TMO], 1u); break; } }
    }
    nloc = mine > 0u ? mine : 1u; nx = cnt > 0u ? cnt : 1u;
}
__device__ __forceinline__ void xcd_barrier(const XcdBarrier& b) {
    asm volatile("s_waitcnt vmcnt(0)" ::: "memory");
    __syncthreads();
    if (threadIdx.x == 0) {
        unsigned* bar = b.bar;
        __builtin_amdgcn_s_waitcnt(0);
        unsigned nloc = b.st[0], nx = b.st[1];
        if (nloc == 0u) { xcd_barrier_complete(bar, b.x, nloc, nx); b.st[0] = nloc; b.st[1] = nx; }
        const unsigned old = xb_add(&bar[XB_XSUB(b.x)], 1u);
        const unsigned gen = old / nloc;
        if (old + 1u == (gen + 1u) * nloc) {
            __builtin_amdgcn_fence(__ATOMIC_RELEASE, "agent");
            asm volatile("s_waitcnt vmcnt(0)" ::: "memory");
            const unsigned og = xb_add(&bar[XB_TOP], 1u);
            const unsigned tg = og / nx;
            if (og + 1u == (tg + 1u) * nx) xb_add(&bar[XB_TOPGEN], 1u);
            else XB_SPIN(xb_ld(&bar[XB_TOPGEN]) == tg, bar);
            __builtin_amdgcn_fence(__ATOMIC_ACQUIRE, "agent");
            xb_add(&bar[XB_XGEN(b.x)], 1u);
            asm volatile("s_waitcnt vmcnt(0)" ::: "memory");
        } else {
            XB_SPIN(xb_ld(&bar[XB_XGEN(b.x)]) == gen, bar);
            __builtin_amdgcn_fence(__ATOMIC_ACQUIRE, "agent");
            asm volatile("s_waitcnt vmcnt(0)" ::: "memory");
        }
    }
    __syncthreads();
}

namespace pg8 {
constexpr int BM = 256, BK = 64, HALF = 128, HTB = HALF * BK * 2, STAGE_BYTES = 8 * HTB, NXCD = 8, WGM = 8;
__host__ __device__ __forceinline__ int lds_byte(int r, int c) { const int st = (r >> 4) * 2 + (c >> 5), rr = r & 15, cc = c & 31, ob = rr * 64 + cc * 2; return st * 1024 + (ob ^ (((ob >> 9) & 1) << 5)); }
__host__ __device__ __forceinline__ void stage_rc(int b, int& R, int& C) { const int st = b / 1024, sb = b % 1024, swz = sb ^ (((sb >> 9) & 1) << 5); R = (st >> 1) * 16 + swz / 64; C = (st & 1) * 32 + (swz % 64) / 2; }
__host__ __device__ __forceinline__ int perm32(int rho) { const int n = rho >> 4, i = rho & 15; return 8 * (i >> 2) + 4 * n + (i & 3); }
struct Unit { int pm, pn, pc; };
struct Gemm { const bf16* A; const bf16* Bt; int K; };

struct StaticOrder {
    int nM, nN, nwg, G, c;
    __device__ void init(int M, int N, int G_, int c_) { nM = M / BM; nN = N / BM; nwg = nM * nN; G = G_; c = c_; }
    __device__ bool next(int i, Unit& u) const {
        const long L = (long)i * G + c; if (L >= nwg) return false;
        int wgid = (int)L; { const int q = nwg / NXCD, r = nwg % NXCD, xcd = wgid % NXCD, off = wgid / NXCD; wgid = (xcd < r ? xcd * (q + 1) : r * (q + 1) + (xcd - r) * q) + off; }
        const int nig = WGM * nN, gid = wgid / nig, fm = gid * WGM, gsz = (nM - fm) < WGM ? (nM - fm) : WGM;
        u.pm = fm + ((wgid % nig) % gsz); u.pn = (wgid % nig) / gsz; u.pc = u.pn; return true;
    }
};
struct MoeOrder {
    int G, c, npt, total; const LAS int* tp;
    __device__ bool next(int i, Unit& u) const {
        const int L = i * G + c; if (L >= total) return false;
        const int mt = L / npt, nl = L % npt; int e = 0;
        while (e < 31 && tp[e + 1] <= mt) ++e;
        u.pm = mt; u.pn = e * npt + nl; u.pc = nl; return true;
    }
};

__device__ __forceinline__ unsigned cvt_pk_bf16(float lo, float hi) { unsigned r; asm volatile("v_cvt_pk_bf16_f32 %0, %1, %2" : "=v"(r) : "v"(lo), "v"(hi)); return r; }

struct EpiBf16Store {
    static constexpr bool PERM = true;
    bf16* O; int ldc;
    __device__ __forceinline__ void operator()(const f32x4 (&acc)[2][2][4][2], const Unit& u, int wr, int wc, int fr, int fq) const {
        const int row0 = u.pm * BM + wr * 64 + fr, col0 = u.pc * BM + wc * 32 + 8 * fq;
#pragma unroll
        for (int ai = 0; ai < 2; ++ai)
#pragma unroll
            for (int m = 0; m < 4; ++m) { bf16* rowp = O + (size_t)(row0 + ai * HALF + m * 16) * ldc + col0;
#pragma unroll
                for (int bj = 0; bj < 2; ++bj) { const f32x4 v0 = acc[ai][bj][m][0], v1 = acc[ai][bj][m][1];
                    u32x4 w; w.x = cvt_pk_bf16(v0[0], v0[1]); w.y = cvt_pk_bf16(v0[2], v0[3]); w.z = cvt_pk_bf16(v1[0], v1[1]); w.w = cvt_pk_bf16(v1[2], v1[3]);
                    *(u32x4*)(rowp + bj * HALF) = w; } }
    }
};
struct EpiSwiGLU {
    static constexpr bool PERM = true;
    bf16* O;
    __device__ __forceinline__ void operator()(const f32x4 (&acc)[2][2][4][2], const Unit& u, int wr, int wc, int fr, int fq) const {
        const int row0 = u.pm * BM + wr * 64 + fr, col0 = u.pc * HALF + wc * 32 + 8 * fq;
#pragma unroll
        for (int ai = 0; ai < 2; ++ai)
#pragma unroll
            for (int m = 0; m < 4; ++m) { bf16* rowp = O + (size_t)(row0 + ai * HALF + m * 16) * DEXP + col0;
                float h[8];
#pragma unroll
                for (int n = 0; n < 2; ++n)
#pragma unroll
                    for (int j = 0; j < 4; ++j) { const float g = acc[ai][0][m][n][j], up = acc[ai][1][m][n][j]; h[n * 4 + j] = g / (1.0f + __expf(-g)) * up; }
                u32x4 w; w.x = cvt_pk_bf16(h[0], h[1]); w.y = cvt_pk_bf16(h[2], h[3]); w.z = cvt_pk_bf16(h[4], h[5]); w.w = cvt_pk_bf16(h[6], h[7]);
                *(u32x4*)rowp = w; }
    }
};
struct EpiResGate {
    static constexpr bool PERM = false;
    const float* res; float* out; const float* gate;
    __device__ __forceinline__ void operator()(const f32x4 (&acc)[2][2][4][2], const Unit& u, int wr, int wc, int fr, int fq) const {
        const int row0 = u.pm * BM + wr * 64 + fr, col0 = u.pc * BM + wc * 32 + 4 * fq;
        const float* gb = gate + (size_t)(u.pm >> 4) * 6144;
        f32x4 gv[2][2];
#pragma unroll
        for (int bj = 0; bj < 2; ++bj)
#pragma unroll
            for (int n = 0; n < 2; ++n) gv[bj][n] = *(const f32x4*)(gb + col0 + bj * HALF + n * 16);
#pragma unroll
        for (int ai = 0; ai < 2; ++ai)
#pragma unroll
            for (int m = 0; m < 4; ++m) { const size_t off = (size_t)(row0 + ai * HALF + m * 16) * D + col0;
#pragma unroll
                for (int bj = 0; bj < 2; ++bj)
#pragma unroll
                    for (int n = 0; n < 2; ++n) { const f32x4 r = *(const f32x4*)(res + off + bj * HALF + n * 16); *(f32x4*)(out + off + bj * HALF + n * 16) = r + gv[bj][n] * acc[ai][bj][m][n]; } }
    }
};

template <class Epi, class Sched, bool GATHER>
__device__ __forceinline__ void gemm_phase(LAS unsigned char* lds, const Gemm g, const Sched& S, const Epi& E, const LAS int* gidx) {
    const int tid = threadIdx.x, wid = __builtin_amdgcn_readfirstlane(tid >> 6), lane = tid & 63, wr = wid >> 2, wc = wid & 3, fr = lane & 15, fq = lane >> 4;
    const int K = g.K, nt = K / BK;
    unsigned voffA[2], voffB[2];
#pragma unroll
    for (int i = 0; i < 2; ++i) { int R, C; stage_rc(tid * 16 + i * 8192, R, C); const int Rb = Epi::PERM ? ((R & ~31) + perm32(R & 31)) : R;
        voffA[i] = (unsigned)(R * K + C) * 2u; voffB[i] = (unsigned)(Rb * K + C) * 2u; }
    const size_t kstep = (size_t)(BK * 2);
    const size_t hstep = (size_t)HALF * K * 2;
    const size_t tstep = 2 * hstep;
    const unsigned ldsw = (unsigned)wid * 1024u;
    const int aoff = lds_byte(wr * 64 + fr, fq * 8), boff = lds_byte(wc * 32 + fr, fq * 8);
    int nslot = 0;
#define PG8_SA(b, h) (((b) * 2 + (h)) * HTB)
#define PG8_SB(b, h) ((4 + (b) * 2 + (h)) * HTB)
#define PG8_GLDS(gp, lp) __builtin_amdgcn_global_load_lds((const unsigned*)(gp), (LAS unsigned*)(lp), 16, 0, 0)
#define PG8_STAGE(bufoff, gbase, voff) do { _Pragma("unroll") for (int _i = 0; _i < 2; ++_i) PG8_GLDS((const char*)(gbase) + (voff)[_i], lds + (bufoff) + ldsw + _i * 8192); } while (0)
#define PG8_STAGE_A(bufoff, gptr, h, nx) do { if constexpr (GATHER) { const int _slot = (nx) ? nslot : ui; _Pragma("unroll") for (int _i = 0; _i < 2; ++_i) { int _R, _C; stage_rc(tid * 16 + _i * 8192, _R, _C); \
            const unsigned _vo = (unsigned)gidx[_slot * 256 + (h) * HALF + _R] + (unsigned)_C * 2u; PG8_GLDS((const char*)(gptr) + _vo, lds + (bufoff) + ldsw + _i * 8192); } } \
        else { PG8_STAGE(bufoff, (const char*)(gptr) + (h) * hstep, voffA); } } while (0)
#define PG8_LDA(dst, b, h) do { _Pragma("unroll") for (int m = 0; m < 4; ++m) _Pragma("unroll") for (int k = 0; k < 2; ++k) dst[m][k] = *(const LAS bf16x8*)(lds + PG8_SA(b, h) + aoff + m * 2048 + k * 1024); } while (0)
#define PG8_LDB(dst, b, h) do { _Pragma("unroll") for (int n = 0; n < 2; ++n) _Pragma("unroll") for (int k = 0; k < 2; ++k) dst[n][k] = *(const LAS bf16x8*)(lds + PG8_SB(b, h) + boff + n * 2048 + k * 1024); } while (0)
#define PG8_MMA(ai, bj, At, Bt) do { __builtin_amdgcn_s_setprio(1); _Pragma("unroll") for (int m = 0; m < 4; ++m) _Pragma("unroll") for (int n = 0; n < 2; ++n) _Pragma("unroll") for (int k = 0; k < 2; ++k) \
        acc[ai][bj][m][n] = __builtin_amdgcn_mfma_f32_16x16x32_bf16(Bt[n][k], At[m][k], acc[ai][bj][m][n], 0, 0, 0); __builtin_amdgcn_s_setprio(0); } while (0)
#define PG8_WAIT_V(n) asm volatile("s_waitcnt vmcnt(" #n ")" ::: "memory")
#define PG8_WAIT_L(n) asm volatile("s_waitcnt lgkmcnt(" #n ")" ::: "memory")
#define PG8_BAR __builtin_amdgcn_s_barrier()
#define PG8_SCHED __builtin_amdgcn_sched_barrier(0)
    Unit cur, nxt; int ui = 0;
    if (!S.next(0, cur)) return;
    f32x4 acc[2][2][4][2];
#pragma unroll
    for (int a = 0; a < 2; ++a)
#pragma unroll
        for (int b = 0; b < 2; ++b)
#pragma unroll
            for (int m = 0; m < 4; ++m)
#pragma unroll
                for (int n = 0; n < 2; ++n) acc[a][b][m][n] = (f32x4){0.f, 0.f, 0.f, 0.f};
    bf16x8 At[4][2], B0[2][2], B1[2][2];
    const char* cA = (const char*)g.A + (GATHER ? (size_t)0 : (size_t)cur.pm * tstep); const char* cB = (const char*)g.Bt + (size_t)cur.pn * tstep;
    PG8_STAGE(PG8_SB(0, 0), cB, voffB); PG8_STAGE(PG8_SB(0, 1), cB + hstep, voffB); PG8_STAGE_A(PG8_SA(0, 0), cA, 0, false); PG8_STAGE_A(PG8_SA(0, 1), cA, 1, false);
    if (wr == 1) PG8_BAR;
    PG8_WAIT_V(2); PG8_BAR;
    PG8_STAGE(PG8_SB(1, 0), cB + kstep, voffB); PG8_STAGE_A(PG8_SA(1, 0), cA + kstep, 0, false); PG8_STAGE(PG8_SB(1, 1), cB + hstep + kstep, voffB);
    PG8_WAIT_V(6); PG8_BAR;
    for (;;) {
        const bool has_next = S.next(ui + 1, nxt);
        const char* nA = has_next ? (const char*)g.A + (GATHER ? (size_t)0 : (size_t)nxt.pm * tstep) : cA; const char* nB = has_next ? (const char*)g.Bt + (size_t)nxt.pn * tstep : cB;
        if constexpr (GATHER) nslot = has_next ? ui + 1 : ui;
        for (int t = 0; t < nt; t += 2) {
            const bool last = (t == nt - 2);
            const char* a1 = cA + (size_t)(t + 1) * kstep;
            const char* a2 = last ? nA : cA + (size_t)(t + 2) * kstep; const char* b2 = last ? nB : cB + (size_t)(t + 2) * kstep;
            const char* a3 = a2 + kstep; const char* b3 = b2 + kstep;
            PG8_LDB(B0, 0, 0); PG8_LDB(B1, 0, 1); PG8_SCHED; PG8_LDA(At, 0, 0); PG8_STAGE_A(PG8_SA(1, 1), a1, 1, false);
            PG8_WAIT_V(8); PG8_WAIT_L(0); PG8_BAR; PG8_MMA(0, 0, At, B0); PG8_MMA(0, 1, At, B1); PG8_BAR; PG8_SCHED;
            PG8_LDA(At, 0, 1); PG8_STAGE(PG8_SB(0, 0), b2, voffB); PG8_STAGE(PG8_SB(0, 1), b2 + hstep, voffB); PG8_STAGE_A(PG8_SA(0, 0), a2, 0, last);
            PG8_WAIT_V(8); PG8_WAIT_L(0); PG8_BAR; PG8_MMA(1, 0, At, B0); PG8_MMA(1, 1, At, B1); PG8_BAR; PG8_SCHED;
            PG8_LDB(B0, 1, 0); PG8_LDB(B1, 1, 1); PG8_SCHED; PG8_LDA(At, 1, 0); PG8_STAGE_A(PG8_SA(0, 1), a2, 1, last);
            PG8_WAIT_V(8); PG8_WAIT_L(0); PG8_BAR; PG8_MMA(0, 0, At, B0); PG8_MMA(0, 1, At, B1); PG8_BAR; PG8_SCHED;
            PG8_LDA(At, 1, 1); PG8_STAGE(PG8_SB(1, 0), b3, voffB); PG8_STAGE(PG8_SB(1, 1), b3 + hstep, voffB); PG8_STAGE_A(PG8_SA(1, 0), a3, 0, last);
            PG8_WAIT_V(8); PG8_WAIT_L(0); PG8_BAR; PG8_MMA(1, 0, At, B0); PG8_MMA(1, 1, At, B1); PG8_BAR; PG8_SCHED;
        }
        if (wr == 0) PG8_BAR;
        E(acc, cur, wr, wc, fr, fq);
        if (!has_next) break;
#pragma unroll
        for (int a = 0; a < 2; ++a)
#pragma unroll
            for (int b = 0; b < 2; ++b)
#pragma unroll
                for (int m = 0; m < 4; ++m)
#pragma unroll
                    for (int n = 0; n < 2; ++n) acc[a][b][m][n] = (f32x4){0.f, 0.f, 0.f, 0.f};
        cur = nxt; cA = nA; cB = nB; ++ui;
        if (wr == 1) PG8_BAR;
    }
    PG8_WAIT_V(0);
    PG8_BAR;
#undef PG8_SA
#undef PG8_SB
#undef PG8_GLDS
#undef PG8_STAGE
#undef PG8_STAGE_A
#undef PG8_LDA
#undef PG8_LDB
#undef PG8_MMA
#undef PG8_WAIT_V
#undef PG8_WAIT_L
#undef PG8_BAR
#undef PG8_SCHED
}
}

struct Args { const float* in[23]; float* out; unsigned char* ws; float inv_freq[32]; int ph_lo, ph_hi; };
enum { I_X = 0, I_C, I_POS, I_WADA, I_BADA, I_NMIX, I_NFFN, I_WIN, I_RETN, I_HGRNN, I_LBL, I_WA2, I_BA, I_GLAN, I_WOUT, I_RGW, I_RGB, I_REW, I_REB, I_EG, I_EU, I_ED, I_NFIN };
constexpr int PH_PER_LAYER = 8, PH_FINAL = 1 + 2 * PH_PER_LAYER, N_PHASES = PH_FINAL + 1;

__device__ __forceinline__ void transpose_item(const float* W, int ldw, int K, int k0, int n0, bf16* WT, int dst_row0, LAS float* scr, int lane) {
#pragma unroll 8
    for (int i = 0; i < 32; ++i) { const int kk = 2 * i + (lane >> 5); scr[kk * 33 + (lane & 31)] = W[(size_t)(k0 + kk) * ldw + n0 + (lane & 31)]; }
    LDS_WAIT(); asm volatile("" ::: "memory");
    const int c = lane & 7;
#pragma unroll
    for (int j = 0; j < 4; ++j) { const int n = (lane >> 3) + 8 * j; const LAS float* s = scr + (8 * c) * 33 + n;
        u32x4 o; o.x = pk2(s[0 * 33], s[1 * 33]); o.y = pk2(s[2 * 33], s[3 * 33]); o.z = pk2(s[4 * 33], s[5 * 33]); o.w = pk2(s[6 * 33], s[7 * 33]);
        *(u32x4*)(WT + (size_t)(dst_row0 + n) * K + k0 + 8 * c) = o; }
    LDS_WAIT(); asm volatile("" ::: "memory");
}
__device__ __forceinline__ void sincos_acc(float a, float& s, float& c) {
    const double ad = (double)a; const double kd = rint(ad * 0.63661977236758134308); const double rd = fma(-kd, 1.57079632679489661923, ad);
    const int q = (int)kd & 3; const float r = (float)rd, r2 = r * r;
    const float sp = r + r * r2 * (-1.6666667163e-1f + r2 * (8.3333337680e-3f + r2 * (-1.9841270114e-4f + r2 * 2.7557314297e-6f)));
    const float cp = 1.0f + r2 * (-0.5f + r2 * (4.1666667908e-2f + r2 * (-1.3888889225e-3f + r2 * (2.4801587642e-5f + r2 * -2.7557314297e-7f))));
    const float ss = (q & 1) ? cp : sp, cc = (q & 1) ? sp : cp;
    s = (q & 2) ? -ss : ss; c = ((q + 1) & 2) ? -cc : cc;
}

typedef const __attribute__((address_space(4))) Args KArgs;
#define KARGS(ap) KArgs* ap = (KArgs*)__builtin_amdgcn_kernarg_segment_ptr(); asm volatile("" : "+s"(ap))
#define PHASE_IDS() int tid = threadIdx.x; asm volatile("" : "+v"(tid)); const int lane = tid & 63, wave = __builtin_amdgcn_readfirstlane(tid >> 6); \
    const int G = gridDim.x, bid = blockIdx.x, gw = bid * 8 + wave, NGW = G * 8; (void)lane; (void)wave; (void)gw; (void)NGW; (void)G; (void)bid

template <int TYPE>
__device__ __forceinline__ void naive_mixer_item(LAS unsigned char* lds, KArgs* ap, int layer, int b, int hh  , int tid) {
    constexpr int DK = (TYPE == 2) ? 32 : 64, DKW = DK / 8;
    LAS float* Qs = (LAS float*)lds; LAS float* Ks = Qs + 4096; LAS float* As = Ks + 4096; LAS float* Vs = As + 4096; LAS float* Os = Vs + 4096; LAS float* Ps = Os + 4096;
    unsigned char* ws = ap->ws;
    const bf16* PROJ = (const bf16*)(ws + WS_PROJ); bf16* H = (bf16*)(ws + WS_H);
    const f32x2* ROPE = (const f32x2*)(ws + WS_ROPE);
    const float* lbl = ap->in[I_LBL]; const float* gba = ap->in[I_BA];
    const int e = tid & 63, w = tid >> 6;
    const int qc = (TYPE == 0 ? C_RQ + hh * 64 : TYPE == 1 ? C_HQ + hh * 64 : C_GQ + hh * 32);
    const int kc = (TYPE == 0 ? C_RK + hh * 64 : TYPE == 1 ? C_HF + hh * 64 : C_GK + hh * 32);
    const int vc = (TYPE == 0 ? C_RV : TYPE == 1 ? C_HI : C_GV) + hh * 64;
    const int gc = (TYPE == 0 ? C_RG : TYPE == 1 ? C_HG : C_GG) + hh * 64;
    const int mc = (TYPE == 0 ? 0 : TYPE == 1 ? 384 : 768) + hh * 64;
    const float* gain = ap->in[TYPE == 0 ? I_RETN : TYPE == 1 ? I_HGRNN : I_GLAN] + layer * (TYPE == 2 ? 256 : 384) + hh * 64;
    float S[DKW];
#pragma unroll
    for (int i = 0; i < DKW; ++i) S[i] = 0.f;
    for (int n = 0; n < 64; ++n) {
        __syncthreads();
        const size_t row0 = (size_t)b * SEQ + (size_t)n * 64;
        for (int idx = tid; idx < 4096; idx += 512) {
            const int t = idx >> 6, d = idx & 63; const bf16* p = PROJ + (row0 + t) * NPROJ;
            Vs[idx] = bf2f(p[vc + d]);
            if (TYPE == 0) {
                const int j = d & 31; const f32x2 cs = ROPE[(row0 + t) * 32 + j];
                const float q1 = bf2f(p[qc + j]), q2 = bf2f(p[qc + 32 + j]), k1 = bf2f(p[kc + j]), k2 = bf2f(p[kc + 32 + j]);
                Qs[idx] = d < 32 ? q1 * cs.x - q2 * cs.y : q1 * cs.y + q2 * cs.x;
                Ks[idx] = (d < 32 ? k1 * cs.x - k2 * cs.y : k1 * cs.y + k2 * cs.x) * 0.125f;
                As[idx] = 1.0f - exp2f(-5.0f - (float)hh);
            } else if (TYPE == 1) {
                const float l0 = lbl[hh * 64 + d], l1 = lbl[384 + hh * 64 + d]; const float mx = fmaxf(l0, l1), e0 = expf(l0 - mx), e1 = expf(l1 - mx);
                const float lb = layer == 0 ? 0.f : e1 / (e0 + e1);
                const float z = bf2f(p[kc + d]); const float f = lb + (1.0f - lb) * sigmoidf_(z);
                As[idx] = fmaxf(f, 1e-30f); Ks[idx] = (1.0f - lb) * sigmoidf_(-z); Qs[idx] = siluf_(bf2f(p[qc + d])) * 0.125f;
            } else {
                if (d < 32) { const float pre = bf2f(p[C_GA + hh * 32 + d]) + gba[layer * 128 + hh * 32 + d];
                    const float ls = fminf(pre, 0.f) - log1pf(expf(-fabsf(pre)));
                    As[t * 64 + d] = expf(ls * (1.0f / 16.0f)); Ks[t * 64 + d] = bf2f(p[kc + d]); Qs[t * 64 + d] = bf2f(p[qc + d]) * 0.17677669529663687f; }
            }
        }
        __syncthreads();
        for (int t0 = 0; t0 < 64; t0 += 16) {
            for (int tt = 0; tt < 16; ++tt) { const int t = t0 + tt; const float v = Vs[t * 64 + e]; float part = 0.f;
#pragma unroll
                for (int i = 0; i < DKW; ++i) { const int d = w * DKW + i; S[i] = As[t * 64 + d] * S[i] + Ks[t * 64 + d] * v; part += Qs[t * 64 + d] * S[i]; }
                Ps[(tt * 8 + w) * 64 + e] = part; }
            __syncthreads();
            for (int idx = tid; idx < 1024; idx += 512) { const int tt = idx >> 6, ee = idx & 63; float o = 0.f;
#pragma unroll
                for (int ww = 0; ww < 8; ++ww) o += Ps[(tt * 8 + ww) * 64 + ee];
                Os[(t0 + tt) * 64 + ee] = o; }
            __syncthreads();
        }
        for (int tt = 0; tt < 8; ++tt) { const int t = w * 8 + tt; const float o = Os[t * 64 + e]; const float ss = wave_sum(o * o); const float r = rsqrtf(ss * (1.0f / 64.0f) + EPS);
            const float g = bf2f(PROJ[(row0 + t) * NPROJ + gc + e]);
            H[(row0 + t) * D + mc + e] = (bf16)f2bf(o * r * gain[e] * siluf_(g)); }
    }
}

constexpr int MX_PITCH = 72;
constexpr int MX_ARR = 64 * MX_PITCH * 2;
constexpr int MX_GROUP_BYTES = 5 * MX_ARR + 5 * 256 + 256;
constexpr int NSC = 4, NCH = 64 / NSC;
constexpr int ST_REC = 4096 + 64;
__device__ __forceinline__ float bfx(const u32x4& r, int i) { const unsigned w = r[i >> 1]; return (i & 1) ? bfhi(w) : bflo(w); }
__device__ __forceinline__ unsigned short bfbits(const u32x4& r, int i) { const unsigned w = r[i >> 1]; return (unsigned short)((i & 1) ? (w >> 16) : (w & 0xffffu)); }

template <int TYPE, int MODE>
__device__ __forceinline__ void mixer_chunked(LAS unsigned char* lds, KArgs* ap, int layer, int b, int head  , int hh  , int sc, int tid) {
    constexpr int DK = (TYPE == 2) ? 32 : 64, NKS = DK / 32;
    constexpr bool FULL = (MODE == 1);
    const int lane = tid & 63, wv = __builtin_amdgcn_readfirstlane(tid >> 6), gid = wv >> 2, w = wv & 3, col = lane & 15, rg = lane >> 4;
    LAS unsigned char* gb = lds + gid * MX_GROUP_BYTES;
    LAS bf16* Qt = (LAS bf16*)gb; LAS bf16* Kt = Qt + 64 * MX_PITCH; LAS bf16* KT = Kt + 64 * MX_PITCH; LAS bf16* VT = KT + 64 * MX_PITCH; LAS bf16* ST = VT + 64 * MX_PITCH;
    LAS float* EM = (LAS float*)(gb + 5 * MX_ARR); LAS float* EL = EM + 64; LAS float* ELM = EL + 64; LAS float* LBt = ELM + 64; LAS float* OMLt = LBt + 64;
    unsigned char* ws = ap->ws;
    const bf16* PROJ = (const bf16*)(ws + WS_PROJ); bf16* H = (bf16*)(ws + WS_H);
    float* STATE = (float*)(ws + WS_STATE) + (size_t)((b * 16 + head) * NSC) * ST_REC;
    const int qc = (TYPE == 0 ? C_RQ + hh * 64 : TYPE == 1 ? C_HQ + hh * 64 : C_GQ + hh * 32);
    const int kc = (TYPE == 0 ? C_RK + hh * 64 : TYPE == 1 ? C_HF + hh * 64 : C_GK + hh * 32);
    const int vc = (TYPE == 0 ? C_RV : TYPE == 1 ? C_HI : C_GV) + hh * 64;
    const int gc = (TYPE == 0 ? C_RG : TYPE == 1 ? C_HG : C_GG) + hh * 64;
    const int mc = (TYPE == 0 ? 0 : TYPE == 1 ? 384 : 768) + hh * 64;
    const float lgam = (TYPE == 0) ? log1pf(-exp2f(-5.0f - (float)hh)) : 0.f;
    float gba[16];
    if constexpr (TYPE == 2) { int zl = 0; asm volatile("" : "+v"(zl)); const float* gbap = ap->in[I_BA] + layer * 128 + hh * 32 + 16 * (w & 1) + zl;
#pragma unroll
        for (int p = 0; p < 16; ++p) gba[p] = gbap[p]; }
    if constexpr (TYPE == 1) {
        if (w == 0) { const float* lbl = ap->in[I_LBL]; const float l0 = lbl[hh * 64 + lane], l1 = lbl[384 + hh * 64 + lane]; const float mx = fmaxf(l0, l1), e0 = expf(l0 - mx), e1 = expf(l1 - mx);
            const float lb = layer == 0 ? 0.f : e1 / (e0 + e1); LBt[lane] = lb; OMLt[lane] = 1.0f - lb; }
    }
    f32x4 gn4[4];
    if constexpr (FULL) { const float* gain = ap->in[TYPE == 0 ? I_RETN : TYPE == 1 ? I_HGRNN : I_GLAN] + layer * (TYPE == 2 ? 256 : 384) + hh * 64;
#pragma unroll
        for (int et = 0; et < 4; ++et) gn4[et] = *(const f32x4*)(gain + 16 * et + 4 * rg); }
    const bool owner = (w < DK / 16);
    f32x4 S[4];
    f32x4 Gacc = (f32x4){1.f, 1.f, 1.f, 1.f};
#pragma unroll
    for (int et = 0; et < 4; ++et) S[et] = (f32x4){0.f, 0.f, 0.f, 0.f};
    if constexpr (FULL) { if (owner) { for (int j = 0; j < sc; ++j) { const float* rec = STATE + (size_t)j * ST_REC; const f32x4 gj = *(const f32x4*)(rec + 4096 + 16 * w + 4 * rg);
#pragma unroll
                for (int et = 0; et < 4; ++et) { const f32x4 sj = *(const f32x4*)(rec + ((w * 4 + et) * 64 + lane) * 4); S[et] = gj * S[et] + sj; } } } }
    const size_t rowbase = (size_t)b * SEQ + (size_t)sc * NCH * 64;
    f32x4 rope[8]; u32x4 rq[2], rk[2], rv[2], rr[2], rq2[2], rk2[2];
#define MX_LOAD_RAW(n) do { const bf16* p_ = PROJ + (rowbase + (size_t)(n) * 64 + lane) * NPROJ; \
        if constexpr (TYPE == 0) { rk[0] = *(const u32x4*)(p_ + kc + 16 * w); rk[1] = *(const u32x4*)(p_ + kc + 16 * w + 8); rk2[0] = *(const u32x4*)(p_ + kc + 16 * (w ^ 2)); rk2[1] = *(const u32x4*)(p_ + kc + 16 * (w ^ 2) + 8); \
            if constexpr (FULL) { rq[0] = *(const u32x4*)(p_ + qc + 16 * w); rq[1] = *(const u32x4*)(p_ + qc + 16 * w + 8); rq2[0] = *(const u32x4*)(p_ + qc + 16 * (w ^ 2)); rq2[1] = *(const u32x4*)(p_ + qc + 16 * (w ^ 2) + 8); } \
            const f32x4* rp_ = (const f32x4*)((const f32x2*)(ws + WS_ROPE) + (rowbase + (size_t)(n) * 64 + lane) * 32 + 16 * (w & 1)); \
            _Pragma("unroll") for (int i_ = 0; i_ < 8; ++i_) rope[i_] = rp_[i_]; } \
        else if constexpr (TYPE == 1) { rk[0] = *(const u32x4*)(p_ + kc + 16 * w); rk[1] = *(const u32x4*)(p_ + kc + 16 * w + 8); \
            if constexpr (FULL) { rq[0] = *(const u32x4*)(p_ + qc + 16 * w); rq[1] = *(const u32x4*)(p_ + qc + 16 * w + 8); } } \
        else { if (w < 2) { rk[0] = *(const u32x4*)(p_ + kc + 16 * w); rk[1] = *(const u32x4*)(p_ + kc + 16 * w + 8); rr[0] = *(const u32x4*)(p_ + C_GA + hh * 32 + 16 * w); rr[1] = *(const u32x4*)(p_ + C_GA + hh * 32 + 16 * w + 8); \
                            if constexpr (FULL) { rq[0] = *(const u32x4*)(p_ + qc + 16 * w); rq[1] = *(const u32x4*)(p_ + qc + 16 * w + 8); } } } \
        rv[0] = *(const u32x4*)(p_ + vc + 16 * w); rv[1] = *(const u32x4*)(p_ + vc + 16 * w + 8); } while (0)
    MX_LOAD_RAW(0);
    __syncthreads();
    for (int n = 0; n < NCH; ++n) {
        float em4[4];
        {
            float Qr[16], Kr[16];
            if constexpr (TYPE == 0) {
                const float sq = __expf((float)(lane - 31) * lgam), sk = __expf((float)(31 - lane) * lgam) * 0.125f;
#pragma unroll
                for (int p = 0; p < 16; ++p) { const float cs = rope[p >> 1][(p & 1) * 2], sn = rope[p >> 1][(p & 1) * 2 + 1];
                    const float ks_ = bfx(rk[p >> 3], p & 7), kp = bfx(rk2[p >> 3], p & 7);
                    Kr[p] = ((w < 2) ? (ks_ * cs - kp * sn) : (kp * sn + ks_ * cs)) * sk;
                    if constexpr (FULL) { const float qs = bfx(rq[p >> 3], p & 7), qp = bfx(rq2[p >> 3], p & 7); Qr[p] = ((w < 2) ? (qs * cs - qp * sn) : (qp * sn + qs * cs)) * sq; } }
                const float em = __expf(32.0f * lgam);
#pragma unroll
                for (int i = 0; i < 4; ++i) em4[i] = em;
                if (lane < 16) { EL[16 * w + lane] = __expf(64.0f * lgam); ELM[16 * w + lane] = em; }
            } else if (TYPE == 1 || w < 2) {
                float c[16]; float myM = 0.f, myL = 0.f;
                if constexpr (TYPE == 1) {
                    const f32x4 lb0 = *(const LAS f32x4*)(LBt + 16 * w), lb1 = *(const LAS f32x4*)(LBt + 16 * w + 4), lb2 = *(const LAS f32x4*)(LBt + 16 * w + 8), lb3 = *(const LAS f32x4*)(LBt + 16 * w + 12);
                    const f32x4 om0 = *(const LAS f32x4*)(OMLt + 16 * w), om1 = *(const LAS f32x4*)(OMLt + 16 * w + 4), om2 = *(const LAS f32x4*)(OMLt + 16 * w + 8), om3 = *(const LAS f32x4*)(OMLt + 16 * w + 12);
#pragma unroll
                    for (int p = 0; p < 16; ++p) { const float lb = (p < 4 ? lb0 : p < 8 ? lb1 : p < 12 ? lb2 : lb3)[p & 3], om = (p < 4 ? om0 : p < 8 ? om1 : p < 12 ? om2 : om3)[p & 3];
                        const float z = bfx(rk[p >> 3], p & 7); const float sg = 1.0f / (1.0f + __expf(-z));
                        const float f = lb + om * sg; c[p] = __logf(fmaxf(f, 1e-30f)); Kr[p] = om * (1.0f - sg);
                        if constexpr (FULL) { const float qv = bfx(rq[p >> 3], p & 7); Qr[p] = qv / (1.0f + __expf(-qv)) * 0.125f; } }
                } else {
#pragma unroll
                    for (int p = 0; p < 16; ++p) { const float pre = bfx(rr[p >> 3], p & 7) + gba[p];
                        c[p] = (fminf(pre, 0.f) - __logf(1.0f + __expf(-fabsf(pre)))) * (1.0f / 16.0f); Kr[p] = bfx(rk[p >> 3], p & 7);
                        if constexpr (FULL) Qr[p] = bfx(rq[p >> 3], p & 7) * 0.17677669529663687f; }
                }
#pragma unroll
                for (int p = 0; p < 16; ++p) c[p] = wave_incl_scan(c[p]);
#pragma unroll
                for (int p = 0; p < 16; ++p) { const float m = rdlane(c[p], 31), cl = rdlane(c[p], 63); Kr[p] *= __expf(m - c[p]);
                    if constexpr (FULL) Qr[p] *= __expf(c[p] - m);
                    myM = (lane == p) ? m : myM; myL = (lane == p) ? cl : myL; }
                if (lane < 16) { EM[16 * w + lane] = __expf(myM); EL[16 * w + lane] = __expf(myL); ELM[16 * w + lane] = __expf(myL - myM); }
                if constexpr (FULL) { LDS_WAIT();
                    const f32x4 e4 = *(const LAS f32x4*)(EM + 16 * w + 4 * rg);
#pragma unroll
                    for (int i = 0; i < 4; ++i) em4[i] = e4[i]; }
            } else {
#pragma unroll
                for (int i = 0; i < 4; ++i) em4[i] = 0.f;
            }
            if (TYPE != 2 || w < 2) {
                u32x4 k0, k1;
                k0.x = pg8::cvt_pk_bf16(Kr[0], Kr[1]); k0.y = pg8::cvt_pk_bf16(Kr[2], Kr[3]); k0.z = pg8::cvt_pk_bf16(Kr[4], Kr[5]); k0.w = pg8::cvt_pk_bf16(Kr[6], Kr[7]);
                k1.x = pg8::cvt_pk_bf16(Kr[8], Kr[9]); k1.y = pg8::cvt_pk_bf16(Kr[10], Kr[11]); k1.z = pg8::cvt_pk_bf16(Kr[12], Kr[13]); k1.w = pg8::cvt_pk_bf16(Kr[14], Kr[15]);
                if constexpr (FULL) {
                    u32x4 q0, q1;
                    q0.x = pg8::cvt_pk_bf16(Qr[0], Qr[1]); q0.y = pg8::cvt_pk_bf16(Qr[2], Qr[3]); q0.z = pg8::cvt_pk_bf16(Qr[4], Qr[5]); q0.w = pg8::cvt_pk_bf16(Qr[6], Qr[7]);
                    q1.x = pg8::cvt_pk_bf16(Qr[8], Qr[9]); q1.y = pg8::cvt_pk_bf16(Qr[10], Qr[11]); q1.z = pg8::cvt_pk_bf16(Qr[12], Qr[13]); q1.w = pg8::cvt_pk_bf16(Qr[14], Qr[15]);
                    *(LAS u32x4*)(Qt + lane * MX_PITCH + 16 * w) = q0; *(LAS u32x4*)(Qt + lane * MX_PITCH + 16 * w + 8) = q1;
                    *(LAS u32x4*)(Kt + lane * MX_PITCH + 16 * w) = k0; *(LAS u32x4*)(Kt + lane * MX_PITCH + 16 * w + 8) = k1; }
#pragma unroll
                for (int p = 0; p < 16; ++p) KT[(16 * w + p) * MX_PITCH + lane] = bfbits(p < 8 ? k0 : k1, p & 7);
            }
#pragma unroll
            for (int p = 0; p < 16; ++p) VT[(16 * w + p) * MX_PITCH + lane] = bfbits(rv[p >> 3], p & 7);
            if constexpr (FULL) { if (owner) {
#pragma unroll
                for (int et = 0; et < 4; ++et) { u32x2 o; o.x = pg8::cvt_pk_bf16(S[et][0] * em4[0], S[et][1] * em4[1]); o.y = pg8::cvt_pk_bf16(S[et][2] * em4[2], S[et][3] * em4[3]);
                    *(LAS u32x2*)(ST + (16 * et + col) * MX_PITCH + 16 * w + 4 * rg) = o; } } }
        }
        __syncthreads();
        const size_t trow = rowbase + (size_t)n * 64 + 16 * w + col;
        u32x2 gt[4];
        if constexpr (FULL) {
#pragma unroll
            for (int et = 0; et < 4; ++et) gt[et] = *(const u32x2*)(PROJ + trow * NPROJ + gc + 16 * et + 4 * rg); }
        if (n + 1 < NCH) { MX_LOAD_RAW(n + 1); }
        f32x4 OT[4];
        if constexpr (FULL) {
            bf16x8 Bq[NKS];
#pragma unroll
            for (int ks = 0; ks < NKS; ++ks) Bq[ks] = *(const LAS bf16x8*)(Qt + (16 * w + col) * MX_PITCH + 32 * ks + 8 * rg);
            f32x4 PT[4];
#pragma unroll
            for (int st = 0; st < 4; ++st) { PT[st] = (f32x4){0.f, 0.f, 0.f, 0.f};
                if (st <= w) {
#pragma unroll
                    for (int ks = 0; ks < NKS; ++ks) { const bf16x8 af = *(const LAS bf16x8*)(Kt + (16 * st + col) * MX_PITCH + 32 * ks + 8 * rg); PT[st] = __builtin_amdgcn_mfma_f32_16x16x32_bf16(af, Bq[ks], PT[st], 0, 0, 0); }
                    if (st == w) {
#pragma unroll
                        for (int i = 0; i < 4; ++i) PT[st][i] = (4 * rg + i > col) ? 0.f : PT[st][i]; }
                } }
            u32x4 pb0, pb1;
            pb0.x = pg8::cvt_pk_bf16(PT[0][0], PT[0][1]); pb0.y = pg8::cvt_pk_bf16(PT[0][2], PT[0][3]); pb0.z = pg8::cvt_pk_bf16(PT[1][0], PT[1][1]); pb0.w = pg8::cvt_pk_bf16(PT[1][2], PT[1][3]);
            pb1.x = pg8::cvt_pk_bf16(PT[2][0], PT[2][1]); pb1.y = pg8::cvt_pk_bf16(PT[2][2], PT[2][3]); pb1.z = pg8::cvt_pk_bf16(PT[3][0], PT[3][1]); pb1.w = pg8::cvt_pk_bf16(PT[3][2], PT[3][3]);
#pragma unroll
            for (int et = 0; et < 4; ++et) { OT[et] = (f32x4){0.f, 0.f, 0.f, 0.f};
#pragma unroll
                for (int ks = 0; ks < NKS; ++ks) { const bf16x8 af = *(const LAS bf16x8*)(ST + (16 * et + col) * MX_PITCH + 32 * ks + 8 * rg); OT[et] = __builtin_amdgcn_mfma_f32_16x16x32_bf16(af, Bq[ks], OT[et], 0, 0, 0); }
                { const u32x2 a0 = *(const LAS u32x2*)(VT + (16 * et + col) * MX_PITCH + 4 * rg), a1 = *(const LAS u32x2*)(VT + (16 * et + col) * MX_PITCH + 16 + 4 * rg);
                  u32x4 av; av.x = a0.x; av.y = a0.y; av.z = a1.x; av.w = a1.y;
                  OT[et] = __builtin_amdgcn_mfma_f32_16x16x32_bf16(__builtin_bit_cast(bf16x8, av), __builtin_bit_cast(bf16x8, pb0), OT[et], 0, 0, 0); }
                if (w >= 2) { const u32x2 a0 = *(const LAS u32x2*)(VT + (16 * et + col) * MX_PITCH + 32 + 4 * rg), a1 = *(const LAS u32x2*)(VT + (16 * et + col) * MX_PITCH + 48 + 4 * rg);
                  u32x4 av; av.x = a0.x; av.y = a0.y; av.z = a1.x; av.w = a1.y;
                  OT[et] = __builtin_amdgcn_mfma_f32_16x16x32_bf16(__builtin_bit_cast(bf16x8, av), __builtin_bit_cast(bf16x8, pb1), OT[et], 0, 0, 0); }
            }
        }
        if (owner) {
            const f32x4 el = *(const LAS f32x4*)(EL + 16 * w + 4 * rg), elm = *(const LAS f32x4*)(ELM + 16 * w + 4 * rg);
#pragma unroll
            for (int et = 0; et < 4; ++et) { f32x4 W = (f32x4){0.f, 0.f, 0.f, 0.f};
#pragma unroll
                for (int ks = 0; ks < 2; ++ks) { const bf16x8 af = *(const LAS bf16x8*)(KT + (16 * w + col) * MX_PITCH + 32 * ks + 8 * rg), bfr = *(const LAS bf16x8*)(VT + (16 * et + col) * MX_PITCH + 32 * ks + 8 * rg);
                    W = __builtin_amdgcn_mfma_f32_16x16x32_bf16(af, bfr, W, 0, 0, 0); }
                S[et] = el * S[et] + elm * W; }
            if constexpr (!FULL) Gacc = Gacc * el;
        }
        if constexpr (FULL) {
            float ss = 0.f;
#pragma unroll
            for (int et = 0; et < 4; ++et) ss += (OT[et][0] * OT[et][0] + OT[et][1] * OT[et][1]) + (OT[et][2] * OT[et][2] + OT[et][3] * OT[et][3]);
            ss += __shfl_xor(ss, 16); ss += __shfl_xor(ss, 32);
            const float r = rsqrtf(ss * (1.0f / 64.0f) + EPS);
#pragma unroll
            for (int et = 0; et < 4; ++et) { const f32x4 g4 = gn4[et];
                const float g0 = bflo(gt[et].x), g1 = bfhi(gt[et].x), g2 = bflo(gt[et].y), g3 = bfhi(gt[et].y);
                const float o0 = OT[et][0] * r * g4[0] * (g0 / (1.0f + __expf(-g0))), o1 = OT[et][1] * r * g4[1] * (g1 / (1.0f + __expf(-g1)));
                const float o2 = OT[et][2] * r * g4[2] * (g2 / (1.0f + __expf(-g2))), o3 = OT[et][3] * r * g4[3] * (g3 / (1.0f + __expf(-g3)));
                u32x2 o; o.x = pg8::cvt_pk_bf16(o0, o1); o.y = pg8::cvt_pk_bf16(o2, o3);
                *(u32x2*)(H + trow * D + mc + 16 * et + 4 * rg) = o; }
        }
        __syncthreads();
    }
    if constexpr (!FULL) { if (owner) { float* rec = STATE + (size_t)sc * ST_REC;
#pragma unroll
            for (int et = 0; et < 4; ++et) *(f32x4*)(rec + ((w * 4 + et) * 64 + lane) * 4) = S[et];
            if (col == 0) *(f32x4*)(rec + 4096 + 16 * w + 4 * rg) = Gacc; } }
#undef MX_LOAD_RAW
}

template <int MODE>
__device__ __forceinline__ void phase_mixer(LAS unsigned char* lds, int layer) {
    KARGS(ap); PHASE_IDS();
    constexpr int NS = (MODE == 0) ? NSC - 1 : NSC;
    for (int pr = bid; pr < NB * 8 * NS; pr += G) {
        const int sc = pr % NS, hp = (pr / NS) & 7, b = pr / (NS * 8), hd = 2 * hp + (wave >> 2);
        if (hp < 3) mixer_chunked<0, MODE>(lds, ap, layer, b, hd, hd, sc, tid);
        else if (hp < 6) mixer_chunked<1, MODE>(lds, ap, layer, b, hd, hd - 6, sc, tid);
        else mixer_chunked<2, MODE>(lds, ap, layer, b, hd, hd - 12, sc, tid);
        __syncthreads();
    }
}

__device__ __forceinline__ void build_tp(LAS int* TP, const unsigned* cnt, int tid) {
    if (tid == 0) { int s = 0; for (int e = 0; e < 32; ++e) { TP[e] = s; s += ((int)cnt[e] + 255) >> 8; } TP[32] = s; }
    __syncthreads();
}

__device__ __forceinline__ void phase_prologue(LAS unsigned char* lds) {
    KARGS(ap); PHASE_IDS();
    unsigned char* ws = ap->ws;
    if (bid < 192) {
        float* MOD = (float*)(ws + WS_MOD);
        const float* cin = ap->in[I_C]; const float* wada = ap->in[I_WADA]; const float* bada = ap->in[I_BADA];
        LAS float* cact = (LAS float*)lds;
        for (int i = tid; i < 8192; i += 512) { const int b = i >> 10, k = i & 1023; cact[k * 8 + b] = siluf_(cin[i]); }
        __syncthreads();
        LAS float* red = (LAS float*)(lds + 32768);
        for (int it = bid; it < 192; it += G) {
            const int l = it / 96, j0 = (it % 96) * 64; const float* W = wada + (size_t)l * D * 6144 + j0 + lane;
            float acc[8];
#pragma unroll
            for (int b = 0; b < 8; ++b) acc[b] = 0.f;
#pragma unroll 8
            for (int kk = 0; kk < 128; ++kk) { const int k = wave * 128 + kk; const float wv = W[(size_t)k * 6144];
                const f32x4 c0 = *(const LAS f32x4*)(cact + k * 8), c1 = *(const LAS f32x4*)(cact + k * 8 + 4);
                acc[0] += c0[0] * wv; acc[1] += c0[1] * wv; acc[2] += c0[2] * wv; acc[3] += c0[3] * wv; acc[4] += c1[0] * wv; acc[5] += c1[1] * wv; acc[6] += c1[2] * wv; acc[7] += c1[3] * wv; }
#pragma unroll
            for (int b = 0; b < 8; ++b) red[(wave * 8 + b) * 64 + lane] = acc[b];
            __syncthreads();
            { const int b = tid >> 6, col = tid & 63; float s = 0.f;
#pragma unroll
              for (int ww = 0; ww < 8; ++ww) s += red[(ww * 8 + b) * 64 + col];
              MOD[((size_t)l * 8 + b) * 6144 + j0 + col] = s + bada[l * 6144 + j0 + col]; }
            __syncthreads();
        }
    }
    __syncthreads();
    {
        bf16* WIN_T = (bf16*)(ws + WS_WIN); bf16* WOUT_T = (bf16*)(ws + WS_WOUT); bf16* WGU_T = (bf16*)(ws + WS_WGU); bf16* WD_T = (bf16*)(ws + WS_WD);
        LAS float* scr = (LAS float*)(lds + wave * 16384);
        constexpr int I_IN = 16 * 120, I_OUT = 16 * 32, I_G = 16 * 8, I_D = 4 * 32;
        constexpr int PER_L = I_IN + I_OUT + 32 * I_G * 2 + 32 * I_D;
        for (int it = gw; it < 2 * PER_L; it += NGW) {
            const int l = it / PER_L; int r = it % PER_L;
            if (r < I_IN) { const int kb = r / 120, nb = r % 120; transpose_item(ap->in[I_WIN] + (size_t)l * D * INP, INP, D, kb * 64, nb * 32, WIN_T + (size_t)l * NPROJ * D, nb * 32, scr, lane); continue; } r -= I_IN;
            if (r < I_OUT) { const int kb = r / 32, nb = r % 32; transpose_item(ap->in[I_WOUT] + (size_t)l * D * D, D, D, kb * 64, nb * 32, WOUT_T + (size_t)l * D * D, nb * 32, scr, lane); continue; } r -= I_OUT;
            if (r < 32 * I_G * 2) { const int up = r / (32 * I_G); r %= 32 * I_G; const int e = r / I_G; r %= I_G; const int kb = r / 8, nb = r % 8, n0 = nb * 32;
                transpose_item(ap->in[up ? I_EU : I_EG] + ((size_t)l * NEXP + e) * D * DEXP, DEXP, D, kb * 64, n0, WGU_T + ((size_t)l * NEXP + e) * 512 * D, (n0 >> 7) * 256 + (n0 & 127) + up * 128, scr, lane); continue; } r -= 32 * I_G * 2;
            { const int e = r / I_D; r %= I_D; const int kb = r / 32, nb = r % 32;
                transpose_item(ap->in[I_ED] + ((size_t)l * NEXP + e) * DEXP * D, D, DEXP, kb * 64, nb * 32, WD_T + ((size_t)l * NEXP + e) * D * DEXP, nb * 32, scr, lane); }
        }
        const float* win = ap->in[I_WIN]; const float* wa2 = ap->in[I_WA2];
        for (int it = bid * 512 + tid; it < 2 * 256 * 128; it += G * 512) {
            const int l = it / (256 * 128), r = it % (256 * 128), n = r / 128, k0 = (r % 128) * 8;
            float o[8];
#pragma unroll
            for (int j = 0; j < 8; ++j) o[j] = 0.f;
            if (n < 128) {
#pragma unroll
                for (int j = 0; j < 8; ++j) { const float* wr_ = win + (size_t)l * D * INP + (size_t)(k0 + j) * INP + 3840; float s = 0.f;
#pragma unroll
                    for (int rr = 0; rr < 16; ++rr) s += wr_[rr] * wa2[l * 16 * 128 + rr * 128 + n];
                    o[j] = s; } }
            u32x4 w; w.x = pk2(o[0], o[1]); w.y = pk2(o[2], o[3]); w.z = pk2(o[4], o[5]); w.w = pk2(o[6], o[7]);
            *(u32x4*)(WIN_T + (size_t)l * NPROJ * D + (size_t)(3840 + n) * D + k0) = w;
        }
    }
    {
        f32x2* ROPE = (f32x2*)(ws + WS_ROPE); const int* posp = (const int*)ap->in[I_POS];
        for (int it = bid * 512 + tid; it < MTOK * 32; it += G * 512) {
            const int row = it >> 5, j = it & 31; const int pos = posp[row];
            const float ang = (float)pos * ap->inv_freq[j]; float s, c; sincos_acc(ang, s, c); ROPE[it] = (f32x2){c, s};
        }
    }
}

template <int MODE>
__device__ __forceinline__ void phase_norm1(LAS unsigned char* lds, int layer) {
    KARGS(ap); PHASE_IDS();
    unsigned char* ws = ap->ws; float* outp = ap->out;
    const float* MOD = (const float*)(ws + WS_MOD); bf16* H = (bf16*)(ws + WS_H); const bf16* YP = (const bf16*)(ws + WS_YP);
    const int* ROUTE_I = (const int*)(ws + WS_ROUTE); const float* ROUTE_W = (const float*)(ws + WS_ROUTE + 4 * MTOK * 4);
    LAS int* TP = (LAS int*)(lds + TP_OFF);
    const int pl = (MODE == 2) ? DEPTH - 1 : layer - 1;
    if (MODE != 0) build_tp(TP, (const unsigned*)(ws + WS_CTL) + CW_CNT + pl * 64, tid);
    const float* xin = MODE == 0 ? ap->in[I_X] : outp;
    const float* gn = MODE == 2 ? ap->in[I_NFIN] : ap->in[I_NMIX] + layer * D;
    for (int rb = bid; rb < MTOK / 128; rb += G) {
        const int row0 = rb * 128 + wave * 16, b = row0 >> 12;
        f32x4 Av[4], Bv[4], Gf[4];
#pragma unroll
        for (int j = 0; j < 4; ++j) { const int c0 = 4 * lane + 256 * j; Av[j] = *(const f32x4*)(gn + c0);
            if (MODE != 2) { const float* mb = MOD + (size_t)layer * 8 * 6144 + (size_t)b * 6144; const f32x4 sc = *(const f32x4*)(mb + D + c0); Bv[j] = *(const f32x4*)(mb + c0); Av[j] = Av[j] * (1.0f + sc); }
            if (MODE != 0) Gf[j] = *(const f32x4*)(MOD + (size_t)pl * 8 * 6144 + (size_t)b * 6144 + 5 * D + c0); }
        for (int r = 0; r < 16; r += 2) {
            f32x4 v[2][4];
#pragma unroll
            for (int q = 0; q < 2; ++q)
#pragma unroll
                for (int j = 0; j < 4; ++j) v[q][j] = *(const f32x4*)(xin + (size_t)(row0 + r + q) * D + 4 * lane + 256 * j);
            if (MODE != 0) {
                u32x2 y0[2][4], y1[2][4]; float w0[2], w1[2];
#pragma unroll
                for (int q = 0; q < 2; ++q) { const int m = row0 + r + q; const int e0 = ROUTE_I[m], e1 = ROUTE_I[MTOK + m], r0 = ROUTE_I[2 * MTOK + m], r1 = ROUTE_I[3 * MTOK + m]; w0[q] = ROUTE_W[m]; w1[q] = ROUTE_W[MTOK + m];
                    const bf16* p0 = YP + (size_t)(TP[e0] * 256 + r0) * D; const bf16* p1 = YP + (size_t)(TP[e1] * 256 + r1) * D;
#pragma unroll
                    for (int j = 0; j < 4; ++j) { y0[q][j] = *(const u32x2*)(p0 + 4 * lane + 256 * j); y1[q][j] = *(const u32x2*)(p1 + 4 * lane + 256 * j); } }
#pragma unroll
                for (int q = 0; q < 2; ++q)
#pragma unroll
                    for (int j = 0; j < 4; ++j) { const u32x2 a0 = y0[q][j], a1 = y1[q][j];
                        v[q][j][0] += Gf[j][0] * (w0[q] * bflo(a0.x) + w1[q] * bflo(a1.x)); v[q][j][1] += Gf[j][1] * (w0[q] * bfhi(a0.x) + w1[q] * bfhi(a1.x));
                        v[q][j][2] += Gf[j][2] * (w0[q] * bflo(a0.y) + w1[q] * bflo(a1.y)); v[q][j][3] += Gf[j][3] * (w0[q] * bfhi(a0.y) + w1[q] * bfhi(a1.y));
                        if (MODE == 1) *(f32x4*)(outp + (size_t)(row0 + r + q) * D + 4 * lane + 256 * j) = v[q][j]; }
            }
            float ss[2];
#pragma unroll
            for (int q = 0; q < 2; ++q) { float s = 0.f;
#pragma unroll
                for (int j = 0; j < 4; ++j) s += (v[q][j][0] * v[q][j][0] + v[q][j][1] * v[q][j][1]) + (v[q][j][2] * v[q][j][2] + v[q][j][3] * v[q][j][3]);
                ss[q] = s; }
            ss[0] = wave_sum(ss[0]); ss[1] = wave_sum(ss[1]);
#pragma unroll
            for (int q = 0; q < 2; ++q) { const float rstd = rsqrtf(ss[q] * (1.0f / D) + EPS); const size_t m = (size_t)(row0 + r + q);
#pragma unroll
                for (int j = 0; j < 4; ++j) { const int c0 = 4 * lane + 256 * j;
                    if (MODE == 2) { *(f32x4*)(outp + m * D + c0) = v[q][j] * rstd * Av[j]; }
                    else { const f32x4 y = (v[q][j] * rstd) * Av[j] + Bv[j]; u32x2 o; o.x = pk2(y[0], y[1]); o.y = pk2(y[2], y[3]); *(u32x2*)(H + m * D + c0) = o; } } }
        }
    }
}

__device__ __forceinline__ void phase_inproj(LAS unsigned char* lds, int layer) {
    KARGS(ap); unsigned char* ws = ap->ws;
    pg8::Gemm g{(const bf16*)(ws + WS_H), (const bf16*)(ws + WS_WIN) + (size_t)layer * NPROJ * D, D}; pg8::StaticOrder S; S.init(MTOK, NPROJ, gridDim.x, blockIdx.x);
    pg8::EpiBf16Store E{(bf16*)(ws + WS_PROJ), NPROJ};
    pg8::gemm_phase<pg8::EpiBf16Store, pg8::StaticOrder, false>(lds, g, S, E, nullptr);
}
__device__ __forceinline__ void phase_mixer_naive(LAS unsigned char* lds, int layer) {
    KARGS(ap); PHASE_IDS();
    for (int it = bid; it < NB * 16; it += G) {
        const int b = it >> 4, hd = it & 15;
        if (hd < 6) naive_mixer_item<0>(lds, ap, layer, b, hd, tid);
        else if (hd < 12) naive_mixer_item<1>(lds, ap, layer, b, hd - 6, tid);
        else naive_mixer_item<2>(lds, ap, layer, b, hd - 12, tid);
        __syncthreads();
    }
}
__device__ __forceinline__ void phase_outproj(LAS unsigned char* lds, int layer) {
    KARGS(ap); unsigned char* ws = ap->ws; float* outp = ap->out;
    pg8::Gemm g{(const bf16*)(ws + WS_H), (const bf16*)(ws + WS_WOUT) + (size_t)layer * D * D, D}; pg8::StaticOrder S; S.init(MTOK, D, gridDim.x, blockIdx.x);
    pg8::EpiResGate E{layer == 0 ? ap->in[I_X] : outp, outp, (const float*)(ws + WS_MOD) + (size_t)layer * 8 * 6144 + 2 * D};
    pg8::gemm_phase<pg8::EpiResGate, pg8::StaticOrder, false>(lds, g, S, E, nullptr);
}
__device__ __forceinline__ void phase_norm2_router(LAS unsigned char* lds, int layer) {
    KARGS(ap); PHASE_IDS();
    unsigned char* ws = ap->ws; const float* xres = ap->out;
    bf16* H = (bf16*)(ws + WS_H);
    int* ROUTE_I = (int*)(ws + WS_ROUTE); float* ROUTE_W = (float*)(ws + WS_ROUTE + 4 * MTOK * 4); int* IDX2 = (int*)(ws + WS_IDX2);
    unsigned* cntl = (unsigned*)(ws + WS_CTL) + CW_CNT + layer * 64;
    LAS bf16* Wr = (LAS bf16*)lds;
    { const float* rgw = ap->in[I_RGW] + (size_t)layer * D * 4; const float* rew = ap->in[I_REW] + (size_t)layer * D * 32;
      for (int i = tid; i < 36 * 1024; i += 512) { const int n = i >> 10, k = i & 1023; const float wv = n < 4 ? rgw[k * 4 + n] : rew[k * 32 + (n - 4)]; Wr[i] = (bf16)f2bf(wv); } }
    __syncthreads();
    const float* gn = ap->in[I_NFFN] + layer * D; const float* rgb = ap->in[I_RGB] + layer * 4; const float* reb = ap->in[I_REB] + layer * 32;
    const float* modl = (const float*)(ws + WS_MOD) + (size_t)layer * 8 * 6144;
    for (int rb = bid; rb < MTOK / 128; rb += G) {
        const int row0 = rb * 128 + wave * 16, b = row0 >> 12; const float* mb = modl + (size_t)b * 6144 + 3 * D;
        f32x4 Av[4], Bv[4];
#pragma unroll
        for (int j = 0; j < 4; ++j) { const int c0 = 4 * lane + 256 * j; const f32x4 sc = *(const f32x4*)(mb + D + c0); Bv[j] = *(const f32x4*)(mb + c0); Av[j] = *(const f32x4*)(gn + c0) * (1.0f + sc); }
        for (int r = 0; r < 16; r += 2) {
            f32x4 v[2][4];
#pragma unroll
            for (int q = 0; q < 2; ++q)
#pragma unroll
                for (int j = 0; j < 4; ++j) v[q][j] = *(const f32x4*)(xres + (size_t)(row0 + r + q) * D + 4 * lane + 256 * j);
            float ss[2];
#pragma unroll
            for (int q = 0; q < 2; ++q) { float s = 0.f;
#pragma unroll
                for (int j = 0; j < 4; ++j) s += (v[q][j][0] * v[q][j][0] + v[q][j][1] * v[q][j][1]) + (v[q][j][2] * v[q][j][2] + v[q][j][3] * v[q][j][3]);
                ss[q] = s; }
            ss[0] = wave_sum(ss[0]); ss[1] = wave_sum(ss[1]);
#pragma unroll
            for (int q = 0; q < 2; ++q) { const float rstd = rsqrtf(ss[q] * (1.0f / D) + EPS);
#pragma unroll
                for (int j = 0; j < 4; ++j) { v[q][j] = (v[q][j] * rstd) * Av[j] + Bv[j]; u32x2 o; o.x = pk2(v[q][j][0], v[q][j][1]); o.y = pk2(v[q][j][2], v[q][j][3]);
                    *(u32x2*)(H + (size_t)(row0 + r + q) * D + 4 * lane + 256 * j) = o; } }
            float lgv[2] = {0.f, 0.f};
#pragma unroll 3
            for (int n0 = 0; n0 < 36; n0 += 2) {
                float p[2][2];
#pragma unroll
                for (int nn = 0; nn < 2; ++nn) { float a0 = 0.f, a1 = 0.f;
#pragma unroll
                    for (int j = 0; j < 4; ++j) { const u32x2 wv = *(const LAS u32x2*)(Wr + (n0 + nn) * 1024 + 4 * lane + 256 * j); const float w0 = bflo(wv.x), w1 = bfhi(wv.x), w2 = bflo(wv.y), w3 = bfhi(wv.y);
                        a0 += v[0][j][0] * w0 + v[0][j][1] * w1 + v[0][j][2] * w2 + v[0][j][3] * w3; a1 += v[1][j][0] * w0 + v[1][j][1] * w1 + v[1][j][2] * w2 + v[1][j][3] * w3; }
                    p[0][nn] = a0; p[1][nn] = a1; }
#pragma unroll
                for (int nn = 0; nn < 2; ++nn) { const float s0 = wave_sum(p[0][nn]), s1 = wave_sum(p[1][nn]); lgv[0] = (lane == n0 + nn) ? s0 : lgv[0]; lgv[1] = (lane == n0 + nn) ? s1 : lgv[1]; }
            }
#pragma unroll
            for (int q = 0; q < 2; ++q) {
                const int m = row0 + r + q;
                float gl[4];
#pragma unroll
                for (int t = 0; t < 4; ++t) gl[t] = rdlane(lgv[q], t) + rgb[t];
                int gi = 0; float gm = gl[0];
#pragma unroll
                for (int t = 1; t < 4; ++t) if (gl[t] > gm) { gm = gl[t]; gi = t; }
                float gs = 0.f;
#pragma unroll
                for (int t = 0; t < 4; ++t) gs += __expf(gl[t] - gm);
                const float gwt = 1.0f / gs;
                gi = __builtin_amdgcn_readfirstlane(gi);
                float el[8];
#pragma unroll
                for (int t = 0; t < 8; ++t) el[t] = rdlane(lgv[q], 4 + gi * 8 + t) + reb[gi * 8 + t];
                int i0 = 0; float m0 = el[0];
#pragma unroll
                for (int t = 1; t < 8; ++t) if (el[t] > m0) { m0 = el[t]; i0 = t; }
                int i1 = -1; float m1 = -3.0e38f;
#pragma unroll
                for (int t = 0; t < 8; ++t) if (t != i0 && el[t] > m1) { m1 = el[t]; i1 = t; }
                const float ex = __expf(m1 - m0); const float w0 = gwt / (1.0f + ex), w1 = gwt * ex / (1.0f + ex);
                if (lane == 0) {
                    const int e0 = gi * 8 + i0, e1 = gi * 8 + i1;
                    const int r0 = (int)atomicAdd(cntl + e0, 1u), r1 = (int)atomicAdd(cntl + e1, 1u);
                    IDX2[e0 * MTOK + r0] = m; IDX2[e1 * MTOK + r1] = m;
                    ROUTE_I[m] = e0; ROUTE_I[MTOK + m] = e1; ROUTE_I[2 * MTOK + m] = r0; ROUTE_I[3 * MTOK + m] = r1; ROUTE_W[m] = w0; ROUTE_W[MTOK + m] = w1;
                }
            }
        }
    }
}
__device__ __forceinline__ void phase_moe_up(LAS unsigned char* lds, int layer) {
    KARGS(ap); unsigned char* ws = ap->ws;
    LAS int* TP = (LAS int*)(lds + TP_OFF); LAS int* AUX = (LAS int*)(lds + AUX_OFF);
    const unsigned* cntl = (const unsigned*)(ws + WS_CTL) + CW_CNT + layer * 64;
    { int tid = threadIdx.x; build_tp(TP, cntl, tid);
      pg8::MoeOrder S0; S0.G = gridDim.x; S0.c = blockIdx.x; S0.npt = 2; S0.total = TP[32] * 2; S0.tp = TP;
      const int* IDX2 = (const int*)(ws + WS_IDX2);
      pg8::Unit u; for (int i = 0; i < 8; ++i) { if (!S0.next(i, u)) break; const int e = u.pn >> 1, j = u.pm - TP[e], cnt = (int)cntl[e];
          if (tid < 256) { const int rank = j * 256 + tid; AUX[i * 256 + tid] = (rank < cnt ? IDX2[e * MTOK + rank] : 0) * (D * 2); } }
      __syncthreads(); }
    pg8::MoeOrder S; S.G = gridDim.x; S.c = blockIdx.x; S.npt = 2; S.total = TP[32] * 2; S.tp = TP;
    pg8::Gemm g{(const bf16*)(ws + WS_H), (const bf16*)(ws + WS_WGU) + (size_t)layer * NEXP * 512 * D, D};
    pg8::EpiSwiGLU E{(bf16*)(ws + WS_HID)};
    pg8::gemm_phase<pg8::EpiSwiGLU, pg8::MoeOrder, true>(lds, g, S, E, AUX);
}
__device__ __forceinline__ void phase_moe_down(LAS unsigned char* lds, int layer) {
    KARGS(ap); unsigned char* ws = ap->ws;
    LAS int* TP = (LAS int*)(lds + TP_OFF);
    build_tp(TP, (const unsigned*)(ws + WS_CTL) + CW_CNT + layer * 64, threadIdx.x);
    pg8::MoeOrder S; S.G = gridDim.x; S.c = blockIdx.x; S.npt = 4; S.total = TP[32] * 4; S.tp = TP;
    pg8::Gemm g{(const bf16*)(ws + WS_HID), (const bf16*)(ws + WS_WD) + (size_t)layer * NEXP * D * DEXP, DEXP};
    pg8::EpiBf16Store E{(bf16*)(ws + WS_YP), D};
    pg8::gemm_phase<pg8::EpiBf16Store, pg8::MoeOrder, false>(lds, g, S, E, nullptr);
}

__global__ void __launch_bounds__(512, 2) fwd(Args a) {
    extern __shared__ __attribute__((aligned(16))) unsigned char lds_raw[];
    LAS unsigned char* lds = (LAS unsigned char*)lds_raw;
    volatile LAS unsigned* MISC = (volatile LAS unsigned*)(lds + LDSCTL_OFF);
    for (int u = threadIdx.x; u < (LDS_BYTES - LDSCTL_OFF) / 4; u += 512) ((LAS unsigned*)(lds + LDSCTL_OFF))[u] = 0u;
    __syncthreads();
#if MK_ONE_LAUNCH
    { unsigned* ctl0 = (unsigned*)(a.ws + WS_CTL); (void)xcd_barrier_post(ctl0 + CW_BAR, MISC + 8); }
    constexpr int lo = 0, hi = N_PHASES;
#define SEAM(k) do { if ((k) + 1 < hi) { KARGS(_ap); XcdBarrier _b; _b.bar = (unsigned*)(_ap->ws + WS_CTL) + CW_BAR; _b.x = xb_xcc_id(); _b.st = (volatile LAS unsigned*)(lds + LDSCTL_OFF) + 8; xcd_barrier(_b); } } while (0)
#else
    (void)MISC;
    const int lo = a.ph_lo, hi = a.ph_hi;
#define SEAM(k) do { } while (0)
#endif
#define IN(k) (lo <= (k) && (k) < hi)
    if (EN_P0 && IN(0)) { phase_prologue(lds); SEAM(0); if (PROBE_D) { phase_prologue(lds); SEAM(0); } }
#define LAYER_PHASES(layer) do { constexpr int pb = 1 + PH_PER_LAYER * (layer); \
        if (EN_PA && IN(pb + 0)) { if ((layer) == 0) phase_norm1<0>(lds, (layer)); else phase_norm1<1>(lds, (layer)); SEAM(pb + 0); } \
        if (EN_PB && IN(pb + 1)) { phase_inproj(lds, (layer)); SEAM(pb + 1); } \
        if (EN_PC && IN(pb + 2)) { if (!MK_NAIVE_MIXER) phase_mixer<0>(lds, (layer)); SEAM(pb + 2); } \
        if (EN_PC && IN(pb + 3)) { if (MK_NAIVE_MIXER) phase_mixer_naive(lds, (layer)); else phase_mixer<1>(lds, (layer)); SEAM(pb + 3); } \
        if (EN_PD && IN(pb + 4)) { phase_outproj(lds, (layer)); SEAM(pb + 4); } \
        if (EN_PE && IN(pb + 5)) { phase_norm2_router(lds, (layer)); SEAM(pb + 5); } \
        if (EN_PG && IN(pb + 6)) { phase_moe_up(lds, (layer)); SEAM(pb + 6); if (PROBE_C) { phase_moe_up(lds, (layer)); SEAM(pb + 6); } } \
        if (EN_PH && IN(pb + 7)) { phase_moe_down(lds, (layer)); SEAM(pb + 7); if (PROBE_C) { phase_moe_down(lds, (layer)); SEAM(pb + 7); } } } while (0)
    LAYER_PHASES(0);
    LAYER_PHASES(1);
#undef LAYER_PHASES
    if (EN_PF && IN(PH_FINAL)) phase_norm1<2>(lds, 0);
#undef IN
#undef SEAM
}

extern "C" void kernel_launch(void* const* d_in, const int* in_sizes, int n_in, void* d_out, int out_size, void* d_ws, size_t ws_size, hipStream_t stream) {
    static int grid = 0;
    if (grid == 0) {
        if (n_in != 23 || out_size != MTOK * D || ws_size < WS_END) { fprintf(stderr, "kernel_launch: unexpected shapes (n_in %d out %d ws %zu)\n", n_in, out_size, ws_size); grid = -1; return; }
        int dev = 0, cus = 0;
        if (hipGetDevice(&dev) != hipSuccess || hipDeviceGetAttribute(&cus, hipDeviceAttributeMultiprocessorCount, dev) != hipSuccess) { grid = -1; return; }
        if (hipFuncSetAttribute((const void*)fwd, hipFuncAttributeMaxDynamicSharedMemorySize, LDS_BYTES) != hipSuccess) { fprintf(stderr, "kernel_launch: hipFuncSetAttribute failed\n"); grid = -1; return; }
        int per_cu = 0;
        if (hipOccupancyMaxActiveBlocksPerMultiprocessor(&per_cu, (const void*)fwd, 512, LDS_BYTES) != hipSuccess || per_cu < 1) fprintf(stderr, "kernel_launch: occupancy query reports %d\n", per_cu);
        (void)hipGetLastError();
        grid = cus;
    }
    if (grid < 0) return;
    (void)hipMemsetAsync((char*)d_ws + WS_CTL, 0, CTL_ZERO_BYTES, stream);
    Args a{};
    for (int i = 0; i < 23; ++i) a.in[i] = (const float*)d_in[i];
    a.out = (float*)d_out; a.ws = (unsigned char*)d_ws;
    for (int j = 0; j < 32; ++j) a.inv_freq[j] = (float)std::pow(10000.0, -(double)j / 32.0);
#if MK_ONE_LAUNCH
    a.ph_lo = 0; a.ph_hi = N_PHASES;
    hipLaunchKernelGGL(fwd, dim3(grid), dim3(512), LDS_BYTES, stream, a);
#else
    for (int p = 0; p < N_PHASES; ++p) { a.ph_lo = p; a.ph_hi = p + 1; hipLaunchKernelGGL(fwd, dim3(grid), dim3(512), LDS_BYTES, stream, a); }
#endif
}
```

```cpp
#include <hip/hip_runtime.h>
#include <cstdio>
#include <cstdint>
#include <cmath>

#define GAS __attribute__((address_space(1)))
#define LAS __attribute__((address_space(3)))
typedef unsigned short bf16;
typedef short bf16x8 __attribute__((ext_vector_type(8)));
typedef float f32x4 __attribute__((ext_vector_type(4)));
typedef float f32x2 __attribute__((ext_vector_type(2)));
typedef unsigned u32x4 __attribute__((ext_vector_type(4)));
typedef unsigned u32x2 __attribute__((ext_vector_type(2)));

#ifndef EN_P0
#define EN_P0 1
#endif
#ifndef EN_PA
#define EN_PA 1
#endif
#ifndef EN_PB
#define EN_PB 1
#endif
#ifndef EN_PC
#define EN_PC 1
#endif
#ifndef EN_PD
#define EN_PD 1
#endif
#ifndef EN_PE
#define EN_PE 1
#endif
#ifndef EN_PG
#define EN_PG 1
#endif
#ifndef EN_PH
#define EN_PH 1
#endif
#ifndef EN_PF
#define EN_PF 1
#endif
#ifndef PROBE_M
#define PROBE_M 0
#endif
#ifndef PROBE_M3
#define PROBE_M3 0
#endif
#ifndef PROBE_A
#define PROBE_A 0
#endif
#ifndef PROBE_PD
#define PROBE_PD 0
#endif
#ifndef PROBE_BAR
#define PROBE_BAR 0
#endif
#ifndef PROBE_B
#define PROBE_B 0
#endif
#ifndef PROBE_C
#define PROBE_C 0
#endif
#ifndef PROBE_D
#define PROBE_D 0
#endif
#ifndef MK_NAIVE_MIXER
#define MK_NAIVE_MIXER 0
#endif
#ifndef MK_ONE_LAUNCH
#define MK_ONE_LAUNCH 1
#endif

constexpr int NB = 8, SEQ = 4096, MTOK = NB * SEQ, D = 1024, DEPTH = 2;
constexpr int NPROJ = 4096;
constexpr int INP = 3856;
constexpr int C_RQ = 0, C_RK = 384, C_RV = 768, C_RG = 1152, C_HQ = 1536, C_HF = 1920, C_HI = 2304, C_HG = 2688, C_GQ = 3072, C_GK = 3200, C_GV = 3328, C_GG = 3584, C_GA = 3840;
constexpr int NEXP = 32, DEXP = 256;
constexpr int MAXROWS = 73728;
constexpr float EPS = 1e-6f;

constexpr size_t MiB = 1u << 20;
constexpr size_t WS_CTL = 0, CTL_ZERO_BYTES = 1 * MiB;
constexpr size_t WS_MOD = 1 * MiB;
constexpr size_t WS_ROPE = 2 * MiB;
constexpr size_t WS_WIN = 10 * MiB;
constexpr size_t WS_WOUT = 26 * MiB;
constexpr size_t WS_WGU = 30 * MiB;
constexpr size_t WS_WD = 94 * MiB;
constexpr size_t WS_H = 126 * MiB;
constexpr size_t WS_PROJ = 190 * MiB;
constexpr size_t WS_HID = 190 * MiB;
constexpr size_t WS_YP = 226 * MiB;
constexpr size_t WS_STATE = 446 * MiB;
constexpr size_t WS_ROUTE = 474 * MiB;
constexpr size_t WS_IDX2 = 476 * MiB;
constexpr size_t WS_END = 480 * MiB;
constexpr int CW_CNT = 64;
constexpr int CW_BAR = 4096;

constexpr int RING_BYTES = 131072;
constexpr int LDSCTL_OFF = RING_BYTES;
constexpr int TP_OFF = RING_BYTES + 512;
constexpr int AUX_OFF = RING_BYTES + 1024;
constexpr int LDS_BYTES = 147456;

#define RLX_AGENT __ATOMIC_RELAXED, __HIP_MEMORY_SCOPE_AGENT
#define LDS_WAIT() asm volatile("s_waitcnt lgkmcnt(0)" ::: "memory")
#define VM_WAIT() asm volatile("s_waitcnt vmcnt(0)" ::: "memory")

__device__ __forceinline__ unsigned f2bf(float f) { unsigned u = __builtin_bit_cast(unsigned, f); return (u + 0x7fffu + ((u >> 16) & 1u)) >> 16; }
__device__ __forceinline__ unsigned pk2(float lo, float hi) { return f2bf(lo) | (f2bf(hi) << 16); }
__device__ __forceinline__ float bf2f(unsigned short b) { return __builtin_bit_cast(float, ((unsigned)b) << 16); }
__device__ __forceinline__ float bflo(unsigned w) { return __builtin_bit_cast(float, w << 16); }
__device__ __forceinline__ float bfhi(unsigned w) { return __builtin_bit_cast(float, w & 0xffff0000u); }
__device__ __forceinline__ float sigmoidf_(float x) { return 1.0f / (1.0f + __expf(-x)); }
__device__ __forceinline__ float siluf_(float x) { return x / (1.0f + __expf(-x)); }
template <int CTRL, int RMASK, bool BC> __device__ __forceinline__ float dpp_f(float v) {
    return __builtin_bit_cast(float, __builtin_amdgcn_update_dpp(0, __builtin_bit_cast(int, v), CTRL, RMASK, 0xf, BC)); }
__device__ __forceinline__ float rdlane(float v, int l) { return __builtin_bit_cast(float, __builtin_amdgcn_readlane(__builtin_bit_cast(int, v), l)); }
__device__ __forceinline__ float wave_sum(float v) {
    v += dpp_f<0x128, 0xf, false>(v); v += dpp_f<0x124, 0xf, false>(v); v += dpp_f<0x122, 0xf, false>(v); v += dpp_f<0x121, 0xf, false>(v);
    v += dpp_f<0x142, 0xa, false>(v); v += dpp_f<0x143, 0xc, false>(v);
    return rdlane(v, 63);
}
__device__ __forceinline__ float wave_incl_scan(float v) {
    v += dpp_f<0x111, 0xf, true>(v); v += dpp_f<0x112, 0xf, true>(v); v += dpp_f<0x114, 0xf, true>(v); v += dpp_f<0x118, 0xf, true>(v);
    v += dpp_f<0x142, 0xa, false>(v); v += dpp_f<0x143, 0xc, false>(v);
    return v;
}
#define XB_TMO      128
#define XB_XCNT(j)  (256  + 64 * (j))
#define XB_XSUB(j)  (1280 + 64 * (j))
#define XB_XGEN(j)  (2304 + 64 * (j))
#define XB_TOP      3328
#define XB_TOPGEN   3392
#define XCD_BAR_WORDS 3456
#define XB_SPIN_CAP (1u << 18)
__device__ __forceinline__ unsigned xb_ld(unsigned* p)              { return __hip_atomic_load(p, __ATOMIC_RELAXED, __HIP_MEMORY_SCOPE_AGENT); }
__device__ __forceinline__ unsigned xb_add(unsigned* p, unsigned v) { return __hip_atomic_fetch_add(p, v, __ATOMIC_RELAXED, __HIP_MEMORY_SCOPE_AGENT); }
__device__ __forceinline__ unsigned xb_xcc_id() { return (unsigned)__builtin_amdgcn_s_getreg((3 << 11) | 20) & 0xFu; }
#define XB_SPIN(cond, bar) do { unsigned _sp = 0; while (cond) { __builtin_amdgcn_s_sleep(1); \
    if ((++_sp & 255u) == 0u) { if (xb_ld(&(bar)[XB_TMO])) break; if (_sp > XB_SPIN_CAP) { atomicAdd(&(bar)[XB_TMO], 1u); break; } } } } while (0)
struct XcdBarrier { unsigned* bar; unsigned x; volatile LAS unsigned* st; };
__device__ __forceinline__ XcdBarrier xcd_barrier_post(unsigned* bar, volatile LAS unsigned* st) {
    XcdBarrier b; b.bar = bar; b.x = xb_xcc_id(); b.st = st;
    if (threadIdx.x == 0) (void)xb_add(&bar[XB_XCNT(b.x)], 1u);
    return b;
}
__device__ __forceinline__ void xcd_barrier_complete(unsigned* bar, unsigned x, unsigned& nloc, unsigned& nx) {
    const unsigned G = gridDim.x * gridDim.y * gridDim.z;
    unsigned sum, cnt, mine, sp = 0u;
    for (;;) {
        sum = 0u; cnt = 0u; mine = 0u;
#pragma unroll
        for (unsigned j = 0; j < 16; ++j) { const unsigned c = xb_ld(&bar[XB_XCNT(j)]); sum += c; cnt += (c > 0u) ? 1u : 0u; mine = (j == x) ? c : mine; }
        if (sum == G) break;
        __builtin_amdgcn_s_sleep(1);
        if ((++sp & 255u) == 0u) { if (xb_ld(&bar[XB_TMO])) break; if (sp > XB_SPIN_CAP) { atomicAdd(&bar[XB_TMO], 1u); break; } }
    }
    nloc = mine > 0u ? mine : 1u; nx = cnt > 0u ? cnt : 1u;
}
__device__ __forceinline__ void xcd_barrier(const XcdBarrier& b) {
    asm volatile("s_waitcnt vmcnt(0)" ::: "memory");
    __syncthreads();
    if (threadIdx.x == 0) {
        unsigned* bar = b.bar;
        __builtin_amdgcn_s_waitcnt(0);
        unsigned nloc = b.st[0], nx = b.st[1];
        if (nloc == 0u) { xcd_barrier_complete(bar, b.x, nloc, nx); b.st[0] = nloc; b.st[1] = nx; }
        const unsigned old = xb_add(&bar[XB_XSUB(b.x)], 1u);
        const unsigned gen = old / nloc;
        if (old + 1u == (gen + 1u) * nloc) {
            __builtin_amdgcn_fence(__ATOMIC_RELEASE, "agent");
            asm volatile("s_waitcnt vmcnt(0)" ::: "memory");
            const unsigned og = xb_add(&bar[XB_TOP], 1u);
            const unsigned tg = og / nx;
            if (og + 1u == (tg + 1u) * nx) xb_add(&bar[XB_TOPGEN], 1u);
            else XB_SPIN(xb_ld(&bar[XB_TOPGEN]) == tg, bar);
            __builtin_amdgcn_fence(__ATOMIC_ACQUIRE, "agent");
            xb_add(&bar[XB_XGEN(b.x)], 1u);
            asm volatile("s_waitcnt vmcnt(0)" ::: "memory");
        } else {
            XB_SPIN(xb_ld(&bar[XB_XGEN(b.x)]) == gen, bar);
            __builtin_amdgcn_fence(__ATOMIC_ACQUIRE, "agent");
            asm volatile("s_waitcnt vmcnt(0)" ::: "memory");
        }
    }
    __syncthreads();
}

namespace pg8 {
constexpr int BM = 256, BK = 64, HALF = 128, HTB = HALF * BK * 2, STAGE_BYTES = 8 * HTB, NXCD = 8, WGM = 8;
__host__ __device__ __forceinline__ int lds_byte(int r, int c) { const int st = (r >> 4) * 2 + (c >> 5), rr = r & 15, cc = c & 31, ob = rr * 64 + cc * 2; return st * 1024 + (ob ^ (((ob >> 9) & 1) << 5)); }
__host__ __device__ __forceinline__ void stage_rc(int b, int& R, int& C) { const int st = b / 1024, sb = b % 1024, swz = sb ^ (((sb >> 9) & 1) << 5); R = (st >> 1) * 16 + swz / 64; C = (st & 1) * 32 + (swz % 64) / 2; }
__host__ __device__ __forceinline__ int perm32(int rho) { const int n = rho >> 4, i = rho & 15; return 8 * (i >> 2) + 4 * n + (i & 3); }
struct Unit { int pm, pn, pc; };
struct Gemm { const bf16* A; const bf16* Bt; int K; };

struct StaticOrder {
    int nM, nN, nwg, G, c;
    __device__ void init(int M, int N, int G_, int c_) { nM = M / BM; nN = N / BM; nwg = nM * nN; G = G_; c = c_; }
    __device__ bool next(int i, Unit& u) const {
        const long L = (long)i * G + c; if (L >= nwg) return false;
        int wgid = (int)L; { const int q = nwg / NXCD, r = nwg % NXCD, xcd = wgid % NXCD, off = wgid / NXCD; wgid = (xcd < r ? xcd * (q + 1) : r * (q + 1) + (xcd - r) * q) + off; }
        const int nig = WGM * nN, gid = wgid / nig, fm = gid * WGM, gsz = (nM - fm) < WGM ? (nM - fm) : WGM;
        u.pm = fm + ((wgid % nig) % gsz); u.pn = (wgid % nig) / gsz; u.pc = u.pn; return true;
    }
};
struct MoeOrder {
    int G, c, npt, total; const LAS int* tp;
    __device__ bool next(int i, Unit& u) const {
        const int L = i * G + c; if (L >= total) return false;
        const int mt = L / npt, nl = L % npt; int e = 0;
        while (e < 31 && tp[e + 1] <= mt) ++e;
        u.pm = mt; u.pn = e * npt + nl; u.pc = nl; return true;
    }
};

__device__ __forceinline__ unsigned cvt_pk_bf16(float lo, float hi) { unsigned r; asm volatile("v_cvt_pk_bf16_f32 %0, %1, %2" : "=v"(r) : "v"(lo), "v"(hi)); return r; }

struct EpiBf16Store {
    static constexpr bool PERM = true;
    bf16* O; int ldc;
    __device__ __forceinline__ void operator()(const f32x4 (&acc)[2][2][4][2], const Unit& u, int wr, int wc, int fr, int fq) const {
        const int row0 = u.pm * BM + wr * 64 + fr, col0 = u.pc * BM + wc * 32 + 8 * fq;
#pragma unroll
        for (int ai = 0; ai < 2; ++ai)
#pragma unroll
            for (int m = 0; m < 4; ++m) { bf16* rowp = O + (size_t)(row0 + ai * HALF + m * 16) * ldc + col0;
#pragma unroll
                for (int bj = 0; bj < 2; ++bj) { const f32x4 v0 = acc[ai][bj][m][0], v1 = acc[ai][bj][m][1];
                    u32x4 w; w.x = cvt_pk_bf16(v0[0], v0[1]); w.y = cvt_pk_bf16(v0[2], v0[3]); w.z = cvt_pk_bf16(v1[0], v1[1]); w.w = cvt_pk_bf16(v1[2], v1[3]);
                    *(u32x4*)(rowp + bj * HALF) = w; } }
    }
};
struct EpiSwiGLU {
    static constexpr bool PERM = true;
    bf16* O;
    __device__ __forceinline__ void operator()(const f32x4 (&acc)[2][2][4][2], const Unit& u, int wr, int wc, int fr, int fq) const {
        const int row0 = u.pm * BM + wr * 64 + fr, col0 = u.pc * HALF + wc * 32 + 8 * fq;
#pragma unroll
        for (int ai = 0; ai < 2; ++ai)
#pragma unroll
            for (int m = 0; m < 4; ++m) { bf16* rowp = O + (size_t)(row0 + ai * HALF + m * 16) * DEXP + col0;
                float h[8];
#pragma unroll
                for (int n = 0; n < 2; ++n)
#pragma unroll
                    for (int j = 0; j < 4; ++j) { const float g = acc[ai][0][m][n][j], up = acc[ai][1][m][n][j]; h[n * 4 + j] = g / (1.0f + __expf(-g)) * up; }
                u32x4 w; w.x = cvt_pk_bf16(h[0], h[1]); w.y = cvt_pk_bf16(h[2], h[3]); w.z = cvt_pk_bf16(h[4], h[5]); w.w = cvt_pk_bf16(h[6], h[7]);
                *(u32x4*)rowp = w; }
    }
};
struct EpiResGate {
    static constexpr bool PERM = false;
    const float* res; float* out; const float* gate;
    __device__ __forceinline__ void operator()(const f32x4 (&acc)[2][2][4][2], const Unit& u, int wr, int wc, int fr, int fq) const {
        const int row0 = u.pm * BM + wr * 64 + fr, col0 = u.pc * BM + wc * 32 + 4 * fq;
        const float* gb = gate + (size_t)(u.pm >> 4) * 6144;
        f32x4 gv[2][2];
#pragma unroll
        for (int bj = 0; bj < 2; ++bj)
#pragma unroll
            for (int n = 0; n < 2; ++n) gv[bj][n] = *(const f32x4*)(gb + col0 + bj * HALF + n * 16);
#pragma unroll
        for (int ai = 0; ai < 2; ++ai)
#pragma unroll
            for (int m = 0; m < 4; ++m) { const size_t off = (size_t)(row0 + ai * HALF + m * 16) * D + col0;
#pragma unroll
                for (int bj = 0; bj < 2; ++bj)
#pragma unroll
                    for (int n = 0; n < 2; ++n) { const f32x4 r = *(const f32x4*)(res + off + bj * HALF + n * 16); *(f32x4*)(out + off + bj * HALF + n * 16) = r + gv[bj][n] * acc[ai][bj][m][n]; } }
    }
};

template <class Epi, class Sched, bool GATHER>
__device__ __forceinline__ void gemm_phase(LAS unsigned char* lds, const Gemm g, const Sched& S, const Epi& E, const LAS int* gidx) {
    const int tid = threadIdx.x, wid = __builtin_amdgcn_readfirstlane(tid >> 6), lane = tid & 63, wr = wid >> 2, wc = wid & 3, fr = lane & 15, fq = lane >> 4;
    const int K = g.K, nt = K / BK;
    unsigned voffA[2], voffB[2];
#pragma unroll
    for (int i = 0; i < 2; ++i) { int R, C; stage_rc(tid * 16 + i * 8192, R, C); const int Rb = Epi::PERM ? ((R & ~31) + perm32(R & 31)) : R;
        voffA[i] = (unsigned)(R * K + C) * 2u; voffB[i] = (unsigned)(Rb * K + C) * 2u; }
    const size_t kstep = (size_t)(BK * 2);
    const size_t hstep = (size_t)HALF * K * 2;
    const size_t tstep = 2 * hstep;
    const unsigned ldsw = (unsigned)wid * 1024u;
    const int aoff = lds_byte(wr * 64 + fr, fq * 8), boff = lds_byte(wc * 32 + fr, fq * 8);
    int nslot = 0;
#define PG8_SA(b, h) (((b) * 2 + (h)) * HTB)
#define PG8_SB(b, h) ((4 + (b) * 2 + (h)) * HTB)
#define PG8_GLDS(gp, lp) __builtin_amdgcn_global_load_lds((const unsigned*)(gp), (LAS unsigned*)(lp), 16, 0, 0)
#define PG8_STAGE(bufoff, gbase, voff) do { _Pragma("unroll") for (int _i = 0; _i < 2; ++_i) PG8_GLDS((const char*)(gbase) + (voff)[_i], lds + (bufoff) + ldsw + _i * 8192); } while (0)
#define PG8_STAGE_A(bufoff, gptr, h, nx) do { if constexpr (GATHER) { const int _slot = (nx) ? nslot : ui; _Pragma("unroll") for (int _i = 0; _i < 2; ++_i) { int _R, _C; stage_rc(tid * 16 + _i * 8192, _R, _C); \
            const unsigned _vo = (unsigned)gidx[_slot * 256 + (h) * HALF + _R] + (unsigned)_C * 2u; PG8_GLDS((const char*)(gptr) + _vo, lds + (bufoff) + ldsw + _i * 8192); } } \
        else { PG8_STAGE(bufoff, (const char*)(gptr) + (h) * hstep, voffA); } } while (0)
#define PG8_LDA(dst, b, h) do { _Pragma("unroll") for (int m = 0; m < 4; ++m) _Pragma("unroll") for (int k = 0; k < 2; ++k) dst[m][k] = *(const LAS bf16x8*)(lds + PG8_SA(b, h) + aoff + m * 2048 + k * 1024); } while (0)
#define PG8_LDB(dst, b, h) do { _Pragma("unroll") for (int n = 0; n < 2; ++n) _Pragma("unroll") for (int k = 0; k < 2; ++k) dst[n][k] = *(const LAS bf16x8*)(lds + PG8_SB(b, h) + boff + n * 2048 + k * 1024); } while (0)
#define PG8_MMA(ai, bj, At, Bt) do { __builtin_amdgcn_s_setprio(1); _Pragma("unroll") for (int m = 0; m < 4; ++m) _Pragma("unroll") for (int n = 0; n < 2; ++n) _Pragma("unroll") for (int k = 0; k < 2; ++k) \
        acc[ai][bj][m][n] = __builtin_amdgcn_mfma_f32_16x16x32_bf16(Bt[n][k], At[m][k], acc[ai][bj][m][n], 0, 0, 0); __builtin_amdgcn_s_setprio(0); } while (0)
#define PG8_WAIT_V(n) asm volatile("s_waitcnt vmcnt(" #n ")" ::: "memory")
#define PG8_WAIT_L(n) asm volatile("s_waitcnt lgkmcnt(" #n ")" ::: "memory")
#define PG8_BAR __builtin_amdgcn_s_barrier()
#define PG8_SCHED __builtin_amdgcn_sched_barrier(0)
    Unit cur, nxt; int ui = 0;
    if (!S.next(0, cur)) return;
    f32x4 acc[2][2][4][2];
#pragma unroll
    for (int a = 0; a < 2; ++a)
#pragma unroll
        for (int b = 0; b < 2; ++b)
#pragma unroll
            for (int m = 0; m < 4; ++m)
#pragma unroll
                for (int n = 0; n < 2; ++n) acc[a][b][m][n] = (f32x4){0.f, 0.f, 0.f, 0.f};
    bf16x8 At[4][2], B0[2][2], B1[2][2];
    const char* cA = (const char*)g.A + (GATHER ? (size_t)0 : (size_t)cur.pm * tstep); const char* cB = (const char*)g.Bt + (size_t)cur.pn * tstep;
    PG8_STAGE(PG8_SB(0, 0), cB, voffB); PG8_STAGE(PG8_SB(0, 1), cB + hstep, voffB); PG8_STAGE_A(PG8_SA(0, 0), cA, 0, false); PG8_STAGE_A(PG8_SA(0, 1), cA, 1, false);
    if (wr == 1) PG8_BAR;
    PG8_WAIT_V(2); PG8_BAR;
    PG8_STAGE(PG8_SB(1, 0), cB + kstep, voffB); PG8_STAGE_A(PG8_SA(1, 0), cA + kstep, 0, false); PG8_STAGE(PG8_SB(1, 1), cB + hstep + kstep, voffB);
    PG8_WAIT_V(6); PG8_BAR;
    for (;;) {
        const bool has_next = S.next(ui + 1, nxt);
        const char* nA = has_next ? (const char*)g.A + (GATHER ? (size_t)0 : (size_t)nxt.pm * tstep) : cA; const char* nB = has_next ? (const char*)g.Bt + (size_t)nxt.pn * tstep : cB;
        if constexpr (GATHER) nslot = has_next ? ui + 1 : ui;
        for (int t = 0; t < nt; t += 2) {
            const bool last = (t == nt - 2);
            const char* a1 = cA + (size_t)(t + 1) * kstep;
            const char* a2 = last ? nA : cA + (size_t)(t + 2) * kstep; const char* b2 = last ? nB : cB + (size_t)(t + 2) * kstep;
            const char* a3 = a2 + kstep; const char* b3 = b2 + kstep;
            PG8_LDB(B0, 0, 0); PG8_LDB(B1, 0, 1); PG8_SCHED; PG8_LDA(At, 0, 0); PG8_STAGE_A(PG8_SA(1, 1), a1, 1, false);
            PG8_WAIT_V(8); PG8_WAIT_L(0); PG8_BAR; PG8_MMA(0, 0, At, B0); PG8_MMA(0, 1, At, B1); PG8_BAR; PG8_SCHED;
            PG8_LDA(At, 0, 1); PG8_STAGE(PG8_SB(0, 0), b2, voffB); PG8_STAGE(PG8_SB(0, 1), b2 + hstep, voffB); PG8_STAGE_A(PG8_SA(0, 0), a2, 0, last);
            PG8_WAIT_V(8); PG8_WAIT_L(0); PG8_BAR; PG8_MMA(1, 0, At, B0); PG8_MMA(1, 1, At, B1); PG8_BAR; PG8_SCHED;
            PG8_LDB(B0, 1, 0); PG8_LDB(B1, 1, 1); PG8_SCHED; PG8_LDA(At, 1, 0); PG8_STAGE_A(PG8_SA(0, 1), a2, 1, last);
            PG8_WAIT_V(8); PG8_WAIT_L(0); PG8_BAR; PG8_MMA(0, 0, At, B0); PG8_MMA(0, 1, At, B1); PG8_BAR; PG8_SCHED;
            PG8_LDA(At, 1, 1); PG8_STAGE(PG8_SB(1, 0), b3, voffB); PG8_STAGE(PG8_SB(1, 1), b3 + hstep, voffB); PG8_STAGE_A(PG8_SA(1, 0), a3, 0, last);
            PG8_WAIT_V(8); PG8_WAIT_L(0); PG8_BAR; PG8_MMA(1, 0, At, B0); PG8_MMA(1, 1, At, B1); PG8_BAR; PG8_SCHED;
        }
        if (wr == 0) PG8_BAR;
        E(acc, cur, wr, wc, fr, fq);
        if (!has_next) break;
#pragma unroll
        for (int a = 0; a < 2; ++a)
#pragma unroll
            for (int b = 0; b < 2; ++b)
#pragma unroll
                for (int m = 0; m < 4; ++m)
#pragma unroll
                    for (int n = 0; n < 2; ++n) acc[a][b][m][n] = (f32x4){0.f, 0.f, 0.f, 0.f};
        cur = nxt; cA = nA; cB = nB; ++ui;
        if (wr == 1) PG8_BAR;
    }
    PG8_WAIT_V(0);
    PG8_BAR;
#undef PG8_SA
#undef PG8_SB
#undef PG8_GLDS
#undef PG8_STAGE
#undef PG8_STAGE_A
#undef PG8_LDA
#undef PG8_LDB
#undef PG8_MMA
#undef PG8_WAIT_V
#undef PG8_WAIT_L
#undef PG8_BAR
#undef PG8_SCHED
}
}

struct Args { const float* in[23]; float* out; unsigned char* ws; float inv_freq[32]; int ph_lo, ph_hi; };
enum { I_X = 0, I_C, I_POS, I_WADA, I_BADA, I_NMIX, I_NFFN, I_WIN, I_RETN, I_HGRNN, I_LBL, I_WA2, I_BA, I_GLAN, I_WOUT, I_RGW, I_RGB, I_REW, I_REB, I_EG, I_EU, I_ED, I_NFIN };
constexpr int PH_PER_LAYER = 8, PH_FINAL = 1 + 2 * PH_PER_LAYER, N_PHASES = PH_FINAL + 1;

__device__ __forceinline__ void transpose_item(const float* W, int ldw, int K, int k0, int n0, bf16* WT, int dst_row0, LAS float* scr, int lane) {
#pragma unroll 8
    for (int i = 0; i < 32; ++i) { const int kk = 2 * i + (lane >> 5); scr[kk * 33 + (lane & 31)] = W[(size_t)(k0 + kk) * ldw + n0 + (lane & 31)]; }
    LDS_WAIT(); asm volatile("" ::: "memory");
    const int c = lane & 7;
#pragma unroll
    for (int j = 0; j < 4; ++j) { const int n = (lane >> 3) + 8 * j; const LAS float* s = scr + (8 * c) * 33 + n;
        u32x4 o; o.x = pk2(s[0 * 33], s[1 * 33]); o.y = pk2(s[2 * 33], s[3 * 33]); o.z = pk2(s[4 * 33], s[5 * 33]); o.w = pk2(s[6 * 33], s[7 * 33]);
        *(u32x4*)(WT + (size_t)(dst_row0 + n) * K + k0 + 8 * c) = o; }
    LDS_WAIT(); asm volatile("" ::: "memory");
}
__device__ __forceinline__ void sincos_acc(float a, float& s, float& c) {
    const double ad = (double)a; const double kd = rint(ad * 0.63661977236758134308); const double rd = fma(-kd, 1.57079632679489661923, ad);
    const int q = (int)kd & 3; const float r = (float)rd, r2 = r * r;
    const float sp = r + r * r2 * (-1.6666667163e-1f + r2 * (8.3333337680e-3f + r2 * (-1.9841270114e-4f + r2 * 2.7557314297e-6f)));
    const float cp = 1.0f + r2 * (-0.5f + r2 * (4.1666667908e-2f + r2 * (-1.3888889225e-3f + r2 * (2.4801587642e-5f + r2 * -2.7557314297e-7f))));
    const float ss = (q & 1) ? cp : sp, cc = (q & 1) ? sp : cp;
    s = (q & 2) ? -ss : ss; c = ((q + 1) & 2) ? -cc : cc;
}

typedef const __attribute__((address_space(4))) Args KArgs;
#define KARGS(ap) KArgs* ap = (KArgs*)__builtin_amdgcn_kernarg_segment_ptr(); asm volatile("" : "+s"(ap))
#define PHASE_IDS() int tid = threadIdx.x; asm volatile("" : "+v"(tid)); const int lane = tid & 63, wave = __builtin_amdgcn_readfirstlane(tid >> 6); \
    const int G = gridDim.x, bid = blockIdx.x, gw = bid * 8 + wave, NGW = G * 8; (void)lane; (void)wave; (void)gw; (void)NGW; (void)G; (void)bid

template <int TYPE>
__device__ __forceinline__ void naive_mixer_item(LAS unsigned char* lds, KArgs* ap, int layer, int b, int hh  , int tid) {
    constexpr int DK = (TYPE == 2) ? 32 : 64, DKW = DK / 8;
    LAS float* Qs = (LAS float*)lds; LAS float* Ks = Qs + 4096; LAS float* As = Ks + 4096; LAS float* Vs = As + 4096; LAS float* Os = Vs + 4096; LAS float* Ps = Os + 4096;
    unsigned char* ws = ap->ws;
    const bf16* PROJ = (const bf16*)(ws + WS_PROJ); bf16* H = (bf16*)(ws + WS_H);
    const f32x2* ROPE = (const f32x2*)(ws + WS_ROPE);
    const float* lbl = ap->in[I_LBL]; const float* gba = ap->in[I_BA];
    const int e = tid & 63, w = tid >> 6;
    const int qc = (TYPE == 0 ? C_RQ + hh * 64 : TYPE == 1 ? C_HQ + hh * 64 : C_GQ + hh * 32);
    const int kc = (TYPE == 0 ? C_RK + hh * 64 : TYPE == 1 ? C_HF + hh * 64 : C_GK + hh * 32);
    const int vc = (TYPE == 0 ? C_RV : TYPE == 1 ? C_HI : C_GV) + hh * 64;
    const int gc = (TYPE == 0 ? C_RG : TYPE == 1 ? C_HG : C_GG) + hh * 64;
    const int mc = (TYPE == 0 ? 0 : TYPE == 1 ? 384 : 768) + hh * 64;
    const float* gain = ap->in[TYPE == 0 ? I_RETN : TYPE == 1 ? I_HGRNN : I_GLAN] + layer * (TYPE == 2 ? 256 : 384) + hh * 64;
    float S[DKW];
#pragma unroll
    for (int i = 0; i < DKW; ++i) S[i] = 0.f;
    for (int n = 0; n < 64; ++n) {
        __syncthreads();
        const size_t row0 = (size_t)b * SEQ + (size_t)n * 64;
        for (int idx = tid; idx < 4096; idx += 512) {
            const int t = idx >> 6, d = idx & 63; const bf16* p = PROJ + (row0 + t) * NPROJ;
            Vs[idx] = bf2f(p[vc + d]);
            if (TYPE == 0) {
                const int j = d & 31; const f32x2 cs = ROPE[(row0 + t) * 32 + j];
                const float q1 = bf2f(p[qc + j]), q2 = bf2f(p[qc + 32 + j]), k1 = bf2f(p[kc + j]), k2 = bf2f(p[kc + 32 + j]);
                Qs[idx] = d < 32 ? q1 * cs.x - q2 * cs.y : q1 * cs.y + q2 * cs.x;
                Ks[idx] = (d < 32 ? k1 * cs.x - k2 * cs.y : k1 * cs.y + k2 * cs.x) * 0.125f;
                As[idx] = 1.0f - exp2f(-5.0f - (float)hh);
            } else if (TYPE == 1) {
                const float l0 = lbl[hh * 64 + d], l1 = lbl[384 + hh * 64 + d]; const float mx = fmaxf(l0, l1), e0 = expf(l0 - mx), e1 = expf(l1 - mx);
                const float lb = layer == 0 ? 0.f : e1 / (e0 + e1);
                const float z = bf2f(p[kc + d]); const float f = lb + (1.0f - lb) * sigmoidf_(z);
                As[idx] = fmaxf(f, 1e-30f); Ks[idx] = (1.0f - lb) * sigmoidf_(-z); Qs[idx] = siluf_(bf2f(p[qc + d])) * 0.125f;
            } else {
                if (d < 32) { const float pre = bf2f(p[C_GA + hh * 32 + d]) + gba[layer * 128 + hh * 32 + d];
                    const float ls = fminf(pre, 0.f) - log1pf(expf(-fabsf(pre)));
                    As[t * 64 + d] = expf(ls * (1.0f / 16.0f)); Ks[t * 64 + d] = bf2f(p[kc + d]); Qs[t * 64 + d] = bf2f(p[qc + d]) * 0.17677669529663687f; }
            }
        }
        __syncthreads();
        for (int t0 = 0; t0 < 64; t0 += 16) {
            for (int tt = 0; tt < 16; ++tt) { const int t = t0 + tt; const float v = Vs[t * 64 + e]; float part = 0.f;
#pragma unroll
                for (int i = 0; i < DKW; ++i) { const int d = w * DKW + i; S[i] = As[t * 64 + d] * S[i] + Ks[t * 64 + d] * v; part += Qs[t * 64 + d] * S[i]; }
                Ps[(tt * 8 + w) * 64 + e] = part; }
            __syncthreads();
            for (int idx = tid; idx < 1024; idx += 512) { const int tt = idx >> 6, ee = idx & 63; float o = 0.f;
#pragma unroll
                for (int ww = 0; ww < 8; ++ww) o += Ps[(tt * 8 + ww) * 64 + ee];
                Os[(t0 + tt) * 64 + ee] = o; }
            __syncthreads();
        }
        for (int tt = 0; tt < 8; ++tt) { const int t = w * 8 + tt; const float o = Os[t * 64 + e]; const float ss = wave_sum(o * o); const float r = rsqrtf(ss * (1.0f / 64.0f) + EPS);
            const float g = bf2f(PROJ[(row0 + t) * NPROJ + gc + e]);
            H[(row0 + t) * D + mc + e] = (bf16)f2bf(o * r * gain[e] * siluf_(g)); }
    }
}

constexpr int MX_PITCH = 72;
constexpr int MX_ARR = 64 * MX_PITCH * 2;
constexpr int MX_GROUP_BYTES = 5 * MX_ARR + 5 * 256 + 256;
constexpr int NSC = 4, NCH = 64 / NSC;
constexpr int ST_REC = 4096 + 64;
__device__ __forceinline__ float bfx(const u32x4& r, int i) { const unsigned w = r[i >> 1]; return (i & 1) ? bfhi(w) : bflo(w); }
__device__ __forceinline__ unsigned short bfbits(const u32x4& r, int i) { const unsigned w = r[i >> 1]; return (unsigned short)((i & 1) ? (w >> 16) : (w & 0xffffu)); }

template <int TYPE, int MODE>
__device__ __forceinline__ void mixer_chunked(LAS unsigned char* lds, KArgs* ap, int layer, int b, int head  , int hh  , int sc, int tid) {
    constexpr int DK = (TYPE == 2) ? 32 : 64, NKS = DK / 32;
    constexpr bool FULL = (MODE == 1);
    const int lane = tid & 63, wv = __builtin_amdgcn_readfirstlane(tid >> 6), gid = wv >> 2, w = wv & 3, col = lane & 15, rg = lane >> 4;
    LAS unsigned char* gb = lds + gid * MX_GROUP_BYTES;
    LAS bf16* Qt = (LAS bf16*)gb; LAS bf16* Kt = Qt + 64 * MX_PITCH; LAS bf16* KT = Kt + 64 * MX_PITCH; LAS bf16* VT = KT + 64 * MX_PITCH; LAS bf16* ST = VT + 64 * MX_PITCH;
    LAS float* EM = (LAS float*)(gb + 5 * MX_ARR); LAS float* EL = EM + 64; LAS float* ELM = EL + 64; LAS float* LBt = ELM + 64; LAS float* OMLt = LBt + 64;
    unsigned char* ws = ap->ws;
    const bf16* PROJ = (const bf16*)(ws + WS_PROJ); bf16* H = (bf16*)(ws + WS_H);
    float* STATE = (float*)(ws + WS_STATE) + (size_t)((b * 16 + head) * NSC) * ST_REC;
    const int qc = (TYPE == 0 ? C_RQ + hh * 64 : TYPE == 1 ? C_HQ + hh * 64 : C_GQ + hh * 32);
    const int kc = (TYPE == 0 ? C_RK + hh * 64 : TYPE == 1 ? C_HF + hh * 64 : C_GK + hh * 32);
    const int vc = (TYPE == 0 ? C_RV : TYPE == 1 ? C_HI : C_GV) + hh * 64;
    const int gc = (TYPE == 0 ? C_RG : TYPE == 1 ? C_HG : C_GG) + hh * 64;
    const int mc = (TYPE == 0 ? 0 : TYPE == 1 ? 384 : 768) + hh * 64;
    const float lgam = (TYPE == 0) ? log1pf(-exp2f(-5.0f - (float)hh)) : 0.f;
    float gba[16];
    if constexpr (TYPE == 2) { int zl = 0; asm volatile("" : "+v"(zl)); const float* gbap = ap->in[I_BA] + layer * 128 + hh * 32 + 16 * (w & 1) + zl;
#pragma unroll
        for (int p = 0; p < 16; ++p) gba[p] = gbap[p]; }
    if constexpr (TYPE == 1) {
        if (w == 0) { const float* lbl = ap->in[I_LBL]; const float l0 = lbl[hh * 64 + lane], l1 = lbl[384 + hh * 64 + lane]; const float mx = fmaxf(l0, l1), e0 = expf(l0 - mx), e1 = expf(l1 - mx);
            const float lb = layer == 0 ? 0.f : e1 / (e0 + e1); LBt[lane] = lb; OMLt[lane] = 1.0f - lb; }
    }
    f32x4 gn4[4];
    if constexpr (FULL) { const float* gain = ap->in[TYPE == 0 ? I_RETN : TYPE == 1 ? I_HGRNN : I_GLAN] + layer * (TYPE == 2 ? 256 : 384) + hh * 64;
#pragma unroll
        for (int et = 0; et < 4; ++et) gn4[et] = *(const f32x4*)(gain + 16 * et + 4 * rg); }
    const bool owner = (w < DK / 16);
    f32x4 S[4];
    f32x4 Gacc = (f32x4){1.f, 1.f, 1.f, 1.f};
#pragma unroll
    for (int et = 0; et < 4; ++et) S[et] = (f32x4){0.f, 0.f, 0.f, 0.f};
    if constexpr (FULL) { if (owner) { for (int j = 0; j < sc; ++j) { const float* rec = STATE + (size_t)j * ST_REC; const f32x4 gj = *(const f32x4*)(rec + 4096 + 16 * w + 4 * rg);
#pragma unroll
                for (int et = 0; et < 4; ++et) { const f32x4 sj = *(const f32x4*)(rec + ((w * 4 + et) * 64 + lane) * 4); S[et] = gj * S[et] + sj; } } } }
    const size_t rowbase = (size_t)b * SEQ + (size_t)sc * NCH * 64;
    f32x4 rope[8]; u32x4 rq[2], rk[2], rv[2], rr[2], rq2[2], rk2[2];
#define MX_LOAD_RAW(n) do { const bf16* p_ = PROJ + (rowbase + (size_t)(n) * 64 + lane) * NPROJ; \
        if constexpr (TYPE == 0) { rk[0] = *(const u32x4*)(p_ + kc + 16 * w); rk[1] = *(const u32x4*)(p_ + kc + 16 * w + 8); rk2[0] = *(const u32x4*)(p_ + kc + 16 * (w ^ 2)); rk2[1] = *(const u32x4*)(p_ + kc + 16 * (w ^ 2) + 8); \
            if constexpr (FULL) { rq[0] = *(const u32x4*)(p_ + qc + 16 * w); rq[1] = *(const u32x4*)(p_ + qc + 16 * w + 8); rq2[0] = *(const u32x4*)(p_ + qc + 16 * (w ^ 2)); rq2[1] = *(const u32x4*)(p_ + qc + 16 * (w ^ 2) + 8); } \
            const f32x4* rp_ = (const f32x4*)((const f32x2*)(ws + WS_ROPE) + (rowbase + (size_t)(n) * 64 + lane) * 32 + 16 * (w & 1)); \
            _Pragma("unroll") for (int i_ = 0; i_ < 8; ++i_) rope[i_] = rp_[i_]; } \
        else if constexpr (TYPE == 1) { rk[0] = *(const u32x4*)(p_ + kc + 16 * w); rk[1] = *(const u32x4*)(p_ + kc + 16 * w + 8); \
            if constexpr (FULL) { rq[0] = *(const u32x4*)(p_ + qc + 16 * w); rq[1] = *(const u32x4*)(p_ + qc + 16 * w + 8); } } \
        else { if (w < 2) { rk[0] = *(const u32x4*)(p_ + kc + 16 * w); rk[1] = *(const u32x4*)(p_ + kc + 16 * w + 8); rr[0] = *(const u32x4*)(p_ + C_GA + hh * 32 + 16 * w); rr[1] = *(const u32x4*)(p_ + C_GA + hh * 32 + 16 * w + 8); \
                            if constexpr (FULL) { rq[0] = *(const u32x4*)(p_ + qc + 16 * w); rq[1] = *(const u32x4*)(p_ + qc + 16 * w + 8); } } } \
        rv[0] = *(const u32x4*)(p_ + vc + 16 * w); rv[1] = *(const u32x4*)(p_ + vc + 16 * w + 8); } while (0)
    MX_LOAD_RAW(0);
    __syncthreads();
    for (int n = 0; n < NCH; ++n) {
        float em4[4];
        {
            float Qr[16], Kr[16];
            if constexpr (TYPE == 0) {
                const float sq = __expf((float)(lane - 31) * lgam), sk = __expf((float)(31 - lane) * lgam) * 0.125f;
#pragma unroll
                for (int p = 0; p < 16; ++p) { const float cs = rope[p >> 1][(p & 1) * 2], sn = rope[p >> 1][(p & 1) * 2 + 1];
                    const float ks_ = bfx(rk[p >> 3], p & 7), kp = bfx(rk2[p >> 3], p & 7);
                    Kr[p] = ((w < 2) ? (ks_ * cs - kp * sn) : (kp * sn + ks_ * cs)) * sk;
                    if constexpr (FULL) { const float qs = bfx(rq[p >> 3], p & 7), qp = bfx(rq2[p >> 3], p & 7); Qr[p] = ((w < 2) ? (qs * cs - qp * sn) : (qp * sn + qs * cs)) * sq; } }
                const float em = __expf(32.0f * lgam);
#pragma unroll
                for (int i = 0; i < 4; ++i) em4[i] = em;
                if (lane < 16) { EL[16 * w + lane] = __expf(64.0f * lgam); ELM[16 * w + lane] = em; }
            } else if (TYPE == 1 || w < 2) {
                float c[16]; float myM = 0.f, myL = 0.f;
                if constexpr (TYPE == 1) {
                    const f32x4 lb0 = *(const LAS f32x4*)(LBt + 16 * w), lb1 = *(const LAS f32x4*)(LBt + 16 * w + 4), lb2 = *(const LAS f32x4*)(LBt + 16 * w + 8), lb3 = *(const LAS f32x4*)(LBt + 16 * w + 12);
                    const f32x4 om0 = *(const LAS f32x4*)(OMLt + 16 * w), om1 = *(const LAS f32x4*)(OMLt + 16 * w + 4), om2 = *(const LAS f32x4*)(OMLt + 16 * w + 8), om3 = *(const LAS f32x4*)(OMLt + 16 * w + 12);
#pragma unroll
                    for (int p = 0; p < 16; ++p) { const float lb = (p < 4 ? lb0 : p < 8 ? lb1 : p < 12 ? lb2 : lb3)[p & 3], om = (p < 4 ? om0 : p < 8 ? om1 : p < 12 ? om2 : om3)[p & 3];
                        const float z = bfx(rk[p >> 3], p & 7); const float sg = 1.0f / (1.0f + __expf(-z));
                        const float f = lb + om * sg; c[p] = __logf(fmaxf(f, 1e-30f)); Kr[p] = om * (1.0f - sg);
                        if constexpr (FULL) { const float qv = bfx(rq[p >> 3], p & 7); Qr[p] = qv / (1.0f + __expf(-qv)) * 0.125f; } }
                } else {
#pragma unroll
                    for (int p = 0; p < 16; ++p) { const float pre = bfx(rr[p >> 3], p & 7) + gba[p];
                        c[p] = (fminf(pre, 0.f) - __logf(1.0f + __expf(-fabsf(pre)))) * (1.0f / 16.0f); Kr[p] = bfx(rk[p >> 3], p & 7);
                        if constexpr (FULL) Qr[p] = bfx(rq[p >> 3], p & 7) * 0.17677669529663687f; }
                }
#pragma unroll
                for (int p = 0; p < 16; ++p) c[p] = wave_incl_scan(c[p]);
#pragma unroll
                for (int p = 0; p < 16; ++p) { const float m = rdlane(c[p], 31), cl = rdlane(c[p], 63); Kr[p] *= __expf(m - c[p]);
                    if constexpr (FULL) Qr[p] *= __expf(c[p] - m);
                    myM = (lane == p) ? m : myM; myL = (lane == p) ? cl : myL; }
                if (lane < 16) { EM[16 * w + lane] = __expf(myM); EL[16 * w + lane] = __expf(myL); ELM[16 * w + lane] = __expf(myL - myM); }
                if constexpr (FULL) { LDS_WAIT();
                    const f32x4 e4 = *(const LAS f32x4*)(EM + 16 * w + 4 * rg);
#pragma unroll
                    for (int i = 0; i < 4; ++i) em4[i] = e4[i]; }
            } else {
#pragma unroll
                for (int i = 0; i < 4; ++i) em4[i] = 0.f;
            }
            if (TYPE != 2 || w < 2) {
                u32x4 k0, k1;
                k0.x = pg8::cvt_pk_bf16(Kr[0], Kr[1]); k0.y = pg8::cvt_pk_bf16(Kr[2], Kr[3]); k0.z = pg8::cvt_pk_bf16(Kr[4], Kr[5]); k0.w = pg8::cvt_pk_bf16(Kr[6], Kr[7]);
                k1.x = pg8::cvt_pk_bf16(Kr[8], Kr[9]); k1.y = pg8::cvt_pk_bf16(Kr[10], Kr[11]); k1.z = pg8::cvt_pk_bf16(Kr[12], Kr[13]); k1.w = pg8::cvt_pk_bf16(Kr[14], Kr[15]);
                if constexpr (FULL) {
                    u32x4 q0, q1;
                    q0.x = pg8::cvt_pk_bf16(Qr[0], Qr[1]); q0.y = pg8::cvt_pk_bf16(Qr[2], Qr[3]); q0.z = pg8::cvt_pk_bf16(Qr[4], Qr[5]); q0.w = pg8::cvt_pk_bf16(Qr[6], Qr[7]);
                    q1.x = pg8::cvt_pk_bf16(Qr[8], Qr[9]); q1.y = pg8::cvt_pk_bf16(Qr[10], Qr[11]); q1.z = pg8::cvt_pk_bf16(Qr[12], Qr[13]); q1.w = pg8::cvt_pk_bf16(Qr[14], Qr[15]);
                    *(LAS u32x4*)(Qt + lane * MX_PITCH + 16 * w) = q0; *(LAS u32x4*)(Qt + lane * MX_PITCH + 16 * w + 8) = q1;
                    *(LAS u32x4*)(Kt + lane * MX_PITCH + 16 * w) = k0; *(LAS u32x4*)(Kt + lane * MX_PITCH + 16 * w + 8) = k1; }
#pragma unroll
                for (int p = 0; p < 16; ++p) KT[(16 * w + p) * MX_PITCH + lane] = bfbits(p < 8 ? k0 : k1, p & 7);
            }
#pragma unroll
            for (int p = 0; p < 16; ++p) VT[(16 * w + p) * MX_PITCH + lane] = bfbits(rv[p >> 3], p & 7);
            if constexpr (FULL) { if (owner) {
#pragma unroll
                for (int et = 0; et < 4; ++et) { u32x2 o; o.x = pg8::cvt_pk_bf16(S[et][0] * em4[0], S[et][1] * em4[1]); o.y = pg8::cvt_pk_bf16(S[et][2] * em4[2], S[et][3] * em4[3]);
                    *(LAS u32x2*)(ST + (16 * et + col) * MX_PITCH + 16 * w + 4 * rg) = o; } } }
        }
        __syncthreads();
        const size_t trow = rowbase + (size_t)n * 64 + 16 * w + col;
        u32x2 gt[4];
        if constexpr (FULL) {
#pragma unroll
            for (int et = 0; et < 4; ++et) gt[et] = *(const u32x2*)(PROJ + trow * NPROJ + gc + 16 * et + 4 * rg); }
        if (n + 1 < NCH) { MX_LOAD_RAW(n + 1); }
        f32x4 OT[4];
        if constexpr (FULL) {
            bf16x8 Bq[NKS];
#pragma unroll
            for (int ks = 0; ks < NKS; ++ks) Bq[ks] = *(const LAS bf16x8*)(Qt + (16 * w + col) * MX_PITCH + 32 * ks + 8 * rg);
            f32x4 PT[4];
#pragma unroll
            for (int st = 0; st < 4; ++st) { PT[st] = (f32x4){0.f, 0.f, 0.f, 0.f};
                if (st <= w) {
#pragma unroll
                    for (int ks = 0; ks < NKS; ++ks) { const bf16x8 af = *(const LAS bf16x8*)(Kt + (16 * st + col) * MX_PITCH + 32 * ks + 8 * rg); PT[st] = __builtin_amdgcn_mfma_f32_16x16x32_bf16(af, Bq[ks], PT[st], 0, 0, 0); }
                    if (st == w) {
#pragma unroll
                        for (int i = 0; i < 4; ++i) PT[st][i] = (4 * rg + i > col) ? 0.f : PT[st][i]; }
                } }
            u32x4 pb0, pb1;
            pb0.x = pg8::cvt_pk_bf16(PT[0][0], PT[0][1]); pb0.y = pg8::cvt_pk_bf16(PT[0][2], PT[0][3]); pb0.z = pg8::cvt_pk_bf16(PT[1][0], PT[1][1]); pb0.w = pg8::cvt_pk_bf16(PT[1][2], PT[1][3]);
            pb1.x = pg8::cvt_pk_bf16(PT[2][0], PT[2][1]); pb1.y = pg8::cvt_pk_bf16(PT[2][2], PT[2][3]); pb1.z = pg8::cvt_pk_bf16(PT[3][0], PT[3][1]); pb1.w = pg8::cvt_pk_bf16(PT[3][2], PT[3][3]);
#pragma unroll
            for (int et = 0; et < 4; ++et) { OT[et] = (f32x4){0.f, 0.f, 0.f, 0.f};
#pragma unroll
                for (int ks = 0; ks < NKS; ++ks) { const bf16x8 af = *(const LAS bf16x8*)(ST + (16 * et + col) * MX_PITCH + 32 * ks + 8 * rg); OT[et] = __builtin_amdgcn_mfma_f32_16x16x32_bf16(af, Bq[ks], OT[et], 0, 0, 0); }
                { const u32x2 a0 = *(const LAS u32x2*)(VT + (16 * et + col) * MX_PITCH + 4 * rg), a1 = *(const LAS u32x2*)(VT + (16 * et + col) * MX_PITCH + 16 + 4 * rg);
                  u32x4 av; av.x = a0.x; av.y = a0.y; av.z = a1.x; av.w = a1.y;
                  OT[et] = __builtin_amdgcn_mfma_f32_16x16x32_bf16(__builtin_bit_cast(bf16x8, av), __builtin_bit_cast(bf16x8, pb0), OT[et], 0, 0, 0); }
                if (w >= 2) { const u32x2 a0 = *(const LAS u32x2*)(VT + (16 * et + col) * MX_PITCH + 32 + 4 * rg), a1 = *(const LAS u32x2*)(VT + (16 * et + col) * MX_PITCH + 48 + 4 * rg);
                  u32x4 av; av.x = a0.x; av.y = a0.y; av.z = a1.x; av.w = a1.y;
                  OT[et] = __builtin_amdgcn_mfma_f32_16x16x32_bf16(__builtin_bit_cast(bf16x8, av), __builtin_bit_cast(bf16x8, pb1), OT[et], 0, 0, 0); }
            }
        }
        if (owner) {
            const f32x4 el = *(const LAS f32x4*)(EL + 16 * w + 4 * rg), elm = *(const LAS f32x4*)(ELM + 16 * w + 4 * rg);
#pragma unroll
            for (int et = 0; et < 4; ++et) { f32x4 W = (f32x4){0.f, 0.f, 0.f, 0.f};
#pragma unroll
                for (int ks = 0; ks < 2; ++ks) { const bf16x8 af = *(const LAS bf16x8*)(KT + (16 * w + col) * MX_PITCH + 32 * ks + 8 * rg), bfr = *(const LAS bf16x8*)(VT + (16 * et + col) * MX_PITCH + 32 * ks + 8 * rg);
                    W = __builtin_amdgcn_mfma_f32_16x16x32_bf16(af, bfr, W, 0, 0, 0); }
                S[et] = el * S[et] + elm * W; }
            if constexpr (!FULL) Gacc = Gacc * el;
        }
        if constexpr (FULL) {
            float ss = 0.f;
#pragma unroll
            for (int et = 0; et < 4; ++et) ss += (OT[et][0] * OT[et][0] + OT[et][1] * OT[et][1]) + (OT[et][2] * OT[et][2] + OT[et][3] * OT[et][3]);
            ss += __shfl_xor(ss, 16); ss += __shfl_xor(ss, 32);
            const float r = rsqrtf(ss * (1.0f / 64.0f) + EPS);
#pragma unroll
            for (int et = 0; et < 4; ++et) { const f32x4 g4 = gn4[et];
                const float g0 = bflo(gt[et].x), g1 = bfhi(gt[et].x), g2 = bflo(gt[et].y), g3 = bfhi(gt[et].y);
                const float o0 = OT[et][0] * r * g4[0] * (g0 / (1.0f + __expf(-g0))), o1 = OT[et][1] * r * g4[1] * (g1 / (1.0f + __expf(-g1)));
                const float o2 = OT[et][2] * r * g4[2] * (g2 / (1.0f + __expf(-g2))), o3 = OT[et][3] * r * g4[3] * (g3 / (1.0f + __expf(-g3)));
                u32x2 o; o.x = pg8::cvt_pk_bf16(o0, o1); o.y = pg8::cvt_pk_bf16(o2, o3);
                *(u32x2*)(H + trow * D + mc + 16 * et + 4 * rg) = o; }
        }
        __syncthreads();
    }
    if constexpr (!FULL) { if (owner) { float* rec = STATE + (size_t)sc * ST_REC;
#pragma unroll
            for (int et = 0; et < 4; ++et) *(f32x4*)(rec + ((w * 4 + et) * 64 + lane) * 4) = S[et];
            if (col == 0) *(f32x4*)(rec + 4096 + 16 * w + 4 * rg) = Gacc; } }
#undef MX_LOAD_RAW
}

template <int MODE>
__device__ __forceinline__ void phase_mixer(LAS unsigned char* lds, int layer) {
    KARGS(ap); PHASE_IDS();
    constexpr int NS = (MODE == 0) ? NSC - 1 : NSC;
    for (int pr = bid; pr < NB * 8 * NS; pr += G) {
        const int sc = pr % NS, hp = (pr / NS) & 7, b = pr / (NS * 8), hd = 2 * hp + (wave >> 2);
        if (hp < 3) mixer_chunked<0, MODE>(lds, ap, layer, b, hd, hd, sc, tid);
        else if (hp < 6) mixer_chunked<1, MODE>(lds, ap, layer, b, hd, hd - 6, sc, tid);
        else mixer_chunked<2, MODE>(lds, ap, layer, b, hd, hd - 12, sc, tid);
        __syncthreads();
    }
}

__device__ __forceinline__ void build_tp(LAS int* TP, const unsigned* cnt, int tid) {
    if (tid == 0) { int s = 0; for (int e = 0; e < 32; ++e) { TP[e] = s; s += ((int)cnt[e] + 255) >> 8; } TP[32] = s; }
    __syncthreads();
}

__device__ __forceinline__ void phase_prologue(LAS unsigned char* lds) {
    KARGS(ap); PHASE_IDS();
    unsigned char* ws = ap->ws;
    if (bid < 192) {
        float* MOD = (float*)(ws + WS_MOD);
        const float* cin = ap->in[I_C]; const float* wada = ap->in[I_WADA]; const float* bada = ap->in[I_BADA];
        LAS float* cact = (LAS float*)lds;
        for (int i = tid; i < 8192; i += 512) { const int b = i >> 10, k = i & 1023; cact[k * 8 + b] = siluf_(cin[i]); }
        __syncthreads();
        LAS float* red = (LAS float*)(lds + 32768);
        for (int it = bid; it < 192; it += G) {
            const int l = it / 96, j0 = (it % 96) * 64; const float* W = wada + (size_t)l * D * 6144 + j0 + lane;
            float acc[8];
#pragma unroll
            for (int b = 0; b < 8; ++b) acc[b] = 0.f;
#pragma unroll 8
            for (int kk = 0; kk < 128; ++kk) { const int k = wave * 128 + kk; const float wv = W[(size_t)k * 6144];
                const f32x4 c0 = *(const LAS f32x4*)(cact + k * 8), c1 = *(const LAS f32x4*)(cact + k * 8 + 4);
                acc[0] += c0[0] * wv; acc[1] += c0[1] * wv; acc[2] += c0[2] * wv; acc[3] += c0[3] * wv; acc[4] += c1[0] * wv; acc[5] += c1[1] * wv; acc[6] += c1[2] * wv; acc[7] += c1[3] * wv; }
#pragma unroll
            for (int b = 0; b < 8; ++b) red[(wave * 8 + b) * 64 + lane] = acc[b];
            __syncthreads();
            { const int b = tid >> 6, col = tid & 63; float s = 0.f;
#pragma unroll
              for (int ww = 0; ww < 8; ++ww) s += red[(ww * 8 + b) * 64 + col];
              MOD[((size_t)l * 8 + b) * 6144 + j0 + col] = s + bada[l * 6144 + j0 + col]; }
            __syncthreads();
        }
    }
    __syncthreads();
    {
        bf16* WIN_T = (bf16*)(ws + WS_WIN); bf16* WOUT_T = (bf16*)(ws + WS_WOUT); bf16* WGU_T = (bf16*)(ws + WS_WGU); bf16* WD_T = (bf16*)(ws + WS_WD);
        LAS float* scr = (LAS float*)(lds + wave * 16384);
        constexpr int I_IN = 16 * 120, I_OUT = 16 * 32, I_G = 16 * 8, I_D = 4 * 32;
        constexpr int PER_L = I_IN + I_OUT + 32 * I_G * 2 + 32 * I_D;
        for (int it = gw; it < 2 * PER_L; it += NGW) {
            const int l = it / PER_L; int r = it % PER_L;
            if (r < I_IN) { const int kb = r / 120, nb = r % 120; transpose_item(ap->in[I_WIN] + (size_t)l * D * INP, INP, D, kb * 64, nb * 32, WIN_T + (size_t)l * NPROJ * D, nb * 32, scr, lane); continue; } r -= I_IN;
            if (r < I_OUT) { const int kb = r / 32, nb = r % 32; transpose_item(ap->in[I_WOUT] + (size_t)l * D * D, D, D, kb * 64, nb * 32, WOUT_T + (size_t)l * D * D, nb * 32, scr, lane); continue; } r -= I_OUT;
            if (r < 32 * I_G * 2) { const int up = r / (32 * I_G); r %= 32 * I_G; const int e = r / I_G; r %= I_G; const int kb = r / 8, nb = r % 8, n0 = nb * 32;
                transpose_item(ap->in[up ? I_EU : I_EG] + ((size_t)l * NEXP + e) * D * DEXP, DEXP, D, kb * 64, n0, WGU_T + ((size_t)l * NEXP + e) * 512 * D, (n0 >> 7) * 256 + (n0 & 127) + up * 128, scr, lane); continue; } r -= 32 * I_G * 2;
            { const int e = r / I_D; r %= I_D; const int kb = r / 32, nb = r % 32;
                transpose_item(ap->in[I_ED] + ((size_t)l * NEXP + e) * DEXP * D, D, DEXP, kb * 64, nb * 32, WD_T + ((size_t)l * NEXP + e) * D * DEXP, nb * 32, scr, lane); }
        }
        const float* win = ap->in[I_WIN]; const float* wa2 = ap->in[I_WA2];
        for (int it = bid * 512 + tid; it < 2 * 256 * 128; it += G * 512) {
            const int l = it / (256 * 128), r = it % (256 * 128), n = r / 128, k0 = (r % 128) * 8;
            float o[8];
#pragma unroll
            for (int j = 0; j < 8; ++j) o[j] = 0.f;
            if (n < 128) {
#pragma unroll
                for (int j = 0; j < 8; ++j) { const float* wr_ = win + (size_t)l * D * INP + (size_t)(k0 + j) * INP + 3840; float s = 0.f;
#pragma unroll
                    for (int rr = 0; rr < 16; ++rr) s += wr_[rr] * wa2[l * 16 * 128 + rr * 128 + n];
                    o[j] = s; } }
            u32x4 w; w.x = pk2(o[0], o[1]); w.y = pk2(o[2], o[3]); w.z = pk2(o[4], o[5]); w.w = pk2(o[6], o[7]);
            *(u32x4*)(WIN_T + (size_t)l * NPROJ * D + (size_t)(3840 + n) * D + k0) = w;
        }
    }
    {
        f32x2* ROPE = (f32x2*)(ws + WS_ROPE); const int* posp = (const int*)ap->in[I_POS];
        for (int it = bid * 512 + tid; it < MTOK * 32; it += G * 512) {
            const int row = it >> 5, j = it & 31; const int pos = posp[row];
            const float ang = (float)pos * ap->inv_freq[j]; float s, c; sincos_acc(ang, s, c); ROPE[it] = (f32x2){c, s};
        }
    }
}

template <int MODE>
__device__ __forceinline__ void phase_norm1(LAS unsigned char* lds, int layer) {
    KARGS(ap); PHASE_IDS();
    unsigned char* ws = ap->ws; float* outp = ap->out;
    const float* MOD = (const float*)(ws + WS_MOD); bf16* H = (bf16*)(ws + WS_H); const bf16* YP = (const bf16*)(ws + WS_YP);
    const int* ROUTE_I = (const int*)(ws + WS_ROUTE); const float* ROUTE_W = (const float*)(ws + WS_ROUTE + 4 * MTOK * 4);
    LAS int* TP = (LAS int*)(lds + TP_OFF);
    const int pl = (MODE == 2) ? DEPTH - 1 : layer - 1;
    if (MODE != 0) build_tp(TP, (const unsigned*)(ws + WS_CTL) + CW_CNT + pl * 64, tid);
    const float* xin = MODE == 0 ? ap->in[I_X] : outp;
    const float* gn = MODE == 2 ? ap->in[I_NFIN] : ap->in[I_NMIX] + layer * D;
    for (int rb = bid; rb < MTOK / 128; rb += G) {
        const int row0 = rb * 128 + wave * 16, b = row0 >> 12;
        f32x4 Av[4], Bv[4], Gf[4];
#pragma unroll
        for (int j = 0; j < 4; ++j) { const int c0 = 4 * lane + 256 * j; Av[j] = *(const f32x4*)(gn + c0);
            if (MODE != 2) { const float* mb = MOD + (size_t)layer * 8 * 6144 + (size_t)b * 6144; const f32x4 sc = *(const f32x4*)(mb + D + c0); Bv[j] = *(const f32x4*)(mb + c0); Av[j] = Av[j] * (1.0f + sc); }
            if (MODE != 0) Gf[j] = *(const f32x4*)(MOD + (size_t)pl * 8 * 6144 + (size_t)b * 6144 + 5 * D + c0); }
        for (int r = 0; r < 16; r += 2) {
            f32x4 v[2][4];
#pragma unroll
            for (int q = 0; q < 2; ++q)
#pragma unroll
                for (int j = 0; j < 4; ++j) v[q][j] = *(const f32x4*)(xin + (size_t)(row0 + r + q) * D + 4 * lane + 256 * j);
            if (MODE != 0) {
                u32x2 y0[2][4], y1[2][4]; float w0[2], w1[2];
#pragma unroll
                for (int q = 0; q < 2; ++q) { const int m = row0 + r + q; const int e0 = ROUTE_I[m], e1 = ROUTE_I[MTOK + m], r0 = ROUTE_I[2 * MTOK + m], r1 = ROUTE_I[3 * MTOK + m]; w0[q] = ROUTE_W[m]; w1[q] = ROUTE_W[MTOK + m];
                    const bf16* p0 = YP + (size_t)(TP[e0] * 256 + r0) * D; const bf16* p1 = YP + (size_t)(TP[e1] * 256 + r1) * D;
#pragma unroll
                    for (int j = 0; j < 4; ++j) { y0[q][j] = *(const u32x2*)(p0 + 4 * lane + 256 * j); y1[q][j] = *(const u32x2*)(p1 + 4 * lane + 256 * j); } }
#pragma unroll
                for (int q = 0; q < 2; ++q)
#pragma unroll
                    for (int j = 0; j < 4; ++j) { const u32x2 a0 = y0[q][j], a1 = y1[q][j];
                        v[q][j][0] += Gf[j][0] * (w0[q] * bflo(a0.x) + w1[q] * bflo(a1.x)); v[q][j][1] += Gf[j][1] * (w0[q] * bfhi(a0.x) + w1[q] * bfhi(a1.x));
                        v[q][j][2] += Gf[j][2] * (w0[q] * bflo(a0.y) + w1[q] * bflo(a1.y)); v[q][j][3] += Gf[j][3] * (w0[q] * bfhi(a0.y) + w1[q] * bfhi(a1.y));
                        if (MODE == 1) *(f32x4*)(outp + (size_t)(row0 + r + q) * D + 4 * lane + 256 * j) = v[q][j]; }
            }
            float ss[2];
#pragma unroll
            for (int q = 0; q < 2; ++q) { float s = 0.f;
#pragma unroll
                for (int j = 0; j < 4; ++j) s += (v[q][j][0] * v[q][j][0] + v[q][j][1] * v[q][j][1]) + (v[q][j][2] * v[q][j][2] + v[q][j][3] * v[q][j][3]);
                ss[q] = s; }
            ss[0] = wave_sum(ss[0]); ss[1] = wave_sum(ss[1]);
#pragma unroll
            for (int q = 0; q < 2; ++q) { const float rstd = rsqrtf(ss[q] * (1.0f / D) + EPS); const size_t m = (size_t)(row0 + r + q);
#pragma unroll
                for (int j = 0; j < 4; ++j) { const int c0 = 4 * lane + 256 * j;
                    if (MODE == 2) { *(f32x4*)(outp + m * D + c0) = v[q][j] * rstd * Av[j]; }
                    else { const f32x4 y = (v[q][j] * rstd) * Av[j] + Bv[j]; u32x2 o; o.x = pk2(y[0], y[1]); o.y = pk2(y[2], y[3]); *(u32x2*)(H + m * D + c0) = o; } } }
        }
    }
}

__device__ __forceinline__ void phase_inproj(LAS unsigned char* lds, int layer) {
    KARGS(ap); unsigned char* ws = ap->ws;
    pg8::Gemm g{(const bf16*)(ws + WS_H), (const bf16*)(ws + WS_WIN) + (size_t)layer * NPROJ * D, D}; pg8::StaticOrder S; S.init(MTOK, NPROJ, gridDim.x, blockIdx.x);
    pg8::EpiBf16Store E{(bf16*)(ws + WS_PROJ), NPROJ};
    pg8::gemm_phase<pg8::EpiBf16Store, pg8::StaticOrder, false>(lds, g, S, E, nullptr);
}
__device__ __forceinline__ void phase_mixer_naive(LAS unsigned char* lds, int layer) {
    KARGS(ap); PHASE_IDS();
    for (int it = bid; it < NB * 16; it += G) {
        const int b = it >> 4, hd = it & 15;
        if (hd < 6) naive_mixer_item<0>(lds, ap, layer, b, hd, tid);
        else if (hd < 12) naive_mixer_item<1>(lds, ap, layer, b, hd - 6, tid);
        else naive_mixer_item<2>(lds, ap, layer, b, hd - 12, tid);
        __syncthreads();
    }
}
__device__ __forceinline__ void phase_outproj(LAS unsigned char* lds, int layer) {
    KARGS(ap); unsigned char* ws = ap->ws; float* outp = ap->out;
    pg8::Gemm g{(const bf16*)(ws + WS_H), (const bf16*)(ws + WS_WOUT) + (size_t)layer * D * D, D}; pg8::StaticOrder S; S.init(MTOK, D, gridDim.x, blockIdx.x);
    pg8::EpiResGate E{layer == 0 ? ap->in[I_X] : outp, outp, (const float*)(ws + WS_MOD) + (size_t)layer * 8 * 6144 + 2 * D};
    pg8::gemm_phase<pg8::EpiResGate, pg8::StaticOrder, false>(lds, g, S, E, nullptr);
}
__device__ __forceinline__ void phase_norm2_router(LAS unsigned char* lds, int layer) {
    KARGS(ap); PHASE_IDS();
    unsigned char* ws = ap->ws; const float* xres = ap->out;
    bf16* H = (bf16*)(ws + WS_H);
    int* ROUTE_I = (int*)(ws + WS_ROUTE); float* ROUTE_W = (float*)(ws + WS_ROUTE + 4 * MTOK * 4); int* IDX2 = (int*)(ws + WS_IDX2);
    unsigned* cntl = (unsigned*)(ws + WS_CTL) + CW_CNT + layer * 64;
    LAS bf16* Wr = (LAS bf16*)lds;
    { const float* rgw = ap->in[I_RGW] + (size_t)layer * D * 4; const float* rew = ap->in[I_REW] + (size_t)layer * D * 32;
      for (int i = tid; i < 36 * 1024; i += 512) { const int n = i >> 10, k = i & 1023; const float wv = n < 4 ? rgw[k * 4 + n] : rew[k * 32 + (n - 4)]; Wr[i] = (bf16)f2bf(wv); } }
    __syncthreads();
    const float* gn = ap->in[I_NFFN] + layer * D; const float* rgb = ap->in[I_RGB] + layer * 4; const float* reb = ap->in[I_REB] + layer * 32;
    const float* modl = (const float*)(ws + WS_MOD) + (size_t)layer * 8 * 6144;
    LAS int* HIST = (LAS int*)(lds + 73728); LAS int* BASE = HIST + 32; LAS int* RI = BASE + 32; LAS float* RW = (LAS float*)(RI + 128 * 4);
    for (int rb = bid; rb < MTOK / 128; rb += G) {
        if (tid < 32) HIST[tid] = 0;
        __syncthreads();
        const int row0 = rb * 128 + wave * 16, b = row0 >> 12; const float* mb = modl + (size_t)b * 6144 + 3 * D;
        f32x4 Av[4], Bv[4];
#pragma unroll
        for (int j = 0; j < 4; ++j) { const int c0 = 4 * lane + 256 * j; const f32x4 sc = *(const f32x4*)(mb + D + c0); Bv[j] = *(const f32x4*)(mb + c0); Av[j] = *(const f32x4*)(gn + c0) * (1.0f + sc); }
        for (int r = 0; r < 16; r += 2) {
            f32x4 v[2][4];
#pragma unroll
            for (int q = 0; q < 2; ++q)
#pragma unroll
                for (int j = 0; j < 4; ++j) v[q][j] = *(const f32x4*)(xres + (size_t)(row0 + r + q) * D + 4 * lane + 256 * j);
            float ss[2];
#pragma unroll
            for (int q = 0; q < 2; ++q) { float s = 0.f;
#pragma unroll
                for (int j = 0; j < 4; ++j) s += (v[q][j][0] * v[q][j][0] + v[q][j][1] * v[q][j][1]) + (v[q][j][2] * v[q][j][2] + v[q][j][3] * v[q][j][3]);
                ss[q] = s; }
            ss[0] = wave_sum(ss[0]); ss[1] = wave_sum(ss[1]);
#pragma unroll
            for (int q = 0; q < 2; ++q) { const float rstd = rsqrtf(ss[q] * (1.0f / D) + EPS);
#pragma unroll
                for (int j = 0; j < 4; ++j) { v[q][j] = (v[q][j] * rstd) * Av[j] + Bv[j]; u32x2 o; o.x = pk2(v[q][j][0], v[q][j][1]); o.y = pk2(v[q][j][2], v[q][j][3]);
                    *(u32x2*)(H + (size_t)(row0 + r + q) * D + 4 * lane + 256 * j) = o; } }
            float lgv[2] = {0.f, 0.f};
#pragma unroll 3
            for (int n0 = 0; n0 < 36; n0 += 2) {
                float p[2][2];
#pragma unroll
                for (int nn = 0; nn < 2; ++nn) { float a0 = 0.f, a1 = 0.f;
#pragma unroll
                    for (int j = 0; j < 4; ++j) { const u32x2 wv = *(const LAS u32x2*)(Wr + (n0 + nn) * 1024 + 4 * lane + 256 * j); const float w0 = bflo(wv.x), w1 = bfhi(wv.x), w2 = bflo(wv.y), w3 = bfhi(wv.y);
                        a0 += v[0][j][0] * w0 + v[0][j][1] * w1 + v[0][j][2] * w2 + v[0][j][3] * w3; a1 += v[1][j][0] * w0 + v[1][j][1] * w1 + v[1][j][2] * w2 + v[1][j][3] * w3; }
                    p[0][nn] = a0; p[1][nn] = a1; }
#pragma unroll
                for (int nn = 0; nn < 2; ++nn) { const float s0 = wave_sum(p[0][nn]), s1 = wave_sum(p[1][nn]); lgv[0] = (lane == n0 + nn) ? s0 : lgv[0]; lgv[1] = (lane == n0 + nn) ? s1 : lgv[1]; }
            }
#pragma unroll
            for (int q = 0; q < 2; ++q) {
                const int m = row0 + r + q;
                float gl[4];
#pragma unroll
                for (int t = 0; t < 4; ++t) gl[t] = rdlane(lgv[q], t) + rgb[t];
                int gi = 0; float gm = gl[0];
#pragma unroll
                for (int t = 1; t < 4; ++t) if (gl[t] > gm) { gm = gl[t]; gi = t; }
                float gs = 0.f;
#pragma unroll
                for (int t = 0; t < 4; ++t) gs += __expf(gl[t] - gm);
                const float gwt = 1.0f / gs;
                gi = __builtin_amdgcn_readfirstlane(gi);
                float el[8];
#pragma unroll
                for (int t = 0; t < 8; ++t) el[t] = rdlane(lgv[q], 4 + gi * 8 + t) + reb[gi * 8 + t];
                int i0 = 0; float m0 = el[0];
#pragma unroll
                for (int t = 1; t < 8; ++t) if (el[t] > m0) { m0 = el[t]; i0 = t; }
                int i1 = -1; float m1 = -3.0e38f;
#pragma unroll
                for (int t = 0; t < 8; ++t) if (t != i0 && el[t] > m1) { m1 = el[t]; i1 = t; }
                const float ex = __expf(m1 - m0); const float w0 = gwt / (1.0f + ex), w1 = gwt * ex / (1.0f + ex);
                if (lane == 0) {
                    const int e0 = gi * 8 + i0, e1 = gi * 8 + i1, lr = wave * 16 + r + q;
                    const int l0 = __hip_atomic_fetch_add(HIST + e0, 1, __ATOMIC_RELAXED, __HIP_MEMORY_SCOPE_WORKGROUP), l1 = __hip_atomic_fetch_add(HIST + e1, 1, __ATOMIC_RELAXED, __HIP_MEMORY_SCOPE_WORKGROUP);
                    RI[lr * 4 + 0] = e0; RI[lr * 4 + 1] = e1; RI[lr * 4 + 2] = l0; RI[lr * 4 + 3] = l1; RW[lr * 2 + 0] = w0; RW[lr * 2 + 1] = w1;
                }
            }
        }
        __syncthreads();
        if (tid < 32) { const int c = HIST[tid]; BASE[tid] = c ? (int)atomicAdd(cntl + tid, (unsigned)c) : 0; }
        __syncthreads();
        if (tid < 128) { const int m = rb * 128 + tid; const int e0 = RI[tid * 4 + 0], e1 = RI[tid * 4 + 1]; const int r0 = BASE[e0] + RI[tid * 4 + 2], r1 = BASE[e1] + RI[tid * 4 + 3];
            IDX2[e0 * MTOK + r0] = m; IDX2[e1 * MTOK + r1] = m;
            ROUTE_I[m] = e0; ROUTE_I[MTOK + m] = e1; ROUTE_I[2 * MTOK + m] = r0; ROUTE_I[3 * MTOK + m] = r1; ROUTE_W[m] = RW[tid * 2 + 0]; ROUTE_W[MTOK + m] = RW[tid * 2 + 1]; }
        __syncthreads();
    }
}
__device__ __forceinline__ void phase_moe_up(LAS unsigned char* lds, int layer) {
    KARGS(ap); unsigned char* ws = ap->ws;
    LAS int* TP = (LAS int*)(lds + TP_OFF); LAS int* AUX = (LAS int*)(lds + AUX_OFF);
    const unsigned* cntl = (const unsigned*)(ws + WS_CTL) + CW_CNT + layer * 64;
    { int tid = threadIdx.x; build_tp(TP, cntl, tid);
      pg8::MoeOrder S0; S0.G = gridDim.x; S0.c = blockIdx.x; S0.npt = 2; S0.total = TP[32] * 2; S0.tp = TP;
      const int* IDX2 = (const int*)(ws + WS_IDX2);
      pg8::Unit u; for (int i = 0; i < 8; ++i) { if (!S0.next(i, u)) break; const int e = u.pn >> 1, j = u.pm - TP[e], cnt = (int)cntl[e];
          if (tid < 256) { const int rank = j * 256 + tid; AUX[i * 256 + tid] = (rank < cnt ? IDX2[e * MTOK + rank] : 0) * (D * 2); } }
      __syncthreads(); }
    pg8::MoeOrder S; S.G = gridDim.x; S.c = blockIdx.x; S.npt = 2; S.total = TP[32] * 2; S.tp = TP;
    pg8::Gemm g{(const bf16*)(ws + WS_H), (const bf16*)(ws + WS_WGU) + (size_t)layer * NEXP * 512 * D, D};
    pg8::EpiSwiGLU E{(bf16*)(ws + WS_HID)};
    pg8::gemm_phase<pg8::EpiSwiGLU, pg8::MoeOrder, true>(lds, g, S, E, AUX);
}
__device__ __forceinline__ void phase_moe_down(LAS unsigned char* lds, int layer) {
    KARGS(ap); unsigned char* ws = ap->ws;
    LAS int* TP = (LAS int*)(lds + TP_OFF);
    build_tp(TP, (const unsigned*)(ws + WS_CTL) + CW_CNT + layer * 64, threadIdx.x);
    pg8::MoeOrder S; S.G = gridDim.x; S.c = blockIdx.x; S.npt = 4; S.total = TP[32] * 4; S.tp = TP;
    pg8::Gemm g{(const bf16*)(ws + WS_HID), (const bf16*)(ws + WS_WD) + (size_t)layer * NEXP * D * DEXP, DEXP};
    pg8::EpiBf16Store E{(bf16*)(ws + WS_YP), D};
    pg8::gemm_phase<pg8::EpiBf16Store, pg8::MoeOrder, false>(lds, g, S, E, nullptr);
}

__global__ void __launch_bounds__(512, 2) fwd(Args a) {
    extern __shared__ __attribute__((aligned(16))) unsigned char lds_raw[];
    LAS unsigned char* lds = (LAS unsigned char*)lds_raw;
    volatile LAS unsigned* MISC = (volatile LAS unsigned*)(lds + LDSCTL_OFF);
    for (int u = threadIdx.x; u < (LDS_BYTES - LDSCTL_OFF) / 4; u += 512) ((LAS unsigned*)(lds + LDSCTL_OFF))[u] = 0u;
    __syncthreads();
#if MK_ONE_LAUNCH
    { unsigned* ctl0 = (unsigned*)(a.ws + WS_CTL); (void)xcd_barrier_post(ctl0 + CW_BAR, MISC + 8); }
    constexpr int lo = 0, hi = N_PHASES;
#define SEAM(k) do { if ((k) + 1 < hi) { KARGS(_ap); XcdBarrier _b; _b.bar = (unsigned*)(_ap->ws + WS_CTL) + CW_BAR; _b.x = xb_xcc_id(); _b.st = (volatile LAS unsigned*)(lds + LDSCTL_OFF) + 8; xcd_barrier(_b); if (PROBE_BAR) xcd_barrier(_b); } } while (0)
#else
    (void)MISC;
    const int lo = a.ph_lo, hi = a.ph_hi;
#define SEAM(k) do { } while (0)
#endif
#define IN(k) (lo <= (k) && (k) < hi)
    if (EN_P0 && IN(0)) { phase_prologue(lds); SEAM(0); if (PROBE_D) { phase_prologue(lds); SEAM(0); } }
#define LAYER_PHASES(layer) do { constexpr int pb = 1 + PH_PER_LAYER * (layer); \
        if (EN_PA && IN(pb + 0)) { if ((layer) == 0) { phase_norm1<0>(lds, (layer)); if (PROBE_A) { SEAM(pb + 0); phase_norm1<0>(lds, (layer)); } } else phase_norm1<1>(lds, (layer)); SEAM(pb + 0); } \
        if (EN_PB && IN(pb + 1)) { phase_inproj(lds, (layer)); SEAM(pb + 1); } \
        if (EN_PC && IN(pb + 2)) { if (!MK_NAIVE_MIXER) phase_mixer<0>(lds, (layer)); SEAM(pb + 2); } \
        if (EN_PC && IN(pb + 3)) { if (MK_NAIVE_MIXER) phase_mixer_naive(lds, (layer)); else phase_mixer<1>(lds, (layer)); SEAM(pb + 3); if (PROBE_M) { phase_mixer<0>(lds, (layer)); SEAM(pb + 3); } if (PROBE_M3) { phase_mixer<1>(lds, (layer)); SEAM(pb + 3); } } \
        if (EN_PD && IN(pb + 4)) { phase_outproj(lds, (layer)); SEAM(pb + 4); if (PROBE_PD && (layer) == 0) { phase_outproj(lds, (layer)); SEAM(pb + 4); } } \
        if (EN_PE && IN(pb + 5)) { phase_norm2_router(lds, (layer)); SEAM(pb + 5); } \
        if (EN_PG && IN(pb + 6)) { phase_moe_up(lds, (layer)); SEAM(pb + 6); if (PROBE_C) { phase_moe_up(lds, (layer)); SEAM(pb + 6); } } \
        if (EN_PH && IN(pb + 7)) { phase_moe_down(lds, (layer)); SEAM(pb + 7); if (PROBE_C) { phase_moe_down(lds, (layer)); SEAM(pb + 7); } } } while (0)
    LAYER_PHASES(0);
    LAYER_PHASES(1);
#undef LAYER_PHASES
    if (EN_PF && IN(PH_FINAL)) phase_norm1<2>(lds, 0);
#undef IN
#undef SEAM
}

extern "C" void kernel_launch(void* const* d_in, const int* in_sizes, int n_in, void* d_out, int out_size, void* d_ws, size_t ws_size, hipStream_t stream) {
    static int grid = 0;
    if (grid == 0) {
        if (n_in != 23 || out_size != MTOK * D || ws_size < WS_END) { fprintf(stderr, "kernel_launch: unexpected shapes (n_in %d out %d ws %zu)\n", n_in, out_size, ws_size); grid = -1; return; }
        int dev = 0, cus = 0;
        if (hipGetDevice(&dev) != hipSuccess || hipDeviceGetAttribute(&cus, hipDeviceAttributeMultiprocessorCount, dev) != hipSuccess) { grid = -1; return; }
        if (hipFuncSetAttribute((const void*)fwd, hipFuncAttributeMaxDynamicSharedMemorySize, LDS_BYTES) != hipSuccess) { fprintf(stderr, "kernel_launch: hipFuncSetAttribute failed\n"); grid = -1; return; }
        int per_cu = 0;
        if (hipOccupancyMaxActiveBlocksPerMultiprocessor(&per_cu, (const void*)fwd, 512, LDS_BYTES) != hipSuccess || per_cu < 1) fprintf(stderr, "kernel_launch: occupancy query reports %d\n", per_cu);
        (void)hipGetLastError();
        grid = cus;
    }
    if (grid < 0) return;
    (void)hipMemsetAsync((char*)d_ws + WS_CTL, 0, CTL_ZERO_BYTES, stream);
    Args a{};
    for (int i = 0; i < 23; ++i) a.in[i] = (const float*)d_in[i];
    a.out = (float*)d_out; a.ws = (unsigned char*)d_ws;
    for (int j = 0; j < 32; ++j) a.inv_freq[j] = (float)std::pow(10000.0, -(double)j / 32.0);
#if MK_ONE_LAUNCH
    a.ph_lo = 0; a.ph_hi = N_PHASES;
    hipLaunchKernelGGL(fwd, dim3(grid), dim3(512), LDS_BYTES, stream, a);
#else
    for (int p = 0; p < N_PHASES; ++p) { a.ph_lo = p; a.ph_hi = p + 1; hipLaunchKernelGGL(fwd, dim3(grid), dim3(512), LDS_BYTES, stream, a); }
#endif
}
```

```cpp
#include <hip/hip_runtime.h>
#include <cstdio>
#include <cstdint>
#include <cmath>

#define GAS __attribute__((address_space(1)))
#define LAS __attribute__((address_space(3)))
typedef unsigned short bf16;
typedef short bf16x8 __attribute__((ext_vector_type(8)));
typedef float f32x4 __attribute__((ext_vector_type(4)));
typedef float f32x2 __attribute__((ext_vector_type(2)));
typedef unsigned u32x4 __attribute__((ext_vector_type(4)));
typedef unsigned u32x2 __attribute__((ext_vector_type(2)));

#ifndef EN_P0
#define EN_P0 1
#endif
#ifndef EN_PA
#define EN_PA 1
#endif
#ifndef EN_PB
#define EN_PB 1
#endif
#ifndef EN_PC
#define EN_PC 1
#endif
#ifndef EN_PD
#define EN_PD 1
#endif
#ifndef EN_PE
#define EN_PE 1
#endif
#ifndef EN_PG
#define EN_PG 1
#endif
#ifndef EN_PH
#define EN_PH 1
#endif
#ifndef EN_PF
#define EN_PF 1
#endif
#ifndef PROBE_M
#define PROBE_M 0
#endif
#ifndef PROBE_M3
#define PROBE_M3 0
#endif
#ifndef PROBE_A
#define PROBE_A 0
#endif
#ifndef PROBE_PD
#define PROBE_PD 0
#endif
#ifndef PROBE_BAR
#define PROBE_BAR 0
#endif
#ifndef PROBE_E
#define PROBE_E 0
#endif
#ifndef PROBE_B
#define PROBE_B 0
#endif
#ifndef PROBE_C
#define PROBE_C 0
#endif
#ifndef PROBE_D
#define PROBE_D 0
#endif
#ifndef MK_NAIVE_MIXER
#define MK_NAIVE_MIXER 0
#endif
#ifndef MK_ONE_LAUNCH
#define MK_ONE_LAUNCH 1
#endif

constexpr int NB = 8, SEQ = 4096, MTOK = NB * SEQ, D = 1024, DEPTH = 2;
constexpr int NPROJ = 4096;
constexpr int INP = 3856;
constexpr int C_RQ = 0, C_RK = 384, C_RV = 768, C_RG = 1152, C_HQ = 1536, C_HF = 1920, C_HI = 2304, C_HG = 2688, C_GQ = 3072, C_GK = 3200, C_GV = 3328, C_GG = 3584, C_GA = 3840;
constexpr int NEXP = 32, DEXP = 256;
constexpr int MAXROWS = 73728;
constexpr float EPS = 1e-6f;

constexpr size_t MiB = 1u << 20;
constexpr size_t WS_CTL = 0, CTL_ZERO_BYTES = 1 * MiB;
constexpr size_t WS_MOD = 1 * MiB;
constexpr size_t WS_ROPE = 2 * MiB;
constexpr size_t WS_WIN = 10 * MiB;
constexpr size_t WS_WOUT = 26 * MiB;
constexpr size_t WS_WGU = 30 * MiB;
constexpr size_t WS_WD = 94 * MiB;
constexpr size_t WS_H = 126 * MiB;
constexpr size_t WS_PROJ = 190 * MiB;
constexpr size_t WS_HID = 190 * MiB;
constexpr size_t WS_YP = 226 * MiB;
constexpr size_t WS_STATE = 446 * MiB;
constexpr size_t WS_ROUTE = 474 * MiB;
constexpr size_t WS_IDX2 = 476 * MiB;
constexpr size_t WS_END = 480 * MiB;
constexpr int CW_CNT = 64;
constexpr int CW_BAR = 4096;

constexpr int RING_BYTES = 131072;
constexpr int LDSCTL_OFF = RING_BYTES;
constexpr int TP_OFF = RING_BYTES + 512;
constexpr int AUX_OFF = RING_BYTES + 1024;
constexpr int LDS_BYTES = 147456;

#define RLX_AGENT __ATOMIC_RELAXED, __HIP_MEMORY_SCOPE_AGENT
#define LDS_WAIT() asm volatile("s_waitcnt lgkmcnt(0)" ::: "memory")
#define VM_WAIT() asm volatile("s_waitcnt vmcnt(0)" ::: "memory")

__device__ __forceinline__ unsigned f2bf(float f) { unsigned u = __builtin_bit_cast(unsigned, f); return (u + 0x7fffu + ((u >> 16) & 1u)) >> 16; }
__device__ __forceinline__ unsigned pk2(float lo, float hi) { return f2bf(lo) | (f2bf(hi) << 16); }
__device__ __forceinline__ float bf2f(unsigned short b) { return __builtin_bit_cast(float, ((unsigned)b) << 16); }
__device__ __forceinline__ float bflo(unsigned w) { return __builtin_bit_cast(float, w << 16); }
__device__ __forceinline__ float bfhi(unsigned w) { return __builtin_bit_cast(float, w & 0xffff0000u); }
__device__ __forceinline__ float sigmoidf_(float x) { return 1.0f / (1.0f + __expf(-x)); }
__device__ __forceinline__ float siluf_(float x) { return x / (1.0f + __expf(-x)); }
template <int CTRL, int RMASK, bool BC> __device__ __forceinline__ float dpp_f(float v) {
    return __builtin_bit_cast(float, __builtin_amdgcn_update_dpp(0, __builtin_bit_cast(int, v), CTRL, RMASK, 0xf, BC)); }
__device__ __forceinline__ float rdlane(float v, int l) { return __builtin_bit_cast(float, __builtin_amdgcn_readlane(__builtin_bit_cast(int, v), l)); }
__device__ __forceinline__ float wave_sum(float v) {
    v += dpp_f<0x128, 0xf, false>(v); v += dpp_f<0x124, 0xf, false>(v); v += dpp_f<0x122, 0xf, false>(v); v += dpp_f<0x121, 0xf, false>(v);
    v += dpp_f<0x142, 0xa, false>(v); v += dpp_f<0x143, 0xc, false>(v);
    return rdlane(v, 63);
}
__device__ __forceinline__ float wave_incl_scan(float v) {
    v += dpp_f<0x111, 0xf, true>(v); v += dpp_f<0x112, 0xf, true>(v); v += dpp_f<0x114, 0xf, true>(v); v += dpp_f<0x118, 0xf, true>(v);
    v += dpp_f<0x142, 0xa, false>(v); v += dpp_f<0x143, 0xc, false>(v);
    return v;
}
#define XB_TMO      128
#define XB_XCNT(j)  (256  + 64 * (j))
#define XB_XSUB(j)  (1280 + 64 * (j))
#define XB_XGEN(j)  (2304 + 64 * (j))
#define XB_TOP      3328
#define XB_TOPGEN   3392
#define XCD_BAR_WORDS 3456
#define XB_SPIN_CAP (1u << 18)
__device__ __forceinline__ unsigned xb_ld(unsigned* p)              { return __hip_atomic_load(p, __ATOMIC_RELAXED, __HIP_MEMORY_SCOPE_AGENT); }
__device__ __forceinline__ unsigned xb_add(unsigned* p, unsigned v) { return __hip_atomic_fetch_add(p, v, __ATOMIC_RELAXED, __HIP_MEMORY_SCOPE_AGENT); }
__device__ __forceinline__ unsigned xb_xcc_id() { return (unsigned)__builtin_amdgcn_s_getreg((3 << 11) | 20) & 0xFu; }
#define XB_SPIN(cond, bar) do { unsigned _sp = 0; while (cond) { __builtin_amdgcn_s_sleep(1); \
    if ((++_sp & 255u) == 0u) { if (xb_ld(&(bar)[XB_TMO])) break; if (_sp > XB_SPIN_CAP) { atomicAdd(&(bar)[XB_TMO], 1u); break; } } } } while (0)
struct XcdBarrier { unsigned* bar; unsigned x; volatile LAS unsigned* st; };
__device__ __forceinline__ XcdBarrier xcd_barrier_post(unsigned* bar, volatile LAS unsigned* st) {
    XcdBarrier b; b.bar = bar; b.x = xb_xcc_id(); b.st = st;
    if (threadIdx.x == 0) (void)xb_add(&bar[XB_XCNT(b.x)], 1u);
    return b;
}
__device__ __forceinline__ void xcd_barrier_complete(unsigned* bar, unsigned x, unsigned& nloc, unsigned& nx) {
    const unsigned G = gridDim.x * gridDim.y * gridDim.z;
    unsigned sum, cnt, mine, sp = 0u;
    for (;;) {
        sum = 0u; cnt = 0u; mine = 0u;
#pragma unroll
        for (unsigned j = 0; j < 16; ++j) { const unsigned c = xb_ld(&bar[XB_XCNT(j)]); sum += c; cnt += (c > 0u) ? 1u : 0u; mine = (j == x) ? c : mine; }
        if (sum == G) break;
        __builtin_amdgcn_s_sleep(1);
        if ((++sp & 255u) == 0u) { if (xb_ld(&bar[XB_TMO])) break; if (sp > XB_SPIN_CAP) { atomicAdd(&bar[XB_TMO], 1u); break; } }
    }
    nloc = mine > 0u ? mine : 1u; nx = cnt > 0u ? cnt : 1u;
}
__device__ __forceinline__ void xcd_barrier(const XcdBarrier& b) {
    asm volatile("s_waitcnt vmcnt(0)" ::: "memory");
    __syncthreads();
    if (threadIdx.x == 0) {
        unsigned* bar = b.bar;
        __builtin_amdgcn_s_waitcnt(0);
        unsigned nloc = b.st[0], nx = b.st[1];
        if (nloc == 0u) { xcd_barrier_complete(bar, b.x, nloc, nx); b.st[0] = nloc; b.st[1] = nx; }
        const unsigned old = xb_add(&bar[XB_XSUB(b.x)], 1u);
        const unsigned gen = old / nloc;
        if (old + 1u == (gen + 1u) * nloc) {
            __builtin_amdgcn_fence(__ATOMIC_RELEASE, "agent");
            asm volatile("s_waitcnt vmcnt(0)" ::: "memory");
            const unsigned og = xb_add(&bar[XB_TOP], 1u);
            const unsigned tg = og / nx;
            if (og + 1u == (tg + 1u) * nx) xb_add(&bar[XB_TOPGEN], 1u);
            else XB_SPIN(xb_ld(&bar[XB_TOPGEN]) == tg, bar);
            __builtin_amdgcn_fence(__ATOMIC_ACQUIRE, "agent");
            xb_add(&bar[XB_XGEN(b.x)], 1u);
            asm volatile("s_waitcnt vmcnt(0)" ::: "memory");
        } else {
            XB_SPIN(xb_ld(&bar[XB_XGEN(b.x)]) == gen, bar);
            __builtin_amdgcn_fence(__ATOMIC_ACQUIRE, "agent");
            asm volatile("s_waitcnt vmcnt(0)" ::: "memory");
        }
    }
    __syncthreads();
}

namespace pg8 {
constexpr int BM = 256, BK = 64, HALF = 128, HTB = HALF * BK * 2, STAGE_BYTES = 8 * HTB, NXCD = 8, WGM = 8;
__host__ __device__ __forceinline__ int lds_byte(int r, int c) { const int st = (r >> 4) * 2 + (c >> 5), rr = r & 15, cc = c & 31, ob = rr * 64 + cc * 2; return st * 1024 + (ob ^ (((ob >> 9) & 1) << 5)); }
__host__ __device__ __forceinline__ void stage_rc(int b, int& R, int& C) { const int st = b / 1024, sb = b % 1024, swz = sb ^ (((sb >> 9) & 1) << 5); R = (st >> 1) * 16 + swz / 64; C = (st & 1) * 32 + (swz % 64) / 2; }
__host__ __device__ __forceinline__ int perm32(int rho) { const int n = rho >> 4, i = rho & 15; return 8 * (i >> 2) + 4 * n + (i & 3); }
struct Unit { int pm, pn, pc; };
struct Gemm { const bf16* A; const bf16* Bt; int K; };

struct StaticOrder {
    int nM, nN, nwg, G, c;
    __device__ void init(int M, int N, int G_, int c_) { nM = M / BM; nN = N / BM; nwg = nM * nN; G = G_; c = c_; }
    __device__ bool next(int i, Unit& u) const {
        const long L = (long)i * G + c; if (L >= nwg) return false;
        int wgid = (int)L; { const int q = nwg / NXCD, r = nwg % NXCD, xcd = wgid % NXCD, off = wgid / NXCD; wgid = (xcd < r ? xcd * (q + 1) : r * (q + 1) + (xcd - r) * q) + off; }
        const int nig = WGM * nN, gid = wgid / nig, fm = gid * WGM, gsz = (nM - fm) < WGM ? (nM - fm) : WGM;
        u.pm = fm + ((wgid % nig) % gsz); u.pn = (wgid % nig) / gsz; u.pc = u.pn; return true;
    }
};
struct MoeOrder {
    int G, c, npt, total; const LAS int* tp;
    __device__ bool next(int i, Unit& u) const {
        const int L = i * G + c; if (L >= total) return false;
        const int mt = L / npt, nl = L % npt; int e = 0;
        while (e < 31 && tp[e + 1] <= mt) ++e;
        u.pm = mt; u.pn = e * npt + nl; u.pc = nl; return true;
    }
};

__device__ __forceinline__ unsigned cvt_pk_bf16(float lo, float hi) { unsigned r; asm volatile("v_cvt_pk_bf16_f32 %0, %1, %2" : "=v"(r) : "v"(lo), "v"(hi)); return r; }

struct EpiBf16Store {
    static constexpr bool PERM = true;
    bf16* O; int ldc;
    __device__ __forceinline__ void operator()(const f32x4 (&acc)[2][2][4][2], const Unit& u, int wr, int wc, int fr, int fq) const {
        const int row0 = u.pm * BM + wr * 64 + fr, col0 = u.pc * BM + wc * 32 + 8 * fq;
#pragma unroll
        for (int ai = 0; ai < 2; ++ai)
#pragma unroll
            for (int m = 0; m < 4; ++m) { bf16* rowp = O + (size_t)(row0 + ai * HALF + m * 16) * ldc + col0;
#pragma unroll
                for (int bj = 0; bj < 2; ++bj) { const f32x4 v0 = acc[ai][bj][m][0], v1 = acc[ai][bj][m][1];
                    u32x4 w; w.x = cvt_pk_bf16(v0[0], v0[1]); w.y = cvt_pk_bf16(v0[2], v0[3]); w.z = cvt_pk_bf16(v1[0], v1[1]); w.w = cvt_pk_bf16(v1[2], v1[3]);
                    *(u32x4*)(rowp + bj * HALF) = w; } }
    }
};
struct EpiSwiGLU {
    static constexpr bool PERM = true;
    bf16* O;
    __device__ __forceinline__ void operator()(const f32x4 (&acc)[2][2][4][2], const Unit& u, int wr, int wc, int fr, int fq) const {
        const int row0 = u.pm * BM + wr * 64 + fr, col0 = u.pc * HALF + wc * 32 + 8 * fq;
#pragma unroll
        for (int ai = 0; ai < 2; ++ai)
#pragma unroll
            for (int m = 0; m < 4; ++m) { bf16* rowp = O + (size_t)(row0 + ai * HALF + m * 16) * DEXP + col0;
                float h[8];
#pragma unroll
                for (int n = 0; n < 2; ++n)
#pragma unroll
                    for (int j = 0; j < 4; ++j) { const float g = acc[ai][0][m][n][j], up = acc[ai][1][m][n][j]; h[n * 4 + j] = g / (1.0f + __expf(-g)) * up; }
                u32x4 w; w.x = cvt_pk_bf16(h[0], h[1]); w.y = cvt_pk_bf16(h[2], h[3]); w.z = cvt_pk_bf16(h[4], h[5]); w.w = cvt_pk_bf16(h[6], h[7]);
                *(u32x4*)rowp = w; }
    }
};
struct EpiResGate {
    static constexpr bool PERM = false;
    const float* res; float* out; const float* gate;
    __device__ __forceinline__ void operator()(const f32x4 (&acc)[2][2][4][2], const Unit& u, int wr, int wc, int fr, int fq) const {
        const int row0 = u.pm * BM + wr * 64 + fr, col0 = u.pc * BM + wc * 32 + 4 * fq;
        const float* gb = gate + (size_t)(u.pm >> 4) * 6144;
        f32x4 gv[2][2];
#pragma unroll
        for (int bj = 0; bj < 2; ++bj)
#pragma unroll
            for (int n = 0; n < 2; ++n) gv[bj][n] = *(const f32x4*)(gb + col0 + bj * HALF + n * 16);
#pragma unroll
        for (int ai = 0; ai < 2; ++ai)
#pragma unroll
            for (int m = 0; m < 4; ++m) { const size_t off = (size_t)(row0 + ai * HALF + m * 16) * D + col0;
#pragma unroll
                for (int bj = 0; bj < 2; ++bj)
#pragma unroll
                    for (int n = 0; n < 2; ++n) { const f32x4 r = *(const f32x4*)(res + off + bj * HALF + n * 16); *(f32x4*)(out + off + bj * HALF + n * 16) = r + gv[bj][n] * acc[ai][bj][m][n]; } }
    }
};

template <class Epi, class Sched, bool GATHER>
__device__ __forceinline__ void gemm_phase(LAS unsigned char* lds, const Gemm g, const Sched& S, const Epi& E, const LAS int* gidx) {
    const int tid = threadIdx.x, wid = __builtin_amdgcn_readfirstlane(tid >> 6), lane = tid & 63, wr = wid >> 2, wc = wid & 3, fr = lane & 15, fq = lane >> 4;
    const int K = g.K, nt = K / BK;
    unsigned voffA[2], voffB[2];
#pragma unroll
    for (int i = 0; i < 2; ++i) { int R, C; stage_rc(tid * 16 + i * 8192, R, C); const int Rb = Epi::PERM ? ((R & ~31) + perm32(R & 31)) : R;
        voffA[i] = (unsigned)(R * K + C) * 2u; voffB[i] = (unsigned)(Rb * K + C) * 2u; }
    const size_t kstep = (size_t)(BK * 2);
    const size_t hstep = (size_t)HALF * K * 2;
    const size_t tstep = 2 * hstep;
    const unsigned ldsw = (unsigned)wid * 1024u;
    const int aoff = lds_byte(wr * 64 + fr, fq * 8), boff = lds_byte(wc * 32 + fr, fq * 8);
    int nslot = 0;
#define PG8_SA(b, h) (((b) * 2 + (h)) * HTB)
#define PG8_SB(b, h) ((4 + (b) * 2 + (h)) * HTB)
#define PG8_GLDS(gp, lp) __builtin_amdgcn_global_load_lds((const unsigned*)(gp), (LAS unsigned*)(lp), 16, 0, 0)
#define PG8_STAGE(bufoff, gbase, voff) do { _Pragma("unroll") for (int _i = 0; _i < 2; ++_i) PG8_GLDS((const char*)(gbase) + (voff)[_i], lds + (bufoff) + ldsw + _i * 8192); } while (0)
#define PG8_STAGE_A(bufoff, gptr, h, nx) do { if constexpr (GATHER) { const int _slot = (nx) ? nslot : ui; _Pragma("unroll") for (int _i = 0; _i < 2; ++_i) { int _R, _C; stage_rc(tid * 16 + _i * 8192, _R, _C); \
            const unsigned _vo = (unsigned)gidx[_slot * 256 + (h) * HALF + _R] + (unsigned)_C * 2u; PG8_GLDS((const char*)(gptr) + _vo, lds + (bufoff) + ldsw + _i * 8192); } } \
        else { PG8_STAGE(bufoff, (const char*)(gptr) + (h) * hstep, voffA); } } while (0)
#define PG8_LDA(dst, b, h) do { _Pragma("unroll") for (int m = 0; m < 4; ++m) _Pragma("unroll") for (int k = 0; k < 2; ++k) dst[m][k] = *(const LAS bf16x8*)(lds + PG8_SA(b, h) + aoff + m * 2048 + k * 1024); } while (0)
#define PG8_LDB(dst, b, h) do { _Pragma("unroll") for (int n = 0; n < 2; ++n) _Pragma("unroll") for (int k = 0; k < 2; ++k) dst[n][k] = *(const LAS bf16x8*)(lds + PG8_SB(b, h) + boff + n * 2048 + k * 1024); } while (0)
#define PG8_MMA(ai, bj, At, Bt) do { __builtin_amdgcn_s_setprio(1); _Pragma("unroll") for (int m = 0; m < 4; ++m) _Pragma("unroll") for (int n = 0; n < 2; ++n) _Pragma("unroll") for (int k = 0; k < 2; ++k) \
        acc[ai][bj][m][n] = __builtin_amdgcn_mfma_f32_16x16x32_bf16(Bt[n][k], At[m][k], acc[ai][bj][m][n], 0, 0, 0); __builtin_amdgcn_s_setprio(0); } while (0)
#define PG8_WAIT_V(n) asm volatile("s_waitcnt vmcnt(" #n ")" ::: "memory")
#define PG8_WAIT_L(n) asm volatile("s_waitcnt lgkmcnt(" #n ")" ::: "memory")
#define PG8_BAR __builtin_amdgcn_s_barrier()
#define PG8_SCHED __builtin_amdgcn_sched_barrier(0)
    Unit cur, nxt; int ui = 0;
    if (!S.next(0, cur)) return;
    f32x4 acc[2][2][4][2];
#pragma unroll
    for (int a = 0; a < 2; ++a)
#pragma unroll
        for (int b = 0; b < 2; ++b)
#pragma unroll
            for (int m = 0; m < 4; ++m)
#pragma unroll
                for (int n = 0; n < 2; ++n) acc[a][b][m][n] = (f32x4){0.f, 0.f, 0.f, 0.f};
    bf16x8 At[4][2], B0[2][2], B1[2][2];
    const char* cA = (const char*)g.A + (GATHER ? (size_t)0 : (size_t)cur.pm * tstep); const char* cB = (const char*)g.Bt + (size_t)cur.pn * tstep;
    PG8_STAGE(PG8_SB(0, 0), cB, voffB); PG8_STAGE(PG8_SB(0, 1), cB + hstep, voffB); PG8_STAGE_A(PG8_SA(0, 0), cA, 0, false); PG8_STAGE_A(PG8_SA(0, 1), cA, 1, false);
    if (wr == 1) PG8_BAR;
    PG8_WAIT_V(2); PG8_BAR;
    PG8_STAGE(PG8_SB(1, 0), cB + kstep, voffB); PG8_STAGE_A(PG8_SA(1, 0), cA + kstep, 0, false); PG8_STAGE(PG8_SB(1, 1), cB + hstep + kstep, voffB);
    PG8_WAIT_V(6); PG8_BAR;
    for (;;) {
        const bool has_next = S.next(ui + 1, nxt);
        const char* nA = has_next ? (const char*)g.A + (GATHER ? (size_t)0 : (size_t)nxt.pm * tstep) : cA; const char* nB = has_next ? (const char*)g.Bt + (size_t)nxt.pn * tstep : cB;
        if constexpr (GATHER) nslot = has_next ? ui + 1 : ui;
        for (int t = 0; t < nt; t += 2) {
            const bool last = (t == nt - 2);
            const char* a1 = cA + (size_t)(t + 1) * kstep;
            const char* a2 = last ? nA : cA + (size_t)(t + 2) * kstep; const char* b2 = last ? nB : cB + (size_t)(t + 2) * kstep;
            const char* a3 = a2 + kstep; const char* b3 = b2 + kstep;
            PG8_LDB(B0, 0, 0); PG8_LDB(B1, 0, 1); PG8_SCHED; PG8_LDA(At, 0, 0); PG8_STAGE_A(PG8_SA(1, 1), a1, 1, false);
            PG8_WAIT_V(8); PG8_WAIT_L(0); PG8_BAR; PG8_MMA(0, 0, At, B0); PG8_MMA(0, 1, At, B1); PG8_BAR; PG8_SCHED;
            PG8_LDA(At, 0, 1); PG8_STAGE(PG8_SB(0, 0), b2, voffB); PG8_STAGE(PG8_SB(0, 1), b2 + hstep, voffB); PG8_STAGE_A(PG8_SA(0, 0), a2, 0, last);
            PG8_WAIT_V(8); PG8_WAIT_L(0); PG8_BAR; PG8_MMA(1, 0, At, B0); PG8_MMA(1, 1, At, B1); PG8_BAR; PG8_SCHED;
            PG8_LDB(B0, 1, 0); PG8_LDB(B1, 1, 1); PG8_SCHED; PG8_LDA(At, 1, 0); PG8_STAGE_A(PG8_SA(0, 1), a2, 1, last);
            PG8_WAIT_V(8); PG8_WAIT_L(0); PG8_BAR; PG8_MMA(0, 0, At, B0); PG8_MMA(0, 1, At, B1); PG8_BAR; PG8_SCHED;
            PG8_LDA(At, 1, 1); PG8_STAGE(PG8_SB(1, 0), b3, voffB); PG8_STAGE(PG8_SB(1, 1), b3 + hstep, voffB); PG8_STAGE_A(PG8_SA(1, 0), a3, 0, last);
            PG8_WAIT_V(8); PG8_WAIT_L(0); PG8_BAR; PG8_MMA(1, 0, At, B0); PG8_MMA(1, 1, At, B1); PG8_BAR; PG8_SCHED;
        }
        if (wr == 0) PG8_BAR;
        E(acc, cur, wr, wc, fr, fq);
        if (!has_next) break;
#pragma unroll
        for (int a = 0; a < 2; ++a)
#pragma unroll
            for (int b = 0; b < 2; ++b)
#pragma unroll
                for (int m = 0; m < 4; ++m)
#pragma unroll
                    for (int n = 0; n < 2; ++n) acc[a][b][m][n] = (f32x4){0.f, 0.f, 0.f, 0.f};
        cur = nxt; cA = nA; cB = nB; ++ui;
        if (wr == 1) PG8_BAR;
    }
    PG8_WAIT_V(0);
    PG8_BAR;
#undef PG8_SA
#undef PG8_SB
#undef PG8_GLDS
#undef PG8_STAGE
#undef PG8_STAGE_A
#undef PG8_LDA
#undef PG8_LDB
#undef PG8_MMA
#undef PG8_WAIT_V
#undef PG8_WAIT_L
#undef PG8_BAR
#undef PG8_SCHED
}
}

struct Args { const float* in[23]; float* out; unsigned char* ws; float inv_freq[32]; int ph_lo, ph_hi; };
enum { I_X = 0, I_C, I_POS, I_WADA, I_BADA, I_NMIX, I_NFFN, I_WIN, I_RETN, I_HGRNN, I_LBL, I_WA2, I_BA, I_GLAN, I_WOUT, I_RGW, I_RGB, I_REW, I_REB, I_EG, I_EU, I_ED, I_NFIN };
constexpr int PH_PER_LAYER = 8, PH_FINAL = 1 + 2 * PH_PER_LAYER, N_PHASES = PH_FINAL + 1;

__device__ __forceinline__ void transpose_item(const float* W, int ldw, int K, int k0, int n0, bf16* WT, int dst_row0, LAS float* scr, int lane) {
#pragma unroll 8
    for (int i = 0; i < 32; ++i) { const int kk = 2 * i + (lane >> 5); scr[kk * 33 + (lane & 31)] = W[(size_t)(k0 + kk) * ldw + n0 + (lane & 31)]; }
    LDS_WAIT(); asm volatile("" ::: "memory");
    const int c = lane & 7;
#pragma unroll
    for (int j = 0; j < 4; ++j) { const int n = (lane >> 3) + 8 * j; const LAS float* s = scr + (8 * c) * 33 + n;
        u32x4 o; o.x = pk2(s[0 * 33], s[1 * 33]); o.y = pk2(s[2 * 33], s[3 * 33]); o.z = pk2(s[4 * 33], s[5 * 33]); o.w = pk2(s[6 * 33], s[7 * 33]);
        *(u32x4*)(WT + (size_t)(dst_row0 + n) * K + k0 + 8 * c) = o; }
    LDS_WAIT(); asm volatile("" ::: "memory");
}
__device__ __forceinline__ void sincos_acc(float a, float& s, float& c) {
    const double ad = (double)a; const double kd = rint(ad * 0.63661977236758134308); const double rd = fma(-kd, 1.57079632679489661923, ad);
    const int q = (int)kd & 3; const float r = (float)rd, r2 = r * r;
    const float sp = r + r * r2 * (-1.6666667163e-1f + r2 * (8.3333337680e-3f + r2 * (-1.9841270114e-4f + r2 * 2.7557314297e-6f)));
    const float cp = 1.0f + r2 * (-0.5f + r2 * (4.1666667908e-2f + r2 * (-1.3888889225e-3f + r2 * (2.4801587642e-5f + r2 * -2.7557314297e-7f))));
    const float ss = (q & 1) ? cp : sp, cc = (q & 1) ? sp : cp;
    s = (q & 2) ? -ss : ss; c = ((q + 1) & 2) ? -cc : cc;
}

typedef const __attribute__((address_space(4))) Args KArgs;
#define KARGS(ap) KArgs* ap = (KArgs*)__builtin_amdgcn_kernarg_segment_ptr(); asm volatile("" : "+s"(ap))
#define PHASE_IDS() int tid = threadIdx.x; asm volatile("" : "+v"(tid)); const int lane = tid & 63, wave = __builtin_amdgcn_readfirstlane(tid >> 6); \
    const int G = gridDim.x, bid = blockIdx.x, gw = bid * 8 + wave, NGW = G * 8; (void)lane; (void)wave; (void)gw; (void)NGW; (void)G; (void)bid

template <int TYPE>
__device__ __forceinline__ void naive_mixer_item(LAS unsigned char* lds, KArgs* ap, int layer, int b, int hh  , int tid) {
    constexpr int DK = (TYPE == 2) ? 32 : 64, DKW = DK / 8;
    LAS float* Qs = (LAS float*)lds; LAS float* Ks = Qs + 4096; LAS float* As = Ks + 4096; LAS float* Vs = As + 4096; LAS float* Os = Vs + 4096; LAS float* Ps = Os + 4096;
    unsigned char* ws = ap->ws;
    const bf16* PROJ = (const bf16*)(ws + WS_PROJ); bf16* H = (bf16*)(ws + WS_H);
    const f32x2* ROPE = (const f32x2*)(ws + WS_ROPE);
    const float* lbl = ap->in[I_LBL]; const float* gba = ap->in[I_BA];
    const int e = tid & 63, w = tid >> 6;
    const int qc = (TYPE == 0 ? C_RQ + hh * 64 : TYPE == 1 ? C_HQ + hh * 64 : C_GQ + hh * 32);
    const int kc = (TYPE == 0 ? C_RK + hh * 64 : TYPE == 1 ? C_HF + hh * 64 : C_GK + hh * 32);
    const int vc = (TYPE == 0 ? C_RV : TYPE == 1 ? C_HI : C_GV) + hh * 64;
    const int gc = (TYPE == 0 ? C_RG : TYPE == 1 ? C_HG : C_GG) + hh * 64;
    const int mc = (TYPE == 0 ? 0 : TYPE == 1 ? 384 : 768) + hh * 64;
    const float* gain = ap->in[TYPE == 0 ? I_RETN : TYPE == 1 ? I_HGRNN : I_GLAN] + layer * (TYPE == 2 ? 256 : 384) + hh * 64;
    float S[DKW];
#pragma unroll
    for (int i = 0; i < DKW; ++i) S[i] = 0.f;
    for (int n = 0; n < 64; ++n) {
        __syncthreads();
        const size_t row0 = (size_t)b * SEQ + (size_t)n * 64;
        for (int idx = tid; idx < 4096; idx += 512) {
            const int t = idx >> 6, d = idx & 63; const bf16* p = PROJ + (row0 + t) * NPROJ;
            Vs[idx] = bf2f(p[vc + d]);
            if (TYPE == 0) {
                const int j = d & 31; const f32x2 cs = ROPE[(row0 + t) * 32 + j];
                const float q1 = bf2f(p[qc + j]), q2 = bf2f(p[qc + 32 + j]), k1 = bf2f(p[kc + j]), k2 = bf2f(p[kc + 32 + j]);
                Qs[idx] = d < 32 ? q1 * cs.x - q2 * cs.y : q1 * cs.y + q2 * cs.x;
                Ks[idx] = (d < 32 ? k1 * cs.x - k2 * cs.y : k1 * cs.y + k2 * cs.x) * 0.125f;
                As[idx] = 1.0f - exp2f(-5.0f - (float)hh);
            } else if (TYPE == 1) {
                const float l0 = lbl[hh * 64 + d], l1 = lbl[384 + hh * 64 + d]; const float mx = fmaxf(l0, l1), e0 = expf(l0 - mx), e1 = expf(l1 - mx);
                const float lb = layer == 0 ? 0.f : e1 / (e0 + e1);
                const float z = bf2f(p[kc + d]); const float f = lb + (1.0f - lb) * sigmoidf_(z);
                As[idx] = fmaxf(f, 1e-30f); Ks[idx] = (1.0f - lb) * sigmoidf_(-z); Qs[idx] = siluf_(bf2f(p[qc + d])) * 0.125f;
            } else {
                if (d < 32) { const float pre = bf2f(p[C_GA + hh * 32 + d]) + gba[layer * 128 + hh * 32 + d];
                    const float ls = fminf(pre, 0.f) - log1pf(expf(-fabsf(pre)));
                    As[t * 64 + d] = expf(ls * (1.0f / 16.0f)); Ks[t * 64 + d] = bf2f(p[kc + d]); Qs[t * 64 + d] = bf2f(p[qc + d]) * 0.17677669529663687f; }
            }
        }
        __syncthreads();
        for (int t0 = 0; t0 < 64; t0 += 16) {
            for (int tt = 0; tt < 16; ++tt) { const int t = t0 + tt; const float v = Vs[t * 64 + e]; float part = 0.f;
#pragma unroll
                for (int i = 0; i < DKW; ++i) { const int d = w * DKW + i; S[i] = As[t * 64 + d] * S[i] + Ks[t * 64 + d] * v; part += Qs[t * 64 + d] * S[i]; }
                Ps[(tt * 8 + w) * 64 + e] = part; }
            __syncthreads();
            for (int idx = tid; idx < 1024; idx += 512) { const int tt = idx >> 6, ee = idx & 63; float o = 0.f;
#pragma unroll
                for (int ww = 0; ww < 8; ++ww) o += Ps[(tt * 8 + ww) * 64 + ee];
                Os[(t0 + tt) * 64 + ee] = o; }
            __syncthreads();
        }
        for (int tt = 0; tt < 8; ++tt) { const int t = w * 8 + tt; const float o = Os[t * 64 + e]; const float ss = wave_sum(o * o); const float r = rsqrtf(ss * (1.0f / 64.0f) + EPS);
            const float g = bf2f(PROJ[(row0 + t) * NPROJ + gc + e]);
            H[(row0 + t) * D + mc + e] = (bf16)f2bf(o * r * gain[e] * siluf_(g)); }
    }
}

constexpr int MX_PITCH = 72;
constexpr int MX_ARR = 64 * MX_PITCH * 2;
constexpr int MX_GROUP_BYTES = 5 * MX_ARR + 5 * 256 + 256;
constexpr int NSC = 4, NCH = 64 / NSC;
constexpr int ST_REC = 4096 + 64;
__device__ __forceinline__ float bfx(const u32x4& r, int i) { const unsigned w = r[i >> 1]; return (i & 1) ? bfhi(w) : bflo(w); }
__device__ __forceinline__ unsigned short bfbits(const u32x4& r, int i) { const unsigned w = r[i >> 1]; return (unsigned short)((i & 1) ? (w >> 16) : (w & 0xffffu)); }

template <int TYPE, int MODE>
__device__ __forceinline__ void mixer_chunked(LAS unsigned char* lds, KArgs* ap, int layer, int b, int head  , int hh  , int sc, int tid) {
    constexpr int DK = (TYPE == 2) ? 32 : 64, NKS = DK / 32;
    constexpr bool FULL = (MODE == 1);
    const int lane = tid & 63, wv = __builtin_amdgcn_readfirstlane(tid >> 6), gid = wv >> 2, w = wv & 3, col = lane & 15, rg = lane >> 4;
    LAS unsigned char* gb = lds + gid * MX_GROUP_BYTES;
    LAS bf16* Qt = (LAS bf16*)gb; LAS bf16* Kt = Qt + 64 * MX_PITCH; LAS bf16* KT = Kt + 64 * MX_PITCH; LAS bf16* VT = KT + 64 * MX_PITCH; LAS bf16* ST = VT + 64 * MX_PITCH;
    LAS float* EM = (LAS float*)(gb + 5 * MX_ARR); LAS float* EL = EM + 64; LAS float* ELM = EL + 64; LAS float* LBt = ELM + 64; LAS float* OMLt = LBt + 64;
    unsigned char* ws = ap->ws;
    const bf16* PROJ = (const bf16*)(ws + WS_PROJ); bf16* H = (bf16*)(ws + WS_H);
    float* STATE = (float*)(ws + WS_STATE) + (size_t)((b * 16 + head) * NSC) * ST_REC;
    const int qc = (TYPE == 0 ? C_RQ + hh * 64 : TYPE == 1 ? C_HQ + hh * 64 : C_GQ + hh * 32);
    const int kc = (TYPE == 0 ? C_RK + hh * 64 : TYPE == 1 ? C_HF + hh * 64 : C_GK + hh * 32);
    const int vc = (TYPE == 0 ? C_RV : TYPE == 1 ? C_HI : C_GV) + hh * 64;
    const int gc = (TYPE == 0 ? C_RG : TYPE == 1 ? C_HG : C_GG) + hh * 64;
    const int mc = (TYPE == 0 ? 0 : TYPE == 1 ? 384 : 768) + hh * 64;
    const float lgam = (TYPE == 0) ? log1pf(-exp2f(-5.0f - (float)hh)) : 0.f;
    float gba[16];
    if constexpr (TYPE == 2) { int zl = 0; asm volatile("" : "+v"(zl)); const float* gbap = ap->in[I_BA] + layer * 128 + hh * 32 + 16 * (w & 1) + zl;
#pragma unroll
        for (int p = 0; p < 16; ++p) gba[p] = gbap[p]; }
    if constexpr (TYPE == 1) {
        if (w == 0) { const float* lbl = ap->in[I_LBL]; const float l0 = lbl[hh * 64 + lane], l1 = lbl[384 + hh * 64 + lane]; const float mx = fmaxf(l0, l1), e0 = expf(l0 - mx), e1 = expf(l1 - mx);
            const float lb = layer == 0 ? 0.f : e1 / (e0 + e1); LBt[lane] = lb; OMLt[lane] = 1.0f - lb; }
    }
    f32x4 gn4[4];
    if constexpr (FULL) { const float* gain = ap->in[TYPE == 0 ? I_RETN : TYPE == 1 ? I_HGRNN : I_GLAN] + layer * (TYPE == 2 ? 256 : 384) + hh * 64;
#pragma unroll
        for (int et = 0; et < 4; ++et) gn4[et] = *(const f32x4*)(gain + 16 * et + 4 * rg); }
    const bool owner = (w < DK / 16);
    f32x4 S[4];
    f32x4 Gacc = (f32x4){1.f, 1.f, 1.f, 1.f};
#pragma unroll
    for (int et = 0; et < 4; ++et) S[et] = (f32x4){0.f, 0.f, 0.f, 0.f};
    if constexpr (FULL) { if (owner) { for (int j = 0; j < sc; ++j) { const float* rec = STATE + (size_t)j * ST_REC; const f32x4 gj = *(const f32x4*)(rec + 4096 + 16 * w + 4 * rg);
#pragma unroll
                for (int et = 0; et < 4; ++et) { const f32x4 sj = *(const f32x4*)(rec + ((w * 4 + et) * 64 + lane) * 4); S[et] = gj * S[et] + sj; } } } }
    const size_t rowbase = (size_t)b * SEQ + (size_t)sc * NCH * 64;
    f32x4 rope[8]; u32x4 rq[2], rk[2], rv[2], rr[2], rq2[2], rk2[2];
#define MX_LOAD_RAW(n) do { const bf16* p_ = PROJ + (rowbase + (size_t)(n) * 64 + lane) * NPROJ; \
        if constexpr (TYPE == 0) { rk[0] = *(const u32x4*)(p_ + kc + 16 * w); rk[1] = *(const u32x4*)(p_ + kc + 16 * w + 8); rk2[0] = *(const u32x4*)(p_ + kc + 16 * (w ^ 2)); rk2[1] = *(const u32x4*)(p_ + kc + 16 * (w ^ 2) + 8); \
            if constexpr (FULL) { rq[0] = *(const u32x4*)(p_ + qc + 16 * w); rq[1] = *(const u32x4*)(p_ + qc + 16 * w + 8); rq2[0] = *(const u32x4*)(p_ + qc + 16 * (w ^ 2)); rq2[1] = *(const u32x4*)(p_ + qc + 16 * (w ^ 2) + 8); } \
            const f32x4* rp_ = (const f32x4*)((const f32x2*)(ws + WS_ROPE) + (rowbase + (size_t)(n) * 64 + lane) * 32 + 16 * (w & 1)); \
            _Pragma("unroll") for (int i_ = 0; i_ < 8; ++i_) rope[i_] = rp_[i_]; } \
        else if constexpr (TYPE == 1) { rk[0] = *(const u32x4*)(p_ + kc + 16 * w); rk[1] = *(const u32x4*)(p_ + kc + 16 * w + 8); \
            if constexpr (FULL) { rq[0] = *(const u32x4*)(p_ + qc + 16 * w); rq[1] = *(const u32x4*)(p_ + qc + 16 * w + 8); } } \
        else { if (w < 2) { rk[0] = *(const u32x4*)(p_ + kc + 16 * w); rk[1] = *(const u32x4*)(p_ + kc + 16 * w + 8); rr[0] = *(const u32x4*)(p_ + C_GA + hh * 32 + 16 * w); rr[1] = *(const u32x4*)(p_ + C_GA + hh * 32 + 16 * w + 8); \
                            if constexpr (FULL) { rq[0] = *(const u32x4*)(p_ + qc + 16 * w); rq[1] = *(const u32x4*)(p_ + qc + 16 * w + 8); } } } \
        rv[0] = *(const u32x4*)(p_ + vc + 16 * w); rv[1] = *(const u32x4*)(p_ + vc + 16 * w + 8); } while (0)
    MX_LOAD_RAW(0);
    __syncthreads();
    for (int n = 0; n < NCH; ++n) {
        float em4[4];
        {
            float Qr[16], Kr[16];
            if constexpr (TYPE == 0) {
                const float sq = __expf((float)(lane - 31) * lgam), sk = __expf((float)(31 - lane) * lgam) * 0.125f;
#pragma unroll
                for (int p = 0; p < 16; ++p) { const float cs = rope[p >> 1][(p & 1) * 2], sn = rope[p >> 1][(p & 1) * 2 + 1];
                    const float ks_ = bfx(rk[p >> 3], p & 7), kp = bfx(rk2[p >> 3], p & 7);
                    Kr[p] = ((w < 2) ? (ks_ * cs - kp * sn) : (kp * sn + ks_ * cs)) * sk;
                    if constexpr (FULL) { const float qs = bfx(rq[p >> 3], p & 7), qp = bfx(rq2[p >> 3], p & 7); Qr[p] = ((w < 2) ? (qs * cs - qp * sn) : (qp * sn + qs * cs)) * sq; } }
                const float em = __expf(32.0f * lgam);
#pragma unroll
                for (int i = 0; i < 4; ++i) em4[i] = em;
                if (lane < 16) { EL[16 * w + lane] = __expf(64.0f * lgam); ELM[16 * w + lane] = em; }
            } else if (TYPE == 1 || w < 2) {
                float c[16]; float myM = 0.f, myL = 0.f;
                if constexpr (TYPE == 1) {
                    const f32x4 lb0 = *(const LAS f32x4*)(LBt + 16 * w), lb1 = *(const LAS f32x4*)(LBt + 16 * w + 4), lb2 = *(const LAS f32x4*)(LBt + 16 * w + 8), lb3 = *(const LAS f32x4*)(LBt + 16 * w + 12);
                    const f32x4 om0 = *(const LAS f32x4*)(OMLt + 16 * w), om1 = *(const LAS f32x4*)(OMLt + 16 * w + 4), om2 = *(const LAS f32x4*)(OMLt + 16 * w + 8), om3 = *(const LAS f32x4*)(OMLt + 16 * w + 12);
#pragma unroll
                    for (int p = 0; p < 16; ++p) { const float lb = (p < 4 ? lb0 : p < 8 ? lb1 : p < 12 ? lb2 : lb3)[p & 3], om = (p < 4 ? om0 : p < 8 ? om1 : p < 12 ? om2 : om3)[p & 3];
                        const float z = bfx(rk[p >> 3], p & 7); const float sg = 1.0f / (1.0f + __expf(-z));
                        const float f = lb + om * sg; c[p] = __logf(fmaxf(f, 1e-30f)); Kr[p] = om * (1.0f - sg);
                        if constexpr (FULL) { const float qv = bfx(rq[p >> 3], p & 7); Qr[p] = qv / (1.0f + __expf(-qv)) * 0.125f; } }
                } else {
#pragma unroll
                    for (int p = 0; p < 16; ++p) { const float pre = bfx(rr[p >> 3], p & 7) + gba[p];
                        c[p] = (fminf(pre, 0.f) - __logf(1.0f + __expf(-fabsf(pre)))) * (1.0f / 16.0f); Kr[p] = bfx(rk[p >> 3], p & 7);
                        if constexpr (FULL) Qr[p] = bfx(rq[p >> 3], p & 7) * 0.17677669529663687f; }
                }
#pragma unroll
                for (int p = 0; p < 16; ++p) c[p] = wave_incl_scan(c[p]);
#pragma unroll
                for (int p = 0; p < 16; ++p) { const float m = rdlane(c[p], 31), cl = rdlane(c[p], 63); Kr[p] *= __expf(m - c[p]);
                    if constexpr (FULL) Qr[p] *= __expf(c[p] - m);
                    myM = (lane == p) ? m : myM; myL = (lane == p) ? cl : myL; }
                if (lane < 16) { EM[16 * w + lane] = __expf(myM); EL[16 * w + lane] = __expf(myL); ELM[16 * w + lane] = __expf(myL - myM); }
                if constexpr (FULL) { LDS_WAIT();
                    const f32x4 e4 = *(const LAS f32x4*)(EM + 16 * w + 4 * rg);
#pragma unroll
                    for (int i = 0; i < 4; ++i) em4[i] = e4[i]; }
            } else {
#pragma unroll
                for (int i = 0; i < 4; ++i) em4[i] = 0.f;
            }
            if (TYPE != 2 || w < 2) {
                u32x4 k0, k1;
                k0.x = pg8::cvt_pk_bf16(Kr[0], Kr[1]); k0.y = pg8::cvt_pk_bf16(Kr[2], Kr[3]); k0.z = pg8::cvt_pk_bf16(Kr[4], Kr[5]); k0.w = pg8::cvt_pk_bf16(Kr[6], Kr[7]);
                k1.x = pg8::cvt_pk_bf16(Kr[8], Kr[9]); k1.y = pg8::cvt_pk_bf16(Kr[10], Kr[11]); k1.z = pg8::cvt_pk_bf16(Kr[12], Kr[13]); k1.w = pg8::cvt_pk_bf16(Kr[14], Kr[15]);
                if constexpr (FULL) {
                    u32x4 q0, q1;
                    q0.x = pg8::cvt_pk_bf16(Qr[0], Qr[1]); q0.y = pg8::cvt_pk_bf16(Qr[2], Qr[3]); q0.z = pg8::cvt_pk_bf16(Qr[4], Qr[5]); q0.w = pg8::cvt_pk_bf16(Qr[6], Qr[7]);
                    q1.x = pg8::cvt_pk_bf16(Qr[8], Qr[9]); q1.y = pg8::cvt_pk_bf16(Qr[10], Qr[11]); q1.z = pg8::cvt_pk_bf16(Qr[12], Qr[13]); q1.w = pg8::cvt_pk_bf16(Qr[14], Qr[15]);
                    *(LAS u32x4*)(Qt + lane * MX_PITCH + 16 * w) = q0; *(LAS u32x4*)(Qt + lane * MX_PITCH + 16 * w + 8) = q1;
                    *(LAS u32x4*)(Kt + lane * MX_PITCH + 16 * w) = k0; *(LAS u32x4*)(Kt + lane * MX_PITCH + 16 * w + 8) = k1; }
#pragma unroll
                for (int p = 0; p < 16; ++p) KT[(16 * w + p) * MX_PITCH + lane] = bfbits(p < 8 ? k0 : k1, p & 7);
            }
#pragma unroll
            for (int p = 0; p < 16; ++p) VT[(16 * w + p) * MX_PITCH + lane] = bfbits(rv[p >> 3], p & 7);
            if constexpr (FULL) { if (owner) {
#pragma unroll
                for (int et = 0; et < 4; ++et) { u32x2 o; o.x = pg8::cvt_pk_bf16(S[et][0] * em4[0], S[et][1] * em4[1]); o.y = pg8::cvt_pk_bf16(S[et][2] * em4[2], S[et][3] * em4[3]);
                    *(LAS u32x2*)(ST + (16 * et + col) * MX_PITCH + 16 * w + 4 * rg) = o; } } }
        }
        __syncthreads();
        const size_t trow = rowbase + (size_t)n * 64 + 16 * w + col;
        u32x2 gt[4];
        if constexpr (FULL) {
#pragma unroll
            for (int et = 0; et < 4; ++et) gt[et] = *(const u32x2*)(PROJ + trow * NPROJ + gc + 16 * et + 4 * rg); }
        if (n + 1 < NCH) { MX_LOAD_RAW(n + 1); }
        f32x4 OT[4];
        if constexpr (FULL) {
            bf16x8 Bq[NKS];
#pragma unroll
            for (int ks = 0; ks < NKS; ++ks) Bq[ks] = *(const LAS bf16x8*)(Qt + (16 * w + col) * MX_PITCH + 32 * ks + 8 * rg);
            f32x4 PT[4];
#pragma unroll
            for (int st = 0; st < 4; ++st) { PT[st] = (f32x4){0.f, 0.f, 0.f, 0.f};
                if (st <= w) {
#pragma unroll
                    for (int ks = 0; ks < NKS; ++ks) { const bf16x8 af = *(const LAS bf16x8*)(Kt + (16 * st + col) * MX_PITCH + 32 * ks + 8 * rg); PT[st] = __builtin_amdgcn_mfma_f32_16x16x32_bf16(af, Bq[ks], PT[st], 0, 0, 0); }
                    if (st == w) {
#pragma unroll
                        for (int i = 0; i < 4; ++i) PT[st][i] = (4 * rg + i > col) ? 0.f : PT[st][i]; }
                } }
            u32x4 pb0, pb1;
            pb0.x = pg8::cvt_pk_bf16(PT[0][0], PT[0][1]); pb0.y = pg8::cvt_pk_bf16(PT[0][2], PT[0][3]); pb0.z = pg8::cvt_pk_bf16(PT[1][0], PT[1][1]); pb0.w = pg8::cvt_pk_bf16(PT[1][2], PT[1][3]);
            pb1.x = pg8::cvt_pk_bf16(PT[2][0], PT[2][1]); pb1.y = pg8::cvt_pk_bf16(PT[2][2], PT[2][3]); pb1.z = pg8::cvt_pk_bf16(PT[3][0], PT[3][1]); pb1.w = pg8::cvt_pk_bf16(PT[3][2], PT[3][3]);
#pragma unroll
            for (int et = 0; et < 4; ++et) { OT[et] = (f32x4){0.f, 0.f, 0.f, 0.f};
#pragma unroll
                for (int ks = 0; ks < NKS; ++ks) { const bf16x8 af = *(const LAS bf16x8*)(ST + (16 * et + col) * MX_PITCH + 32 * ks + 8 * rg); OT[et] = __builtin_amdgcn_mfma_f32_16x16x32_bf16(af, Bq[ks], OT[et], 0, 0, 0); }
                { const u32x2 a0 = *(const LAS u32x2*)(VT + (16 * et + col) * MX_PITCH + 4 * rg), a1 = *(const LAS u32x2*)(VT + (16 * et + col) * MX_PITCH + 16 + 4 * rg);
                  u32x4 av; av.x = a0.x; av.y = a0.y; av.z = a1.x; av.w = a1.y;
                  OT[et] = __builtin_amdgcn_mfma_f32_16x16x32_bf16(__builtin_bit_cast(bf16x8, av), __builtin_bit_cast(bf16x8, pb0), OT[et], 0, 0, 0); }
                if (w >= 2) { const u32x2 a0 = *(const LAS u32x2*)(VT + (16 * et + col) * MX_PITCH + 32 + 4 * rg), a1 = *(const LAS u32x2*)(VT + (16 * et + col) * MX_PITCH + 48 + 4 * rg);
                  u32x4 av; av.x = a0.x; av.y = a0.y; av.z = a1.x; av.w = a1.y;
                  OT[et] = __builtin_amdgcn_mfma_f32_16x16x32_bf16(__builtin_bit_cast(bf16x8, av), __builtin_bit_cast(bf16x8, pb1), OT[et], 0, 0, 0); }
            }
        }
        if (owner) {
            const f32x4 el = *(const LAS f32x4*)(EL + 16 * w + 4 * rg), elm = *(const LAS f32x4*)(ELM + 16 * w + 4 * rg);
#pragma unroll
            for (int et = 0; et < 4; ++et) { f32x4 W = (f32x4){0.f, 0.f, 0.f, 0.f};
#pragma unroll
                for (int ks = 0; ks < 2; ++ks) { const bf16x8 af = *(const LAS bf16x8*)(KT + (16 * w + col) * MX_PITCH + 32 * ks + 8 * rg), bfr = *(const LAS bf16x8*)(VT + (16 * et + col) * MX_PITCH + 32 * ks + 8 * rg);
                    W = __builtin_amdgcn_mfma_f32_16x16x32_bf16(af, bfr, W, 0, 0, 0); }
                S[et] = el * S[et] + elm * W; }
            if constexpr (!FULL) Gacc = Gacc * el;
        }
        if constexpr (FULL) {
            float ss = 0.f;
#pragma unroll
            for (int et = 0; et < 4; ++et) ss += (OT[et][0] * OT[et][0] + OT[et][1] * OT[et][1]) + (OT[et][2] * OT[et][2] + OT[et][3] * OT[et][3]);
            ss += __shfl_xor(ss, 16); ss += __shfl_xor(ss, 32);
            const float r = rsqrtf(ss * (1.0f / 64.0f) + EPS);
#pragma unroll
            for (int et = 0; et < 4; ++et) { const f32x4 g4 = gn4[et];
                const float g0 = bflo(gt[et].x), g1 = bfhi(gt[et].x), g2 = bflo(gt[et].y), g3 = bfhi(gt[et].y);
                const float o0 = OT[et][0] * r * g4[0] * (g0 / (1.0f + __expf(-g0))), o1 = OT[et][1] * r * g4[1] * (g1 / (1.0f + __expf(-g1)));
                const float o2 = OT[et][2] * r * g4[2] * (g2 / (1.0f + __expf(-g2))), o3 = OT[et][3] * r * g4[3] * (g3 / (1.0f + __expf(-g3)));
                u32x2 o; o.x = pg8::cvt_pk_bf16(o0, o1); o.y = pg8::cvt_pk_bf16(o2, o3);
                *(u32x2*)(H + trow * D + mc + 16 * et + 4 * rg) = o; }
        }
        __syncthreads();
    }
    if constexpr (!FULL) { if (owner) { float* rec = STATE + (size_t)sc * ST_REC;
#pragma unroll
            for (int et = 0; et < 4; ++et) *(f32x4*)(rec + ((w * 4 + et) * 64 + lane) * 4) = S[et];
            if (col == 0) *(f32x4*)(rec + 4096 + 16 * w + 4 * rg) = Gacc; } }
#undef MX_LOAD_RAW
}

template <int MODE>
__device__ __forceinline__ void phase_mixer(LAS unsigned char* lds, int layer) {
    KARGS(ap); PHASE_IDS();
    constexpr int NS = (MODE == 0) ? NSC - 1 : NSC;
    for (int pr = bid; pr < NB * 8 * NS; pr += G) {
        const int sc = pr % NS, hp = (pr / NS) & 7, b = pr / (NS * 8), hd = 2 * hp + (wave >> 2);
        if (hp < 3) mixer_chunked<0, MODE>(lds, ap, layer, b, hd, hd, sc, tid);
        else if (hp < 6) mixer_chunked<1, MODE>(lds, ap, layer, b, hd, hd - 6, sc, tid);
        else mixer_chunked<2, MODE>(lds, ap, layer, b, hd, hd - 12, sc, tid);
        __syncthreads();
    }
}

__device__ __forceinline__ void build_tp(LAS int* TP, const unsigned* cnt, int tid) {
    if (tid == 0) { int s = 0; for (int e = 0; e < 32; ++e) { TP[e] = s; s += ((int)cnt[e] + 255) >> 8; } TP[32] = s; }
    __syncthreads();
}

__device__ __forceinline__ void phase_prologue(LAS unsigned char* lds) {
    KARGS(ap); PHASE_IDS();
    unsigned char* ws = ap->ws;
    if (bid < 192) {
        float* MOD = (float*)(ws + WS_MOD);
        const float* cin = ap->in[I_C]; const float* wada = ap->in[I_WADA]; const float* bada = ap->in[I_BADA];
        LAS float* cact = (LAS float*)lds;
        for (int i = tid; i < 8192; i += 512) { const int b = i >> 10, k = i & 1023; cact[k * 8 + b] = siluf_(cin[i]); }
        __syncthreads();
        LAS float* red = (LAS float*)(lds + 32768);
        for (int it = bid; it < 192; it += G) {
            const int l = it / 96, j0 = (it % 96) * 64; const float* W = wada + (size_t)l * D * 6144 + j0 + lane;
            float acc[8];
#pragma unroll
            for (int b = 0; b < 8; ++b) acc[b] = 0.f;
#pragma unroll 8
            for (int kk = 0; kk < 128; ++kk) { const int k = wave * 128 + kk; const float wv = W[(size_t)k * 6144];
                const f32x4 c0 = *(const LAS f32x4*)(cact + k * 8), c1 = *(const LAS f32x4*)(cact + k * 8 + 4);
                acc[0] += c0[0] * wv; acc[1] += c0[1] * wv; acc[2] += c0[2] * wv; acc[3] += c0[3] * wv; acc[4] += c1[0] * wv; acc[5] += c1[1] * wv; acc[6] += c1[2] * wv; acc[7] += c1[3] * wv; }
#pragma unroll
            for (int b = 0; b < 8; ++b) red[(wave * 8 + b) * 64 + lane] = acc[b];
            __syncthreads();
            { const int b = tid >> 6, col = tid & 63; float s = 0.f;
#pragma unroll
              for (int ww = 0; ww < 8; ++ww) s += red[(ww * 8 + b) * 64 + col];
              MOD[((size_t)l * 8 + b) * 6144 + j0 + col] = s + bada[l * 6144 + j0 + col]; }
            __syncthreads();
        }
    }
    __syncthreads();
    {
        bf16* WIN_T = (bf16*)(ws + WS_WIN); bf16* WOUT_T = (bf16*)(ws + WS_WOUT); bf16* WGU_T = (bf16*)(ws + WS_WGU); bf16* WD_T = (bf16*)(ws + WS_WD);
        LAS float* scr = (LAS float*)(lds + wave * 16384);
        constexpr int I_IN = 16 * 120, I_OUT = 16 * 32, I_G = 16 * 8, I_D = 4 * 32;
        constexpr int PER_L = I_IN + I_OUT + 32 * I_G * 2 + 32 * I_D;
        for (int it = gw; it < 2 * PER_L; it += NGW) {
            const int l = it / PER_L; int r = it % PER_L;
            if (r < I_IN) { const int kb = r / 120, nb = r % 120; transpose_item(ap->in[I_WIN] + (size_t)l * D * INP, INP, D, kb * 64, nb * 32, WIN_T + (size_t)l * NPROJ * D, nb * 32, scr, lane); continue; } r -= I_IN;
            if (r < I_OUT) { const int kb = r / 32, nb = r % 32; transpose_item(ap->in[I_WOUT] + (size_t)l * D * D, D, D, kb * 64, nb * 32, WOUT_T + (size_t)l * D * D, nb * 32, scr, lane); continue; } r -= I_OUT;
            if (r < 32 * I_G * 2) { const int up = r / (32 * I_G); r %= 32 * I_G; const int e = r / I_G; r %= I_G; const int kb = r / 8, nb = r % 8, n0 = nb * 32;
                transpose_item(ap->in[up ? I_EU : I_EG] + ((size_t)l * NEXP + e) * D * DEXP, DEXP, D, kb * 64, n0, WGU_T + ((size_t)l * NEXP + e) * 512 * D, (n0 >> 7) * 256 + (n0 & 127) + up * 128, scr, lane); continue; } r -= 32 * I_G * 2;
            { const int e = r / I_D; r %= I_D; const int kb = r / 32, nb = r % 32;
                transpose_item(ap->in[I_ED] + ((size_t)l * NEXP + e) * DEXP * D, D, DEXP, kb * 64, nb * 32, WD_T + ((size_t)l * NEXP + e) * D * DEXP, nb * 32, scr, lane); }
        }
        const float* win = ap->in[I_WIN]; const float* wa2 = ap->in[I_WA2];
        for (int it = bid * 512 + tid; it < 2 * 256 * 128; it += G * 512) {
            const int l = it / (256 * 128), r = it % (256 * 128), n = r / 128, k0 = (r % 128) * 8;
            float o[8];
#pragma unroll
            for (int j = 0; j < 8; ++j) o[j] = 0.f;
            if (n < 128) {
#pragma unroll
                for (int j = 0; j < 8; ++j) { const float* wr_ = win + (size_t)l * D * INP + (size_t)(k0 + j) * INP + 3840; float s = 0.f;
#pragma unroll
                    for (int rr = 0; rr < 16; ++rr) s += wr_[rr] * wa2[l * 16 * 128 + rr * 128 + n];
                    o[j] = s; } }
            u32x4 w; w.x = pk2(o[0], o[1]); w.y = pk2(o[2], o[3]); w.z = pk2(o[4], o[5]); w.w = pk2(o[6], o[7]);
            *(u32x4*)(WIN_T + (size_t)l * NPROJ * D + (size_t)(3840 + n) * D + k0) = w;
        }
    }
    {
        f32x2* ROPE = (f32x2*)(ws + WS_ROPE); const int* posp = (const int*)ap->in[I_POS];
        for (int it = bid * 512 + tid; it < MTOK * 32; it += G * 512) {
            const int row = it >> 5, j = it & 31; const int pos = posp[row];
            const float ang = (float)pos * ap->inv_freq[j]; float s, c; sincos_acc(ang, s, c); ROPE[it] = (f32x2){c, s};
        }
    }
}

template <int MODE>
__device__ __forceinline__ void phase_norm1(LAS unsigned char* lds, int layer) {
    KARGS(ap); PHASE_IDS();
    unsigned char* ws = ap->ws; float* outp = ap->out;
    const float* MOD = (const float*)(ws + WS_MOD); bf16* H = (bf16*)(ws + WS_H); const bf16* YP = (const bf16*)(ws + WS_YP);
    const int* ROUTE_I = (const int*)(ws + WS_ROUTE); const float* ROUTE_W = (const float*)(ws + WS_ROUTE + 4 * MTOK * 4);
    LAS int* TP = (LAS int*)(lds + TP_OFF);
    const int pl = (MODE == 2) ? DEPTH - 1 : layer - 1;
    if (MODE != 0) build_tp(TP, (const unsigned*)(ws + WS_CTL) + CW_CNT + pl * 64, tid);
    const float* xin = MODE == 0 ? ap->in[I_X] : outp;
    const float* gn = MODE == 2 ? ap->in[I_NFIN] : ap->in[I_NMIX] + layer * D;
    for (int rb = bid; rb < MTOK / 128; rb += G) {
        const int row0 = rb * 128 + wave * 16, b = row0 >> 12;
        f32x4 Av[4], Bv[4], Gf[4];
#pragma unroll
        for (int j = 0; j < 4; ++j) { const int c0 = 4 * lane + 256 * j; Av[j] = *(const f32x4*)(gn + c0);
            if (MODE != 2) { const float* mb = MOD + (size_t)layer * 8 * 6144 + (size_t)b * 6144; const f32x4 sc = *(const f32x4*)(mb + D + c0); Bv[j] = *(const f32x4*)(mb + c0); Av[j] = Av[j] * (1.0f + sc); }
            if (MODE != 0) Gf[j] = *(const f32x4*)(MOD + (size_t)pl * 8 * 6144 + (size_t)b * 6144 + 5 * D + c0); }
        for (int r = 0; r < 16; r += 2) {
            f32x4 v[2][4];
#pragma unroll
            for (int q = 0; q < 2; ++q)
#pragma unroll
                for (int j = 0; j < 4; ++j) v[q][j] = *(const f32x4*)(xin + (size_t)(row0 + r + q) * D + 4 * lane + 256 * j);
            if (MODE != 0) {
                u32x2 y0[2][4], y1[2][4]; float w0[2], w1[2];
#pragma unroll
                for (int q = 0; q < 2; ++q) { const int m = row0 + r + q; const int e0 = ROUTE_I[m], e1 = ROUTE_I[MTOK + m], r0 = ROUTE_I[2 * MTOK + m], r1 = ROUTE_I[3 * MTOK + m]; w0[q] = ROUTE_W[m]; w1[q] = ROUTE_W[MTOK + m];
                    const bf16* p0 = YP + (size_t)(TP[e0] * 256 + r0) * D; const bf16* p1 = YP + (size_t)(TP[e1] * 256 + r1) * D;
#pragma unroll
                    for (int j = 0; j < 4; ++j) { y0[q][j] = *(const u32x2*)(p0 + 4 * lane + 256 * j); y1[q][j] = *(const u32x2*)(p1 + 4 * lane + 256 * j); } }
#pragma unroll
                for (int q = 0; q < 2; ++q)
#pragma unroll
                    for (int j = 0; j < 4; ++j) { const u32x2 a0 = y0[q][j], a1 = y1[q][j];
                        v[q][j][0] += Gf[j][0] * (w0[q] * bflo(a0.x) + w1[q] * bflo(a1.x)); v[q][j][1] += Gf[j][1] * (w0[q] * bfhi(a0.x) + w1[q] * bfhi(a1.x));
                        v[q][j][2] += Gf[j][2] * (w0[q] * bflo(a0.y) + w1[q] * bflo(a1.y)); v[q][j][3] += Gf[j][3] * (w0[q] * bfhi(a0.y) + w1[q] * bfhi(a1.y));
                        if (MODE == 1) *(f32x4*)(outp + (size_t)(row0 + r + q) * D + 4 * lane + 256 * j) = v[q][j]; }
            }
            float ss[2];
#pragma unroll
            for (int q = 0; q < 2; ++q) { float s = 0.f;
#pragma unroll
                for (int j = 0; j < 4; ++j) s += (v[q][j][0] * v[q][j][0] + v[q][j][1] * v[q][j][1]) + (v[q][j][2] * v[q][j][2] + v[q][j][3] * v[q][j][3]);
                ss[q] = s; }
            ss[0] = wave_sum(ss[0]); ss[1] = wave_sum(ss[1]);
#pragma unroll
            for (int q = 0; q < 2; ++q) { const float rstd = rsqrtf(ss[q] * (1.0f / D) + EPS); const size_t m = (size_t)(row0 + r + q);
#pragma unroll
                for (int j = 0; j < 4; ++j) { const int c0 = 4 * lane + 256 * j;
                    if (MODE == 2) { *(f32x4*)(outp + m * D + c0) = v[q][j] * rstd * Av[j]; }
                    else { const f32x4 y = (v[q][j] * rstd) * Av[j] + Bv[j]; u32x2 o; o.x = pk2(y[0], y[1]); o.y = pk2(y[2], y[3]); *(u32x2*)(H + m * D + c0) = o; } } }
        }
    }
}

__device__ __forceinline__ void phase_inproj(LAS unsigned char* lds, int layer) {
    KARGS(ap); unsigned char* ws = ap->ws;
    pg8::Gemm g{(const bf16*)(ws + WS_H), (const bf16*)(ws + WS_WIN) + (size_t)layer * NPROJ * D, D}; pg8::StaticOrder S; S.init(MTOK, NPROJ, gridDim.x, blockIdx.x);
    pg8::EpiBf16Store E{(bf16*)(ws + WS_PROJ), NPROJ};
    pg8::gemm_phase<pg8::EpiBf16Store, pg8::StaticOrder, false>(lds, g, S, E, nullptr);
}
__device__ __forceinline__ void phase_mixer_naive(LAS unsigned char* lds, int layer) {
    KARGS(ap); PHASE_IDS();
    for (int it = bid; it < NB * 16; it += G) {
        const int b = it >> 4, hd = it & 15;
        if (hd < 6) naive_mixer_item<0>(lds, ap, layer, b, hd, tid);
        else if (hd < 12) naive_mixer_item<1>(lds, ap, layer, b, hd - 6, tid);
        else naive_mixer_item<2>(lds, ap, layer, b, hd - 12, tid);
        __syncthreads();
    }
}
__device__ __forceinline__ void phase_outproj(LAS unsigned char* lds, int layer) {
    KARGS(ap); unsigned char* ws = ap->ws; float* outp = ap->out;
    pg8::Gemm g{(const bf16*)(ws + WS_H), (const bf16*)(ws + WS_WOUT) + (size_t)layer * D * D, D}; pg8::StaticOrder S; S.init(MTOK, D, gridDim.x, blockIdx.x);
    pg8::EpiResGate E{layer == 0 ? ap->in[I_X] : outp, outp, (const float*)(ws + WS_MOD) + (size_t)layer * 8 * 6144 + 2 * D};
    pg8::gemm_phase<pg8::EpiResGate, pg8::StaticOrder, false>(lds, g, S, E, nullptr);
}
constexpr int WR_PITCH = 1032;
__device__ __forceinline__ void phase_norm2_router(LAS unsigned char* lds, int layer) {
    KARGS(ap); PHASE_IDS();
    unsigned char* ws = ap->ws; const float* xres = ap->out;
    bf16* H = (bf16*)(ws + WS_H);
    int* ROUTE_I = (int*)(ws + WS_ROUTE); float* ROUTE_W = (float*)(ws + WS_ROUTE + 4 * MTOK * 4); int* IDX2 = (int*)(ws + WS_IDX2);
    unsigned* cntl = (unsigned*)(ws + WS_CTL) + CW_CNT + layer * 64;
    LAS bf16* Wr = (LAS bf16*)lds;
    LAS float* LG = (LAS float*)(lds + 99072);
    LAS float* AB = (LAS float*)(lds + 119552);
    LAS int* HIST = (LAS int*)(lds + 127744); LAS int* BASE = HIST + 32; LAS int* RI = BASE + 32; LAS float* RW = (LAS float*)(RI + 128 * 4);
    { const float* rgw = ap->in[I_RGW] + (size_t)layer * D * 4; const float* rew = ap->in[I_REW] + (size_t)layer * D * 32;
      for (int i = tid; i < 48 * 1024; i += 512) { const int n = i >> 10, k = i & 1023; const float wv = n < 4 ? rgw[k * 4 + n] : (n < 36 ? rew[k * 32 + (n - 4)] : 0.f); Wr[n * WR_PITCH + k] = (bf16)f2bf(wv); } }
    const float* gn = ap->in[I_NFFN] + layer * D; const float* rgb = ap->in[I_RGB] + layer * 4; const float* reb = ap->in[I_REB] + layer * 32;
    const float* modl = (const float*)(ws + WS_MOD) + (size_t)layer * 8 * 6144;
    const int r = lane & 15, kq = lane >> 4;
    for (int rb = bid; rb < MTOK / 128; rb += G) {
        const int row0 = rb * 128 + wave * 16, b = row0 >> 12; const float* mb = modl + (size_t)b * 6144 + 3 * D;
        __syncthreads();
        if (tid < 32) HIST[tid] = 0;
        for (int i = tid; i < 1024; i += 512) { AB[i] = gn[i] * (1.0f + mb[D + i]); AB[1024 + i] = mb[i]; }
        __syncthreads();
        const float* xr = xres + (size_t)(row0 + r) * D + 8 * kq;
        float ss = 0.f;
#pragma unroll 8
        for (int ks = 0; ks < 32; ++ks) { const f32x4 xa = *(const f32x4*)(xr + 32 * ks), xb = *(const f32x4*)(xr + 32 * ks + 4);
            ss += (xa[0] * xa[0] + xa[1] * xa[1]) + (xa[2] * xa[2] + xa[3] * xa[3]) + (xb[0] * xb[0] + xb[1] * xb[1]) + (xb[2] * xb[2] + xb[3] * xb[3]); }
        ss += __shfl_xor(ss, 16); ss += __shfl_xor(ss, 32);
        const float rstd = rsqrtf(ss * (1.0f / D) + EPS);
        f32x4 acc[3];
#pragma unroll
        for (int nt = 0; nt < 3; ++nt) acc[nt] = (f32x4){0.f, 0.f, 0.f, 0.f};
        bf16* hr = H + (size_t)(row0 + r) * D + 8 * kq;
#pragma unroll 4
        for (int ks = 0; ks < 32; ++ks) { const f32x4 xa = *(const f32x4*)(xr + 32 * ks), xb = *(const f32x4*)(xr + 32 * ks + 4);
            const f32x4 a0 = *(const LAS f32x4*)(AB + 32 * ks + 8 * kq), a1 = *(const LAS f32x4*)(AB + 32 * ks + 8 * kq + 4), b0 = *(const LAS f32x4*)(AB + 1024 + 32 * ks + 8 * kq), b1 = *(const LAS f32x4*)(AB + 1024 + 32 * ks + 8 * kq + 4);
            const f32x4 ya = (xa * rstd) * a0 + b0, yb = (xb * rstd) * a1 + b1;
            u32x4 o; o.x = pg8::cvt_pk_bf16(ya[0], ya[1]); o.y = pg8::cvt_pk_bf16(ya[2], ya[3]); o.z = pg8::cvt_pk_bf16(yb[0], yb[1]); o.w = pg8::cvt_pk_bf16(yb[2], yb[3]);
            *(u32x4*)(hr + 32 * ks) = o;
            const bf16x8 af = __builtin_bit_cast(bf16x8, o);
#pragma unroll
            for (int nt = 0; nt < 3; ++nt) { const bf16x8 bfr = *(const LAS bf16x8*)(Wr + (16 * nt + r) * WR_PITCH + 32 * ks + 8 * kq); acc[nt] = __builtin_amdgcn_mfma_f32_16x16x32_bf16(af, bfr, acc[nt], 0, 0, 0); } }
        LAS float* lgw = LG + wave * 16 * 40;
#pragma unroll
        for (int nt = 0; nt < 3; ++nt) { if (16 * nt + r < 40) {
#pragma unroll
            for (int i = 0; i < 4; ++i) lgw[(4 * kq + i) * 40 + 16 * nt + r] = acc[nt][i]; } }
        LDS_WAIT();
        if (lane < 16) {
            const LAS float* lg = lgw + lane * 40;
            float gl[4];
#pragma unroll
            for (int t = 0; t < 4; ++t) gl[t] = lg[t] + rgb[t];
            int gi = 0; float gm = gl[0];
#pragma unroll
            for (int t = 1; t < 4; ++t) if (gl[t] > gm) { gm = gl[t]; gi = t; }
            float gs = 0.f;
#pragma unroll
            for (int t = 0; t < 4; ++t) gs += __expf(gl[t] - gm);
            const float gwt = 1.0f / gs;
            float el[8];
#pragma unroll
            for (int t = 0; t < 8; ++t) el[t] = lg[4 + gi * 8 + t] + reb[gi * 8 + t];
            int i0 = 0; float m0 = el[0];
#pragma unroll
            for (int t = 1; t < 8; ++t) if (el[t] > m0) { m0 = el[t]; i0 = t; }
            int i1 = -1; float m1 = -3.0e38f;
#pragma unroll
            for (int t = 0; t < 8; ++t) if (t != i0 && el[t] > m1) { m1 = el[t]; i1 = t; }
            const float ex = __expf(m1 - m0); const float w0 = gwt / (1.0f + ex), w1 = gwt * ex / (1.0f + ex);
            const int e0 = gi * 8 + i0, e1 = gi * 8 + i1, lr = wave * 16 + lane;
            const int l0 = __hip_atomic_fetch_add(HIST + e0, 1, __ATOMIC_RELAXED, __HIP_MEMORY_SCOPE_WORKGROUP), l1 = __hip_atomic_fetch_add(HIST + e1, 1, __ATOMIC_RELAXED, __HIP_MEMORY_SCOPE_WORKGROUP);
            RI[lr * 4 + 0] = e0; RI[lr * 4 + 1] = e1; RI[lr * 4 + 2] = l0; RI[lr * 4 + 3] = l1; RW[lr * 2 + 0] = w0; RW[lr * 2 + 1] = w1;
        }
        __syncthreads();
        if (tid < 32) { const int c = HIST[tid]; BASE[tid] = c ? (int)atomicAdd(cntl + tid, (unsigned)c) : 0; }
        __syncthreads();
        if (tid < 128) { const int m = rb * 128 + tid; const int e0 = RI[tid * 4 + 0], e1 = RI[tid * 4 + 1]; const int r0 = BASE[e0] + RI[tid * 4 + 2], r1 = BASE[e1] + RI[tid * 4 + 3];
            IDX2[e0 * MTOK + r0] = m; IDX2[e1 * MTOK + r1] = m;
            ROUTE_I[m] = e0; ROUTE_I[MTOK + m] = e1; ROUTE_I[2 * MTOK + m] = r0; ROUTE_I[3 * MTOK + m] = r1; ROUTE_W[m] = RW[tid * 2 + 0]; ROUTE_W[MTOK + m] = RW[tid * 2 + 1]; }
    }
}
__device__ __forceinline__ void phase_moe_up(LAS unsigned char* lds, int layer) {
    KARGS(ap); unsigned char* ws = ap->ws;
    LAS int* TP = (LAS int*)(lds + TP_OFF); LAS int* AUX = (LAS int*)(lds + AUX_OFF);
    const unsigned* cntl = (const unsigned*)(ws + WS_CTL) + CW_CNT + layer * 64;
    { int tid = threadIdx.x; build_tp(TP, cntl, tid);
      pg8::MoeOrder S0; S0.G = gridDim.x; S0.c = blockIdx.x; S0.npt = 2; S0.total = TP[32] * 2; S0.tp = TP;
      const int* IDX2 = (const int*)(ws + WS_IDX2);
      pg8::Unit u; for (int i = 0; i < 8; ++i) { if (!S0.next(i, u)) break; const int e = u.pn >> 1, j = u.pm - TP[e], cnt = (int)cntl[e];
          if (tid < 256) { const int rank = j * 256 + tid; AUX[i * 256 + tid] = (rank < cnt ? IDX2[e * MTOK + rank] : 0) * (D * 2); } }
      __syncthreads(); }
    pg8::MoeOrder S; S.G = gridDim.x; S.c = blockIdx.x; S.npt = 2; S.total = TP[32] * 2; S.tp = TP;
    pg8::Gemm g{(const bf16*)(ws + WS_H), (const bf16*)(ws + WS_WGU) + (size_t)layer * NEXP * 512 * D, D};
    pg8::EpiSwiGLU E{(bf16*)(ws + WS_HID)};
    pg8::gemm_phase<pg8::EpiSwiGLU, pg8::MoeOrder, true>(lds, g, S, E, AUX);
}
__device__ __forceinline__ void phase_moe_down(LAS unsigned char* lds, int layer) {
    KARGS(ap); unsigned char* ws = ap->ws;
    LAS int* TP = (LAS int*)(lds + TP_OFF);
    build_tp(TP, (const unsigned*)(ws + WS_CTL) + CW_CNT + layer * 64, threadIdx.x);
    pg8::MoeOrder S; S.G = gridDim.x; S.c = blockIdx.x; S.npt = 4; S.total = TP[32] * 4; S.tp = TP;
    pg8::Gemm g{(const bf16*)(ws + WS_HID), (const bf16*)(ws + WS_WD) + (size_t)layer * NEXP * D * DEXP, DEXP};
    pg8::EpiBf16Store E{(bf16*)(ws + WS_YP), D};
    pg8::gemm_phase<pg8::EpiBf16Store, pg8::MoeOrder, false>(lds, g, S, E, nullptr);
}

__global__ void __launch_bounds__(512, 2) fwd(Args a) {
    extern __shared__ __attribute__((aligned(16))) unsigned char lds_raw[];
    LAS unsigned char* lds = (LAS unsigned char*)lds_raw;
    volatile LAS unsigned* MISC = (volatile LAS unsigned*)(lds + LDSCTL_OFF);
    for (int u = threadIdx.x; u < (LDS_BYTES - LDSCTL_OFF) / 4; u += 512) ((LAS unsigned*)(lds + LDSCTL_OFF))[u] = 0u;
    __syncthreads();
#if MK_ONE_LAUNCH
    { unsigned* ctl0 = (unsigned*)(a.ws + WS_CTL); (void)xcd_barrier_post(ctl0 + CW_BAR, MISC + 8); }
    constexpr int lo = 0, hi = N_PHASES;
#define SEAM(k) do { if ((k) + 1 < hi) { KARGS(_ap); XcdBarrier _b; _b.bar = (unsigned*)(_ap->ws + WS_CTL) + CW_BAR; _b.x = xb_xcc_id(); _b.st = (volatile LAS unsigned*)(lds + LDSCTL_OFF) + 8; xcd_barrier(_b); if (PROBE_BAR) xcd_barrier(_b); } } while (0)
#else
    (void)MISC;
    const int lo = a.ph_lo, hi = a.ph_hi;
#define SEAM(k) do { } while (0)
#endif
#define IN(k) (lo <= (k) && (k) < hi)
    if (EN_P0 && IN(0)) { phase_prologue(lds); SEAM(0); if (PROBE_D) { phase_prologue(lds); SEAM(0); } }
#define LAYER_PHASES(layer) do { constexpr int pb = 1 + PH_PER_LAYER * (layer); \
        if (EN_PA && IN(pb + 0)) { if ((layer) == 0) { phase_norm1<0>(lds, (layer)); if (PROBE_A) { SEAM(pb + 0); phase_norm1<0>(lds, (layer)); } } else phase_norm1<1>(lds, (layer)); SEAM(pb + 0); } \
        if (EN_PB && IN(pb + 1)) { phase_inproj(lds, (layer)); SEAM(pb + 1); } \
        if (EN_PC && IN(pb + 2)) { if (!MK_NAIVE_MIXER) phase_mixer<0>(lds, (layer)); SEAM(pb + 2); } \
        if (EN_PC && IN(pb + 3)) { if (MK_NAIVE_MIXER) phase_mixer_naive(lds, (layer)); else phase_mixer<1>(lds, (layer)); SEAM(pb + 3); if (PROBE_M) { phase_mixer<0>(lds, (layer)); SEAM(pb + 3); } if (PROBE_M3) { phase_mixer<1>(lds, (layer)); SEAM(pb + 3); } } \
        if (EN_PD && IN(pb + 4)) { phase_outproj(lds, (layer)); SEAM(pb + 4); if (PROBE_PD && (layer) == 0) { phase_outproj(lds, (layer)); SEAM(pb + 4); } } \
        if (EN_PE && IN(pb + 5)) { phase_norm2_router(lds, (layer)); SEAM(pb + 5); if (PROBE_E) { if (blockIdx.x == 0 && threadIdx.x < 64) { KARGS(_a2); ((unsigned*)(_a2->ws + WS_CTL))[CW_CNT + (layer) * 64 + threadIdx.x] = 0u; } SEAM(pb + 5); phase_norm2_router(lds, (layer)); SEAM(pb + 5); } } \
        if (EN_PG && IN(pb + 6)) { phase_moe_up(lds, (layer)); SEAM(pb + 6); if (PROBE_C) { phase_moe_up(lds, (layer)); SEAM(pb + 6); } } \
        if (EN_PH && IN(pb + 7)) { phase_moe_down(lds, (layer)); SEAM(pb + 7); if (PROBE_C) { phase_moe_down(lds, (layer)); SEAM(pb + 7); } } } while (0)
    LAYER_PHASES(0);
    LAYER_PHASES(1);
#undef LAYER_PHASES
    if (EN_PF && IN(PH_FINAL)) phase_norm1<2>(lds, 0);
#undef IN
#undef SEAM
}

extern "C" void kernel_launch(void* const* d_in, const int* in_sizes, int n_in, void* d_out, int out_size, void* d_ws, size_t ws_size, hipStream_t stream) {
    static int grid = 0;
    if (grid == 0) {
        if (n_in != 23 || out_size != MTOK * D || ws_size < WS_END) { fprintf(stderr, "kernel_launch: unexpected shapes (n_in %d out %d ws %zu)\n", n_in, out_size, ws_size); grid = -1; return; }
        int dev = 0, cus = 0;
        if (hipGetDevice(&dev) != hipSuccess || hipDeviceGetAttribute(&cus, hipDeviceAttributeMultiprocessorCount, dev) != hipSuccess) { grid = -1; return; }
        if (hipFuncSetAttribute((const void*)fwd, hipFuncAttributeMaxDynamicSharedMemorySize, LDS_BYTES) != hipSuccess) { fprintf(stderr, "kernel_launch: hipFuncSetAttribute failed\n"); grid = -1; return; }
        int per_cu = 0;
        if (hipOccupancyMaxActiveBlocksPerMultiprocessor(&per_cu, (const void*)fwd, 512, LDS_BYTES) != hipSuccess || per_cu < 1) fprintf(stderr, "kernel_launch: occupancy query reports %d\n", per_cu);
        (void)hipGetLastError();
        grid = cus;
    }
    if (grid < 0) return;
    (void)hipMemsetAsync((char*)d_ws + WS_CTL, 0, CTL_ZERO_BYTES, stream);
    Args a{};
    for (int i = 0; i < 23; ++i) a.in[i] = (const float*)d_in[i];
    a.out = (float*)d_out; a.ws = (unsigned char*)d_ws;
    for (int j = 0; j < 32; ++j) a.inv_freq[j] = (float)std::pow(10000.0, -(double)j / 32.0);
#if MK_ONE_LAUNCH
    a.ph_lo = 0; a.ph_hi = N_PHASES;
    hipLaunchKernelGGL(fwd, dim3(grid), dim3(512), LDS_BYTES, stream, a);
#else
    for (int p = 0; p < N_PHASES; ++p) { a.ph_lo = p; a.ph_hi = p + 1; hipLaunchKernelGGL(fwd, dim3(grid), dim3(512), LDS_BYTES, stream, a); }
#endif
}
```

```cpp
#include <hip/hip_runtime.h>
#include <cstdio>
#include <cstdint>
#include <cmath>

#define GAS __attribute__((address_space(1)))
#define LAS __attribute__((address_space(3)))
typedef unsigned short bf16;
typedef short bf16x8 __attribute__((ext_vector_type(8)));
typedef float f32x4 __attribute__((ext_vector_type(4)));
typedef float f32x2 __attribute__((ext_vector_type(2)));
typedef unsigned u32x4 __attribute__((ext_vector_type(4)));
typedef unsigned u32x2 __attribute__((ext_vector_type(2)));

#ifndef EN_P0
#define EN_P0 1
#endif
#ifndef EN_PA
#define EN_PA 1
#endif
#ifndef EN_PB
#define EN_PB 1
#endif
#ifndef EN_PC
#define EN_PC 1
#endif
#ifndef EN_PD
#define EN_PD 1
#endif
#ifndef EN_PE
#define EN_PE 1
#endif
#ifndef EN_PG
#define EN_PG 1
#endif
#ifndef EN_PH
#define EN_PH 1
#endif
#ifndef EN_PF
#define EN_PF 1
#endif
#ifndef PROBE_M
#define PROBE_M 0
#endif
#ifndef PROBE_M3
#define PROBE_M3 0
#endif
#ifndef PROBE_A
#define PROBE_A 0
#endif
#ifndef PROBE_PD
#define PROBE_PD 0
#endif
#ifndef PROBE_BAR
#define PROBE_BAR 0
#endif
#ifndef PROBE_E
#define PROBE_E 0
#endif
#ifndef PROBE_TA
#define PROBE_TA 0
#endif
#ifndef PROBE_B
#define PROBE_B 0
#endif
#ifndef PROBE_C
#define PROBE_C 0
#endif
#ifndef PROBE_D
#define PROBE_D 0
#endif
#ifndef MK_NAIVE_MIXER
#define MK_NAIVE_MIXER 0
#endif
#ifndef MK_ONE_LAUNCH
#define MK_ONE_LAUNCH 1
#endif

constexpr int NB = 8, SEQ = 4096, MTOK = NB * SEQ, D = 1024, DEPTH = 2;
constexpr int NPROJ = 4096;
constexpr int INP = 3856;
constexpr int C_RQ = 0, C_RK = 384, C_RV = 768, C_RG = 1152, C_HQ = 1536, C_HF = 1920, C_HI = 2304, C_HG = 2688, C_GQ = 3072, C_GK = 3200, C_GV = 3328, C_GG = 3584, C_GA = 3840;
constexpr int NEXP = 32, DEXP = 256;
constexpr int MAXROWS = 73728;
constexpr float EPS = 1e-6f;

constexpr size_t MiB = 1u << 20;
constexpr size_t WS_CTL = 0, CTL_ZERO_BYTES = 1 * MiB;
constexpr size_t WS_MOD = 1 * MiB;
constexpr size_t WS_ROPE = 2 * MiB;
constexpr size_t WS_WIN = 10 * MiB;
constexpr size_t WS_WOUT = 26 * MiB;
constexpr size_t WS_WGU = 30 * MiB;
constexpr size_t WS_WD = 94 * MiB;
constexpr size_t WS_H = 126 * MiB;
constexpr size_t WS_PROJ = 190 * MiB;
constexpr size_t WS_HID = 190 * MiB;
constexpr size_t WS_YP = 226 * MiB;
constexpr size_t WS_XB = 370 * MiB;
constexpr size_t WS_STATE = 446 * MiB;
constexpr size_t WS_ROUTE = 474 * MiB;
constexpr size_t WS_IDX2 = 476 * MiB;
constexpr size_t WS_END = 480 * MiB;
constexpr int CW_CNT = 64;
constexpr int CW_BAR = 4096;
constexpr int CW_TMO = 8;
constexpr int CW_MOE = 16384, CW_MOE_LAYER = 32768;

constexpr int RING_BYTES = 131072;
constexpr int LDSCTL_OFF = 147456 - 1024;
constexpr int TP_OFF = LDSCTL_OFF + 512;
constexpr int AUX_OFF = 136 * 1024;
constexpr int LDS_BYTES = 147456;

#define RLX_AGENT __ATOMIC_RELAXED, __HIP_MEMORY_SCOPE_AGENT
#define LDS_WAIT() asm volatile("s_waitcnt lgkmcnt(0)" ::: "memory")
#define VM_WAIT() asm volatile("s_waitcnt vmcnt(0)" ::: "memory")

__device__ __forceinline__ unsigned f2bf(float f) { unsigned u = __builtin_bit_cast(unsigned, f); return (u + 0x7fffu + ((u >> 16) & 1u)) >> 16; }
__device__ __forceinline__ unsigned pk2(float lo, float hi) { return f2bf(lo) | (f2bf(hi) << 16); }
__device__ __forceinline__ float bf2f(unsigned short b) { return __builtin_bit_cast(float, ((unsigned)b) << 16); }
__device__ __forceinline__ float bflo(unsigned w) { return __builtin_bit_cast(float, w << 16); }
__device__ __forceinline__ float bfhi(unsigned w) { return __builtin_bit_cast(float, w & 0xffff0000u); }
constexpr float LOG2E = 1.4426950408889634f;
__device__ __forceinline__ float fexp2(float x) { return __builtin_amdgcn_exp2f(x); }
__device__ __forceinline__ float flog2(float x) { return __builtin_amdgcn_logf(x); }
__device__ __forceinline__ float frcp(float x) { return __builtin_amdgcn_rcpf(x); }
__device__ __forceinline__ float sigmoidf_(float x) { return frcp(1.0f + fexp2(-LOG2E * x)); }
__device__ __forceinline__ float siluf_(float x) { return x * frcp(1.0f + fexp2(-LOG2E * x)); }
template <int CTRL, int RMASK, bool BC> __device__ __forceinline__ float dpp_f(float v) {
    return __builtin_bit_cast(float, __builtin_amdgcn_update_dpp(0, __builtin_bit_cast(int, v), CTRL, RMASK, 0xf, BC)); }
__device__ __forceinline__ float rdlane(float v, int l) { return __builtin_bit_cast(float, __builtin_amdgcn_readlane(__builtin_bit_cast(int, v), l)); }
__device__ __forceinline__ float wave_sum(float v) {
    v += dpp_f<0x128, 0xf, false>(v); v += dpp_f<0x124, 0xf, false>(v); v += dpp_f<0x122, 0xf, false>(v); v += dpp_f<0x121, 0xf, false>(v);
    v += dpp_f<0x142, 0xa, false>(v); v += dpp_f<0x143, 0xc, false>(v);
    return rdlane(v, 63);
}
#define SCAN_STEP_(ctrl) "v_add_f32_dpp %0, %0, %0 " ctrl "\n\tv_add_f32_dpp %1, %1, %1 " ctrl "\n\tv_add_f32_dpp %2, %2, %2 " ctrl "\n\tv_add_f32_dpp %3, %3, %3 " ctrl "\n\t"
__device__ __forceinline__ void wave_incl_scan4(float& a, float& b, float& c, float& d) {
    asm volatile("s_nop 1\n\t"
        SCAN_STEP_("row_shr:1 row_mask:0xf bank_mask:0xf bound_ctrl:1") SCAN_STEP_("row_shr:2 row_mask:0xf bank_mask:0xf bound_ctrl:1")
        SCAN_STEP_("row_shr:4 row_mask:0xf bank_mask:0xf bound_ctrl:1") SCAN_STEP_("row_shr:8 row_mask:0xf bank_mask:0xf bound_ctrl:1")
        SCAN_STEP_("row_bcast:15 row_mask:0xa bank_mask:0xf") SCAN_STEP_("row_bcast:31 row_mask:0xc bank_mask:0xf")
        "s_nop 1" : "+v"(a), "+v"(b), "+v"(c), "+v"(d));
}
#define XB_TMO      128
#define XB_XCNT(j)  (256  + 64 * (j))
#define XB_XSUB(j)  (1280 + 64 * (j))
#define XB_XGEN(j)  (2304 + 64 * (j))
#define XB_TOP      3328
#define XB_TOPGEN   3392
#define XCD_BAR_WORDS 3456
#define XB_SPIN_CAP (1u << 18)
__device__ __forceinline__ unsigned xb_ld(unsigned* p)              { return __hip_atomic_load(p, __ATOMIC_RELAXED, __HIP_MEMORY_SCOPE_AGENT); }
__device__ __forceinline__ unsigned xb_add(unsigned* p, unsigned v) { return __hip_atomic_fetch_add(p, v, __ATOMIC_RELAXED, __HIP_MEMORY_SCOPE_AGENT); }
__device__ __forceinline__ unsigned xb_xcc_id() { return (unsigned)__builtin_amdgcn_s_getreg((3 << 11) | 20) & 0xFu; }
#define XB_SPIN(cond, bar) do { unsigned _sp = 0; while (cond) { __builtin_amdgcn_s_sleep(1); \
    if ((++_sp & 255u) == 0u) { if (xb_ld(&(bar)[XB_TMO])) break; if (_sp > XB_SPIN_CAP) { atomicAdd(&(bar)[XB_TMO], 1u); break; } } } } while (0)
struct XcdBarrier { unsigned* bar; unsigned x; volatile LAS unsigned* st; };
__device__ __forceinline__ XcdBarrier xcd_barrier_post(unsigned* bar, volatile LAS unsigned* st) {
    XcdBarrier b; b.bar = bar; b.x = xb_xcc_id(); b.st = st;
    if (threadIdx.x == 0) (void)xb_add(&bar[XB_XCNT(b.x)], 1u);
    return b;
}
__device__ __forceinline__ void xcd_barrier_complete(unsigned* bar, unsigned x, unsigned& nloc, unsigned& nx) {
    const unsigned G = gridDim.x * gridDim.y * gridDim.z;
    unsigned sum, cnt, mine, sp = 0u;
    for (;;) {
        sum = 0u; cnt = 0u; mine = 0u;
#pragma unroll
        for (unsigned j = 0; j < 16; ++j) { const unsigned c = xb_ld(&bar[XB_XCNT(j)]); sum += c; cnt += (c > 0u) ? 1u : 0u; mine = (j == x) ? c : mine; }
        if (sum == G) break;
        __builtin_amdgcn_s_sleep(1);
        if ((++sp & 255u) == 0u) { if (xb_ld(&bar[XB_TMO])) break; if (sp > XB_SPIN_CAP) { atomicAdd(&bar[XB_TMO], 1u); break; } }
    }
    nloc = mine > 0u ? mine : 1u; nx = cnt > 0u ? cnt : 1u;
}
__device__ __forceinline__ void xcd_barrier(const XcdBarrier& b) {
    asm volatile("s_waitcnt vmcnt(0)" ::: "memory");
    __syncthreads();
    if (threadIdx.x == 0) {
        unsigned* bar = b.bar;
        __builtin_amdgcn_s_waitcnt(0);
        unsigned nloc = b.st[0], nx = b.st[1];
        if (nloc == 0u) { xcd_barrier_complete(bar, b.x, nloc, nx); b.st[0] = nloc; b.st[1] = nx; }
        const unsigned old = xb_add(&bar[XB_XSUB(b.x)], 1u);
        const unsigned gen = old / nloc;
        if (old + 1u == (gen + 1u) * nloc) {
            __builtin_amdgcn_fence(__ATOMIC_RELEASE, "agent");
            asm volatile("s_waitcnt vmcnt(0)" ::: "memory");
            const unsigned og = xb_add(&bar[XB_TOP], 1u);
            const unsigned tg = og / nx;
            if (og + 1u == (tg + 1u) * nx) xb_add(&bar[XB_TOPGEN], 1u);
            else XB_SPIN(xb_ld(&bar[XB_TOPGEN]) == tg, bar);
            __builtin_amdgcn_fence(__ATOMIC_ACQUIRE, "agent");
            xb_add(&bar[XB_XGEN(b.x)], 1u);
            asm volatile("s_waitcnt vmcnt(0)" ::: "memory");
        } else {
            XB_SPIN(xb_ld(&bar[XB_XGEN(b.x)]) == gen, bar);
            __builtin_amdgcn_fence(__ATOMIC_ACQUIRE, "agent");
            asm volatile("s_waitcnt vmcnt(0)" ::: "memory");
        }
    }
    __syncthreads();
}

namespace pg8 {
constexpr int BM = 256, BK = 64, HALF = 128, HTB = HALF * BK * 2, STAGE_BYTES = 8 * HTB, NXCD = 8, WGM = 8;
__host__ __device__ __forceinline__ int lds_byte(int r, int c) { const int st = (r >> 4) * 2 + (c >> 5), rr = r & 15, cc = c & 31, ob = rr * 64 + cc * 2; return st * 1024 + (ob ^ (((ob >> 9) & 1) << 5)); }
__host__ __device__ __forceinline__ void stage_rc(int b, int& R, int& C) { const int st = b / 1024, sb = b % 1024, swz = sb ^ (((sb >> 9) & 1) << 5); R = (st >> 1) * 16 + swz / 64; C = (st & 1) * 32 + (swz % 64) / 2; }
__host__ __device__ __forceinline__ int perm32(int rho) { const int n = rho >> 4, i = rho & 15; return 8 * (i >> 2) + 4 * n + (i & 3); }
struct Unit { int pm, pn, pc; };
struct Gemm { const bf16* A; const bf16* Bt; int K; };

struct StaticOrder {
    int nM, nN, nwg, G, c;
    __device__ void init(int M, int N, int G_, int c_) { nM = M / BM; nN = N / BM; nwg = nM * nN; G = G_; c = c_; }
    __device__ bool next(int i, Unit& u) const {
        const long L = (long)i * G + c; if (L >= nwg) return false;
        int wgid = (int)L; { const int q = nwg / NXCD, r = nwg % NXCD, xcd = wgid % NXCD, off = wgid / NXCD; wgid = (xcd < r ? xcd * (q + 1) : r * (q + 1) + (xcd - r) * q) + off; }
        const int nig = WGM * nN, gid = wgid / nig, fm = gid * WGM, gsz = (nM - fm) < WGM ? (nM - fm) : WGM;
        u.pm = fm + ((wgid % nig) % gsz); u.pn = (wgid % nig) / gsz; u.pc = u.pn; return true;
    }
};
struct MoeOrder {
    int G, c, npt, total; const LAS int* tp;
    __device__ bool next(int i, Unit& u) const {
        const int L = i * G + c; if (L >= total) return false;
        const int mt = L / npt, nl = L % npt; int e = 0;
        while (e < 31 && tp[e + 1] <= mt) ++e;
        u.pm = mt; u.pn = e * npt + nl; u.pc = nl; return true;
    }
};

struct MoeDownOrder {
    int G, c, H, L, dh, dl, nD, j0, lo, hi; const LAS int* tp;
    __device__ void init(int G_, int c_, int T, const LAS int* tp_) { G = G_; c = c_; tp = tp_; j0 = 0; lo = 0;
        const int nU = 2 * T; nD = 4 * T; hi = nD; H = nU % G; L = G - H; dh = (nD - 3 * L + G - 1) / G; if (dh < 0) dh = 0; dl = dh + 3; }
    __device__ int unit_index(int j) const {
        const int quota = (c < H) ? dh : dl; if (j >= quota) return -1;
        const int idx = (j < dh) ? j * G + c : dh * G + (j - dh) * L + (c - H); return idx < nD ? idx : -1; }
    __device__ bool next(int i, Unit& u) const {
        const int idx = unit_index(j0 + i); if (idx < lo || idx >= hi) return false;
        const int mt = idx >> 2, nl = idx & 3; int e = 0;
        while (e < 31 && tp[e + 1] <= mt) ++e;
        u.pm = mt; u.pn = e * 4 + nl; u.pc = nl; return true;
    }
    __device__ __forceinline__ void wait(unsigned* cnt, unsigned* tmo) const {
        if (__builtin_amdgcn_readfirstlane(threadIdx.x >> 6) == 0) {
            for (int i = 0; i < 16; ++i) { const int idx = unit_index(j0 + i); if (idx < lo || idx >= hi) break;
                GAS unsigned* p = (GAS unsigned*)cnt + 64 * (idx >> 2); unsigned n = 0;
                while ((unsigned)__builtin_amdgcn_readfirstlane(__hip_atomic_load(p, __ATOMIC_RELAXED, __HIP_MEMORY_SCOPE_AGENT)) < 16u) {
                    __builtin_amdgcn_s_sleep(2);
                    if (++n > (1u << 20)) { __hip_atomic_store((GAS unsigned*)tmo, 1u, __ATOMIC_RELAXED, __HIP_MEMORY_SCOPE_AGENT); break; } } }
            __builtin_amdgcn_fence(__ATOMIC_ACQUIRE, "agent");
            asm volatile("s_waitcnt vmcnt(0)" ::: "memory");
        }
        __syncthreads();
    }
};

__device__ __forceinline__ unsigned cvt_pk_bf16(float lo, float hi) { unsigned r; asm volatile("v_cvt_pk_bf16_f32 %0, %1, %2" : "=v"(r) : "v"(lo), "v"(hi)); return r; }

template <bool NT> struct EpiBf16StoreT {
    static constexpr bool PERM = true;
    bf16* O; int ldc;
    __device__ __forceinline__ void operator()(const f32x4 (&acc)[2][2][4][2], const Unit& u, int wr, int wc, int fr, int fq) const {
        const int row0 = u.pm * BM + wr * 64 + fr, col0 = u.pc * BM + wc * 32 + 8 * fq;
#pragma unroll
        for (int ai = 0; ai < 2; ++ai)
#pragma unroll
            for (int m = 0; m < 4; ++m) { bf16* rowp = O + (size_t)(row0 + ai * HALF + m * 16) * ldc + col0;
#pragma unroll
                for (int bj = 0; bj < 2; ++bj) { const f32x4 v0 = acc[ai][bj][m][0], v1 = acc[ai][bj][m][1];
                    u32x4 w; w.x = cvt_pk_bf16(v0[0], v0[1]); w.y = cvt_pk_bf16(v0[2], v0[3]); w.z = cvt_pk_bf16(v1[0], v1[1]); w.w = cvt_pk_bf16(v1[2], v1[3]);
                    if constexpr (NT) __builtin_nontemporal_store(w, (u32x4*)(rowp + bj * HALF)); else *(u32x4*)(rowp + bj * HALF) = w; } }
    }
};
typedef EpiBf16StoreT<false> EpiBf16Store;
struct EpiSwiGLU {
    static constexpr bool PERM = true;
    bf16* O; unsigned* cnt;
    __device__ __forceinline__ void operator()(const f32x4 (&acc)[2][2][4][2], const Unit& u, int wr, int wc, int fr, int fq) const {
        const int row0 = u.pm * BM + wr * 64 + fr, col0 = u.pc * HALF + wc * 32 + 8 * fq;
#pragma unroll
        for (int ai = 0; ai < 2; ++ai)
#pragma unroll
            for (int m = 0; m < 4; ++m) { bf16* rowp = O + (size_t)(row0 + ai * HALF + m * 16) * DEXP + col0;
                float h[8];
#pragma unroll
                for (int n = 0; n < 2; ++n)
#pragma unroll
                    for (int j = 0; j < 4; ++j) { const float g = acc[ai][0][m][n][j], up = acc[ai][1][m][n][j]; h[n * 4 + j] = g * __builtin_amdgcn_rcpf(1.0f + __builtin_amdgcn_exp2f(-1.4426950408889634f * g)) * up; }
                const unsigned long long w0 = (unsigned long long)cvt_pk_bf16(h[0], h[1]) | ((unsigned long long)cvt_pk_bf16(h[2], h[3]) << 32), w1 = (unsigned long long)cvt_pk_bf16(h[4], h[5]) | ((unsigned long long)cvt_pk_bf16(h[6], h[7]) << 32);
                GAS unsigned long long* gp = (GAS unsigned long long*)rowp;
                __hip_atomic_store(gp, w0, __ATOMIC_RELAXED, __HIP_MEMORY_SCOPE_AGENT);
                __hip_atomic_store(gp + 1, w1, __ATOMIC_RELAXED, __HIP_MEMORY_SCOPE_AGENT); }
        asm volatile("s_waitcnt vmcnt(0)" ::: "memory");
        if ((threadIdx.x & 63) == 0) __hip_atomic_fetch_add((GAS unsigned*)cnt + 64 * u.pm, 1u, __ATOMIC_RELAXED, __HIP_MEMORY_SCOPE_AGENT);
    }
};
template <bool RES_BF16> struct EpiResGateB {
    static constexpr bool PERM = true;
    const void* res; bf16* out; const float* gate;
    __device__ __forceinline__ void operator()(const f32x4 (&acc)[2][2][4][2], const Unit& u, int wr, int wc, int fr, int fq) const {
        const int row0 = u.pm * BM + wr * 64 + fr, col0 = u.pc * BM + wc * 32 + 8 * fq;
        const float* gb = gate + (size_t)(u.pm >> 4) * 6144;
        f32x4 gv[2][2];
#pragma unroll
        for (int bj = 0; bj < 2; ++bj)
#pragma unroll
            for (int n = 0; n < 2; ++n) gv[bj][n] = *(const f32x4*)(gb + col0 + bj * HALF + n * 4);
#pragma unroll
        for (int ai = 0; ai < 2; ++ai)
#pragma unroll
            for (int m = 0; m < 4; ++m) { const size_t off = (size_t)(row0 + ai * HALF + m * 16) * D + col0;
#pragma unroll
                for (int bj = 0; bj < 2; ++bj) { f32x4 r0, r1;
                    if constexpr (RES_BF16) { const u32x4 rr = *(const u32x4*)((const bf16*)res + off + bj * HALF);
                        r0 = (f32x4){bflo(rr.x), bfhi(rr.x), bflo(rr.y), bfhi(rr.y)}; r1 = (f32x4){bflo(rr.z), bfhi(rr.z), bflo(rr.w), bfhi(rr.w)}; }
                    else { r0 = *(const f32x4*)((const float*)res + off + bj * HALF); r1 = *(const f32x4*)((const float*)res + off + bj * HALF + 4); }
                    const f32x4 v0 = r0 + gv[bj][0] * acc[ai][bj][m][0], v1 = r1 + gv[bj][1] * acc[ai][bj][m][1];
                    u32x4 w; w.x = cvt_pk_bf16(v0[0], v0[1]); w.y = cvt_pk_bf16(v0[2], v0[3]); w.z = cvt_pk_bf16(v1[0], v1[1]); w.w = cvt_pk_bf16(v1[2], v1[3]);
                    *(u32x4*)(out + off + bj * HALF) = w; } }
    }
};
struct EpiResGate {
    static constexpr bool PERM = false;
    const float* res; float* out; const float* gate;
    __device__ __forceinline__ void operator()(const f32x4 (&acc)[2][2][4][2], const Unit& u, int wr, int wc, int fr, int fq) const {
        const int row0 = u.pm * BM + wr * 64 + fr, col0 = u.pc * BM + wc * 32 + 4 * fq;
        const float* gb = gate + (size_t)(u.pm >> 4) * 6144;
        f32x4 gv[2][2];
#pragma unroll
        for (int bj = 0; bj < 2; ++bj)
#pragma unroll
            for (int n = 0; n < 2; ++n) gv[bj][n] = *(const f32x4*)(gb + col0 + bj * HALF + n * 16);
#pragma unroll
        for (int ai = 0; ai < 2; ++ai)
#pragma unroll
            for (int m = 0; m < 4; ++m) { const size_t off = (size_t)(row0 + ai * HALF + m * 16) * D + col0;
#pragma unroll
                for (int bj = 0; bj < 2; ++bj)
#pragma unroll
                    for (int n = 0; n < 2; ++n) { const f32x4 r = *(const f32x4*)(res + off + bj * HALF + n * 16); *(f32x4*)(out + off + bj * HALF + n * 16) = r + gv[bj][n] * acc[ai][bj][m][n]; } }
    }
};

template <class Epi, class Sched, bool GATHER>
__device__ __forceinline__ void gemm_phase(LAS unsigned char* lds, const Gemm g, const Sched& S, const Epi& E, const LAS int* gidx) {
    const int tid = threadIdx.x, wid = __builtin_amdgcn_readfirstlane(tid >> 6), lane = tid & 63, wr = wid >> 2, wc = wid & 3, fr = lane & 15, fq = lane >> 4;
    const int K = g.K, nt = K / BK;
    unsigned voffA[2], voffB[2];
#pragma unroll
    for (int i = 0; i < 2; ++i) { int R, C; stage_rc(tid * 16 + i * 8192, R, C); const int Rb = Epi::PERM ? ((R & ~31) + perm32(R & 31)) : R;
        voffA[i] = (unsigned)(R * K + C) * 2u; voffB[i] = (unsigned)(Rb * K + C) * 2u; }
    const size_t kstep = (size_t)(BK * 2);
    const size_t hstep = (size_t)HALF * K * 2;
    const size_t tstep = 2 * hstep;
    const unsigned ldsw = (unsigned)wid * 1024u;
    const int aoff = lds_byte(wr * 64 + fr, fq * 8), boff = lds_byte(wc * 32 + fr, fq * 8);
    int nslot = 0;
#define PG8_SA(b, h) (((b) * 2 + (h)) * HTB)
#define PG8_SB(b, h) ((4 + (b) * 2 + (h)) * HTB)
#define PG8_GLDS(gp, lp) __builtin_amdgcn_global_load_lds((const unsigned*)(gp), (LAS unsigned*)(lp), 16, 0, 0)
#define PG8_STAGE(bufoff, gbase, voff) do { _Pragma("unroll") for (int _i = 0; _i < 2; ++_i) PG8_GLDS((const char*)(gbase) + (voff)[_i], lds + (bufoff) + ldsw + _i * 8192); } while (0)
#define PG8_STAGE_A(bufoff, gptr, h, nx) do { if constexpr (GATHER) { const int _slot = (nx) ? nslot : ui; _Pragma("unroll") for (int _i = 0; _i < 2; ++_i) { int _R, _C; stage_rc(tid * 16 + _i * 8192, _R, _C); \
            const unsigned _vo = (unsigned)gidx[_slot * 256 + (h) * HALF + _R] + (unsigned)_C * 2u; PG8_GLDS((const char*)(gptr) + _vo, lds + (bufoff) + ldsw + _i * 8192); } } \
        else { PG8_STAGE(bufoff, (const char*)(gptr) + (h) * hstep, voffA); } } while (0)
#define PG8_LDA(dst, b, h) do { _Pragma("unroll") for (int m = 0; m < 4; ++m) _Pragma("unroll") for (int k = 0; k < 2; ++k) dst[m][k] = *(const LAS bf16x8*)(lds + PG8_SA(b, h) + aoff + m * 2048 + k * 1024); } while (0)
#define PG8_LDB(dst, b, h) do { _Pragma("unroll") for (int n = 0; n < 2; ++n) _Pragma("unroll") for (int k = 0; k < 2; ++k) dst[n][k] = *(const LAS bf16x8*)(lds + PG8_SB(b, h) + boff + n * 2048 + k * 1024); } while (0)
#define PG8_MMA(ai, bj, At, Bt) do { __builtin_amdgcn_s_setprio(1); _Pragma("unroll") for (int m = 0; m < 4; ++m) _Pragma("unroll") for (int n = 0; n < 2; ++n) _Pragma("unroll") for (int k = 0; k < 2; ++k) \
        acc[ai][bj][m][n] = __builtin_amdgcn_mfma_f32_16x16x32_bf16(Bt[n][k], At[m][k], acc[ai][bj][m][n], 0, 0, 0); __builtin_amdgcn_s_setprio(0); } while (0)
#define PG8_WAIT_V(n) asm volatile("s_waitcnt vmcnt(" #n ")" ::: "memory")
#define PG8_WAIT_L(n) asm volatile("s_waitcnt lgkmcnt(" #n ")" ::: "memory")
#define PG8_BAR __builtin_amdgcn_s_barrier()
#define PG8_SCHED __builtin_amdgcn_sched_barrier(0)
    Unit cur, nxt; int ui = 0;
    if (!S.next(0, cur)) return;
    f32x4 acc[2][2][4][2];
#pragma unroll
    for (int a = 0; a < 2; ++a)
#pragma unroll
        for (int b = 0; b < 2; ++b)
#pragma unroll
            for (int m = 0; m < 4; ++m)
#pragma unroll
                for (int n = 0; n < 2; ++n) acc[a][b][m][n] = (f32x4){0.f, 0.f, 0.f, 0.f};
    bf16x8 At[4][2], B0[2][2], B1[2][2];
    const char* cA = (const char*)g.A + (GATHER ? (size_t)0 : (size_t)cur.pm * tstep); const char* cB = (const char*)g.Bt + (size_t)cur.pn * tstep;
    PG8_STAGE(PG8_SB(0, 0), cB, voffB); PG8_STAGE(PG8_SB(0, 1), cB + hstep, voffB); PG8_STAGE_A(PG8_SA(0, 0), cA, 0, false); PG8_STAGE_A(PG8_SA(0, 1), cA, 1, false);
    if (wr == 1) PG8_BAR;
    PG8_WAIT_V(2); PG8_BAR;
    PG8_STAGE(PG8_SB(1, 0), cB + kstep, voffB); PG8_STAGE_A(PG8_SA(1, 0), cA + kstep, 0, false); PG8_STAGE(PG8_SB(1, 1), cB + hstep + kstep, voffB);
    PG8_WAIT_V(6); PG8_BAR;
    for (;;) {
        const bool has_next = S.next(ui + 1, nxt);
        const char* nA = has_next ? (const char*)g.A + (GATHER ? (size_t)0 : (size_t)nxt.pm * tstep) : cA; const char* nB = has_next ? (const char*)g.Bt + (size_t)nxt.pn * tstep : cB;
        if constexpr (GATHER) nslot = has_next ? ui + 1 : ui;
        for (int t = 0; t < nt; t += 2) {
            const bool last = (t == nt - 2);
            const char* a1 = cA + (size_t)(t + 1) * kstep;
            const char* a2 = last ? nA : cA + (size_t)(t + 2) * kstep; const char* b2 = last ? nB : cB + (size_t)(t + 2) * kstep;
            const char* a3 = a2 + kstep; const char* b3 = b2 + kstep;
            PG8_LDB(B0, 0, 0); PG8_LDB(B1, 0, 1); PG8_SCHED; PG8_LDA(At, 0, 0); PG8_STAGE_A(PG8_SA(1, 1), a1, 1, false);
            PG8_WAIT_V(8); PG8_WAIT_L(0); PG8_BAR; PG8_MMA(0, 0, At, B0); PG8_MMA(0, 1, At, B1); PG8_BAR; PG8_SCHED;
            PG8_LDA(At, 0, 1); PG8_STAGE(PG8_SB(0, 0), b2, voffB); PG8_STAGE(PG8_SB(0, 1), b2 + hstep, voffB); PG8_STAGE_A(PG8_SA(0, 0), a2, 0, last);
            PG8_WAIT_V(8); PG8_WAIT_L(0); PG8_BAR; PG8_MMA(1, 0, At, B0); PG8_MMA(1, 1, At, B1); PG8_BAR; PG8_SCHED;
            PG8_LDB(B0, 1, 0); PG8_LDB(B1, 1, 1); PG8_SCHED; PG8_LDA(At, 1, 0); PG8_STAGE_A(PG8_SA(0, 1), a2, 1, last);
            PG8_WAIT_V(8); PG8_WAIT_L(0); PG8_BAR; PG8_MMA(0, 0, At, B0); PG8_MMA(0, 1, At, B1); PG8_BAR; PG8_SCHED;
            PG8_LDA(At, 1, 1); PG8_STAGE(PG8_SB(1, 0), b3, voffB); PG8_STAGE(PG8_SB(1, 1), b3 + hstep, voffB); PG8_STAGE_A(PG8_SA(1, 0), a3, 0, last);
            PG8_WAIT_V(8); PG8_WAIT_L(0); PG8_BAR; PG8_MMA(1, 0, At, B0); PG8_MMA(1, 1, At, B1); PG8_BAR; PG8_SCHED;
        }
        if (wr == 0) PG8_BAR;
        E(acc, cur, wr, wc, fr, fq);
        if (!has_next) break;
#pragma unroll
        for (int a = 0; a < 2; ++a)
#pragma unroll
            for (int b = 0; b < 2; ++b)
#pragma unroll
                for (int m = 0; m < 4; ++m)
#pragma unroll
                    for (int n = 0; n < 2; ++n) acc[a][b][m][n] = (f32x4){0.f, 0.f, 0.f, 0.f};
        cur = nxt; cA = nA; cB = nB; ++ui;
        if (wr == 1) PG8_BAR;
    }
    PG8_WAIT_V(0);
    PG8_BAR;
#undef PG8_SA
#undef PG8_SB
#undef PG8_GLDS
#undef PG8_STAGE
#undef PG8_STAGE_A
#undef PG8_LDA
#undef PG8_LDB
#undef PG8_MMA
#undef PG8_WAIT_V
#undef PG8_WAIT_L
#undef PG8_BAR
#undef PG8_SCHED
}
}

struct Args { const float* in[23]; float* out; unsigned char* ws; float inv_freq[32]; int ph_lo, ph_hi; };
enum { I_X = 0, I_C, I_POS, I_WADA, I_BADA, I_NMIX, I_NFFN, I_WIN, I_RETN, I_HGRNN, I_LBL, I_WA2, I_BA, I_GLAN, I_WOUT, I_RGW, I_RGB, I_REW, I_REB, I_EG, I_EU, I_ED, I_NFIN };
constexpr int PH_PER_LAYER = 8, PH_FINAL = 1 + 2 * PH_PER_LAYER, N_PHASES = PH_FINAL + 1;

typedef const __attribute__((address_space(4))) Args KArgs;
#define KARGS(ap) KArgs* ap = (KArgs*)__builtin_amdgcn_kernarg_segment_ptr(); asm volatile("" : "+s"(ap))
#define PHASE_IDS() int tid = threadIdx.x; asm volatile("" : "+v"(tid)); const int lane = tid & 63, wave = __builtin_amdgcn_readfirstlane(tid >> 6); \
    const int G = gridDim.x, bid = blockIdx.x, gw = bid * 8 + wave, NGW = G * 8; (void)lane; (void)wave; (void)gw; (void)NGW; (void)G; (void)bid

__device__ __forceinline__ void transpose_item(const float* W, int ldw, int K, int k0, int n0, bf16* WT, int dst_row0, LAS float* scr, int lane) {
#pragma unroll 8
    for (int i = 0; i < 32; ++i) { const int kk = 2 * i + (lane >> 5); scr[kk * 33 + (lane & 31)] = W[(size_t)(k0 + kk) * ldw + n0 + (lane & 31)]; }
    LDS_WAIT(); asm volatile("" ::: "memory");
    const int c = lane & 7;
#pragma unroll
    for (int j = 0; j < 4; ++j) { const int n = (lane >> 3) + 8 * j; const LAS float* s = scr + (8 * c) * 33 + n;
        u32x4 o; o.x = pk2(s[0 * 33], s[1 * 33]); o.y = pk2(s[2 * 33], s[3 * 33]); o.z = pk2(s[4 * 33], s[5 * 33]); o.w = pk2(s[6 * 33], s[7 * 33]);
        *(u32x4*)(WT + (size_t)(dst_row0 + n) * K + k0 + 8 * c) = o; }
    LDS_WAIT(); asm volatile("" ::: "memory");
}
__device__ __forceinline__ void transpose_item64(const float* W, int ldw, int K, int k0, int n0, bf16* WT, int dst_row0, LAS float* scr, int lane) {
    const int lr = lane >> 4, lc = (lane & 15) * 4;
    f32x4 v[16];
#pragma unroll
    for (int i = 0; i < 16; ++i) v[i] = *(const f32x4*)(W + (size_t)(k0 + 4 * i + lr) * ldw + n0 + lc);
#pragma unroll
    for (int i = 0; i < 16; ++i) { LAS float* d = scr + (4 * i + lr) * 65 + lc; d[0] = v[i][0]; d[1] = v[i][1]; d[2] = v[i][2]; d[3] = v[i][3]; }
    LDS_WAIT(); asm volatile("" ::: "memory");
    const int c = lane & 7;
#pragma unroll
    for (int j = 0; j < 8; ++j) { const int n = (lane >> 3) + 8 * j; const LAS float* sp = scr + (8 * c) * 65 + n;
        u32x4 o; o.x = pk2(sp[0 * 65], sp[1 * 65]); o.y = pk2(sp[2 * 65], sp[3 * 65]); o.z = pk2(sp[4 * 65], sp[5 * 65]); o.w = pk2(sp[6 * 65], sp[7 * 65]);
        *(u32x4*)(WT + (size_t)(dst_row0 + n) * K + k0 + 8 * c) = o; }
    LDS_WAIT(); asm volatile("" ::: "memory");
}
__device__ __forceinline__ void convert_experts(LAS unsigned char* lds, KArgs* ap, int layer, int first, int stride, int wave, int lane) {
    unsigned char* ws = ap->ws;
    bf16* WGU_T = (bf16*)(ws + WS_WGU); bf16* WD_T = (bf16*)(ws + WS_WD);
    LAS float* scr = (LAS float*)(lds + wave * 16640);
    constexpr int I_G = 16 * 4, I_D = 4 * 16;
    for (int it = first; it < 32 * (2 * I_G + I_D); it += stride) {
        int r = it;
        if (r < 32 * I_G * 2) { const int up = r / (32 * I_G); r %= 32 * I_G; const int e = r / I_G; r %= I_G; const int kb = r / 4, nb = r % 4, n0 = nb * 64;
            transpose_item64(ap->in[up ? I_EU : I_EG] + ((size_t)layer * NEXP + e) * D * DEXP, DEXP, D, kb * 64, n0, WGU_T + ((size_t)layer * NEXP + e) * 512 * D, (n0 >> 7) * 256 + (n0 & 127) + up * 128, scr, lane); }
        else { r -= 32 * I_G * 2; const int e = r / I_D; r %= I_D; const int kb = r / 16, nb = r % 16;
            transpose_item64(ap->in[I_ED] + ((size_t)layer * NEXP + e) * DEXP * D, D, DEXP, kb * 64, nb * 64, WD_T + ((size_t)layer * NEXP + e) * D * DEXP, nb * 64, scr, lane); }
    }
}
__device__ __forceinline__ void sincos_acc(float a, float& s, float& c) {
    const double ad = (double)a; const double kd = rint(ad * 0.63661977236758134308); const double rd = fma(-kd, 1.57079632679489661923, ad);
    const int q = (int)kd & 3; const float r = (float)rd, r2 = r * r;
    const float sp = r + r * r2 * (-1.6666667163e-1f + r2 * (8.3333337680e-3f + r2 * (-1.9841270114e-4f + r2 * 2.7557314297e-6f)));
    const float cp = 1.0f + r2 * (-0.5f + r2 * (4.1666667908e-2f + r2 * (-1.3888889225e-3f + r2 * (2.4801587642e-5f + r2 * -2.7557314297e-7f))));
    const float ss = (q & 1) ? cp : sp, cc = (q & 1) ? sp : cp;
    s = (q & 2) ? -ss : ss; c = ((q + 1) & 2) ? -cc : cc;
}

template <int TYPE>
__device__ __forceinline__ void naive_mixer_item(LAS unsigned char* lds, KArgs* ap, int layer, int b, int hh  , int tid) {
    constexpr int DK = (TYPE == 2) ? 32 : 64, DKW = DK / 8;
    LAS float* Qs = (LAS float*)lds; LAS float* Ks = Qs + 4096; LAS float* As = Ks + 4096; LAS float* Vs = As + 4096; LAS float* Os = Vs + 4096; LAS float* Ps = Os + 4096;
    unsigned char* ws = ap->ws;
    const bf16* PROJ = (const bf16*)(ws + WS_PROJ); bf16* H = (bf16*)(ws + WS_H);
    const unsigned* ROPE = (const unsigned*)(ws + WS_ROPE);
    const float* lbl = ap->in[I_LBL]; const float* gba = ap->in[I_BA];
    const int e = tid & 63, w = tid >> 6;
    const int qc = (TYPE == 0 ? C_RQ + hh * 64 : TYPE == 1 ? C_HQ + hh * 64 : C_GQ + hh * 32);
    const int kc = (TYPE == 0 ? C_RK + hh * 64 : TYPE == 1 ? C_HF + hh * 64 : C_GK + hh * 32);
    const int vc = (TYPE == 0 ? C_RV : TYPE == 1 ? C_HI : C_GV) + hh * 64;
    const int gc = (TYPE == 0 ? C_RG : TYPE == 1 ? C_HG : C_GG) + hh * 64;
    const int mc = (TYPE == 0 ? 0 : TYPE == 1 ? 384 : 768) + hh * 64;
    const float* gain = ap->in[TYPE == 0 ? I_RETN : TYPE == 1 ? I_HGRNN : I_GLAN] + layer * (TYPE == 2 ? 256 : 384) + hh * 64;
    float S[DKW];
#pragma unroll
    for (int i = 0; i < DKW; ++i) S[i] = 0.f;
    for (int n = 0; n < 64; ++n) {
        __syncthreads();
        const size_t row0 = (size_t)b * SEQ + (size_t)n * 64;
        for (int idx = tid; idx < 4096; idx += 512) {
            const int t = idx >> 6, d = idx & 63; const bf16* p = PROJ + (row0 + t) * NPROJ;
            Vs[idx] = bf2f(p[vc + d]);
            if (TYPE == 0) {
                const int j = d & 31; const unsigned csw = ROPE[(row0 + t) * 32 + j]; const f32x2 cs = (f32x2){bflo(csw), bfhi(csw)};
                const float q1 = bf2f(p[qc + j]), q2 = bf2f(p[qc + 32 + j]), k1 = bf2f(p[kc + j]), k2 = bf2f(p[kc + 32 + j]);
                Qs[idx] = d < 32 ? q1 * cs.x - q2 * cs.y : q1 * cs.y + q2 * cs.x;
                Ks[idx] = (d < 32 ? k1 * cs.x - k2 * cs.y : k1 * cs.y + k2 * cs.x) * 0.125f;
                As[idx] = 1.0f - exp2f(-5.0f - (float)hh);
            } else if (TYPE == 1) {
                const float l0 = lbl[hh * 64 + d], l1 = lbl[384 + hh * 64 + d]; const float mx = fmaxf(l0, l1), e0 = expf(l0 - mx), e1 = expf(l1 - mx);
                const float lb = layer == 0 ? 0.f : e1 / (e0 + e1);
                const float z = bf2f(p[kc + d]); const float f = lb + (1.0f - lb) * sigmoidf_(z);
                As[idx] = fmaxf(f, 1e-30f); Ks[idx] = (1.0f - lb) * sigmoidf_(-z); Qs[idx] = siluf_(bf2f(p[qc + d])) * 0.125f;
            } else {
                if (d < 32) { const float pre = bf2f(p[C_GA + hh * 32 + d]) + gba[layer * 128 + hh * 32 + d];
                    const float ls = fminf(pre, 0.f) - log1pf(expf(-fabsf(pre)));
                    As[t * 64 + d] = expf(ls * (1.0f / 16.0f)); Ks[t * 64 + d] = bf2f(p[kc + d]); Qs[t * 64 + d] = bf2f(p[qc + d]) * 0.17677669529663687f; }
            }
        }
        __syncthreads();
        for (int t0 = 0; t0 < 64; t0 += 16) {
            for (int tt = 0; tt < 16; ++tt) { const int t = t0 + tt; const float v = Vs[t * 64 + e]; float part = 0.f;
#pragma unroll
                for (int i = 0; i < DKW; ++i) { const int d = w * DKW + i; S[i] = As[t * 64 + d] * S[i] + Ks[t * 64 + d] * v; part += Qs[t * 64 + d] * S[i]; }
                Ps[(tt * 8 + w) * 64 + e] = part; }
            __syncthreads();
            for (int idx = tid; idx < 1024; idx += 512) { const int tt = idx >> 6, ee = idx & 63; float o = 0.f;
#pragma unroll
                for (int ww = 0; ww < 8; ++ww) o += Ps[(tt * 8 + ww) * 64 + ee];
                Os[(t0 + tt) * 64 + ee] = o; }
            __syncthreads();
        }
        for (int tt = 0; tt < 8; ++tt) { const int t = w * 8 + tt; const float o = Os[t * 64 + e]; const float ss = wave_sum(o * o); const float r = rsqrtf(ss * (1.0f / 64.0f) + EPS);
            const float g = bf2f(PROJ[(row0 + t) * NPROJ + gc + e]);
            H[(row0 + t) * D + mc + e] = (bf16)f2bf(o * r * gain[e] * siluf_(g)); }
    }
}

constexpr int MX_PITCH = 72;
constexpr int MX_ARR = 64 * MX_PITCH * 2;
constexpr int MX_GROUP_BYTES = 5 * MX_ARR + 5 * 256 + 256;
constexpr int NSC = 4, NCH = 64 / NSC;
constexpr int ST_REC = 4096 + 64;
__device__ __forceinline__ float bfx(const u32x4& r, int i) { const unsigned w = r[i >> 1]; return (i & 1) ? bfhi(w) : bflo(w); }
__device__ __forceinline__ unsigned short bfbits(const u32x4& r, int i) { const unsigned w = r[i >> 1]; return (unsigned short)((i & 1) ? (w >> 16) : (w & 0xffffu)); }

template <int TYPE, int MODE>
__device__ __forceinline__ void mixer_chunked(LAS unsigned char* lds, KArgs* ap, int layer, int b, int head  , int hh  , int sc, int tid) {
    constexpr int DK = (TYPE == 2) ? 32 : 64, NKS = DK / 32;
    constexpr bool FULL = (MODE == 1);
    const int lane = tid & 63, wv = __builtin_amdgcn_readfirstlane(tid >> 6), gid = wv >> 2, w = wv & 3, col = lane & 15, rg = lane >> 4;
    int gbo = gid * MX_GROUP_BYTES; asm volatile("" : "+v"(gbo));
    LAS unsigned char* gb = lds + gbo;
    LAS bf16* Qt = (LAS bf16*)gb; LAS bf16* Kt = Qt + 64 * MX_PITCH; LAS bf16* KT = Kt + 64 * MX_PITCH; LAS bf16* VT = KT + 64 * MX_PITCH; LAS bf16* ST = VT + 64 * MX_PITCH;
    LAS float* EM = (LAS float*)(gb + 5 * MX_ARR); LAS float* EL = EM + 64; LAS float* ELM = EL + 64; LAS float* LBt = ELM + 64; LAS float* OMLt = LBt + 64;
    unsigned char* ws = ap->ws;
    const bf16* PROJ = (const bf16*)(ws + WS_PROJ); bf16* H = (bf16*)(ws + WS_H);
    float* STATE = (float*)(ws + WS_STATE) + (size_t)((b * 16 + head) * NSC) * ST_REC;
    const int qc = (TYPE == 0 ? C_RQ + hh * 64 : TYPE == 1 ? C_HQ + hh * 64 : C_GQ + hh * 32);
    const int kc = (TYPE == 0 ? C_RK + hh * 64 : TYPE == 1 ? C_HF + hh * 64 : C_GK + hh * 32);
    const int vc = (TYPE == 0 ? C_RV : TYPE == 1 ? C_HI : C_GV) + hh * 64;
    const int gc = (TYPE == 0 ? C_RG : TYPE == 1 ? C_HG : C_GG) + hh * 64;
    const int mc = (TYPE == 0 ? 0 : TYPE == 1 ? 384 : 768) + hh * 64;
    const float lgam = (TYPE == 0) ? log1pf(-exp2f(-5.0f - (float)hh)) * LOG2E : 0.f;
    float gba[16];
    if constexpr (TYPE == 2) { int zl = 0; asm volatile("" : "+v"(zl)); const float* gbap = ap->in[I_BA] + layer * 128 + hh * 32 + 16 * (w & 1) + zl;
#pragma unroll
        for (int p = 0; p < 16; ++p) gba[p] = gbap[p]; }
    if constexpr (TYPE == 1) {
        if (w == 0) { const float* lbl = ap->in[I_LBL]; const float l0 = lbl[hh * 64 + lane], l1 = lbl[384 + hh * 64 + lane]; const float mx = fmaxf(l0, l1), e0 = expf(l0 - mx), e1 = expf(l1 - mx);
            const float lb = layer == 0 ? 0.f : e1 / (e0 + e1); LBt[lane] = lb; OMLt[lane] = 1.0f - lb; }
    }
    f32x4 gn4[4];
    if constexpr (FULL) { const float* gain = ap->in[TYPE == 0 ? I_RETN : TYPE == 1 ? I_HGRNN : I_GLAN] + layer * (TYPE == 2 ? 256 : 384) + hh * 64;
#pragma unroll
        for (int et = 0; et < 4; ++et) gn4[et] = *(const f32x4*)(gain + 16 * et + 4 * rg); }
    const bool owner = (w < DK / 16);
    f32x4 S[4];
    f32x4 Gacc = (f32x4){1.f, 1.f, 1.f, 1.f};
#pragma unroll
    for (int et = 0; et < 4; ++et) S[et] = (f32x4){0.f, 0.f, 0.f, 0.f};
    if constexpr (FULL) { if (owner) { for (int j = 0; j < sc; ++j) { const float* rec = STATE + (size_t)j * ST_REC; const f32x4 gj = *(const f32x4*)(rec + 4096 + 16 * w + 4 * rg);
#pragma unroll
                for (int et = 0; et < 4; ++et) { const f32x4 sj = *(const f32x4*)(rec + ((w * 4 + et) * 64 + lane) * 4); S[et] = gj * S[et] + sj; } } } }
    const size_t rowbase = (size_t)b * SEQ + (size_t)sc * NCH * 64;
    u32x4 rq[2], rk[2], rv[2], rr[2]; u32x4 dummy[6];
#define MX_LOAD_RAW(n) do { const bf16* p_ = PROJ + (rowbase + (size_t)(n) * 64 + lane) * NPROJ; \
        if constexpr (TYPE == 0) { rk[0] = *(const u32x4*)(p_ + kc + 8 * w); rk[1] = *(const u32x4*)(p_ + kc + 32 + 8 * w); \
            if constexpr (FULL) { rq[0] = *(const u32x4*)(p_ + qc + 8 * w); rq[1] = *(const u32x4*)(p_ + qc + 32 + 8 * w); } \
            const u32x4* rp_ = (const u32x4*)((const unsigned*)(ws + WS_ROPE) + (rowbase + (size_t)(n) * 64 + lane) * 32 + 8 * w); rr[0] = rp_[0]; rr[1] = rp_[1]; } \
        else if constexpr (TYPE == 1) { rk[0] = *(const u32x4*)(p_ + kc + 16 * w); rk[1] = *(const u32x4*)(p_ + kc + 16 * w + 8); \
            if constexpr (FULL) { rq[0] = *(const u32x4*)(p_ + qc + 16 * w); rq[1] = *(const u32x4*)(p_ + qc + 16 * w + 8); } } \
        else { if (w < 2) { rk[0] = *(const u32x4*)(p_ + kc + 16 * w); rk[1] = *(const u32x4*)(p_ + kc + 16 * w + 8); rr[0] = *(const u32x4*)(p_ + C_GA + hh * 32 + 16 * w); rr[1] = *(const u32x4*)(p_ + C_GA + hh * 32 + 16 * w + 8); \
                            if constexpr (FULL) { rq[0] = *(const u32x4*)(p_ + qc + 16 * w); rq[1] = *(const u32x4*)(p_ + qc + 16 * w + 8); } } } \
        rv[0] = *(const u32x4*)(p_ + vc + 16 * w); rv[1] = *(const u32x4*)(p_ + vc + 16 * w + 8); \
        if (PROBE_TA && !FULL) { _Pragma("unroll") for (int x_ = 0; x_ < 6; ++x_) { dummy[x_] = *(const volatile u32x4*)(p_ + vc + 16 * w + 8 * (x_ & 1)); } } } while (0)
    MX_LOAD_RAW(0);
    __syncthreads();
    if (gid == 1) __syncthreads();
    for (int n = 0; n < NCH; ++n) {
        float em4[4];
        if (PROBE_TA && !FULL) { _Pragma("unroll") for (int x_ = 0; x_ < 6; ++x_) asm volatile("" :: "v"(dummy[x_])); }
        {
            float Qr[16], Kr[16];
            if constexpr (TYPE == 0) {
                const float sq = fexp2((float)(lane - 31) * lgam), sk = fexp2((float)(31 - lane) * lgam) * 0.125f;
#pragma unroll
                for (int i = 0; i < 8; ++i) { const unsigned csw = rr[i >> 2][i & 3]; const float cs = bflo(csw), sn = bfhi(csw);
                    const float k1 = bfx(rk[0], i), k2 = bfx(rk[1], i);
                    Kr[i] = (k1 * cs - k2 * sn) * sk; Kr[8 + i] = (k1 * sn + k2 * cs) * sk;
                    if constexpr (FULL) { const float q1 = bfx(rq[0], i), q2 = bfx(rq[1], i); Qr[i] = (q1 * cs - q2 * sn) * sq; Qr[8 + i] = (q1 * sn + q2 * cs) * sq; } }
                const float em = fexp2(32.0f * lgam);
#pragma unroll
                for (int i = 0; i < 4; ++i) em4[i] = em;
                if (lane < 16) { EL[16 * w + lane] = fexp2(64.0f * lgam); ELM[16 * w + lane] = em; }
            } else if (TYPE == 1 || w < 2) {
                float c[16]; float myM = 0.f, myL = 0.f;
                if constexpr (TYPE == 1) {
                    const f32x4 lb0 = *(const LAS f32x4*)(LBt + 16 * w), lb1 = *(const LAS f32x4*)(LBt + 16 * w + 4), lb2 = *(const LAS f32x4*)(LBt + 16 * w + 8), lb3 = *(const LAS f32x4*)(LBt + 16 * w + 12);
                    const f32x4 om0 = *(const LAS f32x4*)(OMLt + 16 * w), om1 = *(const LAS f32x4*)(OMLt + 16 * w + 4), om2 = *(const LAS f32x4*)(OMLt + 16 * w + 8), om3 = *(const LAS f32x4*)(OMLt + 16 * w + 12);
#pragma unroll
                    for (int p = 0; p < 16; ++p) { const float lb = (p < 4 ? lb0 : p < 8 ? lb1 : p < 12 ? lb2 : lb3)[p & 3], om = (p < 4 ? om0 : p < 8 ? om1 : p < 12 ? om2 : om3)[p & 3];
                        const float z = bfx(rk[p >> 3], p & 7); const float sg = sigmoidf_(z);
                        const float f = lb + om * sg; c[p] = flog2(fmaxf(f, 1e-30f)); Kr[p] = om * (1.0f - sg);
                        if constexpr (FULL) { const float qv = bfx(rq[p >> 3], p & 7); Qr[p] = siluf_(qv) * 0.125f; } }
                } else {
#pragma unroll
                    for (int p = 0; p < 16; ++p) { const float pre = bfx(rr[p >> 3], p & 7) + gba[p];
                        c[p] = (fminf(pre, 0.f) * LOG2E - flog2(1.0f + fexp2(-LOG2E * fabsf(pre)))) * (1.0f / 16.0f); Kr[p] = bfx(rk[p >> 3], p & 7);
                        if constexpr (FULL) Qr[p] = bfx(rq[p >> 3], p & 7) * 0.17677669529663687f; }
                }
#pragma unroll
                for (int p = 0; p < 16; p += 4) wave_incl_scan4(c[p], c[p + 1], c[p + 2], c[p + 3]);
#pragma unroll
                for (int p = 0; p < 16; ++p) { const float m = rdlane(c[p], 31), cl = rdlane(c[p], 63); Kr[p] *= fexp2(m - c[p]);
                    if constexpr (FULL) Qr[p] *= fexp2(c[p] - m);
                    myM = (lane == p) ? m : myM; myL = (lane == p) ? cl : myL; }
                if (lane < 16) { EM[16 * w + lane] = fexp2(myM); EL[16 * w + lane] = fexp2(myL); ELM[16 * w + lane] = fexp2(myL - myM); }
                if constexpr (FULL) { LDS_WAIT();
                    const f32x4 e4 = *(const LAS f32x4*)(EM + 16 * w + 4 * rg);
#pragma unroll
                    for (int i = 0; i < 4; ++i) em4[i] = e4[i]; }
            } else {
#pragma unroll
                for (int i = 0; i < 4; ++i) em4[i] = 0.f;
            }
            if (TYPE != 2 || w < 2) {
                u32x4 k0, k1;
                k0.x = pg8::cvt_pk_bf16(Kr[0], Kr[1]); k0.y = pg8::cvt_pk_bf16(Kr[2], Kr[3]); k0.z = pg8::cvt_pk_bf16(Kr[4], Kr[5]); k0.w = pg8::cvt_pk_bf16(Kr[6], Kr[7]);
                k1.x = pg8::cvt_pk_bf16(Kr[8], Kr[9]); k1.y = pg8::cvt_pk_bf16(Kr[10], Kr[11]); k1.z = pg8::cvt_pk_bf16(Kr[12], Kr[13]); k1.w = pg8::cvt_pk_bf16(Kr[14], Kr[15]);
                if constexpr (FULL) {
                    u32x4 q0, q1;
                    q0.x = pg8::cvt_pk_bf16(Qr[0], Qr[1]); q0.y = pg8::cvt_pk_bf16(Qr[2], Qr[3]); q0.z = pg8::cvt_pk_bf16(Qr[4], Qr[5]); q0.w = pg8::cvt_pk_bf16(Qr[6], Qr[7]);
                    q1.x = pg8::cvt_pk_bf16(Qr[8], Qr[9]); q1.y = pg8::cvt_pk_bf16(Qr[10], Qr[11]); q1.z = pg8::cvt_pk_bf16(Qr[12], Qr[13]); q1.w = pg8::cvt_pk_bf16(Qr[14], Qr[15]);
                    *(LAS u32x4*)(Qt + lane * MX_PITCH + 16 * w) = q0; *(LAS u32x4*)(Qt + lane * MX_PITCH + 16 * w + 8) = q1;
                    *(LAS u32x4*)(Kt + lane * MX_PITCH + 16 * w) = k0; *(LAS u32x4*)(Kt + lane * MX_PITCH + 16 * w + 8) = k1; }
#pragma unroll
                for (int p = 0; p < 16; ++p) KT[(16 * w + p) * MX_PITCH + lane] = bfbits(p < 8 ? k0 : k1, p & 7);
            }
#pragma unroll
            for (int p = 0; p < 16; ++p) VT[(16 * w + p) * MX_PITCH + lane] = bfbits(rv[p >> 3], p & 7);
            if constexpr (FULL) { if (owner) {
#pragma unroll
                for (int et = 0; et < 4; ++et) { u32x2 o; o.x = pg8::cvt_pk_bf16(S[et][0] * em4[0], S[et][1] * em4[1]); o.y = pg8::cvt_pk_bf16(S[et][2] * em4[2], S[et][3] * em4[3]);
                    *(LAS u32x2*)(ST + (16 * et + col) * MX_PITCH + 16 * w + 4 * rg) = o; } } }
        }
        __syncthreads();
        const size_t trow = rowbase + (size_t)n * 64 + 16 * w + col;
        u32x2 gt[4];
        if constexpr (FULL) {
#pragma unroll
            for (int et = 0; et < 4; ++et) gt[et] = *(const u32x2*)(PROJ + trow * NPROJ + gc + 16 * et + 4 * rg); }
        if (n + 1 < NCH) { MX_LOAD_RAW(n + 1); }
        f32x4 OT[4];
        if constexpr (FULL) {
            bf16x8 Bq[NKS];
#pragma unroll
            for (int ks = 0; ks < NKS; ++ks) Bq[ks] = *(const LAS bf16x8*)(Qt + (16 * w + col) * MX_PITCH + 32 * ks + 8 * rg);
            f32x4 PT[4];
#pragma unroll
            for (int st = 0; st < 4; ++st) { PT[st] = (f32x4){0.f, 0.f, 0.f, 0.f};
                if (st <= w) {
#pragma unroll
                    for (int ks = 0; ks < NKS; ++ks) { const bf16x8 af = *(const LAS bf16x8*)(Kt + (16 * st + col) * MX_PITCH + 32 * ks + 8 * rg); PT[st] = __builtin_amdgcn_mfma_f32_16x16x32_bf16(af, Bq[ks], PT[st], 0, 0, 0); }
                    if (st == w) {
#pragma unroll
                        for (int i = 0; i < 4; ++i) PT[st][i] = (4 * rg + i > col) ? 0.f : PT[st][i]; }
                } }
            u32x4 pb0, pb1;
            pb0.x = pg8::cvt_pk_bf16(PT[0][0], PT[0][1]); pb0.y = pg8::cvt_pk_bf16(PT[0][2], PT[0][3]); pb0.z = pg8::cvt_pk_bf16(PT[1][0], PT[1][1]); pb0.w = pg8::cvt_pk_bf16(PT[1][2], PT[1][3]);
            pb1.x = pg8::cvt_pk_bf16(PT[2][0], PT[2][1]); pb1.y = pg8::cvt_pk_bf16(PT[2][2], PT[2][3]); pb1.z = pg8::cvt_pk_bf16(PT[3][0], PT[3][1]); pb1.w = pg8::cvt_pk_bf16(PT[3][2], PT[3][3]);
#pragma unroll
            for (int et = 0; et < 4; ++et) { OT[et] = (f32x4){0.f, 0.f, 0.f, 0.f};
#pragma unroll
                for (int ks = 0; ks < NKS; ++ks) { const bf16x8 af = *(const LAS bf16x8*)(ST + (16 * et + col) * MX_PITCH + 32 * ks + 8 * rg); OT[et] = __builtin_amdgcn_mfma_f32_16x16x32_bf16(af, Bq[ks], OT[et], 0, 0, 0); }
                { const u32x2 a0 = *(const LAS u32x2*)(VT + (16 * et + col) * MX_PITCH + 4 * rg), a1 = *(const LAS u32x2*)(VT + (16 * et + col) * MX_PITCH + 16 + 4 * rg);
                  u32x4 av; av.x = a0.x; av.y = a0.y; av.z = a1.x; av.w = a1.y;
                  OT[et] = __builtin_amdgcn_mfma_f32_16x16x32_bf16(__builtin_bit_cast(bf16x8, av), __builtin_bit_cast(bf16x8, pb0), OT[et], 0, 0, 0); }
                if (w >= 2) { const u32x2 a0 = *(const LAS u32x2*)(VT + (16 * et + col) * MX_PITCH + 32 + 4 * rg), a1 = *(const LAS u32x2*)(VT + (16 * et + col) * MX_PITCH + 48 + 4 * rg);
                  u32x4 av; av.x = a0.x; av.y = a0.y; av.z = a1.x; av.w = a1.y;
                  OT[et] = __builtin_amdgcn_mfma_f32_16x16x32_bf16(__builtin_bit_cast(bf16x8, av), __builtin_bit_cast(bf16x8, pb1), OT[et], 0, 0, 0); }
            }
        }
        if (owner) {
            const f32x4 el = *(const LAS f32x4*)(EL + 16 * w + 4 * rg), elm = *(const LAS f32x4*)(ELM + 16 * w + 4 * rg);
#pragma unroll
            for (int et = 0; et < 4; ++et) { f32x4 W = (f32x4){0.f, 0.f, 0.f, 0.f};
#pragma unroll
                for (int ks = 0; ks < 2; ++ks) { const bf16x8 af = *(const LAS bf16x8*)(KT + (16 * w + col) * MX_PITCH + 32 * ks + 8 * rg), bfr = *(const LAS bf16x8*)(VT + (16 * et + col) * MX_PITCH + 32 * ks + 8 * rg);
                    W = __builtin_amdgcn_mfma_f32_16x16x32_bf16(af, bfr, W, 0, 0, 0); }
                S[et] = el * S[et] + elm * W; }
            if constexpr (!FULL) Gacc = Gacc * el;
        }
        if constexpr (FULL) {
            float ss = 0.f;
#pragma unroll
            for (int et = 0; et < 4; ++et) ss += (OT[et][0] * OT[et][0] + OT[et][1] * OT[et][1]) + (OT[et][2] * OT[et][2] + OT[et][3] * OT[et][3]);
            ss += __shfl_xor(ss, 16); ss += __shfl_xor(ss, 32);
            const float r = rsqrtf(ss * (1.0f / 64.0f) + EPS);
#pragma unroll
            for (int et = 0; et < 4; ++et) { const f32x4 g4 = gn4[et];
                const float g0 = bflo(gt[et].x), g1 = bfhi(gt[et].x), g2 = bflo(gt[et].y), g3 = bfhi(gt[et].y);
                const float o0 = OT[et][0] * r * g4[0] * siluf_(g0), o1 = OT[et][1] * r * g4[1] * siluf_(g1);
                const float o2 = OT[et][2] * r * g4[2] * siluf_(g2), o3 = OT[et][3] * r * g4[3] * siluf_(g3);
                u32x2 o; o.x = pg8::cvt_pk_bf16(o0, o1); o.y = pg8::cvt_pk_bf16(o2, o3);
                *(u32x2*)(H + trow * D + mc + 16 * et + 4 * rg) = o; }
        }
        __syncthreads();
    }
    if (gid == 0) __syncthreads();
    if constexpr (!FULL) { if (owner) { float* rec = STATE + (size_t)sc * ST_REC;
#pragma unroll
            for (int et = 0; et < 4; ++et) *(f32x4*)(rec + ((w * 4 + et) * 64 + lane) * 4) = S[et];
            if (col == 0) *(f32x4*)(rec + 4096 + 16 * w + 4 * rg) = Gacc; } }
#undef MX_LOAD_RAW
}

template <int MODE>
__device__ __forceinline__ void phase_mixer(LAS unsigned char* lds, int layer) {
    KARGS(ap); PHASE_IDS();
    constexpr int NS = (MODE == 0) ? NSC - 1 : NSC;
    constexpr int NPAIRS = NB * 8 * NS;
    for (int pr = bid; pr < NPAIRS; pr += G) {
        const int sc = pr % NS, hp = (pr / NS) & 7, b = pr / (NS * 8), hd = 2 * hp + (wave >> 2);
        if (hp < 3) mixer_chunked<0, MODE>(lds, ap, layer, b, hd, hd, sc, tid);
        else if (hp < 6) mixer_chunked<1, MODE>(lds, ap, layer, b, hd, hd - 6, sc, tid);
        else mixer_chunked<2, MODE>(lds, ap, layer, b, hd, hd - 12, sc, tid);
        __syncthreads();
    }
    if constexpr (MODE == 0) {
        const int nidle = G - NPAIRS;
        if (nidle > 0) { if (bid >= NPAIRS) convert_experts(lds, ap, layer, (bid - NPAIRS) * 8 + wave, nidle * 8, wave, lane); }
        else convert_experts(lds, ap, layer, gw, NGW, wave, lane);
    }
}

__device__ __forceinline__ void build_tp(LAS int* TP, const unsigned* cnt, int tid) {
    if (tid == 0) { int s = 0; for (int e = 0; e < 32; ++e) { TP[e] = s; s += ((int)cnt[e] + 255) >> 8; } TP[32] = s; }
    __syncthreads();
}

__device__ __forceinline__ void phase_prologue(LAS unsigned char* lds) {
    KARGS(ap); PHASE_IDS();
    unsigned char* ws = ap->ws;
    if (bid < 192) {
        float* MOD = (float*)(ws + WS_MOD);
        const float* cin = ap->in[I_C]; const float* wada = ap->in[I_WADA]; const float* bada = ap->in[I_BADA];
        LAS float* cact = (LAS float*)lds;
        for (int i = tid; i < 8192; i += 512) { const int b = i >> 10, k = i & 1023; cact[k * 8 + b] = siluf_(cin[i]); }
        __syncthreads();
        LAS float* red = (LAS float*)(lds + 32768);
        const int kr = lane >> 4, c4 = (lane & 15) * 4;
        for (int it = bid; it < 192; it += G) {
            const int l = it / 96, j0 = (it % 96) * 64; const float* W = wada + (size_t)l * D * 6144 + j0 + c4;
            f32x4 acc[8];
#pragma unroll
            for (int b = 0; b < 8; ++b) acc[b] = (f32x4){0.f, 0.f, 0.f, 0.f};
#pragma unroll 8
            for (int i = 0; i < 32; ++i) { const int k = wave * 128 + 4 * i + kr; const f32x4 wv = *(const f32x4*)(W + (size_t)k * 6144);
                const f32x4 c0 = *(const LAS f32x4*)(cact + k * 8), c1 = *(const LAS f32x4*)(cact + k * 8 + 4);
                acc[0] += c0[0] * wv; acc[1] += c0[1] * wv; acc[2] += c0[2] * wv; acc[3] += c0[3] * wv; acc[4] += c1[0] * wv; acc[5] += c1[1] * wv; acc[6] += c1[2] * wv; acc[7] += c1[3] * wv; }
#pragma unroll
            for (int b = 0; b < 8; ++b) *(LAS f32x4*)(red + ((wave * 4 + kr) * 8 + b) * 64 + c4) = acc[b];
            __syncthreads();
            { const int b = tid >> 6, col = tid & 63; float s = 0.f;
#pragma unroll
              for (int p = 0; p < 32; ++p) s += red[(p * 8 + b) * 64 + col];
              MOD[((size_t)l * 8 + b) * 6144 + j0 + col] = s + bada[l * 6144 + j0 + col]; }
            __syncthreads();
        }
    }
    __syncthreads();
    {
        bf16* WIN_T = (bf16*)(ws + WS_WIN); bf16* WOUT_T = (bf16*)(ws + WS_WOUT);
        LAS float* scr = (LAS float*)(lds + wave * 16384);
        constexpr int I_IN = 16 * 120, I_OUT = 16 * 32;
        constexpr int PER_L = I_IN + I_OUT;
        for (int it = gw; it < 2 * PER_L; it += NGW) {
            const int l = it / PER_L; int r = it % PER_L;
            if (r < I_IN) { const int kb = r / 120, nb = r % 120; transpose_item(ap->in[I_WIN] + (size_t)l * D * INP, INP, D, kb * 64, nb * 32, WIN_T + (size_t)l * NPROJ * D, nb * 32, scr, lane); continue; } r -= I_IN;
            { const int kb = r / 32, nb = r % 32; transpose_item(ap->in[I_WOUT] + (size_t)l * D * D, D, D, kb * 64, nb * 32, WOUT_T + (size_t)l * D * D, nb * 32, scr, lane); }
        }
        const float* win = ap->in[I_WIN]; const float* wa2 = ap->in[I_WA2];
        for (int it = bid * 512 + tid; it < 2 * 256 * 128; it += G * 512) {
            const int l = it / (256 * 128), r = it % (256 * 128), n = r / 128, k0 = (r % 128) * 8;
            float o[8];
#pragma unroll
            for (int j = 0; j < 8; ++j) o[j] = 0.f;
            if (n < 128) {
#pragma unroll
                for (int j = 0; j < 8; ++j) { const float* wr_ = win + (size_t)l * D * INP + (size_t)(k0 + j) * INP + 3840; float s = 0.f;
#pragma unroll
                    for (int rr = 0; rr < 16; ++rr) s += wr_[rr] * wa2[l * 16 * 128 + rr * 128 + n];
                    o[j] = s; } }
            u32x4 w; w.x = pk2(o[0], o[1]); w.y = pk2(o[2], o[3]); w.z = pk2(o[4], o[5]); w.w = pk2(o[6], o[7]);
            *(u32x4*)(WIN_T + (size_t)l * NPROJ * D + (size_t)(3840 + n) * D + k0) = w;
        }
    }
    {
        unsigned* ROPE = (unsigned*)(ws + WS_ROPE); const int* posp = (const int*)ap->in[I_POS];
        for (int it = bid * 512 + tid; it < MTOK * 32; it += G * 512) {
            const int row = it >> 5, j = it & 31; const int pos = posp[row];
            const float ang = (float)pos * ap->inv_freq[j]; float s, c; sincos_acc(ang, s, c); ROPE[it] = pk2(c, s);
        }
    }
}

template <int MODE>
__device__ __forceinline__ void phase_norm1(LAS unsigned char* lds, int layer) {
    KARGS(ap); PHASE_IDS();
    unsigned char* ws = ap->ws; float* outp = ap->out;
    const float* MOD = (const float*)(ws + WS_MOD); bf16* H = (bf16*)(ws + WS_H); const bf16* YP = (const bf16*)(ws + WS_YP);
    const int* ROUTE_I = (const int*)(ws + WS_ROUTE); const float* ROUTE_W = (const float*)(ws + WS_ROUTE + 4 * MTOK * 4);
    LAS int* TP = (LAS int*)(lds + TP_OFF);
    const int pl = (MODE == 2) ? DEPTH - 1 : layer - 1;
    if (MODE != 0) build_tp(TP, (const unsigned*)(ws + WS_CTL) + CW_CNT + pl * 64, tid);
    const float* xin = ap->in[I_X]; const bf16* xb16 = (const bf16*)(ws + WS_XB); bf16* x2 = (bf16*)outp;
    const float* gn = MODE == 2 ? ap->in[I_NFIN] : ap->in[I_NMIX] + layer * D;
    for (int rb = bid; rb < MTOK / 128; rb += G) {
        const int row0 = rb * 128 + wave * 16, b = row0 >> 12;
        f32x4 Av[4], Bv[4], Gf[4];
#pragma unroll
        for (int j = 0; j < 4; ++j) { const int c0 = 4 * lane + 256 * j; Av[j] = *(const f32x4*)(gn + c0);
            if (MODE != 2) { const float* mb = MOD + (size_t)layer * 8 * 6144 + (size_t)b * 6144; const f32x4 sc = *(const f32x4*)(mb + D + c0); Bv[j] = *(const f32x4*)(mb + c0); Av[j] = Av[j] * (1.0f + sc); }
            if (MODE != 0) Gf[j] = *(const f32x4*)(MOD + (size_t)pl * 8 * 6144 + (size_t)b * 6144 + 5 * D + c0); }
        for (int r = 0; r < 16; r += 2) {
            f32x4 v[2][4];
#pragma unroll
            for (int q = 0; q < 2; ++q)
#pragma unroll
                for (int j = 0; j < 4; ++j) { if (MODE == 0) v[q][j] = *(const f32x4*)(xin + (size_t)(row0 + r + q) * D + 4 * lane + 256 * j);
                    else { const u32x2 xv = *(const u32x2*)(xb16 + (size_t)(row0 + r + q) * D + 4 * lane + 256 * j); v[q][j] = (f32x4){bflo(xv.x), bfhi(xv.x), bflo(xv.y), bfhi(xv.y)}; } }
            if (MODE != 0) {
                u32x2 y0[2][4], y1[2][4]; float w0[2], w1[2];
#pragma unroll
                for (int q = 0; q < 2; ++q) { const int m = row0 + r + q; const int e0 = ROUTE_I[m], e1 = ROUTE_I[MTOK + m], r0 = ROUTE_I[2 * MTOK + m], r1 = ROUTE_I[3 * MTOK + m]; w0[q] = ROUTE_W[m]; w1[q] = ROUTE_W[MTOK + m];
                    const bf16* p0 = YP + (size_t)(TP[e0] * 256 + r0) * D; const bf16* p1 = YP + (size_t)(TP[e1] * 256 + r1) * D;
#pragma unroll
                    for (int j = 0; j < 4; ++j) { y0[q][j] = *(const u32x2*)(p0 + 4 * lane + 256 * j); y1[q][j] = *(const u32x2*)(p1 + 4 * lane + 256 * j); } }
#pragma unroll
                for (int q = 0; q < 2; ++q)
#pragma unroll
                    for (int j = 0; j < 4; ++j) { const u32x2 a0 = y0[q][j], a1 = y1[q][j];
                        v[q][j][0] += Gf[j][0] * (w0[q] * bflo(a0.x) + w1[q] * bflo(a1.x)); v[q][j][1] += Gf[j][1] * (w0[q] * bfhi(a0.x) + w1[q] * bfhi(a1.x));
                        v[q][j][2] += Gf[j][2] * (w0[q] * bflo(a0.y) + w1[q] * bflo(a1.y)); v[q][j][3] += Gf[j][3] * (w0[q] * bfhi(a0.y) + w1[q] * bfhi(a1.y));
                        if (MODE == 1) { u32x2 xo; xo.x = pk2(v[q][j][0], v[q][j][1]); xo.y = pk2(v[q][j][2], v[q][j][3]); *(u32x2*)(x2 + (size_t)(row0 + r + q) * D + 4 * lane + 256 * j) = xo; } }
            }
            float ss[2];
#pragma unroll
            for (int q = 0; q < 2; ++q) { float s = 0.f;
#pragma unroll
                for (int j = 0; j < 4; ++j) s += (v[q][j][0] * v[q][j][0] + v[q][j][1] * v[q][j][1]) + (v[q][j][2] * v[q][j][2] + v[q][j][3] * v[q][j][3]);
                ss[q] = s; }
            ss[0] = wave_sum(ss[0]); ss[1] = wave_sum(ss[1]);
#pragma unroll
            for (int q = 0; q < 2; ++q) { const float rstd = rsqrtf(ss[q] * (1.0f / D) + EPS); const size_t m = (size_t)(row0 + r + q);
#pragma unroll
                for (int j = 0; j < 4; ++j) { const int c0 = 4 * lane + 256 * j;
                    if (MODE == 2) { *(f32x4*)(outp + m * D + c0) = v[q][j] * rstd * Av[j]; }
                    else { const f32x4 y = (v[q][j] * rstd) * Av[j] + Bv[j]; u32x2 o; o.x = pk2(y[0], y[1]); o.y = pk2(y[2], y[3]); *(u32x2*)(H + m * D + c0) = o; } } }
        }
    }
}

__device__ __forceinline__ void phase_inproj(LAS unsigned char* lds, int layer) {
    KARGS(ap); unsigned char* ws = ap->ws;
    pg8::Gemm g{(const bf16*)(ws + WS_H), (const bf16*)(ws + WS_WIN) + (size_t)layer * NPROJ * D, D}; pg8::StaticOrder S; S.init(MTOK, NPROJ, gridDim.x, blockIdx.x);
    pg8::EpiBf16StoreT<true> E{(bf16*)(ws + WS_PROJ), NPROJ};
    pg8::gemm_phase<pg8::EpiBf16StoreT<true>, pg8::StaticOrder, false>(lds, g, S, E, nullptr);
}
__device__ __forceinline__ void phase_mixer_naive(LAS unsigned char* lds, int layer) {
    KARGS(ap); PHASE_IDS();
    for (int it = bid; it < NB * 16; it += G) {
        const int b = it >> 4, hd = it & 15;
        if (hd < 6) naive_mixer_item<0>(lds, ap, layer, b, hd, tid);
        else if (hd < 12) naive_mixer_item<1>(lds, ap, layer, b, hd - 6, tid);
        else naive_mixer_item<2>(lds, ap, layer, b, hd - 12, tid);
        __syncthreads();
    }
}
__device__ __forceinline__ void phase_outproj(LAS unsigned char* lds, int layer) {
    KARGS(ap); unsigned char* ws = ap->ws;
    pg8::Gemm g{(const bf16*)(ws + WS_H), (const bf16*)(ws + WS_WOUT) + (size_t)layer * D * D, D}; pg8::StaticOrder S; S.init(MTOK, D, gridDim.x, blockIdx.x);
    const float* gate = (const float*)(ws + WS_MOD) + (size_t)layer * 8 * 6144 + 2 * D;
    if (layer == 0) { pg8::EpiResGateB<false> E{ap->in[I_X], (bf16*)(ws + WS_XB), gate}; pg8::gemm_phase<pg8::EpiResGateB<false>, pg8::StaticOrder, false>(lds, g, S, E, nullptr); }
    else { pg8::EpiResGateB<true> E{ap->out, (bf16*)(ws + WS_XB), gate}; pg8::gemm_phase<pg8::EpiResGateB<true>, pg8::StaticOrder, false>(lds, g, S, E, nullptr); }
}
constexpr int WR_PITCH = 1032;
__device__ __forceinline__ void phase_norm2_router(LAS unsigned char* lds, int layer) {
    KARGS(ap); PHASE_IDS();
    unsigned char* ws = ap->ws; const bf16* xres = (const bf16*)(ws + WS_XB);
    bf16* H = (bf16*)(ws + WS_H);
    int* ROUTE_I = (int*)(ws + WS_ROUTE); float* ROUTE_W = (float*)(ws + WS_ROUTE + 4 * MTOK * 4); int* IDX2 = (int*)(ws + WS_IDX2);
    unsigned* cntl = (unsigned*)(ws + WS_CTL) + CW_CNT + layer * 64;
    LAS bf16* Wr = (LAS bf16*)lds;
    LAS float* LG = (LAS float*)(lds + 99072);
    LAS float* AB = (LAS float*)(lds + 119552);
    LAS int* HIST = (LAS int*)(lds + 127744); LAS int* BASE = HIST + 32; LAS int* RI = BASE + 32; LAS float* RW = (LAS float*)(RI + 128 * 4);
    { const float* rgw = ap->in[I_RGW] + (size_t)layer * D * 4; const float* rew = ap->in[I_REW] + (size_t)layer * D * 32;
      for (int i = tid; i < 32 * 1024; i += 512) { const int k = i >> 5, n = i & 31; Wr[(4 + n) * WR_PITCH + k] = (bf16)f2bf(rew[i]); }
      for (int i = tid; i < 4 * 1024; i += 512) { const int k = i >> 2, n = i & 3; Wr[n * WR_PITCH + k] = (bf16)f2bf(rgw[i]); }
      for (int i = tid; i < 12 * 1024; i += 512) { const int n = 36 + (i >> 10), k = i & 1023; Wr[n * WR_PITCH + k] = (bf16)0; } }
    const float* gn = ap->in[I_NFFN] + layer * D; const float* rgb = ap->in[I_RGB] + layer * 4; const float* reb = ap->in[I_REB] + layer * 32;
    const float* modl = (const float*)(ws + WS_MOD) + (size_t)layer * 8 * 6144;
    const int r = lane & 15, kq = lane >> 4;
    for (int rb = bid; rb < MTOK / 128; rb += G) {
        const int row0 = rb * 128 + wave * 16, b = row0 >> 12; const float* mb = modl + (size_t)b * 6144 + 3 * D;
        __syncthreads();
        if (tid < 32) HIST[tid] = 0;
        for (int i = tid; i < 1024; i += 512) { AB[i] = gn[i] * (1.0f + mb[D + i]); AB[1024 + i] = mb[i]; }
        __syncthreads();
        const bf16* xr = xres + (size_t)(row0 + r) * D + 8 * kq;
        float ss = 0.f;
#pragma unroll 16
        for (int ks = 0; ks < 32; ++ks) { const u32x4 xv = *(const u32x4*)(xr + 32 * ks); const f32x4 xa = (f32x4){bflo(xv.x), bfhi(xv.x), bflo(xv.y), bfhi(xv.y)}, xb = (f32x4){bflo(xv.z), bfhi(xv.z), bflo(xv.w), bfhi(xv.w)};
            ss += (xa[0] * xa[0] + xa[1] * xa[1]) + (xa[2] * xa[2] + xa[3] * xa[3]) + (xb[0] * xb[0] + xb[1] * xb[1]) + (xb[2] * xb[2] + xb[3] * xb[3]); }
        ss += __shfl_xor(ss, 16); ss += __shfl_xor(ss, 32);
        const float rstd = rsqrtf(ss * (1.0f / D) + EPS);
        f32x4 acc[3];
#pragma unroll
        for (int nt = 0; nt < 3; ++nt) acc[nt] = (f32x4){0.f, 0.f, 0.f, 0.f};
        bf16* hr = H + (size_t)(row0 + r) * D + 8 * kq;
#pragma unroll 8
        for (int ks = 0; ks < 32; ++ks) { const u32x4 xv = *(const u32x4*)(xr + 32 * ks); const f32x4 xa = (f32x4){bflo(xv.x), bfhi(xv.x), bflo(xv.y), bfhi(xv.y)}, xb = (f32x4){bflo(xv.z), bfhi(xv.z), bflo(xv.w), bfhi(xv.w)};
            const f32x4 a0 = *(const LAS f32x4*)(AB + 32 * ks + 8 * kq), a1 = *(const LAS f32x4*)(AB + 32 * ks + 8 * kq + 4), b0 = *(const LAS f32x4*)(AB + 1024 + 32 * ks + 8 * kq), b1 = *(const LAS f32x4*)(AB + 1024 + 32 * ks + 8 * kq + 4);
            const f32x4 ya = (xa * rstd) * a0 + b0, yb = (xb * rstd) * a1 + b1;
            u32x4 o; o.x = pg8::cvt_pk_bf16(ya[0], ya[1]); o.y = pg8::cvt_pk_bf16(ya[2], ya[3]); o.z = pg8::cvt_pk_bf16(yb[0], yb[1]); o.w = pg8::cvt_pk_bf16(yb[2], yb[3]);
            *(u32x4*)(hr + 32 * ks) = o;
            const bf16x8 af = __builtin_bit_cast(bf16x8, o);
#pragma unroll
            for (int nt = 0; nt < 3; ++nt) { const bf16x8 bfr = *(const LAS bf16x8*)(Wr + (16 * nt + r) * WR_PITCH + 32 * ks + 8 * kq); acc[nt] = __builtin_amdgcn_mfma_f32_16x16x32_bf16(af, bfr, acc[nt], 0, 0, 0); } }
        LAS float* lgw = LG + wave * 16 * 40;
#pragma unroll
        for (int nt = 0; nt < 3; ++nt) { if (16 * nt + r < 40) {
#pragma unroll
            for (int i = 0; i < 4; ++i) lgw[(4 * kq + i) * 40 + 16 * nt + r] = acc[nt][i]; } }
        LDS_WAIT();
        if (lane < 16) {
            const LAS float* lg = lgw + lane * 40;
            float gl[4];
#pragma unroll
            for (int t = 0; t < 4; ++t) gl[t] = lg[t] + rgb[t];
            int gi = 0; float gm = gl[0];
#pragma unroll
            for (int t = 1; t < 4; ++t) if (gl[t] > gm) { gm = gl[t]; gi = t; }
            float gs = 0.f;
#pragma unroll
            for (int t = 0; t < 4; ++t) gs += __expf(gl[t] - gm);
            const float gwt = 1.0f / gs;
            float el[8];
#pragma unroll
            for (int t = 0; t < 8; ++t) el[t] = lg[4 + gi * 8 + t] + reb[gi * 8 + t];
            int i0 = 0; float m0 = el[0];
#pragma unroll
            for (int t = 1; t < 8; ++t) if (el[t] > m0) { m0 = el[t]; i0 = t; }
            int i1 = -1; float m1 = -3.0e38f;
#pragma unroll
            for (int t = 0; t < 8; ++t) if (t != i0 && el[t] > m1) { m1 = el[t]; i1 = t; }
            const float ex = __expf(m1 - m0); const float w0 = gwt / (1.0f + ex), w1 = gwt * ex / (1.0f + ex);
            const int e0 = gi * 8 + i0, e1 = gi * 8 + i1, lr = wave * 16 + lane;
            const int l0 = __hip_atomic_fetch_add(HIST + e0, 1, __ATOMIC_RELAXED, __HIP_MEMORY_SCOPE_WORKGROUP), l1 = __hip_atomic_fetch_add(HIST + e1, 1, __ATOMIC_RELAXED, __HIP_MEMORY_SCOPE_WORKGROUP);
            RI[lr * 4 + 0] = e0; RI[lr * 4 + 1] = e1; RI[lr * 4 + 2] = l0; RI[lr * 4 + 3] = l1; RW[lr * 2 + 0] = w0; RW[lr * 2 + 1] = w1;
        }
        __syncthreads();
        if (tid < 32) { const int c = HIST[tid]; BASE[tid] = c ? (int)atomicAdd(cntl + tid, (unsigned)c) : 0; }
        __syncthreads();
        if (tid < 128) { const int m = rb * 128 + tid; const int e0 = RI[tid * 4 + 0], e1 = RI[tid * 4 + 1]; const int r0 = BASE[e0] + RI[tid * 4 + 2], r1 = BASE[e1] + RI[tid * 4 + 3];
            IDX2[e0 * MTOK + r0] = m; IDX2[e1 * MTOK + r1] = m;
            ROUTE_I[m] = e0; ROUTE_I[MTOK + m] = e1; ROUTE_I[2 * MTOK + m] = r0; ROUTE_I[3 * MTOK + m] = r1; ROUTE_W[m] = RW[tid * 2 + 0]; ROUTE_W[MTOK + m] = RW[tid * 2 + 1]; }
    }
}
__device__ __forceinline__ void phase_moe(LAS unsigned char* lds, int layer) {
    KARGS(ap); unsigned char* ws = ap->ws;
    LAS int* TP = (LAS int*)(lds + TP_OFF); LAS int* AUX = (LAS int*)(lds + AUX_OFF);
    unsigned* ctl = (unsigned*)(ws + WS_CTL);
    const unsigned* cntl = ctl + CW_CNT + layer * 64;
    unsigned* arrive = ctl + CW_MOE + layer * CW_MOE_LAYER;
    { int tid = threadIdx.x; build_tp(TP, cntl, tid);
      pg8::MoeOrder S0; S0.G = gridDim.x; S0.c = blockIdx.x; S0.npt = 2; S0.total = TP[32] * 2; S0.tp = TP;
      const int* IDX2 = (const int*)(ws + WS_IDX2);
      pg8::Unit u; for (int i = 0; i < 8; ++i) { if (!S0.next(i, u)) break; const int e = u.pn >> 1, j = u.pm - TP[e], cnt = (int)cntl[e];
          if (tid < 256) { const int rank = j * 256 + tid; AUX[i * 256 + tid] = (rank < cnt ? IDX2[e * MTOK + rank] : 0) * (D * 2); } }
      __syncthreads(); }
    { pg8::MoeOrder S; S.G = gridDim.x; S.c = blockIdx.x; S.npt = 2; S.total = TP[32] * 2; S.tp = TP;
      pg8::Gemm g{(const bf16*)(ws + WS_H), (const bf16*)(ws + WS_WGU) + (size_t)layer * NEXP * 512 * D, D};
      pg8::EpiSwiGLU E{(bf16*)(ws + WS_HID), arrive};
      pg8::gemm_phase<pg8::EpiSwiGLU, pg8::MoeOrder, true>(lds, g, S, E, AUX); }
    const int T_ = TP[32], split = 4 * ((((2 * T_) / (int)gridDim.x) * (int)gridDim.x) >> 1);
    pg8::Gemm gd{(const bf16*)(ws + WS_HID), (const bf16*)(ws + WS_WD) + (size_t)layer * NEXP * D * DEXP, DEXP};
    pg8::EpiBf16Store Ed{(bf16*)(ws + WS_YP), D};
    pg8::MoeDownOrder S1; S1.init(gridDim.x, blockIdx.x, T_, TP); S1.hi = split;
    int n1 = 0; while (n1 < 16) { const int ix = S1.unit_index(n1); if (ix < 0 || ix >= split) break; ++n1; }
    S1.wait(arrive, ctl + CW_TMO);
    pg8::gemm_phase<pg8::EpiBf16Store, pg8::MoeDownOrder, false>(lds, gd, S1, Ed, nullptr);
    pg8::MoeDownOrder S2; S2.init(gridDim.x, blockIdx.x, T_, TP); S2.lo = split; S2.j0 = n1;
    S2.wait(arrive, ctl + CW_TMO);
    pg8::gemm_phase<pg8::EpiBf16Store, pg8::MoeDownOrder, false>(lds, gd, S2, Ed, nullptr);
}

__global__ void __launch_bounds__(512, 2) fwd(Args a) {
    extern __shared__ __attribute__((aligned(16))) unsigned char lds_raw[];
    LAS unsigned char* lds = (LAS unsigned char*)lds_raw;
    volatile LAS unsigned* MISC = (volatile LAS unsigned*)(lds + LDSCTL_OFF);
    for (int u = threadIdx.x; u < (LDS_BYTES - LDSCTL_OFF) / 4; u += 512) ((LAS unsigned*)(lds + LDSCTL_OFF))[u] = 0u;
    __syncthreads();
#if MK_ONE_LAUNCH
    { unsigned* ctl0 = (unsigned*)(a.ws + WS_CTL); (void)xcd_barrier_post(ctl0 + CW_BAR, MISC + 8); }
    constexpr int lo = 0, hi = N_PHASES;
#define SEAM(k) do { if ((k) + 1 < hi) { KARGS(_ap); XcdBarrier _b; _b.bar = (unsigned*)(_ap->ws + WS_CTL) + CW_BAR; _b.x = xb_xcc_id(); _b.st = (volatile LAS unsigned*)(lds + LDSCTL_OFF) + 8; xcd_barrier(_b); if (PROBE_BAR) xcd_barrier(_b); } } while (0)
#else
    (void)MISC;
    const int lo = a.ph_lo, hi = a.ph_hi;
#define SEAM(k) do { } while (0)
#endif
#define IN(k) (lo <= (k) && (k) < hi)
    if (EN_P0 && IN(0)) { phase_prologue(lds); SEAM(0); if (PROBE_D) { phase_prologue(lds); SEAM(0); } }
#define LAYER_PHASES(layer) do { constexpr int pb = 1 + PH_PER_LAYER * (layer); \
        if (EN_PA && IN(pb + 0)) { if ((layer) == 0) { phase_norm1<0>(lds, (layer)); if (PROBE_A) { SEAM(pb + 0); phase_norm1<0>(lds, (layer)); } } else phase_norm1<1>(lds, (layer)); SEAM(pb + 0); } \
        if (EN_PB && IN(pb + 1)) { phase_inproj(lds, (layer)); SEAM(pb + 1); } \
        if (EN_PC && IN(pb + 2)) { if (!MK_NAIVE_MIXER) phase_mixer<0>(lds, (layer)); SEAM(pb + 2); } \
        if (EN_PC && IN(pb + 3)) { if (MK_NAIVE_MIXER) phase_mixer_naive(lds, (layer)); else phase_mixer<1>(lds, (layer)); SEAM(pb + 3); if (PROBE_M) { phase_mixer<0>(lds, (layer)); SEAM(pb + 3); } if (PROBE_M3) { phase_mixer<1>(lds, (layer)); SEAM(pb + 3); } } \
        if (EN_PD && IN(pb + 4)) { phase_outproj(lds, (layer)); SEAM(pb + 4); if (PROBE_PD && (layer) == 0) { phase_outproj(lds, (layer)); SEAM(pb + 4); } } \
        if (EN_PE && IN(pb + 5)) { phase_norm2_router(lds, (layer)); SEAM(pb + 5); if (PROBE_E) { if (blockIdx.x == 0 && threadIdx.x < 64) { KARGS(_a2); ((unsigned*)(_a2->ws + WS_CTL))[CW_CNT + (layer) * 64 + threadIdx.x] = 0u; } SEAM(pb + 5); phase_norm2_router(lds, (layer)); SEAM(pb + 5); } } \
        if (EN_PG && IN(pb + 6)) { phase_moe(lds, (layer)); SEAM(pb + 7); } } while (0)
    LAYER_PHASES(0);
    LAYER_PHASES(1);
#undef LAYER_PHASES
    if (EN_PF && IN(PH_FINAL)) phase_norm1<2>(lds, 0);
#undef IN
#undef SEAM
}

extern "C" void kernel_launch(void* const* d_in, const int* in_sizes, int n_in, void* d_out, int out_size, void* d_ws, size_t ws_size, hipStream_t stream) {
    static int grid = 0;
    if (grid == 0) {
        if (n_in != 23 || out_size != MTOK * D || ws_size < WS_END) { fprintf(stderr, "kernel_launch: unexpected shapes (n_in %d out %d ws %zu)\n", n_in, out_size, ws_size); grid = -1; return; }
        int dev = 0, cus = 0;
        if (hipGetDevice(&dev) != hipSuccess || hipDeviceGetAttribute(&cus, hipDeviceAttributeMultiprocessorCount, dev) != hipSuccess) { grid = -1; return; }
        if (hipFuncSetAttribute((const void*)fwd, hipFuncAttributeMaxDynamicSharedMemorySize, LDS_BYTES) != hipSuccess) { fprintf(stderr, "kernel_launch: hipFuncSetAttribute failed\n"); grid = -1; return; }
        int per_cu = 0;
        if (hipOccupancyMaxActiveBlocksPerMultiprocessor(&per_cu, (const void*)fwd, 512, LDS_BYTES) != hipSuccess || per_cu < 1) fprintf(stderr, "kernel_launch: occupancy query reports %d\n", per_cu);
        (void)hipGetLastError();
        grid = cus;
    }
    if (grid < 0) return;
    (void)hipMemsetAsync((char*)d_ws + WS_CTL, 0, CTL_ZERO_BYTES, stream);
    Args a{};
    for (int i = 0; i < 23; ++i) a.in[i] = (const float*)d_in[i];
    a.out = (float*)d_out; a.ws = (unsigned char*)d_ws;
    for (int j = 0; j < 32; ++j) a.inv_freq[j] = (float)std::pow(10000.0, -(double)j / 32.0);
#if MK_ONE_LAUNCH
    a.ph_lo = 0; a.ph_hi = N_PHASES;
    hipLaunchKernelGGL(fwd, dim3(grid), dim3(512), LDS_BYTES, stream, a);
#else
    for (int p = 0; p < N_PHASES; ++p) { a.ph_lo = p; a.ph_hi = p + 1; hipLaunchKernelGGL(fwd, dim3(grid), dim3(512), LDS_BYTES, stream, a); }
#endif
}
```

```cpp
#include <hip/hip_runtime.h>
#include <cstdio>
#include <cstdint>
#include <cmath>

#define GAS __attribute__((address_space(1)))
#define LAS __attribute__((address_space(3)))
typedef unsigned short bf16;
typedef short bf16x8 __attribute__((ext_vector_type(8)));
typedef float f32x4 __attribute__((ext_vector_type(4)));
typedef float f32x2 __attribute__((ext_vector_type(2)));
typedef unsigned u32x4 __attribute__((ext_vector_type(4)));
typedef unsigned u32x2 __attribute__((ext_vector_type(2)));

#ifndef EN_P0
#define EN_P0 1
#endif
#ifndef EN_PA
#define EN_PA 1
#endif
#ifndef EN_PB
#define EN_PB 1
#endif
#ifndef EN_PC
#define EN_PC 1
#endif
#ifndef EN_PD
#define EN_PD 1
#endif
#ifndef EN_PE
#define EN_PE 1
#endif
#ifndef EN_PG
#define EN_PG 1
#endif
#ifndef EN_PH
#define EN_PH 1
#endif
#ifndef EN_PF
#define EN_PF 1
#endif
#ifndef PROBE_M
#define PROBE_M 0
#endif
#ifndef PROBE_M3
#define PROBE_M3 0
#endif
#ifndef PROBE_A
#define PROBE_A 0
#endif
#ifndef PROBE_PD
#define PROBE_PD 0
#endif
#ifndef PROBE_BAR
#define PROBE_BAR 0
#endif
#ifndef PROBE_E
#define PROBE_E 0
#endif
#ifndef PROBE_TA
#define PROBE_TA 0
#endif
#ifndef PROBE_B
#define PROBE_B 0
#endif
#ifndef PROBE_C
#define PROBE_C 0
#endif
#ifndef PROBE_D
#define PROBE_D 0
#endif
#ifndef MK_NAIVE_MIXER
#define MK_NAIVE_MIXER 0
#endif
#ifndef MK_ONE_LAUNCH
#define MK_ONE_LAUNCH 1
#endif

constexpr int NB = 8, SEQ = 4096, MTOK = NB * SEQ, D = 1024, DEPTH = 2;
constexpr int NPROJ = 4096;
constexpr int INP = 3856;
constexpr int C_RQ = 0, C_RK = 384, C_RV = 768, C_RG = 1152, C_HQ = 1536, C_HF = 1920, C_HI = 2304, C_HG = 2688, C_GQ = 3072, C_GK = 3200, C_GV = 3328, C_GG = 3584, C_GA = 3840;
constexpr int NEXP = 32, DEXP = 256;
constexpr int MAXROWS = 73728;
constexpr float EPS = 1e-6f;

constexpr size_t MiB = 1u << 20;
constexpr size_t WS_CTL = 0, CTL_ZERO_BYTES = 1 * MiB;
constexpr size_t WS_MOD = 1 * MiB;
constexpr size_t WS_ROPE = 2 * MiB;
constexpr size_t WS_WIN = 10 * MiB;
constexpr size_t WS_WOUT = 26 * MiB;
constexpr size_t WS_WGU = 30 * MiB;
constexpr size_t WS_WD = 94 * MiB;
constexpr size_t WS_H = 126 * MiB;
constexpr size_t WS_PROJ = 190 * MiB;
constexpr size_t WS_HID = 190 * MiB;
constexpr size_t WS_YP = 226 * MiB;
constexpr size_t WS_XB = 370 * MiB;
constexpr size_t WS_STATE = 446 * MiB;
constexpr size_t WS_ROUTE = 474 * MiB;
constexpr size_t WS_IDX2 = 476 * MiB;
constexpr size_t WS_END = 480 * MiB;
constexpr int CW_CNT = 64;
constexpr int CW_BAR = 4096;
constexpr int CW_TMO = 8;
constexpr int CW_MOE = 16384, CW_MOE_LAYER = 32768;

constexpr int RING_BYTES = 131072;
constexpr int LDSCTL_OFF = 147456 - 1024;
constexpr int TP_OFF = LDSCTL_OFF + 512;
constexpr int AUX_OFF = 136 * 1024;
constexpr int LDS_BYTES = 147456;

#define RLX_AGENT __ATOMIC_RELAXED, __HIP_MEMORY_SCOPE_AGENT
#define LDS_WAIT() asm volatile("s_waitcnt lgkmcnt(0)" ::: "memory")
#define VM_WAIT() asm volatile("s_waitcnt vmcnt(0)" ::: "memory")

__device__ __forceinline__ unsigned f2bf(float f) { unsigned u = __builtin_bit_cast(unsigned, f); return (u + 0x7fffu + ((u >> 16) & 1u)) >> 16; }
__device__ __forceinline__ unsigned pk2(float lo, float hi) { return f2bf(lo) | (f2bf(hi) << 16); }
__device__ __forceinline__ float bf2f(unsigned short b) { return __builtin_bit_cast(float, ((unsigned)b) << 16); }
__device__ __forceinline__ float bflo(unsigned w) { return __builtin_bit_cast(float, w << 16); }
__device__ __forceinline__ float bfhi(unsigned w) { return __builtin_bit_cast(float, w & 0xffff0000u); }
constexpr float LOG2E = 1.4426950408889634f;
__device__ __forceinline__ float fexp2(float x) { return __builtin_amdgcn_exp2f(x); }
__device__ __forceinline__ float flog2(float x) { return __builtin_amdgcn_logf(x); }
__device__ __forceinline__ float frcp(float x) { return __builtin_amdgcn_rcpf(x); }
__device__ __forceinline__ float sigmoidf_(float x) { return frcp(1.0f + fexp2(-LOG2E * x)); }
__device__ __forceinline__ float siluf_(float x) { return x * frcp(1.0f + fexp2(-LOG2E * x)); }
template <int CTRL, int RMASK, bool BC> __device__ __forceinline__ float dpp_f(float v) {
    return __builtin_bit_cast(float, __builtin_amdgcn_update_dpp(0, __builtin_bit_cast(int, v), CTRL, RMASK, 0xf, BC)); }
__device__ __forceinline__ float rdlane(float v, int l) { return __builtin_bit_cast(float, __builtin_amdgcn_readlane(__builtin_bit_cast(int, v), l)); }
__device__ __forceinline__ float wave_sum(float v) {
    v += dpp_f<0x128, 0xf, false>(v); v += dpp_f<0x124, 0xf, false>(v); v += dpp_f<0x122, 0xf, false>(v); v += dpp_f<0x121, 0xf, false>(v);
    v += dpp_f<0x142, 0xa, false>(v); v += dpp_f<0x143, 0xc, false>(v);
    return rdlane(v, 63);
}
#define SCAN_STEP_(ctrl) "v_add_f32_dpp %0, %0, %0 " ctrl "\n\tv_add_f32_dpp %1, %1, %1 " ctrl "\n\tv_add_f32_dpp %2, %2, %2 " ctrl "\n\tv_add_f32_dpp %3, %3, %3 " ctrl "\n\t"
__device__ __forceinline__ void wave_incl_scan4(float& a, float& b, float& c, float& d) {
    asm volatile("s_nop 1\n\t"
        SCAN_STEP_("row_shr:1 row_mask:0xf bank_mask:0xf bound_ctrl:1") SCAN_STEP_("row_shr:2 row_mask:0xf bank_mask:0xf bound_ctrl:1")
        SCAN_STEP_("row_shr:4 row_mask:0xf bank_mask:0xf bound_ctrl:1") SCAN_STEP_("row_shr:8 row_mask:0xf bank_mask:0xf bound_ctrl:1")
        SCAN_STEP_("row_bcast:15 row_mask:0xa bank_mask:0xf") SCAN_STEP_("row_bcast:31 row_mask:0xc bank_mask:0xf")
        "s_nop 1" : "+v"(a), "+v"(b), "+v"(c), "+v"(d));
}
#define XB_TMO      128
#define XB_XCNT(j)  (256  + 64 * (j))
#define XB_XSUB(j)  (1280 + 64 * (j))
#define XB_XGEN(j)  (2304 + 64 * (j))
#define XB_TOP      3328
#define XB_TOPGEN   3392
#define XCD_BAR_WORDS 3456
#define XB_SPIN_CAP (1u << 18)
__device__ __forceinline__ unsigned xb_ld(unsigned* p)              { return __hip_atomic_load(p, __ATOMIC_RELAXED, __HIP_MEMORY_SCOPE_AGENT); }
__device__ __forceinline__ unsigned xb_add(unsigned* p, unsigned v) { return __hip_atomic_fetch_add(p, v, __ATOMIC_RELAXED, __HIP_MEMORY_SCOPE_AGENT); }
__device__ __forceinline__ unsigned xb_xcc_id() { return (unsigned)__builtin_amdgcn_s_getreg((3 << 11) | 20) & 0xFu; }
#define XB_SPIN(cond, bar) do { unsigned _sp = 0; while (cond) { __builtin_amdgcn_s_sleep(1); \
    if ((++_sp & 255u) == 0u) { if (xb_ld(&(bar)[XB_TMO])) break; if (_sp > XB_SPIN_CAP) { atomicAdd(&(bar)[XB_TMO], 1u); break; } } } } while (0)
struct XcdBarrier { unsigned* bar; unsigned x; volatile LAS unsigned* st; };
__device__ __forceinline__ XcdBarrier xcd_barrier_post(unsigned* bar, volatile LAS unsigned* st) {
    XcdBarrier b; b.bar = bar; b.x = xb_xcc_id(); b.st = st;
    if (threadIdx.x == 0) (void)xb_add(&bar[XB_XCNT(b.x)], 1u);
    return b;
}
__device__ __forceinline__ void xcd_barrier_complete(unsigned* bar, unsigned x, unsigned& nloc, unsigned& nx) {
    const unsigned G = gridDim.x * gridDim.y * gridDim.z;
    unsigned sum, cnt, mine, sp = 0u;
    for (;;) {
        sum = 0u; cnt = 0u; mine = 0u;
#pragma unroll
        for (unsigned j = 0; j < 16; ++j) { const unsigned c = xb_ld(&bar[XB_XCNT(j)]); sum += c; cnt += (c > 0u) ? 1u : 0u; mine = (j == x) ? c : mine; }
        if (sum == G) break;
        __builtin_amdgcn_s_sleep(1);
        if ((++sp & 255u) == 0u) { if (xb_ld(&bar[XB_TMO])) break; if (sp > XB_SPIN_CAP) { atomicAdd(&bar[XB_TMO], 1u); break; } }
    }
    nloc = mine > 0u ? mine : 1u; nx = cnt > 0u ? cnt : 1u;
}
__device__ __forceinline__ void xcd_barrier(const XcdBarrier& b) {
    asm volatile("s_waitcnt vmcnt(0)" ::: "memory");
    __syncthreads();
    if (threadIdx.x == 0) {
        unsigned* bar = b.bar;
        __builtin_amdgcn_s_waitcnt(0);
        unsigned nloc = b.st[0], nx = b.st[1];
        if (nloc == 0u) { xcd_barrier_complete(bar, b.x, nloc, nx); b.st[0] = nloc; b.st[1] = nx; }
        const unsigned old = xb_add(&bar[XB_XSUB(b.x)], 1u);
        const unsigned gen = old / nloc;
        if (old + 1u == (gen + 1u) * nloc) {
            __builtin_amdgcn_fence(__ATOMIC_RELEASE, "agent");
            asm volatile("s_waitcnt vmcnt(0)" ::: "memory");
            const unsigned og = xb_add(&bar[XB_TOP], 1u);
            const unsigned tg = og / nx;
            if (og + 1u == (tg + 1u) * nx) xb_add(&bar[XB_TOPGEN], 1u);
            else XB_SPIN(xb_ld(&bar[XB_TOPGEN]) == tg, bar);
            __builtin_amdgcn_fence(__ATOMIC_ACQUIRE, "agent");
            xb_add(&bar[XB_XGEN(b.x)], 1u);
            asm volatile("s_waitcnt vmcnt(0)" ::: "memory");
        } else {
            XB_SPIN(xb_ld(&bar[XB_XGEN(b.x)]) == gen, bar);
            __builtin_amdgcn_fence(__ATOMIC_ACQUIRE, "agent");
            asm volatile("s_waitcnt vmcnt(0)" ::: "memory");
        }
    }
    __syncthreads();
}

namespace pg8 {
constexpr int BM = 256, BK = 64, HALF = 128, HTB = HALF * BK * 2, STAGE_BYTES = 8 * HTB, NXCD = 8, WGM = 8;
__host__ __device__ __forceinline__ int lds_byte(int r, int c) { const int st = (r >> 4) * 2 + (c >> 5), rr = r & 15, cc = c & 31, ob = rr * 64 + cc * 2; return st * 1024 + (ob ^ (((ob >> 9) & 1) << 5)); }
__host__ __device__ __forceinline__ void stage_rc(int b, int& R, int& C) { const int st = b / 1024, sb = b % 1024, swz = sb ^ (((sb >> 9) & 1) << 5); R = (st >> 1) * 16 + swz / 64; C = (st & 1) * 32 + (swz % 64) / 2; }
__host__ __device__ __forceinline__ int perm32(int rho) { const int n = rho >> 4, i = rho & 15; return 8 * (i >> 2) + 4 * n + (i & 3); }
struct Unit { int pm, pn, pc; };
struct Gemm { const bf16* A; const bf16* Bt; int K; };

struct StaticOrder {
    int nM, nN, nwg, G, c;
    __device__ void init(int M, int N, int G_, int c_) { nM = M / BM; nN = N / BM; nwg = nM * nN; G = G_; c = c_; }
    __device__ bool next(int i, Unit& u) const {
        const long L = (long)i * G + c; if (L >= nwg) return false;
        int wgid = (int)L; { const int q = nwg / NXCD, r = nwg % NXCD, xcd = wgid % NXCD, off = wgid / NXCD; wgid = (xcd < r ? xcd * (q + 1) : r * (q + 1) + (xcd - r) * q) + off; }
        const int nig = WGM * nN, gid = wgid / nig, fm = gid * WGM, gsz = (nM - fm) < WGM ? (nM - fm) : WGM;
        u.pm = fm + ((wgid % nig) % gsz); u.pn = (wgid % nig) / gsz; u.pc = u.pn; return true;
    }
};
struct MoeOrder {
    int G, c, npt, total; const LAS int* tp;
    __device__ bool next(int i, Unit& u) const {
        const int L = i * G + c; if (L >= total) return false;
        const int mt = L / npt, nl = L % npt; int e = 0;
        while (e < 31 && tp[e + 1] <= mt) ++e;
        u.pm = mt; u.pn = e * npt + nl; u.pc = nl; return true;
    }
};

struct MoeDownOrder {
    int G, c, H, L, dh, dl, nD, j0, lo, hi; const LAS int* tp;
    __device__ void init(int G_, int c_, int T, const LAS int* tp_) { G = G_; c = c_; tp = tp_; j0 = 0; lo = 0;
        const int nU = 2 * T; nD = 4 * T; hi = nD; H = nU % G; L = G - H; dh = (nD - 3 * L + G - 1) / G; if (dh < 0) dh = 0; dl = dh + 3; }
    __device__ int unit_index(int j) const {
        const int quota = (c < H) ? dh : dl; if (j >= quota) return -1;
        const int idx = (j < dh) ? j * G + c : dh * G + (j - dh) * L + (c - H); return idx < nD ? idx : -1; }
    __device__ bool next(int i, Unit& u) const {
        const int idx = unit_index(j0 + i); if (idx < lo || idx >= hi) return false;
        const int mt = idx >> 2, nl = idx & 3; int e = 0;
        while (e < 31 && tp[e + 1] <= mt) ++e;
        u.pm = mt; u.pn = e * 4 + nl; u.pc = nl; return true;
    }
    __device__ __forceinline__ void wait(unsigned* cnt, unsigned* tmo) const {
        if (__builtin_amdgcn_readfirstlane(threadIdx.x >> 6) == 0) {
            for (int i = 0; i < 16; ++i) { const int idx = unit_index(j0 + i); if (idx < lo || idx >= hi) break;
                GAS unsigned* p = (GAS unsigned*)cnt + 64 * (idx >> 2); unsigned n = 0;
                while ((unsigned)__builtin_amdgcn_readfirstlane(__hip_atomic_load(p, __ATOMIC_RELAXED, __HIP_MEMORY_SCOPE_AGENT)) < 16u) {
                    __builtin_amdgcn_s_sleep(2);
                    if (++n > (1u << 20)) { __hip_atomic_store((GAS unsigned*)tmo, 1u, __ATOMIC_RELAXED, __HIP_MEMORY_SCOPE_AGENT); break; } } }
            __builtin_amdgcn_fence(__ATOMIC_ACQUIRE, "agent");
            asm volatile("s_waitcnt vmcnt(0)" ::: "memory");
        }
        __syncthreads();
    }
};

__device__ __forceinline__ unsigned cvt_pk_bf16(float lo, float hi) { unsigned r; asm volatile("v_cvt_pk_bf16_f32 %0, %1, %2" : "=v"(r) : "v"(lo), "v"(hi)); return r; }

template <bool NT> struct EpiBf16StoreT {
    static constexpr bool PERM = true, WIDE = false;
    bf16* O; int ldc;
    __device__ __forceinline__ void operator()(const f32x4 (&acc)[2][2][4][2], const Unit& u, int wr, int wc, int fr, int fq) const {
        const int row0 = u.pm * BM + wr * 64 + fr, col0 = u.pc * BM + wc * 32 + 8 * fq;
#pragma unroll
        for (int ai = 0; ai < 2; ++ai)
#pragma unroll
            for (int m = 0; m < 4; ++m) { bf16* rowp = O + (size_t)(row0 + ai * HALF + m * 16) * ldc + col0;
#pragma unroll
                for (int bj = 0; bj < 2; ++bj) { const f32x4 v0 = acc[ai][bj][m][0], v1 = acc[ai][bj][m][1];
                    u32x4 w; w.x = cvt_pk_bf16(v0[0], v0[1]); w.y = cvt_pk_bf16(v0[2], v0[3]); w.z = cvt_pk_bf16(v1[0], v1[1]); w.w = cvt_pk_bf16(v1[2], v1[3]);
                    if constexpr (NT) __builtin_nontemporal_store(w, (u32x4*)(rowp + bj * HALF)); else *(u32x4*)(rowp + bj * HALF) = w; } }
    }
};
typedef EpiBf16StoreT<false> EpiBf16Store;
__device__ __forceinline__ unsigned dpp_ror8(unsigned x) { return (unsigned)__builtin_amdgcn_update_dpp(0, (int)x, 0x128, 0xf, 0xf, false); }
struct EpiBf16WideNT {
    static constexpr bool PERM = true, WIDE = true;
    bf16* O; int ldc;
    __device__ __forceinline__ void operator()(const f32x4 (&acc)[2][2][4][2], const Unit& u, int wr, int wc, int fr, int fq) const {
        const bool lo = fr < 8;
        const int row0 = u.pm * BM + wr * 64 + (fr & 7), col0 = u.pc * BM + wc * 64 + 8 * fq;
        const int cx = lo ? 0 : 32, cy = lo ? 32 : 0;
#pragma unroll
        for (int ai = 0; ai < 2; ++ai)
#pragma unroll
            for (int m = 0; m < 4; ++m) { bf16* rowp = O + (size_t)(row0 + ai * HALF + m * 16) * ldc + col0;
                u32x4 p0, p1, q;
                { const f32x4 v0 = acc[ai][0][m][0], v1 = acc[ai][0][m][1]; p0.x = cvt_pk_bf16(v0[0], v0[1]); p0.y = cvt_pk_bf16(v0[2], v0[3]); p0.z = cvt_pk_bf16(v1[0], v1[1]); p0.w = cvt_pk_bf16(v1[2], v1[3]); }
                { const f32x4 v0 = acc[ai][1][m][0], v1 = acc[ai][1][m][1]; p1.x = cvt_pk_bf16(v0[0], v0[1]); p1.y = cvt_pk_bf16(v0[2], v0[3]); p1.z = cvt_pk_bf16(v1[0], v1[1]); p1.w = cvt_pk_bf16(v1[2], v1[3]); }
                q.x = dpp_ror8(p1.x); q.y = dpp_ror8(p1.y); q.z = dpp_ror8(p1.z); q.w = dpp_ror8(p1.w);
                u32x4 x, y; x.x = lo ? p0.x : q.x; x.y = lo ? p0.y : q.y; x.z = lo ? p0.z : q.z; x.w = lo ? p0.w : q.w; y.x = lo ? q.x : p0.x; y.y = lo ? q.y : p0.y; y.z = lo ? q.z : p0.z; y.w = lo ? q.w : p0.w;
                __builtin_nontemporal_store(x, (u32x4*)(rowp + cx)); __builtin_nontemporal_store(y, (u32x4*)(rowp + (size_t)8 * ldc + cy)); }
    }
};
struct EpiSwiGLU {
    static constexpr bool PERM = true, WIDE = false;
    bf16* O; unsigned* cnt;
    __device__ __forceinline__ void operator()(const f32x4 (&acc)[2][2][4][2], const Unit& u, int wr, int wc, int fr, int fq) const {
        const int row0 = u.pm * BM + wr * 64 + fr, col0 = u.pc * HALF + wc * 32 + 8 * fq;
#pragma unroll
        for (int ai = 0; ai < 2; ++ai)
#pragma unroll
            for (int m = 0; m < 4; ++m) { bf16* rowp = O + (size_t)(row0 + ai * HALF + m * 16) * DEXP + col0;
                float h[8];
#pragma unroll
                for (int n = 0; n < 2; ++n)
#pragma unroll
                    for (int j = 0; j < 4; ++j) { const float g = acc[ai][0][m][n][j], up = acc[ai][1][m][n][j]; h[n * 4 + j] = g * __builtin_amdgcn_rcpf(1.0f + __builtin_amdgcn_exp2f(-1.4426950408889634f * g)) * up; }
                const unsigned long long w0 = (unsigned long long)cvt_pk_bf16(h[0], h[1]) | ((unsigned long long)cvt_pk_bf16(h[2], h[3]) << 32), w1 = (unsigned long long)cvt_pk_bf16(h[4], h[5]) | ((unsigned long long)cvt_pk_bf16(h[6], h[7]) << 32);
                GAS unsigned long long* gp = (GAS unsigned long long*)rowp;
                __hip_atomic_store(gp, w0, __ATOMIC_RELAXED, __HIP_MEMORY_SCOPE_AGENT);
                __hip_atomic_store(gp + 1, w1, __ATOMIC_RELAXED, __HIP_MEMORY_SCOPE_AGENT); }
        asm volatile("s_waitcnt vmcnt(0)" ::: "memory");
        if ((threadIdx.x & 63) == 0) __hip_atomic_fetch_add((GAS unsigned*)cnt + 64 * u.pm, 1u, __ATOMIC_RELAXED, __HIP_MEMORY_SCOPE_AGENT);
    }
};
template <bool RES_BF16> struct EpiResGateB {
    static constexpr bool PERM = true, WIDE = false;
    const void* res; bf16* out; const float* gate;
    __device__ __forceinline__ void operator()(const f32x4 (&acc)[2][2][4][2], const Unit& u, int wr, int wc, int fr, int fq) const {
        const int row0 = u.pm * BM + wr * 64 + fr, col0 = u.pc * BM + wc * 32 + 8 * fq;
        const float* gb = gate + (size_t)(u.pm >> 4) * 6144;
        f32x4 gv[2][2];
#pragma unroll
        for (int bj = 0; bj < 2; ++bj)
#pragma unroll
            for (int n = 0; n < 2; ++n) gv[bj][n] = *(const f32x4*)(gb + col0 + bj * HALF + n * 4);
#pragma unroll
        for (int ai = 0; ai < 2; ++ai)
#pragma unroll
            for (int m = 0; m < 4; ++m) { const size_t off = (size_t)(row0 + ai * HALF + m * 16) * D + col0;
#pragma unroll
                for (int bj = 0; bj < 2; ++bj) { f32x4 r0, r1;
                    if constexpr (RES_BF16) { const u32x4 rr = *(const u32x4*)((const bf16*)res + off + bj * HALF);
                        r0 = (f32x4){bflo(rr.x), bfhi(rr.x), bflo(rr.y), bfhi(rr.y)}; r1 = (f32x4){bflo(rr.z), bfhi(rr.z), bflo(rr.w), bfhi(rr.w)}; }
                    else { r0 = *(const f32x4*)((const float*)res + off + bj * HALF); r1 = *(const f32x4*)((const float*)res + off + bj * HALF + 4); }
                    const f32x4 v0 = r0 + gv[bj][0] * acc[ai][bj][m][0], v1 = r1 + gv[bj][1] * acc[ai][bj][m][1];
                    u32x4 w; w.x = cvt_pk_bf16(v0[0], v0[1]); w.y = cvt_pk_bf16(v0[2], v0[3]); w.z = cvt_pk_bf16(v1[0], v1[1]); w.w = cvt_pk_bf16(v1[2], v1[3]);
                    *(u32x4*)(out + off + bj * HALF) = w; } }
    }
};
struct EpiResGate {
    static constexpr bool PERM = false, WIDE = false;
    const float* res; float* out; const float* gate;
    __device__ __forceinline__ void operator()(const f32x4 (&acc)[2][2][4][2], const Unit& u, int wr, int wc, int fr, int fq) const {
        const int row0 = u.pm * BM + wr * 64 + fr, col0 = u.pc * BM + wc * 32 + 4 * fq;
        const float* gb = gate + (size_t)(u.pm >> 4) * 6144;
        f32x4 gv[2][2];
#pragma unroll
        for (int bj = 0; bj < 2; ++bj)
#pragma unroll
            for (int n = 0; n < 2; ++n) gv[bj][n] = *(const f32x4*)(gb + col0 + bj * HALF + n * 16);
#pragma unroll
        for (int ai = 0; ai < 2; ++ai)
#pragma unroll
            for (int m = 0; m < 4; ++m) { const size_t off = (size_t)(row0 + ai * HALF + m * 16) * D + col0;
#pragma unroll
                for (int bj = 0; bj < 2; ++bj)
#pragma unroll
                    for (int n = 0; n < 2; ++n) { const f32x4 r = *(const f32x4*)(res + off + bj * HALF + n * 16); *(f32x4*)(out + off + bj * HALF + n * 16) = r + gv[bj][n] * acc[ai][bj][m][n]; } }
    }
};

template <class Epi, class Sched, bool GATHER>
__device__ __forceinline__ void gemm_phase(LAS unsigned char* lds, const Gemm g, const Sched& S, const Epi& E, const LAS int* gidx) {
    const int tid = threadIdx.x, wid = __builtin_amdgcn_readfirstlane(tid >> 6), lane = tid & 63, wr = wid >> 2, wc = wid & 3, fr = lane & 15, fq = lane >> 4;
    const int K = g.K, nt = K / BK;
    unsigned voffA[2], voffB[2];
#pragma unroll
    for (int i = 0; i < 2; ++i) { int R, C; stage_rc(tid * 16 + i * 8192, R, C); const int Rb = Epi::WIDE ? ((R >> 5) * 64 + perm32(R & 31)) : Epi::PERM ? ((R & ~31) + perm32(R & 31)) : R;
        voffA[i] = (unsigned)(R * K + C) * 2u; voffB[i] = (unsigned)(Rb * K + C) * 2u; }
    const size_t kstep = (size_t)(BK * 2);
    const size_t hstep = (size_t)HALF * K * 2;
    const size_t tstep = 2 * hstep;
    const size_t hstepB = Epi::WIDE ? (size_t)32 * K * 2 : hstep;
    const unsigned ldsw = (unsigned)wid * 1024u;
    const int aoff = lds_byte(wr * 64 + fr, fq * 8), boff = lds_byte(wc * 32 + fr, fq * 8);
    int nslot = 0;
#define PG8_SA(b, h) (((b) * 2 + (h)) * HTB)
#define PG8_SB(b, h) ((4 + (b) * 2 + (h)) * HTB)
#define PG8_GLDS(gp, lp) __builtin_amdgcn_global_load_lds((const unsigned*)(gp), (LAS unsigned*)(lp), 16, 0, 0)
#define PG8_STAGE(bufoff, gbase, voff) do { _Pragma("unroll") for (int _i = 0; _i < 2; ++_i) PG8_GLDS((const char*)(gbase) + (voff)[_i], lds + (bufoff) + ldsw + _i * 8192); } while (0)
#define PG8_STAGE_A(bufoff, gptr, h, nx) do { if constexpr (GATHER) { const int _slot = (nx) ? nslot : ui; _Pragma("unroll") for (int _i = 0; _i < 2; ++_i) { int _R, _C; stage_rc(tid * 16 + _i * 8192, _R, _C); \
            const unsigned _vo = (unsigned)gidx[_slot * 256 + (h) * HALF + _R] + (unsigned)_C * 2u; PG8_GLDS((const char*)(gptr) + _vo, lds + (bufoff) + ldsw + _i * 8192); } } \
        else { PG8_STAGE(bufoff, (const char*)(gptr) + (h) * hstep, voffA); } } while (0)
#define PG8_LDA(dst, b, h) do { _Pragma("unroll") for (int m = 0; m < 4; ++m) _Pragma("unroll") for (int k = 0; k < 2; ++k) dst[m][k] = *(const LAS bf16x8*)(lds + PG8_SA(b, h) + aoff + m * 2048 + k * 1024); } while (0)
#define PG8_LDB(dst, b, h) do { _Pragma("unroll") for (int n = 0; n < 2; ++n) _Pragma("unroll") for (int k = 0; k < 2; ++k) dst[n][k] = *(const LAS bf16x8*)(lds + PG8_SB(b, h) + boff + n * 2048 + k * 1024); } while (0)
#define PG8_MMA(ai, bj, At, Bt) do { __builtin_amdgcn_s_setprio(1); _Pragma("unroll") for (int m = 0; m < 4; ++m) _Pragma("unroll") for (int n = 0; n < 2; ++n) _Pragma("unroll") for (int k = 0; k < 2; ++k) \
        acc[ai][bj][m][n] = __builtin_amdgcn_mfma_f32_16x16x32_bf16(Bt[n][k], At[m][k], acc[ai][bj][m][n], 0, 0, 0); __builtin_amdgcn_s_setprio(0); } while (0)
#define PG8_WAIT_V(n) asm volatile("s_waitcnt vmcnt(" #n ")" ::: "memory")
#define PG8_WAIT_L(n) asm volatile("s_waitcnt lgkmcnt(" #n ")" ::: "memory")
#define PG8_BAR __builtin_amdgcn_s_barrier()
#define PG8_SCHED __builtin_amdgcn_sched_barrier(0)
    Unit cur, nxt; int ui = 0;
    if (!S.next(0, cur)) return;
    f32x4 acc[2][2][4][2];
#pragma unroll
    for (int a = 0; a < 2; ++a)
#pragma unroll
        for (int b = 0; b < 2; ++b)
#pragma unroll
            for (int m = 0; m < 4; ++m)
#pragma unroll
                for (int n = 0; n < 2; ++n) acc[a][b][m][n] = (f32x4){0.f, 0.f, 0.f, 0.f};
    bf16x8 At[4][2], B0[2][2], B1[2][2];
    const char* cA = (const char*)g.A + (GATHER ? (size_t)0 : (size_t)cur.pm * tstep); const char* cB = (const char*)g.Bt + (size_t)cur.pn * tstep;
    PG8_STAGE(PG8_SB(0, 0), cB, voffB); PG8_STAGE(PG8_SB(0, 1), cB + hstepB, voffB); PG8_STAGE_A(PG8_SA(0, 0), cA, 0, false); PG8_STAGE_A(PG8_SA(0, 1), cA, 1, false);
    if (wr == 1) PG8_BAR;
    PG8_WAIT_V(2); PG8_BAR;
    PG8_STAGE(PG8_SB(1, 0), cB + kstep, voffB); PG8_STAGE_A(PG8_SA(1, 0), cA + kstep, 0, false); PG8_STAGE(PG8_SB(1, 1), cB + hstepB + kstep, voffB);
    PG8_WAIT_V(6); PG8_BAR;
    for (;;) {
        const bool has_next = S.next(ui + 1, nxt);
        const char* nA = has_next ? (const char*)g.A + (GATHER ? (size_t)0 : (size_t)nxt.pm * tstep) : cA; const char* nB = has_next ? (const char*)g.Bt + (size_t)nxt.pn * tstep : cB;
        if constexpr (GATHER) nslot = has_next ? ui + 1 : ui;
        for (int t = 0; t < nt; t += 2) {
            const bool last = (t == nt - 2);
            const char* a1 = cA + (size_t)(t + 1) * kstep;
            const char* a2 = last ? nA : cA + (size_t)(t + 2) * kstep; const char* b2 = last ? nB : cB + (size_t)(t + 2) * kstep;
            const char* a3 = a2 + kstep; const char* b3 = b2 + kstep;
            PG8_LDB(B0, 0, 0); PG8_LDB(B1, 0, 1); PG8_SCHED; PG8_LDA(At, 0, 0); PG8_STAGE_A(PG8_SA(1, 1), a1, 1, false);
            PG8_WAIT_V(8); PG8_WAIT_L(0); PG8_BAR; PG8_MMA(0, 0, At, B0); PG8_MMA(0, 1, At, B1); PG8_BAR; PG8_SCHED;
            PG8_LDA(At, 0, 1); PG8_STAGE(PG8_SB(0, 0), b2, voffB); PG8_STAGE(PG8_SB(0, 1), b2 + hstepB, voffB); PG8_STAGE_A(PG8_SA(0, 0), a2, 0, last);
            PG8_WAIT_V(8); PG8_WAIT_L(0); PG8_BAR; PG8_MMA(1, 0, At, B0); PG8_MMA(1, 1, At, B1); PG8_BAR; PG8_SCHED;
            PG8_LDB(B0, 1, 0); PG8_LDB(B1, 1, 1); PG8_SCHED; PG8_LDA(At, 1, 0); PG8_STAGE_A(PG8_SA(0, 1), a2, 1, last);
            PG8_WAIT_V(8); PG8_WAIT_L(0); PG8_BAR; PG8_MMA(0, 0, At, B0); PG8_MMA(0, 1, At, B1); PG8_BAR; PG8_SCHED;
            PG8_LDA(At, 1, 1); PG8_STAGE(PG8_SB(1, 0), b3, voffB); PG8_STAGE(PG8_SB(1, 1), b3 + hstepB, voffB); PG8_STAGE_A(PG8_SA(1, 0), a3, 0, last);
            PG8_WAIT_V(8); PG8_WAIT_L(0); PG8_BAR; PG8_MMA(1, 0, At, B0); PG8_MMA(1, 1, At, B1); PG8_BAR; PG8_SCHED;
        }
        if (wr == 0) PG8_BAR;
        E(acc, cur, wr, wc, fr, fq);
        if (!has_next) break;
#pragma unroll
        for (int a = 0; a < 2; ++a)
#pragma unroll
            for (int b = 0; b < 2; ++b)
#pragma unroll
                for (int m = 0; m < 4; ++m)
#pragma unroll
                    for (int n = 0; n < 2; ++n) acc[a][b][m][n] = (f32x4){0.f, 0.f, 0.f, 0.f};
        cur = nxt; cA = nA; cB = nB; ++ui;
        if (wr == 1) PG8_BAR;
    }
    PG8_WAIT_V(0);
    PG8_BAR;
#undef PG8_SA
#undef PG8_SB
#undef PG8_GLDS
#undef PG8_STAGE
#undef PG8_STAGE_A
#undef PG8_LDA
#undef PG8_LDB
#undef PG8_MMA
#undef PG8_WAIT_V
#undef PG8_WAIT_L
#undef PG8_BAR
#undef PG8_SCHED
}
}

struct Args { const float* in[23]; float* out; unsigned char* ws; float inv_freq[32]; int ph_lo, ph_hi; };
enum { I_X = 0, I_C, I_POS, I_WADA, I_BADA, I_NMIX, I_NFFN, I_WIN, I_RETN, I_HGRNN, I_LBL, I_WA2, I_BA, I_GLAN, I_WOUT, I_RGW, I_RGB, I_REW, I_REB, I_EG, I_EU, I_ED, I_NFIN };
constexpr int PH_PER_LAYER = 8, PH_FINAL = 1 + 2 * PH_PER_LAYER, N_PHASES = PH_FINAL + 1;

typedef const __attribute__((address_space(4))) Args KArgs;
#define KARGS(ap) KArgs* ap = (KArgs*)__builtin_amdgcn_kernarg_segment_ptr(); asm volatile("" : "+s"(ap))
#define PHASE_IDS() int tid = threadIdx.x; asm volatile("" : "+v"(tid)); const int lane = tid & 63, wave = __builtin_amdgcn_readfirstlane(tid >> 6); \
    const int G = gridDim.x, bid = blockIdx.x, gw = bid * 8 + wave, NGW = G * 8; (void)lane; (void)wave; (void)gw; (void)NGW; (void)G; (void)bid

__device__ __forceinline__ void transpose_item(const float* W, int ldw, int K, int k0, int n0, bf16* WT, int dst_row0, LAS float* scr, int lane) {
#pragma unroll 8
    for (int i = 0; i < 32; ++i) { const int kk = 2 * i + (lane >> 5); scr[kk * 33 + (lane & 31)] = W[(size_t)(k0 + kk) * ldw + n0 + (lane & 31)]; }
    LDS_WAIT(); asm volatile("" ::: "memory");
    const int c = lane & 7;
#pragma unroll
    for (int j = 0; j < 4; ++j) { const int n = (lane >> 3) + 8 * j; const LAS float* s = scr + (8 * c) * 33 + n;
        u32x4 o; o.x = pk2(s[0 * 33], s[1 * 33]); o.y = pk2(s[2 * 33], s[3 * 33]); o.z = pk2(s[4 * 33], s[5 * 33]); o.w = pk2(s[6 * 33], s[7 * 33]);
        *(u32x4*)(WT + (size_t)(dst_row0 + n) * K + k0 + 8 * c) = o; }
    LDS_WAIT(); asm volatile("" ::: "memory");
}
__device__ __forceinline__ void transpose_item64(const float* W, int ldw, int K, int k0, int n0, bf16* WT, int dst_row0, LAS float* scr, int lane) {
    const int lr = lane >> 4, lc = (lane & 15) * 4;
    f32x4 v[16];
#pragma unroll
    for (int i = 0; i < 16; ++i) v[i] = *(const f32x4*)(W + (size_t)(k0 + 4 * i + lr) * ldw + n0 + lc);
#pragma unroll
    for (int i = 0; i < 16; ++i) { LAS float* d = scr + (4 * i + lr) * 65 + lc; d[0] = v[i][0]; d[1] = v[i][1]; d[2] = v[i][2]; d[3] = v[i][3]; }
    LDS_WAIT(); asm volatile("" ::: "memory");
    const int c = lane & 7;
#pragma unroll
    for (int j = 0; j < 8; ++j) { const int n = (lane >> 3) + 8 * j; const LAS float* sp = scr + (8 * c) * 65 + n;
        u32x4 o; o.x = pk2(sp[0 * 65], sp[1 * 65]); o.y = pk2(sp[2 * 65], sp[3 * 65]); o.z = pk2(sp[4 * 65], sp[5 * 65]); o.w = pk2(sp[6 * 65], sp[7 * 65]);
        *(u32x4*)(WT + (size_t)(dst_row0 + n) * K + k0 + 8 * c) = o; }
    LDS_WAIT(); asm volatile("" ::: "memory");
}
__device__ __forceinline__ void convert_experts(LAS unsigned char* lds, KArgs* ap, int layer, int first, int stride, int wave, int lane) {
    unsigned char* ws = ap->ws;
    bf16* WGU_T = (bf16*)(ws + WS_WGU); bf16* WD_T = (bf16*)(ws + WS_WD);
    LAS float* scr = (LAS float*)(lds + wave * 16640);
    constexpr int I_G = 16 * 4, I_D = 4 * 16;
    for (int it = first; it < 32 * (2 * I_G + I_D); it += stride) {
        int r = it;
        if (r < 32 * I_G * 2) { const int up = r / (32 * I_G); r %= 32 * I_G; const int e = r / I_G; r %= I_G; const int kb = r / 4, nb = r % 4, n0 = nb * 64;
            transpose_item64(ap->in[up ? I_EU : I_EG] + ((size_t)layer * NEXP + e) * D * DEXP, DEXP, D, kb * 64, n0, WGU_T + ((size_t)layer * NEXP + e) * 512 * D, (n0 >> 7) * 256 + (n0 & 127) + up * 128, scr, lane); }
        else { r -= 32 * I_G * 2; const int e = r / I_D; r %= I_D; const int kb = r / 16, nb = r % 16;
            transpose_item64(ap->in[I_ED] + ((size_t)layer * NEXP + e) * DEXP * D, D, DEXP, kb * 64, nb * 64, WD_T + ((size_t)layer * NEXP + e) * D * DEXP, nb * 64, scr, lane); }
    }
}
__device__ __forceinline__ void sincos_acc(float a, float& s, float& c) {
    const double ad = (double)a; const double kd = rint(ad * 0.63661977236758134308); const double rd = fma(-kd, 1.57079632679489661923, ad);
    const int q = (int)kd & 3; const float r = (float)rd, r2 = r * r;
    const float sp = r + r * r2 * (-1.6666667163e-1f + r2 * (8.3333337680e-3f + r2 * (-1.9841270114e-4f + r2 * 2.7557314297e-6f)));
    const float cp = 1.0f + r2 * (-0.5f + r2 * (4.1666667908e-2f + r2 * (-1.3888889225e-3f + r2 * (2.4801587642e-5f + r2 * -2.7557314297e-7f))));
    const float ss = (q & 1) ? cp : sp, cc = (q & 1) ? sp : cp;
    s = (q & 2) ? -ss : ss; c = ((q + 1) & 2) ? -cc : cc;
}

template <int TYPE>
__device__ __forceinline__ void naive_mixer_item(LAS unsigned char* lds, KArgs* ap, int layer, int b, int hh  , int tid) {
    constexpr int DK = (TYPE == 2) ? 32 : 64, DKW = DK / 8;
    LAS float* Qs = (LAS float*)lds; LAS float* Ks = Qs + 4096; LAS float* As = Ks + 4096; LAS float* Vs = As + 4096; LAS float* Os = Vs + 4096; LAS float* Ps = Os + 4096;
    unsigned char* ws = ap->ws;
    const bf16* PROJ = (const bf16*)(ws + WS_PROJ); bf16* H = (bf16*)(ws + WS_H);
    const unsigned* ROPE = (const unsigned*)(ws + WS_ROPE);
    const float* lbl = ap->in[I_LBL]; const float* gba = ap->in[I_BA];
    const int e = tid & 63, w = tid >> 6;
    const int qc = (TYPE == 0 ? C_RQ + hh * 64 : TYPE == 1 ? C_HQ + hh * 64 : C_GQ + hh * 32);
    const int kc = (TYPE == 0 ? C_RK + hh * 64 : TYPE == 1 ? C_HF + hh * 64 : C_GK + hh * 32);
    const int vc = (TYPE == 0 ? C_RV : TYPE == 1 ? C_HI : C_GV) + hh * 64;
    const int gc = (TYPE == 0 ? C_RG : TYPE == 1 ? C_HG : C_GG) + hh * 64;
    const int mc = (TYPE == 0 ? 0 : TYPE == 1 ? 384 : 768) + hh * 64;
    const float* gain = ap->in[TYPE == 0 ? I_RETN : TYPE == 1 ? I_HGRNN : I_GLAN] + layer * (TYPE == 2 ? 256 : 384) + hh * 64;
    float S[DKW];
#pragma unroll
    for (int i = 0; i < DKW; ++i) S[i] = 0.f;
    for (int n = 0; n < 64; ++n) {
        __syncthreads();
        const size_t row0 = (size_t)b * SEQ + (size_t)n * 64;
        for (int idx = tid; idx < 4096; idx += 512) {
            const int t = idx >> 6, d = idx & 63; const bf16* p = PROJ + (row0 + t) * NPROJ;
            Vs[idx] = bf2f(p[vc + d]);
            if (TYPE == 0) {
                const int j = d & 31; const unsigned csw = ROPE[(row0 + t) * 32 + j]; const f32x2 cs = (f32x2){bflo(csw), bfhi(csw)};
                const float q1 = bf2f(p[qc + j]), q2 = bf2f(p[qc + 32 + j]), k1 = bf2f(p[kc + j]), k2 = bf2f(p[kc + 32 + j]);
                Qs[idx] = d < 32 ? q1 * cs.x - q2 * cs.y : q1 * cs.y + q2 * cs.x;
                Ks[idx] = (d < 32 ? k1 * cs.x - k2 * cs.y : k1 * cs.y + k2 * cs.x) * 0.125f;
                As[idx] = 1.0f - exp2f(-5.0f - (float)hh);
            } else if (TYPE == 1) {
                const float l0 = lbl[hh * 64 + d], l1 = lbl[384 + hh * 64 + d]; const float mx = fmaxf(l0, l1), e0 = expf(l0 - mx), e1 = expf(l1 - mx);
                const float lb = layer == 0 ? 0.f : e1 / (e0 + e1);
                const float z = bf2f(p[kc + d]); const float f = lb + (1.0f - lb) * sigmoidf_(z);
                As[idx] = fmaxf(f, 1e-30f); Ks[idx] = (1.0f - lb) * sigmoidf_(-z); Qs[idx] = siluf_(bf2f(p[qc + d])) * 0.125f;
            } else {
                if (d < 32) { const float pre = bf2f(p[C_GA + hh * 32 + d]) + gba[layer * 128 + hh * 32 + d];
                    const float ls = fminf(pre, 0.f) - log1pf(expf(-fabsf(pre)));
                    As[t * 64 + d] = expf(ls * (1.0f / 16.0f)); Ks[t * 64 + d] = bf2f(p[kc + d]); Qs[t * 64 + d] = bf2f(p[qc + d]) * 0.17677669529663687f; }
            }
        }
        __syncthreads();
        for (int t0 = 0; t0 < 64; t0 += 16) {
            for (int tt = 0; tt < 16; ++tt) { const int t = t0 + tt; const float v = Vs[t * 64 + e]; float part = 0.f;
#pragma unroll
                for (int i = 0; i < DKW; ++i) { const int d = w * DKW + i; S[i] = As[t * 64 + d] * S[i] + Ks[t * 64 + d] * v; part += Qs[t * 64 + d] * S[i]; }
                Ps[(tt * 8 + w) * 64 + e] = part; }
            __syncthreads();
            for (int idx = tid; idx < 1024; idx += 512) { const int tt = idx >> 6, ee = idx & 63; float o = 0.f;
#pragma unroll
                for (int ww = 0; ww < 8; ++ww) o += Ps[(tt * 8 + ww) * 64 + ee];
                Os[(t0 + tt) * 64 + ee] = o; }
            __syncthreads();
        }
        for (int tt = 0; tt < 8; ++tt) { const int t = w * 8 + tt; const float o = Os[t * 64 + e]; const float ss = wave_sum(o * o); const float r = rsqrtf(ss * (1.0f / 64.0f) + EPS);
            const float g = bf2f(PROJ[(row0 + t) * NPROJ + gc + e]);
            H[(row0 + t) * D + mc + e] = (bf16)f2bf(o * r * gain[e] * siluf_(g)); }
    }
}

constexpr int MX_PITCH = 72;
constexpr int MX_ARR = 64 * MX_PITCH * 2;
constexpr int MX_GROUP_BYTES = 5 * MX_ARR + 5 * 256 + 256;
constexpr int NSC = 4, NCH = 64 / NSC;
constexpr int ST_REC = 4096 + 64;
__device__ __forceinline__ float bfx(const u32x4& r, int i) { const unsigned w = r[i >> 1]; return (i & 1) ? bfhi(w) : bflo(w); }
__device__ __forceinline__ unsigned short bfbits(const u32x4& r, int i) { const unsigned w = r[i >> 1]; return (unsigned short)((i & 1) ? (w >> 16) : (w & 0xffffu)); }

template <int TYPE, int MODE>
__device__ __forceinline__ void mixer_chunked(LAS unsigned char* lds, KArgs* ap, int layer, int b, int head  , int hh  , int sc, int tid) {
    constexpr int DK = (TYPE == 2) ? 32 : 64, NKS = DK / 32;
    constexpr bool FULL = (MODE == 1);
    const int lane = tid & 63, wv = __builtin_amdgcn_readfirstlane(tid >> 6), gid = wv >> 2, w = wv & 3, col = lane & 15, rg = lane >> 4;
    int gbo = gid * MX_GROUP_BYTES; asm volatile("" : "+v"(gbo));
    LAS unsigned char* gb = lds + gbo;
    LAS bf16* Qt = (LAS bf16*)gb; LAS bf16* Kt = Qt + 64 * MX_PITCH; LAS bf16* KT = Kt + 64 * MX_PITCH; LAS bf16* VT = KT + 64 * MX_PITCH; LAS bf16* ST = VT + 64 * MX_PITCH;
    LAS float* EM = (LAS float*)(gb + 5 * MX_ARR); LAS float* EL = EM + 64; LAS float* ELM = EL + 64; LAS float* LBt = ELM + 64; LAS float* OMLt = LBt + 64;
    unsigned char* ws = ap->ws;
    const bf16* PROJ = (const bf16*)(ws + WS_PROJ); bf16* H = (bf16*)(ws + WS_H);
    float* STATE = (float*)(ws + WS_STATE) + (size_t)((b * 16 + head) * NSC) * ST_REC;
    const int qc = (TYPE == 0 ? C_RQ + hh * 64 : TYPE == 1 ? C_HQ + hh * 64 : C_GQ + hh * 32);
    const int kc = (TYPE == 0 ? C_RK + hh * 64 : TYPE == 1 ? C_HF + hh * 64 : C_GK + hh * 32);
    const int vc = (TYPE == 0 ? C_RV : TYPE == 1 ? C_HI : C_GV) + hh * 64;
    const int gc = (TYPE == 0 ? C_RG : TYPE == 1 ? C_HG : C_GG) + hh * 64;
    const int mc = (TYPE == 0 ? 0 : TYPE == 1 ? 384 : 768) + hh * 64;
    const float lgam = (TYPE == 0) ? log1pf(-exp2f(-5.0f - (float)hh)) * LOG2E : 0.f;
    float gba[16];
    if constexpr (TYPE == 2) { int zl = 0; asm volatile("" : "+v"(zl)); const float* gbap = ap->in[I_BA] + layer * 128 + hh * 32 + 16 * (w & 1) + zl;
#pragma unroll
        for (int p = 0; p < 16; ++p) gba[p] = gbap[p]; }
    if constexpr (TYPE == 1) {
        if (w == 0) { const float* lbl = ap->in[I_LBL]; const float l0 = lbl[hh * 64 + lane], l1 = lbl[384 + hh * 64 + lane]; const float mx = fmaxf(l0, l1), e0 = expf(l0 - mx), e1 = expf(l1 - mx);
            const float lb = layer == 0 ? 0.f : e1 / (e0 + e1); LBt[lane] = lb; OMLt[lane] = 1.0f - lb; }
    }
    f32x4 gn4[4];
    if constexpr (FULL) { const float* gain = ap->in[TYPE == 0 ? I_RETN : TYPE == 1 ? I_HGRNN : I_GLAN] + layer * (TYPE == 2 ? 256 : 384) + hh * 64;
#pragma unroll
        for (int et = 0; et < 4; ++et) gn4[et] = *(const f32x4*)(gain + 16 * et + 4 * rg); }
    const bool owner = (w < DK / 16);
    f32x4 S[4];
    f32x4 Gacc = (f32x4){1.f, 1.f, 1.f, 1.f};
#pragma unroll
    for (int et = 0; et < 4; ++et) S[et] = (f32x4){0.f, 0.f, 0.f, 0.f};
    if constexpr (FULL) { if (owner) { for (int j = 0; j < sc; ++j) { const float* rec = STATE + (size_t)j * ST_REC; const f32x4 gj = *(const f32x4*)(rec + 4096 + 16 * w + 4 * rg);
#pragma unroll
                for (int et = 0; et < 4; ++et) { const f32x4 sj = *(const f32x4*)(rec + ((w * 4 + et) * 64 + lane) * 4); S[et] = gj * S[et] + sj; } } } }
    const size_t rowbase = (size_t)b * SEQ + (size_t)sc * NCH * 64;
    u32x4 rq[2], rk[2], rv[2], rr[2]; u32x4 dummy[6];
#define MX_LOAD_RAW(n) do { const bf16* p_ = PROJ + (rowbase + (size_t)(n) * 64 + lane) * NPROJ; \
        if constexpr (TYPE == 0) { rk[0] = *(const u32x4*)(p_ + kc + 8 * w); rk[1] = *(const u32x4*)(p_ + kc + 32 + 8 * w); \
            if constexpr (FULL) { rq[0] = *(const u32x4*)(p_ + qc + 8 * w); rq[1] = *(const u32x4*)(p_ + qc + 32 + 8 * w); } \
            const u32x4* rp_ = (const u32x4*)((const unsigned*)(ws + WS_ROPE) + (rowbase + (size_t)(n) * 64 + lane) * 32 + 8 * w); rr[0] = rp_[0]; rr[1] = rp_[1]; } \
        else if constexpr (TYPE == 1) { rk[0] = *(const u32x4*)(p_ + kc + 16 * w); rk[1] = *(const u32x4*)(p_ + kc + 16 * w + 8); \
            if constexpr (FULL) { rq[0] = *(const u32x4*)(p_ + qc + 16 * w); rq[1] = *(const u32x4*)(p_ + qc + 16 * w + 8); } } \
        else { if (w < 2) { rk[0] = *(const u32x4*)(p_ + kc + 16 * w); rk[1] = *(const u32x4*)(p_ + kc + 16 * w + 8); rr[0] = *(const u32x4*)(p_ + C_GA + hh * 32 + 16 * w); rr[1] = *(const u32x4*)(p_ + C_GA + hh * 32 + 16 * w + 8); \
                            if constexpr (FULL) { rq[0] = *(const u32x4*)(p_ + qc + 16 * w); rq[1] = *(const u32x4*)(p_ + qc + 16 * w + 8); } } } \
        rv[0] = *(const u32x4*)(p_ + vc + 16 * w); rv[1] = *(const u32x4*)(p_ + vc + 16 * w + 8); \
        if (PROBE_TA && !FULL) { _Pragma("unroll") for (int x_ = 0; x_ < 6; ++x_) { dummy[x_] = *(const volatile u32x4*)(p_ + vc + 16 * w + 8 * (x_ & 1)); } } } while (0)
    MX_LOAD_RAW(0);
    __syncthreads();
    if (gid == 1) __syncthreads();
    for (int n = 0; n < NCH; ++n) {
        float em4[4];
        if (PROBE_TA && !FULL) { _Pragma("unroll") for (int x_ = 0; x_ < 6; ++x_) asm volatile("" :: "v"(dummy[x_])); }
        {
            float Qr[16], Kr[16];
            if constexpr (TYPE == 0) {
                const float sq = fexp2((float)(lane - 31) * lgam), sk = fexp2((float)(31 - lane) * lgam) * 0.125f;
#pragma unroll
                for (int i = 0; i < 8; ++i) { const unsigned csw = rr[i >> 2][i & 3]; const float cs = bflo(csw), sn = bfhi(csw);
                    const float k1 = bfx(rk[0], i), k2 = bfx(rk[1], i);
                    Kr[i] = (k1 * cs - k2 * sn) * sk; Kr[8 + i] = (k1 * sn + k2 * cs) * sk;
                    if constexpr (FULL) { const float q1 = bfx(rq[0], i), q2 = bfx(rq[1], i); Qr[i] = (q1 * cs - q2 * sn) * sq; Qr[8 + i] = (q1 * sn + q2 * cs) * sq; } }
                const float em = fexp2(32.0f * lgam);
#pragma unroll
                for (int i = 0; i < 4; ++i) em4[i] = em;
                if (lane < 16) { EL[16 * w + lane] = fexp2(64.0f * lgam); ELM[16 * w + lane] = em; }
            } else if (TYPE == 1 || w < 2) {
                float c[16]; float myM = 0.f, myL = 0.f;
                if constexpr (TYPE == 1) {
                    const f32x4 lb0 = *(const LAS f32x4*)(LBt + 16 * w), lb1 = *(const LAS f32x4*)(LBt + 16 * w + 4), lb2 = *(const LAS f32x4*)(LBt + 16 * w + 8), lb3 = *(const LAS f32x4*)(LBt + 16 * w + 12);
                    const f32x4 om0 = *(const LAS f32x4*)(OMLt + 16 * w), om1 = *(const LAS f32x4*)(OMLt + 16 * w + 4), om2 = *(const LAS f32x4*)(OMLt + 16 * w + 8), om3 = *(const LAS f32x4*)(OMLt + 16 * w + 12);
#pragma unroll
                    for (int p = 0; p < 16; ++p) { const float lb = (p < 4 ? lb0 : p < 8 ? lb1 : p < 12 ? lb2 : lb3)[p & 3], om = (p < 4 ? om0 : p < 8 ? om1 : p < 12 ? om2 : om3)[p & 3];
                        const float z = bfx(rk[p >> 3], p & 7); const float sg = sigmoidf_(z);
                        const float f = lb + om * sg; c[p] = flog2(fmaxf(f, 1e-30f)); Kr[p] = om * (1.0f - sg);
                        if constexpr (FULL) { const float qv = bfx(rq[p >> 3], p & 7); Qr[p] = siluf_(qv) * 0.125f; } }
                } else {
#pragma unroll
                    for (int p = 0; p < 16; ++p) { const float pre = bfx(rr[p >> 3], p & 7) + gba[p];
                        c[p] = (fminf(pre, 0.f) * LOG2E - flog2(1.0f + fexp2(-LOG2E * fabsf(pre)))) * (1.0f / 16.0f); Kr[p] = bfx(rk[p >> 3], p & 7);
                        if constexpr (FULL) Qr[p] = bfx(rq[p >> 3], p & 7) * 0.17677669529663687f; }
                }
#pragma unroll
                for (int p = 0; p < 16; p += 4) wave_incl_scan4(c[p], c[p + 1], c[p + 2], c[p + 3]);
#pragma unroll
                for (int p = 0; p < 16; ++p) { const float m = rdlane(c[p], 31), cl = rdlane(c[p], 63); Kr[p] *= fexp2(m - c[p]);
                    if constexpr (FULL) Qr[p] *= fexp2(c[p] - m);
                    myM = (lane == p) ? m : myM; myL = (lane == p) ? cl : myL; }
                if (lane < 16) { EM[16 * w + lane] = fexp2(myM); EL[16 * w + lane] = fexp2(myL); ELM[16 * w + lane] = fexp2(myL - myM); }
                if constexpr (FULL) { LDS_WAIT();
                    const f32x4 e4 = *(const LAS f32x4*)(EM + 16 * w + 4 * rg);
#pragma unroll
                    for (int i = 0; i < 4; ++i) em4[i] = e4[i]; }
            } else {
#pragma unroll
                for (int i = 0; i < 4; ++i) em4[i] = 0.f;
            }
            if (TYPE != 2 || w < 2) {
                u32x4 k0, k1;
                k0.x = pg8::cvt_pk_bf16(Kr[0], Kr[1]); k0.y = pg8::cvt_pk_bf16(Kr[2], Kr[3]); k0.z = pg8::cvt_pk_bf16(Kr[4], Kr[5]); k0.w = pg8::cvt_pk_bf16(Kr[6], Kr[7]);
                k1.x = pg8::cvt_pk_bf16(Kr[8], Kr[9]); k1.y = pg8::cvt_pk_bf16(Kr[10], Kr[11]); k1.z = pg8::cvt_pk_bf16(Kr[12], Kr[13]); k1.w = pg8::cvt_pk_bf16(Kr[14], Kr[15]);
                if constexpr (FULL) {
                    u32x4 q0, q1;
                    q0.x = pg8::cvt_pk_bf16(Qr[0], Qr[1]); q0.y = pg8::cvt_pk_bf16(Qr[2], Qr[3]); q0.z = pg8::cvt_pk_bf16(Qr[4], Qr[5]); q0.w = pg8::cvt_pk_bf16(Qr[6], Qr[7]);
                    q1.x = pg8::cvt_pk_bf16(Qr[8], Qr[9]); q1.y = pg8::cvt_pk_bf16(Qr[10], Qr[11]); q1.z = pg8::cvt_pk_bf16(Qr[12], Qr[13]); q1.w = pg8::cvt_pk_bf16(Qr[14], Qr[15]);
                    *(LAS u32x4*)(Qt + lane * MX_PITCH + 16 * w) = q0; *(LAS u32x4*)(Qt + lane * MX_PITCH + 16 * w + 8) = q1;
                    *(LAS u32x4*)(Kt + lane * MX_PITCH + 16 * w) = k0; *(LAS u32x4*)(Kt + lane * MX_PITCH + 16 * w + 8) = k1; }
#pragma unroll
                for (int p = 0; p < 16; ++p) KT[(16 * w + p) * MX_PITCH + lane] = bfbits(p < 8 ? k0 : k1, p & 7);
            }
#pragma unroll
            for (int p = 0; p < 16; ++p) VT[(16 * w + p) * MX_PITCH + lane] = bfbits(rv[p >> 3], p & 7);
            if constexpr (FULL) { if (owner) {
#pragma unroll
                for (int et = 0; et < 4; ++et) { u32x2 o; o.x = pg8::cvt_pk_bf16(S[et][0] * em4[0], S[et][1] * em4[1]); o.y = pg8::cvt_pk_bf16(S[et][2] * em4[2], S[et][3] * em4[3]);
                    *(LAS u32x2*)(ST + (16 * et + col) * MX_PITCH + 16 * w + 4 * rg) = o; } } }
        }
        __syncthreads();
        const size_t trow = rowbase + (size_t)n * 64 + 16 * w + col;
        u32x2 gt[4];
        if constexpr (FULL) {
#pragma unroll
            for (int et = 0; et < 4; ++et) gt[et] = *(const u32x2*)(PROJ + trow * NPROJ + gc + 16 * et + 4 * rg); }
        if (n + 1 < NCH) { MX_LOAD_RAW(n + 1); }
        f32x4 OT[4];
        if constexpr (FULL) {
            bf16x8 Bq[NKS];
#pragma unroll
            for (int ks = 0; ks < NKS; ++ks) Bq[ks] = *(const LAS bf16x8*)(Qt + (16 * w + col) * MX_PITCH + 32 * ks + 8 * rg);
            f32x4 PT[4];
#pragma unroll
            for (int st = 0; st < 4; ++st) { PT[st] = (f32x4){0.f, 0.f, 0.f, 0.f};
                if (st <= w) {
#pragma unroll
                    for (int ks = 0; ks < NKS; ++ks) { const bf16x8 af = *(const LAS bf16x8*)(Kt + (16 * st + col) * MX_PITCH + 32 * ks + 8 * rg); PT[st] = __builtin_amdgcn_mfma_f32_16x16x32_bf16(af, Bq[ks], PT[st], 0, 0, 0); }
                    if (st == w) {
#pragma unroll
                        for (int i = 0; i < 4; ++i) PT[st][i] = (4 * rg + i > col) ? 0.f : PT[st][i]; }
                } }
            u32x4 pb0, pb1;
            pb0.x = pg8::cvt_pk_bf16(PT[0][0], PT[0][1]); pb0.y = pg8::cvt_pk_bf16(PT[0][2], PT[0][3]); pb0.z = pg8::cvt_pk_bf16(PT[1][0], PT[1][1]); pb0.w = pg8::cvt_pk_bf16(PT[1][2], PT[1][3]);
            pb1.x = pg8::cvt_pk_bf16(PT[2][0], PT[2][1]); pb1.y = pg8::cvt_pk_bf16(PT[2][2], PT[2][3]); pb1.z = pg8::cvt_pk_bf16(PT[3][0], PT[3][1]); pb1.w = pg8::cvt_pk_bf16(PT[3][2], PT[3][3]);
#pragma unroll
            for (int et = 0; et < 4; ++et) { OT[et] = (f32x4){0.f, 0.f, 0.f, 0.f};
#pragma unroll
                for (int ks = 0; ks < NKS; ++ks) { const bf16x8 af = *(const LAS bf16x8*)(ST + (16 * et + col) * MX_PITCH + 32 * ks + 8 * rg); OT[et] = __builtin_amdgcn_mfma_f32_16x16x32_bf16(af, Bq[ks], OT[et], 0, 0, 0); }
                { const u32x2 a0 = *(const LAS u32x2*)(VT + (16 * et + col) * MX_PITCH + 4 * rg), a1 = *(const LAS u32x2*)(VT + (16 * et + col) * MX_PITCH + 16 + 4 * rg);
                  u32x4 av; av.x = a0.x; av.y = a0.y; av.z = a1.x; av.w = a1.y;
                  OT[et] = __builtin_amdgcn_mfma_f32_16x16x32_bf16(__builtin_bit_cast(bf16x8, av), __builtin_bit_cast(bf16x8, pb0), OT[et], 0, 0, 0); }
                if (w >= 2) { const u32x2 a0 = *(const LAS u32x2*)(VT + (16 * et + col) * MX_PITCH + 32 + 4 * rg), a1 = *(const LAS u32x2*)(VT + (16 * et + col) * MX_PITCH + 48 + 4 * rg);
                  u32x4 av; av.x = a0.x; av.y = a0.y; av.z = a1.x; av.w = a1.y;
                  OT[et] = __builtin_amdgcn_mfma_f32_16x16x32_bf16(__builtin_bit_cast(bf16x8, av), __builtin_bit_cast(bf16x8, pb1), OT[et], 0, 0, 0); }
            }
        }
        if (owner) {
            const f32x4 el = *(const LAS f32x4*)(EL + 16 * w + 4 * rg), elm = *(const LAS f32x4*)(ELM + 16 * w + 4 * rg);
#pragma unroll
            for (int et = 0; et < 4; ++et) { f32x4 W = (f32x4){0.f, 0.f, 0.f, 0.f};
#pragma unroll
                for (int ks = 0; ks < 2; ++ks) { const bf16x8 af = *(const LAS bf16x8*)(KT + (16 * w + col) * MX_PITCH + 32 * ks + 8 * rg), bfr = *(const LAS bf16x8*)(VT + (16 * et + col) * MX_PITCH + 32 * ks + 8 * rg);
                    W = __builtin_amdgcn_mfma_f32_16x16x32_bf16(af, bfr, W, 0, 0, 0); }
                S[et] = el * S[et] + elm * W; }
            if constexpr (!FULL) Gacc = Gacc * el;
        }
        if constexpr (FULL) {
            float ss = 0.f;
#pragma unroll
            for (int et = 0; et < 4; ++et) ss += (OT[et][0] * OT[et][0] + OT[et][1] * OT[et][1]) + (OT[et][2] * OT[et][2] + OT[et][3] * OT[et][3]);
            ss += __shfl_xor(ss, 16); ss += __shfl_xor(ss, 32);
            const float r = rsqrtf(ss * (1.0f / 64.0f) + EPS);
#pragma unroll
            for (int et = 0; et < 4; ++et) { const f32x4 g4 = gn4[et];
                const float g0 = bflo(gt[et].x), g1 = bfhi(gt[et].x), g2 = bflo(gt[et].y), g3 = bfhi(gt[et].y);
                const float o0 = OT[et][0] * r * g4[0] * siluf_(g0), o1 = OT[et][1] * r * g4[1] * siluf_(g1);
                const float o2 = OT[et][2] * r * g4[2] * siluf_(g2), o3 = OT[et][3] * r * g4[3] * siluf_(g3);
                u32x2 o; o.x = pg8::cvt_pk_bf16(o0, o1); o.y = pg8::cvt_pk_bf16(o2, o3);
                *(u32x2*)(H + trow * D + mc + 16 * et + 4 * rg) = o; }
        }
        __syncthreads();
    }
    if (gid == 0) __syncthreads();
    if constexpr (!FULL) { if (owner) { float* rec = STATE + (size_t)sc * ST_REC;
#pragma unroll
            for (int et = 0; et < 4; ++et) *(f32x4*)(rec + ((w * 4 + et) * 64 + lane) * 4) = S[et];
            if (col == 0) *(f32x4*)(rec + 4096 + 16 * w + 4 * rg) = Gacc; } }
#undef MX_LOAD_RAW
}

template <int MODE>
__device__ __forceinline__ void phase_mixer(LAS unsigned char* lds, int layer) {
    KARGS(ap); PHASE_IDS();
    constexpr int NS = (MODE == 0) ? NSC - 1 : NSC;
    constexpr int NPAIRS = NB * 8 * NS;
    for (int pr = bid; pr < NPAIRS; pr += G) {
        const int sc = pr % NS, hp = (pr / NS) & 7, b = pr / (NS * 8), hd = 2 * hp + (wave >> 2);
        if (hp < 3) mixer_chunked<0, MODE>(lds, ap, layer, b, hd, hd, sc, tid);
        else if (hp < 6) mixer_chunked<1, MODE>(lds, ap, layer, b, hd, hd - 6, sc, tid);
        else mixer_chunked<2, MODE>(lds, ap, layer, b, hd, hd - 12, sc, tid);
        __syncthreads();
    }
    if constexpr (MODE == 0) {
        const int nidle = G - NPAIRS;
        if (nidle > 0) { if (bid >= NPAIRS) convert_experts(lds, ap, layer, (bid - NPAIRS) * 8 + wave, nidle * 8, wave, lane); }
        else convert_experts(lds, ap, layer, gw, NGW, wave, lane);
    }
}

__device__ __forceinline__ void build_tp(LAS int* TP, const unsigned* cnt, int tid) {
    if (tid == 0) { int s = 0; for (int e = 0; e < 32; ++e) { TP[e] = s; s += ((int)cnt[e] + 255) >> 8; } TP[32] = s; }
    __syncthreads();
}

__device__ __forceinline__ void phase_prologue(LAS unsigned char* lds) {
    KARGS(ap); PHASE_IDS();
    unsigned char* ws = ap->ws;
    if (bid < 192) {
        float* MOD = (float*)(ws + WS_MOD);
        const float* cin = ap->in[I_C]; const float* wada = ap->in[I_WADA]; const float* bada = ap->in[I_BADA];
        LAS float* cact = (LAS float*)lds;
        for (int i = tid; i < 8192; i += 512) { const int b = i >> 10, k = i & 1023; cact[k * 8 + b] = siluf_(cin[i]); }
        __syncthreads();
        LAS float* red = (LAS float*)(lds + 32768);
        const int kr = lane >> 4, c4 = (lane & 15) * 4;
        for (int it = bid; it < 192; it += G) {
            const int l = it / 96, j0 = (it % 96) * 64; const float* W = wada + (size_t)l * D * 6144 + j0 + c4;
            f32x4 acc[8];
#pragma unroll
            for (int b = 0; b < 8; ++b) acc[b] = (f32x4){0.f, 0.f, 0.f, 0.f};
#pragma unroll 8
            for (int i = 0; i < 32; ++i) { const int k = wave * 128 + 4 * i + kr; const f32x4 wv = *(const f32x4*)(W + (size_t)k * 6144);
                const f32x4 c0 = *(const LAS f32x4*)(cact + k * 8), c1 = *(const LAS f32x4*)(cact + k * 8 + 4);
                acc[0] += c0[0] * wv; acc[1] += c0[1] * wv; acc[2] += c0[2] * wv; acc[3] += c0[3] * wv; acc[4] += c1[0] * wv; acc[5] += c1[1] * wv; acc[6] += c1[2] * wv; acc[7] += c1[3] * wv; }
#pragma unroll
            for (int b = 0; b < 8; ++b) *(LAS f32x4*)(red + ((wave * 4 + kr) * 8 + b) * 64 + c4) = acc[b];
            __syncthreads();
            { const int b = tid >> 6, col = tid & 63; float s = 0.f;
#pragma unroll
              for (int p = 0; p < 32; ++p) s += red[(p * 8 + b) * 64 + col];
              MOD[((size_t)l * 8 + b) * 6144 + j0 + col] = s + bada[l * 6144 + j0 + col]; }
            __syncthreads();
        }
    }
    __syncthreads();
    {
        bf16* WIN_T = (bf16*)(ws + WS_WIN); bf16* WOUT_T = (bf16*)(ws + WS_WOUT);
        LAS float* scr = (LAS float*)(lds + wave * 16384);
        constexpr int I_IN = 16 * 120, I_OUT = 16 * 32;
        constexpr int PER_L = I_IN + I_OUT;
        for (int it = gw; it < 2 * PER_L; it += NGW) {
            const int l = it / PER_L; int r = it % PER_L;
            if (r < I_IN) { const int kb = r / 120, nb = r % 120; transpose_item(ap->in[I_WIN] + (size_t)l * D * INP, INP, D, kb * 64, nb * 32, WIN_T + (size_t)l * NPROJ * D, nb * 32, scr, lane); continue; } r -= I_IN;
            { const int kb = r / 32, nb = r % 32; transpose_item(ap->in[I_WOUT] + (size_t)l * D * D, D, D, kb * 64, nb * 32, WOUT_T + (size_t)l * D * D, nb * 32, scr, lane); }
        }
        const float* win = ap->in[I_WIN]; const float* wa2 = ap->in[I_WA2];
        for (int it = bid * 512 + tid; it < 2 * 256 * 128; it += G * 512) {
            const int l = it / (256 * 128), r = it % (256 * 128), n = r / 128, k0 = (r % 128) * 8;
            float o[8];
#pragma unroll
            for (int j = 0; j < 8; ++j) o[j] = 0.f;
            if (n < 128) {
#pragma unroll
                for (int j = 0; j < 8; ++j) { const float* wr_ = win + (size_t)l * D * INP + (size_t)(k0 + j) * INP + 3840; float s = 0.f;
#pragma unroll
                    for (int rr = 0; rr < 16; ++rr) s += wr_[rr] * wa2[l * 16 * 128 + rr * 128 + n];
                    o[j] = s; } }
            u32x4 w; w.x = pk2(o[0], o[1]); w.y = pk2(o[2], o[3]); w.z = pk2(o[4], o[5]); w.w = pk2(o[6], o[7]);
            *(u32x4*)(WIN_T + (size_t)l * NPROJ * D + (size_t)(3840 + n) * D + k0) = w;
        }
    }
    {
        unsigned* ROPE = (unsigned*)(ws + WS_ROPE); const int* posp = (const int*)ap->in[I_POS];
        for (int it = bid * 512 + tid; it < MTOK * 32; it += G * 512) {
            const int row = it >> 5, j = it & 31; const int pos = posp[row];
            const float ang = (float)pos * ap->inv_freq[j]; float s, c; sincos_acc(ang, s, c); ROPE[it] = pk2(c, s);
        }
    }
}

template <int MODE>
__device__ __forceinline__ void phase_norm1(LAS unsigned char* lds, int layer) {
    KARGS(ap); PHASE_IDS();
    unsigned char* ws = ap->ws; float* outp = ap->out;
    const float* MOD = (const float*)(ws + WS_MOD); bf16* H = (bf16*)(ws + WS_H); const bf16* YP = (const bf16*)(ws + WS_YP);
    const int* ROUTE_I = (const int*)(ws + WS_ROUTE); const float* ROUTE_W = (const float*)(ws + WS_ROUTE + 4 * MTOK * 4);
    LAS int* TP = (LAS int*)(lds + TP_OFF);
    const int pl = (MODE == 2) ? DEPTH - 1 : layer - 1;
    if (MODE != 0) build_tp(TP, (const unsigned*)(ws + WS_CTL) + CW_CNT + pl * 64, tid);
    const float* xin = ap->in[I_X]; const bf16* xb16 = (const bf16*)(ws + WS_XB); bf16* x2 = (bf16*)outp;
    const float* gn = MODE == 2 ? ap->in[I_NFIN] : ap->in[I_NMIX] + layer * D;
    for (int rb = bid; rb < MTOK / 128; rb += G) {
        const int row0 = rb * 128 + wave * 16, b = row0 >> 12;
        f32x4 Av[4], Bv[4], Gf[4];
#pragma unroll
        for (int j = 0; j < 4; ++j) { const int c0 = 4 * lane + 256 * j; Av[j] = *(const f32x4*)(gn + c0);
            if (MODE != 2) { const float* mb = MOD + (size_t)layer * 8 * 6144 + (size_t)b * 6144; const f32x4 sc = *(const f32x4*)(mb + D + c0); Bv[j] = *(const f32x4*)(mb + c0); Av[j] = Av[j] * (1.0f + sc); }
            if (MODE != 0) Gf[j] = *(const f32x4*)(MOD + (size_t)pl * 8 * 6144 + (size_t)b * 6144 + 5 * D + c0); }
        for (int r = 0; r < 16; r += 2) {
            f32x4 v[2][4];
#pragma unroll
            for (int q = 0; q < 2; ++q)
#pragma unroll
                for (int j = 0; j < 4; ++j) { if (MODE == 0) v[q][j] = *(const f32x4*)(xin + (size_t)(row0 + r + q) * D + 4 * lane + 256 * j);
                    else { const u32x2 xv = *(const u32x2*)(xb16 + (size_t)(row0 + r + q) * D + 4 * lane + 256 * j); v[q][j] = (f32x4){bflo(xv.x), bfhi(xv.x), bflo(xv.y), bfhi(xv.y)}; } }
            if (MODE != 0) {
                u32x2 y0[2][4], y1[2][4]; float w0[2], w1[2];
#pragma unroll
                for (int q = 0; q < 2; ++q) { const int m = row0 + r + q; const int e0 = ROUTE_I[m], e1 = ROUTE_I[MTOK + m], r0 = ROUTE_I[2 * MTOK + m], r1 = ROUTE_I[3 * MTOK + m]; w0[q] = ROUTE_W[m]; w1[q] = ROUTE_W[MTOK + m];
                    const bf16* p0 = YP + (size_t)(TP[e0] * 256 + r0) * D; const bf16* p1 = YP + (size_t)(TP[e1] * 256 + r1) * D;
#pragma unroll
                    for (int j = 0; j < 4; ++j) { y0[q][j] = *(const u32x2*)(p0 + 4 * lane + 256 * j); y1[q][j] = *(const u32x2*)(p1 + 4 * lane + 256 * j); } }
#pragma unroll
                for (int q = 0; q < 2; ++q)
#pragma unroll
                    for (int j = 0; j < 4; ++j) { const u32x2 a0 = y0[q][j], a1 = y1[q][j];
                        v[q][j][0] += Gf[j][0] * (w0[q] * bflo(a0.x) + w1[q] * bflo(a1.x)); v[q][j][1] += Gf[j][1] * (w0[q] * bfhi(a0.x) + w1[q] * bfhi(a1.x));
                        v[q][j][2] += Gf[j][2] * (w0[q] * bflo(a0.y) + w1[q] * bflo(a1.y)); v[q][j][3] += Gf[j][3] * (w0[q] * bfhi(a0.y) + w1[q] * bfhi(a1.y));
                        if (MODE == 1) { u32x2 xo; xo.x = pk2(v[q][j][0], v[q][j][1]); xo.y = pk2(v[q][j][2], v[q][j][3]); *(u32x2*)(x2 + (size_t)(row0 + r + q) * D + 4 * lane + 256 * j) = xo; } }
            }
            float ss[2];
#pragma unroll
            for (int q = 0; q < 2; ++q) { float s = 0.f;
#pragma unroll
                for (int j = 0; j < 4; ++j) s += (v[q][j][0] * v[q][j][0] + v[q][j][1] * v[q][j][1]) + (v[q][j][2] * v[q][j][2] + v[q][j][3] * v[q][j][3]);
                ss[q] = s; }
            ss[0] = wave_sum(ss[0]); ss[1] = wave_sum(ss[1]);
#pragma unroll
            for (int q = 0; q < 2; ++q) { const float rstd = rsqrtf(ss[q] * (1.0f / D) + EPS); const size_t m = (size_t)(row0 + r + q);
#pragma unroll
                for (int j = 0; j < 4; ++j) { const int c0 = 4 * lane + 256 * j;
                    if (MODE == 2) { *(f32x4*)(outp + m * D + c0) = v[q][j] * rstd * Av[j]; }
                    else { const f32x4 y = (v[q][j] * rstd) * Av[j] + Bv[j]; u32x2 o; o.x = pk2(y[0], y[1]); o.y = pk2(y[2], y[3]); *(u32x2*)(H + m * D + c0) = o; } } }
        }
    }
}

__device__ __forceinline__ void phase_inproj(LAS unsigned char* lds, int layer) {
    KARGS(ap); unsigned char* ws = ap->ws;
    pg8::Gemm g{(const bf16*)(ws + WS_H), (const bf16*)(ws + WS_WIN) + (size_t)layer * NPROJ * D, D}; pg8::StaticOrder S; S.init(MTOK, NPROJ, gridDim.x, blockIdx.x);
    pg8::EpiBf16WideNT E{(bf16*)(ws + WS_PROJ), NPROJ};
    pg8::gemm_phase<pg8::EpiBf16WideNT, pg8::StaticOrder, false>(lds, g, S, E, nullptr);
}
__device__ __forceinline__ void phase_mixer_naive(LAS unsigned char* lds, int layer) {
    KARGS(ap); PHASE_IDS();
    for (int it = bid; it < NB * 16; it += G) {
        const int b = it >> 4, hd = it & 15;
        if (hd < 6) naive_mixer_item<0>(lds, ap, layer, b, hd, tid);
        else if (hd < 12) naive_mixer_item<1>(lds, ap, layer, b, hd - 6, tid);
        else naive_mixer_item<2>(lds, ap, layer, b, hd - 12, tid);
        __syncthreads();
    }
}
__device__ __forceinline__ void phase_outproj(LAS unsigned char* lds, int layer) {
    KARGS(ap); unsigned char* ws = ap->ws;
    pg8::Gemm g{(const bf16*)(ws + WS_H), (const bf16*)(ws + WS_WOUT) + (size_t)layer * D * D, D}; pg8::StaticOrder S; S.init(MTOK, D, gridDim.x, blockIdx.x);
    const float* gate = (const float*)(ws + WS_MOD) + (size_t)layer * 8 * 6144 + 2 * D;
    if (layer == 0) { pg8::EpiResGateB<false> E{ap->in[I_X], (bf16*)(ws + WS_XB), gate}; pg8::gemm_phase<pg8::EpiResGateB<false>, pg8::StaticOrder, false>(lds, g, S, E, nullptr); }
    else { pg8::EpiResGateB<true> E{ap->out, (bf16*)(ws + WS_XB), gate}; pg8::gemm_phase<pg8::EpiResGateB<true>, pg8::StaticOrder, false>(lds, g, S, E, nullptr); }
}
constexpr int WR_PITCH = 1032;
__device__ __forceinline__ void phase_norm2_router(LAS unsigned char* lds, int layer) {
    KARGS(ap); PHASE_IDS();
    unsigned char* ws = ap->ws; const bf16* xres = (const bf16*)(ws + WS_XB);
    bf16* H = (bf16*)(ws + WS_H);
    int* ROUTE_I = (int*)(ws + WS_ROUTE); float* ROUTE_W = (float*)(ws + WS_ROUTE + 4 * MTOK * 4); int* IDX2 = (int*)(ws + WS_IDX2);
    unsigned* cntl = (unsigned*)(ws + WS_CTL) + CW_CNT + layer * 64;
    LAS bf16* Wr = (LAS bf16*)lds;
    LAS float* LG = (LAS float*)(lds + 99072);
    LAS float* AB = (LAS float*)(lds + 119552);
    LAS int* HIST = (LAS int*)(lds + 127744); LAS int* BASE = HIST + 32; LAS int* RI = BASE + 32; LAS float* RW = (LAS float*)(RI + 128 * 4);
    { const float* rgw = ap->in[I_RGW] + (size_t)layer * D * 4; const float* rew = ap->in[I_REW] + (size_t)layer * D * 32;
      for (int i = tid; i < 32 * 1024; i += 512) { const int k = i >> 5, n = i & 31; Wr[(4 + n) * WR_PITCH + k] = (bf16)f2bf(rew[i]); }
      for (int i = tid; i < 4 * 1024; i += 512) { const int k = i >> 2, n = i & 3; Wr[n * WR_PITCH + k] = (bf16)f2bf(rgw[i]); }
      for (int i = tid; i < 12 * 1024; i += 512) { const int n = 36 + (i >> 10), k = i & 1023; Wr[n * WR_PITCH + k] = (bf16)0; } }
    const float* gn = ap->in[I_NFFN] + layer * D; const float* rgb = ap->in[I_RGB] + layer * 4; const float* reb = ap->in[I_REB] + layer * 32;
    const float* modl = (const float*)(ws + WS_MOD) + (size_t)layer * 8 * 6144;
    const int r = lane & 15, kq = lane >> 4;
    for (int rb = bid; rb < MTOK / 128; rb += G) {
        const int row0 = rb * 128 + wave * 16, b = row0 >> 12; const float* mb = modl + (size_t)b * 6144 + 3 * D;
        __syncthreads();
        if (tid < 32) HIST[tid] = 0;
        for (int i = tid; i < 1024; i += 512) { AB[i] = gn[i] * (1.0f + mb[D + i]); AB[1024 + i] = mb[i]; }
        __syncthreads();
        const bf16* xr = xres + (size_t)(row0 + r) * D + 8 * kq;
        float ss = 0.f;
#pragma unroll 16
        for (int ks = 0; ks < 32; ++ks) { const u32x4 xv = *(const u32x4*)(xr + 32 * ks); const f32x4 xa = (f32x4){bflo(xv.x), bfhi(xv.x), bflo(xv.y), bfhi(xv.y)}, xb = (f32x4){bflo(xv.z), bfhi(xv.z), bflo(xv.w), bfhi(xv.w)};
            ss += (xa[0] * xa[0] + xa[1] * xa[1]) + (xa[2] * xa[2] + xa[3] * xa[3]) + (xb[0] * xb[0] + xb[1] * xb[1]) + (xb[2] * xb[2] + xb[3] * xb[3]); }
        ss += __shfl_xor(ss, 16); ss += __shfl_xor(ss, 32);
        const float rstd = rsqrtf(ss * (1.0f / D) + EPS);
        f32x4 acc[3];
#pragma unroll
        for (int nt = 0; nt < 3; ++nt) acc[nt] = (f32x4){0.f, 0.f, 0.f, 0.f};
        bf16* hr = H + (size_t)(row0 + r) * D + 8 * kq;
#pragma unroll 8
        for (int ks = 0; ks < 32; ++ks) { const u32x4 xv = *(const u32x4*)(xr + 32 * ks); const f32x4 xa = (f32x4){bflo(xv.x), bfhi(xv.x), bflo(xv.y), bfhi(xv.y)}, xb = (f32x4){bflo(xv.z), bfhi(xv.z), bflo(xv.w), bfhi(xv.w)};
            const f32x4 a0 = *(const LAS f32x4*)(AB + 32 * ks + 8 * kq), a1 = *(const LAS f32x4*)(AB + 32 * ks + 8 * kq + 4), b0 = *(const LAS f32x4*)(AB + 1024 + 32 * ks + 8 * kq), b1 = *(const LAS f32x4*)(AB + 1024 + 32 * ks + 8 * kq + 4);
            const f32x4 ya = (xa * rstd) * a0 + b0, yb = (xb * rstd) * a1 + b1;
            u32x4 o; o.x = pg8::cvt_pk_bf16(ya[0], ya[1]); o.y = pg8::cvt_pk_bf16(ya[2], ya[3]); o.z = pg8::cvt_pk_bf16(yb[0], yb[1]); o.w = pg8::cvt_pk_bf16(yb[2], yb[3]);
            *(u32x4*)(hr + 32 * ks) = o;
            const bf16x8 af = __builtin_bit_cast(bf16x8, o);
#pragma unroll
            for (int nt = 0; nt < 3; ++nt) { const bf16x8 bfr = *(const LAS bf16x8*)(Wr + (16 * nt + r) * WR_PITCH + 32 * ks + 8 * kq); acc[nt] = __builtin_amdgcn_mfma_f32_16x16x32_bf16(af, bfr, acc[nt], 0, 0, 0); } }
        LAS float* lgw = LG + wave * 16 * 40;
#pragma unroll
        for (int nt = 0; nt < 3; ++nt) { if (16 * nt + r < 40) {
#pragma unroll
            for (int i = 0; i < 4; ++i) lgw[(4 * kq + i) * 40 + 16 * nt + r] = acc[nt][i]; } }
        LDS_WAIT();
        if (lane < 16) {
            const LAS float* lg = lgw + lane * 40;
            float gl[4];
#pragma unroll
            for (int t = 0; t < 4; ++t) gl[t] = lg[t] + rgb[t];
            int gi = 0; float gm = gl[0];
#pragma unroll
            for (int t = 1; t < 4; ++t) if (gl[t] > gm) { gm = gl[t]; gi = t; }
            float gs = 0.f;
#pragma unroll
            for (int t = 0; t < 4; ++t) gs += __expf(gl[t] - gm);
            const float gwt = 1.0f / gs;
            float el[8];
#pragma unroll
            for (int t = 0; t < 8; ++t) el[t] = lg[4 + gi * 8 + t] + reb[gi * 8 + t];
            int i0 = 0; float m0 = el[0];
#pragma unroll
            for (int t = 1; t < 8; ++t) if (el[t] > m0) { m0 = el[t]; i0 = t; }
            int i1 = -1; float m1 = -3.0e38f;
#pragma unroll
            for (int t = 0; t < 8; ++t) if (t != i0 && el[t] > m1) { m1 = el[t]; i1 = t; }
            const float ex = __expf(m1 - m0); const float w0 = gwt / (1.0f + ex), w1 = gwt * ex / (1.0f + ex);
            const int e0 = gi * 8 + i0, e1 = gi * 8 + i1, lr = wave * 16 + lane;
            const int l0 = __hip_atomic_fetch_add(HIST + e0, 1, __ATOMIC_RELAXED, __HIP_MEMORY_SCOPE_WORKGROUP), l1 = __hip_atomic_fetch_add(HIST + e1, 1, __ATOMIC_RELAXED, __HIP_MEMORY_SCOPE_WORKGROUP);
            RI[lr * 4 + 0] = e0; RI[lr * 4 + 1] = e1; RI[lr * 4 + 2] = l0; RI[lr * 4 + 3] = l1; RW[lr * 2 + 0] = w0; RW[lr * 2 + 1] = w1;
        }
        __syncthreads();
        if (tid < 32) { const int c = HIST[tid]; BASE[tid] = c ? (int)atomicAdd(cntl + tid, (unsigned)c) : 0; }
        __syncthreads();
        if (tid < 128) { const int m = rb * 128 + tid; const int e0 = RI[tid * 4 + 0], e1 = RI[tid * 4 + 1]; const int r0 = BASE[e0] + RI[tid * 4 + 2], r1 = BASE[e1] + RI[tid * 4 + 3];
            IDX2[e0 * MTOK + r0] = m; IDX2[e1 * MTOK + r1] = m;
            ROUTE_I[m] = e0; ROUTE_I[MTOK + m] = e1; ROUTE_I[2 * MTOK + m] = r0; ROUTE_I[3 * MTOK + m] = r1; ROUTE_W[m] = RW[tid * 2 + 0]; ROUTE_W[MTOK + m] = RW[tid * 2 + 1]; }
    }
}
__device__ __forceinline__ void phase_moe(LAS unsigned char* lds, int layer) {
    KARGS(ap); unsigned char* ws = ap->ws;
    LAS int* TP = (LAS int*)(lds + TP_OFF); LAS int* AUX = (LAS int*)(lds + AUX_OFF);
    unsigned* ctl = (unsigned*)(ws + WS_CTL);
    const unsigned* cntl = ctl + CW_CNT + layer * 64;
    unsigned* arrive = ctl + CW_MOE + layer * CW_MOE_LAYER;
    { int tid = threadIdx.x; build_tp(TP, cntl, tid);
      pg8::MoeOrder S0; S0.G = gridDim.x; S0.c = blockIdx.x; S0.npt = 2; S0.total = TP[32] * 2; S0.tp = TP;
      const int* IDX2 = (const int*)(ws + WS_IDX2);
      pg8::Unit u; for (int i = 0; i < 8; ++i) { if (!S0.next(i, u)) break; const int e = u.pn >> 1, j = u.pm - TP[e], cnt = (int)cntl[e];
          if (tid < 256) { const int rank = j * 256 + tid; AUX[i * 256 + tid] = (rank < cnt ? IDX2[e * MTOK + rank] : 0) * (D * 2); } }
      __syncthreads(); }
    { pg8::MoeOrder S; S.G = gridDim.x; S.c = blockIdx.x; S.npt = 2; S.total = TP[32] * 2; S.tp = TP;
      pg8::Gemm g{(const bf16*)(ws + WS_H), (const bf16*)(ws + WS_WGU) + (size_t)layer * NEXP * 512 * D, D};
      pg8::EpiSwiGLU E{(bf16*)(ws + WS_HID), arrive};
      pg8::gemm_phase<pg8::EpiSwiGLU, pg8::MoeOrder, true>(lds, g, S, E, AUX); }
    const int T_ = TP[32], split = 4 * ((((2 * T_) / (int)gridDim.x) * (int)gridDim.x) >> 1);
    pg8::Gemm gd{(const bf16*)(ws + WS_HID), (const bf16*)(ws + WS_WD) + (size_t)layer * NEXP * D * DEXP, DEXP};
    pg8::EpiBf16Store Ed{(bf16*)(ws + WS_YP), D};
    pg8::MoeDownOrder S1; S1.init(gridDim.x, blockIdx.x, T_, TP); S1.hi = split;
    int n1 = 0; while (n1 < 16) { const int ix = S1.unit_index(n1); if (ix < 0 || ix >= split) break; ++n1; }
    S1.wait(arrive, ctl + CW_TMO);
    pg8::gemm_phase<pg8::EpiBf16Store, pg8::MoeDownOrder, false>(lds, gd, S1, Ed, nullptr);
    pg8::MoeDownOrder S2; S2.init(gridDim.x, blockIdx.x, T_, TP); S2.lo = split; S2.j0 = n1;
    S2.wait(arrive, ctl + CW_TMO);
    pg8::gemm_phase<pg8::EpiBf16Store, pg8::MoeDownOrder, false>(lds, gd, S2, Ed, nullptr);
}

__global__ void __launch_bounds__(512, 2) fwd(Args a) {
    extern __shared__ __attribute__((aligned(16))) unsigned char lds_raw[];
    LAS unsigned char* lds = (LAS unsigned char*)lds_raw;
    volatile LAS unsigned* MISC = (volatile LAS unsigned*)(lds + LDSCTL_OFF);
    for (int u = threadIdx.x; u < (LDS_BYTES - LDSCTL_OFF) / 4; u += 512) ((LAS unsigned*)(lds + LDSCTL_OFF))[u] = 0u;
    __syncthreads();
#if MK_ONE_LAUNCH
    { unsigned* ctl0 = (unsigned*)(a.ws + WS_CTL); (void)xcd_barrier_post(ctl0 + CW_BAR, MISC + 8); }
    constexpr int lo = 0, hi = N_PHASES;
#define SEAM(k) do { if ((k) + 1 < hi) { KARGS(_ap); XcdBarrier _b; _b.bar = (unsigned*)(_ap->ws + WS_CTL) + CW_BAR; _b.x = xb_xcc_id(); _b.st = (volatile LAS unsigned*)(lds + LDSCTL_OFF) + 8; xcd_barrier(_b); if (PROBE_BAR) xcd_barrier(_b); } } while (0)
#else
    (void)MISC;
    const int lo = a.ph_lo, hi = a.ph_hi;
#define SEAM(k) do { } while (0)
#endif
#define IN(k) (lo <= (k) && (k) < hi)
    if (EN_P0 && IN(0)) { phase_prologue(lds); SEAM(0); if (PROBE_D) { phase_prologue(lds); SEAM(0); } }
#define LAYER_PHASES(layer) do { constexpr int pb = 1 + PH_PER_LAYER * (layer); \
        if (EN_PA && IN(pb + 0)) { if ((layer) == 0) { phase_norm1<0>(lds, (layer)); if (PROBE_A) { SEAM(pb + 0); phase_norm1<0>(lds, (layer)); } } else phase_norm1<1>(lds, (layer)); SEAM(pb + 0); } \
        if (EN_PB && IN(pb + 1)) { phase_inproj(lds, (layer)); SEAM(pb + 1); } \
        if (EN_PC && IN(pb + 2)) { if (!MK_NAIVE_MIXER) phase_mixer<0>(lds, (layer)); SEAM(pb + 2); } \
        if (EN_PC && IN(pb + 3)) { if (MK_NAIVE_MIXER) phase_mixer_naive(lds, (layer)); else phase_mixer<1>(lds, (layer)); SEAM(pb + 3); if (PROBE_M) { phase_mixer<0>(lds, (layer)); SEAM(pb + 3); } if (PROBE_M3) { phase_mixer<1>(lds, (layer)); SEAM(pb + 3); } } \
        if (EN_PD && IN(pb + 4)) { phase_outproj(lds, (layer)); SEAM(pb + 4); if (PROBE_PD && (layer) == 0) { phase_outproj(lds, (layer)); SEAM(pb + 4); } } \
        if (EN_PE && IN(pb + 5)) { phase_norm2_router(lds, (layer)); SEAM(pb + 5); if (PROBE_E) { if (blockIdx.x == 0 && threadIdx.x < 64) { KARGS(_a2); ((unsigned*)(_a2->ws + WS_CTL))[CW_CNT + (layer) * 64 + threadIdx.x] = 0u; } SEAM(pb + 5); phase_norm2_router(lds, (layer)); SEAM(pb + 5); } } \
        if (EN_PG && IN(pb + 6)) { phase_moe(lds, (layer)); SEAM(pb + 7); } } while (0)
    LAYER_PHASES(0);
    LAYER_PHASES(1);
#undef LAYER_PHASES
    if (EN_PF && IN(PH_FINAL)) phase_norm1<2>(lds, 0);
#undef IN
#undef SEAM
}

extern "C" void kernel_launch(void* const* d_in, const int* in_sizes, int n_in, void* d_out, int out_size, void* d_ws, size_t ws_size, hipStream_t stream) {
    static int grid = 0;
    if (grid == 0) {
        if (n_in != 23 || out_size != MTOK * D || ws_size < WS_END) { fprintf(stderr, "kernel_launch: unexpected shapes (n_in %d out %d ws %zu)\n", n_in, out_size, ws_size); grid = -1; return; }
        int dev = 0, cus = 0;
        if (hipGetDevice(&dev) != hipSuccess || hipDeviceGetAttribute(&cus, hipDeviceAttributeMultiprocessorCount, dev) != hipSuccess) { grid = -1; return; }
        if (hipFuncSetAttribute((const void*)fwd, hipFuncAttributeMaxDynamicSharedMemorySize, LDS_BYTES) != hipSuccess) { fprintf(stderr, "kernel_launch: hipFuncSetAttribute failed\n"); grid = -1; return; }
        int per_cu = 0;
        if (hipOccupancyMaxActiveBlocksPerMultiprocessor(&per_cu, (const void*)fwd, 512, LDS_BYTES) != hipSuccess || per_cu < 1) fprintf(stderr, "kernel_launch: occupancy query reports %d\n", per_cu);
        (void)hipGetLastError();
        grid = cus;
    }
    if (grid < 0) return;
    (void)hipMemsetAsync((char*)d_ws + WS_CTL, 0, CTL_ZERO_BYTES, stream);
    Args a{};
    for (int i = 0; i < 23; ++i) a.in[i] = (const float*)d_in[i];
    a.out = (float*)d_out; a.ws = (unsigned char*)d_ws;
    for (int j = 0; j < 32; ++j) a.inv_freq[j] = (float)std::pow(10000.0, -(double)j / 32.0);
#if MK_ONE_LAUNCH
    a.ph_lo = 0; a.ph_hi = N_PHASES;
    hipLaunchKernelGGL(fwd, dim3(grid), dim3(512), LDS_BYTES, stream, a);
#else
    for (int p = 0; p < N_PHASES; ++p) { a.ph_lo = p; a.ph_hi = p + 1; hipLaunchKernelGGL(fwd, dim3(grid), dim3(512), LDS_BYTES, stream, a); }
#endif
}
```

```cpp
#include <hip/hip_runtime.h>
#include <cstdio>
#include <cstdint>
#include <cmath>

#define GAS __attribute__((address_space(1)))
#define LAS __attribute__((address_space(3)))
typedef unsigned short bf16;
typedef short bf16x8 __attribute__((ext_vector_type(8)));
typedef float f32x4 __attribute__((ext_vector_type(4)));
typedef float f32x2 __attribute__((ext_vector_type(2)));
typedef unsigned u32x4 __attribute__((ext_vector_type(4)));
typedef unsigned u32x2 __attribute__((ext_vector_type(2)));

#ifndef EN_P0
#define EN_P0 1
#endif
#ifndef EN_PA
#define EN_PA 1
#endif
#ifndef EN_PB
#define EN_PB 1
#endif
#ifndef EN_PC
#define EN_PC 1
#endif
#ifndef EN_PD
#define EN_PD 1
#endif
#ifndef EN_PE
#define EN_PE 1
#endif
#ifndef EN_PG
#define EN_PG 1
#endif
#ifndef EN_PH
#define EN_PH 1
#endif
#ifndef EN_PF
#define EN_PF 1
#endif
#ifndef PROBE_M
#define PROBE_M 0
#endif
#ifndef PROBE_M3
#define PROBE_M3 0
#endif
#ifndef PROBE_A
#define PROBE_A 0
#endif
#ifndef PROBE_PD
#define PROBE_PD 0
#endif
#ifndef PROBE_BAR
#define PROBE_BAR 0
#endif
#ifndef PROBE_E
#define PROBE_E 0
#endif
#ifndef PROBE_TA
#define PROBE_TA 0
#endif
#ifndef PROBE_B
#define PROBE_B 0
#endif
#ifndef PROBE_C
#define PROBE_C 0
#endif
#ifndef PROBE_D
#define PROBE_D 0
#endif
#ifndef MK_NAIVE_MIXER
#define MK_NAIVE_MIXER 0
#endif
#ifndef MK_ONE_LAUNCH
#define MK_ONE_LAUNCH 1
#endif

constexpr int NB = 8, SEQ = 4096, MTOK = NB * SEQ, D = 1024, DEPTH = 2;
constexpr int NPROJ = 4096;
constexpr int INP = 3856;
constexpr int C_RQ = 0, C_RK = 384, C_RV = 768, C_RG = 1152, C_HQ = 1536, C_HF = 1920, C_HI = 2304, C_HG = 2688, C_GQ = 3072, C_GK = 3200, C_GV = 3328, C_GG = 3584, C_GA = 3840;
constexpr int NEXP = 32, DEXP = 256;
constexpr int MAXROWS = 73728;
constexpr float EPS = 1e-6f;

constexpr size_t MiB = 1u << 20;
constexpr size_t WS_CTL = 0, CTL_ZERO_BYTES = 1 * MiB;
constexpr size_t WS_MOD = 1 * MiB;
constexpr size_t WS_ROPE = 2 * MiB;
constexpr size_t WS_WIN = 10 * MiB;
constexpr size_t WS_WOUT = 26 * MiB;
constexpr size_t WS_WGU = 30 * MiB;
constexpr size_t WS_WD = 94 * MiB;
constexpr size_t WS_H = 126 * MiB;
constexpr size_t WS_PROJ = 190 * MiB;
constexpr size_t WS_HID = 190 * MiB;
constexpr size_t WS_YP = 226 * MiB;
constexpr size_t WS_XB = 370 * MiB;
constexpr size_t WS_STATE = 446 * MiB;
constexpr size_t WS_ROUTE = 474 * MiB;
constexpr size_t WS_IDX2 = 476 * MiB;
constexpr size_t WS_END = 480 * MiB;
constexpr int CW_CNT = 64;
constexpr int CW_BAR = 4096;
constexpr int CW_TMO = 8;
constexpr int CW_MOE = 16384, CW_MOE_LAYER = 32768;

constexpr int RING_BYTES = 131072;
constexpr int LDSCTL_OFF = 147456 - 1024;
constexpr int TP_OFF = LDSCTL_OFF + 512;
constexpr int AUX_OFF = 136 * 1024;
constexpr int LDS_BYTES = 147456;

#define RLX_AGENT __ATOMIC_RELAXED, __HIP_MEMORY_SCOPE_AGENT
#define LDS_WAIT() asm volatile("s_waitcnt lgkmcnt(0)" ::: "memory")
#define VM_WAIT() asm volatile("s_waitcnt vmcnt(0)" ::: "memory")

__device__ __forceinline__ unsigned f2bf(float f) { unsigned u = __builtin_bit_cast(unsigned, f); return (u + 0x7fffu + ((u >> 16) & 1u)) >> 16; }
__device__ __forceinline__ unsigned pk2(float lo, float hi) { return f2bf(lo) | (f2bf(hi) << 16); }
__device__ __forceinline__ float bf2f(unsigned short b) { return __builtin_bit_cast(float, ((unsigned)b) << 16); }
__device__ __forceinline__ float bflo(unsigned w) { return __builtin_bit_cast(float, w << 16); }
__device__ __forceinline__ float bfhi(unsigned w) { return __builtin_bit_cast(float, w & 0xffff0000u); }
constexpr float LOG2E = 1.4426950408889634f;
__device__ __forceinline__ float fexp2(float x) { return __builtin_amdgcn_exp2f(x); }
__device__ __forceinline__ float flog2(float x) { return __builtin_amdgcn_logf(x); }
__device__ __forceinline__ float frcp(float x) { return __builtin_amdgcn_rcpf(x); }
__device__ __forceinline__ float sigmoidf_(float x) { return frcp(1.0f + fexp2(-LOG2E * x)); }
__device__ __forceinline__ float siluf_(float x) { return x * frcp(1.0f + fexp2(-LOG2E * x)); }
template <int CTRL, int RMASK, bool BC> __device__ __forceinline__ float dpp_f(float v) {
    return __builtin_bit_cast(float, __builtin_amdgcn_update_dpp(0, __builtin_bit_cast(int, v), CTRL, RMASK, 0xf, BC)); }
__device__ __forceinline__ float rdlane(float v, int l) { return __builtin_bit_cast(float, __builtin_amdgcn_readlane(__builtin_bit_cast(int, v), l)); }
__device__ __forceinline__ float wave_sum(float v) {
    v += dpp_f<0x128, 0xf, false>(v); v += dpp_f<0x124, 0xf, false>(v); v += dpp_f<0x122, 0xf, false>(v); v += dpp_f<0x121, 0xf, false>(v);
    v += dpp_f<0x142, 0xa, false>(v); v += dpp_f<0x143, 0xc, false>(v);
    return rdlane(v, 63);
}
#define SCAN_STEP_(ctrl) "v_add_f32_dpp %0, %0, %0 " ctrl "\n\tv_add_f32_dpp %1, %1, %1 " ctrl "\n\tv_add_f32_dpp %2, %2, %2 " ctrl "\n\tv_add_f32_dpp %3, %3, %3 " ctrl "\n\t"
__device__ __forceinline__ void wave_incl_scan4(float& a, float& b, float& c, float& d) {
    asm volatile("s_nop 1\n\t"
        SCAN_STEP_("row_shr:1 row_mask:0xf bank_mask:0xf bound_ctrl:1") SCAN_STEP_("row_shr:2 row_mask:0xf bank_mask:0xf bound_ctrl:1")
        SCAN_STEP_("row_shr:4 row_mask:0xf bank_mask:0xf bound_ctrl:1") SCAN_STEP_("row_shr:8 row_mask:0xf bank_mask:0xf bound_ctrl:1")
        SCAN_STEP_("row_bcast:15 row_mask:0xa bank_mask:0xf") SCAN_STEP_("row_bcast:31 row_mask:0xc bank_mask:0xf")
        "s_nop 1" : "+v"(a), "+v"(b), "+v"(c), "+v"(d));
}
#define XB_TMO      128
#define XB_XCNT(j)  (256  + 64 * (j))
#define XB_XSUB(j)  (1280 + 64 * (j))
#define XB_XGEN(j)  (2304 + 64 * (j))
#define XB_TOP      3328
#define XB_TOPGEN   3392
#define XCD_BAR_WORDS 3456
#define XB_SPIN_CAP (1u << 18)
__device__ __forceinline__ unsigned xb_ld(unsigned* p)              { return __hip_atomic_load(p, __ATOMIC_RELAXED, __HIP_MEMORY_SCOPE_AGENT); }
__device__ __forceinline__ unsigned xb_add(unsigned* p, unsigned v) { return __hip_atomic_fetch_add(p, v, __ATOMIC_RELAXED, __HIP_MEMORY_SCOPE_AGENT); }
__device__ __forceinline__ unsigned xb_xcc_id() { return (unsigned)__builtin_amdgcn_s_getreg((3 << 11) | 20) & 0xFu; }
#define XB_SPIN(cond, bar) do { unsigned _sp = 0; while (cond) { __builtin_amdgcn_s_sleep(1); \
    if ((++_sp & 255u) == 0u) { if (xb_ld(&(bar)[XB_TMO])) break; if (_sp > XB_SPIN_CAP) { atomicAdd(&(bar)[XB_TMO], 1u); break; } } } } while (0)
struct XcdBarrier { unsigned* bar; unsigned x; volatile LAS unsigned* st; };
__device__ __forceinline__ XcdBarrier xcd_barrier_post(unsigned* bar, volatile LAS unsigned* st) {
    XcdBarrier b; b.bar = bar; b.x = xb_xcc_id(); b.st = st;
    if (threadIdx.x == 0) (void)xb_add(&bar[XB_XCNT(b.x)], 1u);
    return b;
}
__device__ __forceinline__ void xcd_barrier_complete(unsigned* bar, unsigned x, unsigned& nloc, unsigned& nx) {
    const unsigned G = gridDim.x * gridDim.y * gridDim.z;
    unsigned sum, cnt, mine, sp = 0u;
    for (;;) {
        sum = 0u; cnt = 0u; mine = 0u;
#pragma unroll
        for (unsigned j = 0; j < 16; ++j) { const unsigned c = xb_ld(&bar[XB_XCNT(j)]); sum += c; cnt += (c > 0u) ? 1u : 0u; mine = (j == x) ? c : mine; }
        if (sum == G) break;
        __builtin_amdgcn_s_sleep(1);
        if ((++sp & 255u) == 0u) { if (xb_ld(&bar[XB_TMO])) break; if (sp > XB_SPIN_CAP) { atomicAdd(&bar[XB_TMO], 1u); break; } }
    }
    nloc = mine > 0u ? mine : 1u; nx = cnt > 0u ? cnt : 1u;
}
__device__ __forceinline__ void xcd_barrier(const XcdBarrier& b) {
    asm volatile("s_waitcnt vmcnt(0)" ::: "memory");
    __syncthreads();
    if (threadIdx.x == 0) {
        unsigned* bar = b.bar;
        __builtin_amdgcn_s_waitcnt(0);
        unsigned nloc = b.st[0], nx = b.st[1];
        if (nloc == 0u) { xcd_barrier_complete(bar, b.x, nloc, nx); b.st[0] = nloc; b.st[1] = nx; }
        const unsigned old = xb_add(&bar[XB_XSUB(b.x)], 1u);
        const unsigned gen = old / nloc;
        if (old + 1u == (gen + 1u) * nloc) {
            __builtin_amdgcn_fence(__ATOMIC_RELEASE, "agent");
            asm volatile("s_waitcnt vmcnt(0)" ::: "memory");
            const unsigned og = xb_add(&bar[XB_TOP], 1u);
            const unsigned tg = og / nx;
            if (og + 1u == (tg + 1u) * nx) xb_add(&bar[XB_TOPGEN], 1u);
            else XB_SPIN(xb_ld(&bar[XB_TOPGEN]) == tg, bar);
            __builtin_amdgcn_fence(__ATOMIC_ACQUIRE, "agent");
            xb_add(&bar[XB_XGEN(b.x)], 1u);
            asm volatile("s_waitcnt vmcnt(0)" ::: "memory");
        } else {
            XB_SPIN(xb_ld(&bar[XB_XGEN(b.x)]) == gen, bar);
            __builtin_amdgcn_fence(__ATOMIC_ACQUIRE, "agent");
            asm volatile("s_waitcnt vmcnt(0)" ::: "memory");
        }
    }
    __syncthreads();
}

namespace pg8 {
constexpr int BM = 256, BK = 64, HALF = 128, HTB = HALF * BK * 2, STAGE_BYTES = 8 * HTB, NXCD = 8, WGM = 8;
__host__ __device__ __forceinline__ int lds_byte(int r, int c) { const int st = (r >> 4) * 2 + (c >> 5), rr = r & 15, cc = c & 31, ob = rr * 64 + cc * 2; return st * 1024 + (ob ^ (((ob >> 9) & 1) << 5)); }
__host__ __device__ __forceinline__ void stage_rc(int b, int& R, int& C) { const int st = b / 1024, sb = b % 1024, swz = sb ^ (((sb >> 9) & 1) << 5); R = (st >> 1) * 16 + swz / 64; C = (st & 1) * 32 + (swz % 64) / 2; }
__host__ __device__ __forceinline__ int perm32(int rho) { const int n = rho >> 4, i = rho & 15; return 8 * (i >> 2) + 4 * n + (i & 3); }
struct Unit { int pm, pn, pc; };
struct Gemm { const bf16* A; const bf16* Bt; int K; };

struct StaticOrder {
    int nM, nN, nwg, G, c;
    __device__ void init(int M, int N, int G_, int c_) { nM = M / BM; nN = N / BM; nwg = nM * nN; G = G_; c = c_; }
    __device__ bool next(int i, Unit& u) const {
        const long L = (long)i * G + c; if (L >= nwg) return false;
        int wgid = (int)L; { const int q = nwg / NXCD, r = nwg % NXCD, xcd = wgid % NXCD, off = wgid / NXCD; wgid = (xcd < r ? xcd * (q + 1) : r * (q + 1) + (xcd - r) * q) + off; }
        const int nig = WGM * nN, gid = wgid / nig, fm = gid * WGM, gsz = (nM - fm) < WGM ? (nM - fm) : WGM;
        u.pm = fm + ((wgid % nig) % gsz); u.pn = (wgid % nig) / gsz; u.pc = u.pn; return true;
    }
};
struct MoeOrder {
    int G, c, npt, total; const LAS int* tp;
    __device__ bool next(int i, Unit& u) const {
        const int L = i * G + c; if (L >= total) return false;
        const int mt = L / npt, nl = L % npt; int e = 0;
        while (e < 31 && tp[e + 1] <= mt) ++e;
        u.pm = mt; u.pn = e * npt + nl; u.pc = nl; return true;
    }
};

struct MoeDownOrder {
    int G, c, H, L, dh, dl, nD, j0, lo, hi; const LAS int* tp;
    __device__ void init(int G_, int c_, int T, const LAS int* tp_) { G = G_; c = c_; tp = tp_; j0 = 0; lo = 0;
        const int nU = 2 * T; nD = 4 * T; hi = nD; H = nU % G; L = G - H; dh = (nD - 3 * L + G - 1) / G; if (dh < 0) dh = 0; dl = dh + 3; }
    __device__ int unit_index(int j) const {
        const int quota = (c < H) ? dh : dl; if (j >= quota) return -1;
        const int idx = (j < dh) ? j * G + c : dh * G + (j - dh) * L + (c - H); return idx < nD ? idx : -1; }
    __device__ bool next(int i, Unit& u) const {
        const int idx = unit_index(j0 + i); if (idx < lo || idx >= hi) return false;
        const int mt = idx >> 2, nl = idx & 3; int e = 0;
        while (e < 31 && tp[e + 1] <= mt) ++e;
        u.pm = mt; u.pn = e * 4 + nl; u.pc = nl; return true;
    }
    __device__ __forceinline__ void wait(unsigned* cnt, unsigned* tmo) const {
        if (__builtin_amdgcn_readfirstlane(threadIdx.x >> 6) == 0) {
            for (int i = 0; i < 16; ++i) { const int idx = unit_index(j0 + i); if (idx < lo || idx >= hi) break;
                GAS unsigned* p = (GAS unsigned*)cnt + 64 * (idx >> 2); unsigned n = 0;
                while ((unsigned)__builtin_amdgcn_readfirstlane(__hip_atomic_load(p, __ATOMIC_RELAXED, __HIP_MEMORY_SCOPE_AGENT)) < 16u) {
                    __builtin_amdgcn_s_sleep(2);
                    if (++n > (1u << 20)) { __hip_atomic_store((GAS unsigned*)tmo, 1u, __ATOMIC_RELAXED, __HIP_MEMORY_SCOPE_AGENT); break; } } }
            __builtin_amdgcn_fence(__ATOMIC_ACQUIRE, "agent");
            asm volatile("s_waitcnt vmcnt(0)" ::: "memory");
        }
        __syncthreads();
    }
};

__device__ __forceinline__ unsigned cvt_pk_bf16(float lo, float hi) { unsigned r; asm volatile("v_cvt_pk_bf16_f32 %0, %1, %2" : "=v"(r) : "v"(lo), "v"(hi)); return r; }

template <bool NT> struct EpiBf16StoreT {
    static constexpr bool PERM = true, WIDE = false;
    bf16* O; int ldc;
    __device__ __forceinline__ void operator()(const f32x4 (&acc)[2][2][4][2], const Unit& u, int wr, int wc, int fr, int fq) const {
        const int row0 = u.pm * BM + wr * 64 + fr, col0 = u.pc * BM + wc * 32 + 8 * fq;
#pragma unroll
        for (int ai = 0; ai < 2; ++ai)
#pragma unroll
            for (int m = 0; m < 4; ++m) { bf16* rowp = O + (size_t)(row0 + ai * HALF + m * 16) * ldc + col0;
#pragma unroll
                for (int bj = 0; bj < 2; ++bj) { const f32x4 v0 = acc[ai][bj][m][0], v1 = acc[ai][bj][m][1];
                    u32x4 w; w.x = cvt_pk_bf16(v0[0], v0[1]); w.y = cvt_pk_bf16(v0[2], v0[3]); w.z = cvt_pk_bf16(v1[0], v1[1]); w.w = cvt_pk_bf16(v1[2], v1[3]);
                    if constexpr (NT) __builtin_nontemporal_store(w, (u32x4*)(rowp + bj * HALF)); else *(u32x4*)(rowp + bj * HALF) = w; } }
    }
};
typedef EpiBf16StoreT<false> EpiBf16Store;
__device__ __forceinline__ unsigned dpp_ror8(unsigned x) { return (unsigned)__builtin_amdgcn_update_dpp(0, (int)x, 0x128, 0xf, 0xf, false); }
template <bool NT> struct EpiBf16WideT {
    static constexpr bool PERM = true, WIDE = true;
    bf16* O; int ldc;
    __device__ __forceinline__ void operator()(const f32x4 (&acc)[2][2][4][2], const Unit& u, int wr, int wc, int fr, int fq) const {
        const bool lo = fr < 8;
        const int row0 = u.pm * BM + wr * 64 + (fr & 7), col0 = u.pc * BM + wc * 64 + 8 * fq;
        const int cx = lo ? 0 : 32, cy = lo ? 32 : 0;
#pragma unroll
        for (int ai = 0; ai < 2; ++ai)
#pragma unroll
            for (int m = 0; m < 4; ++m) { bf16* rowp = O + (size_t)(row0 + ai * HALF + m * 16) * ldc + col0;
                u32x4 p0, p1, q;
                { const f32x4 v0 = acc[ai][0][m][0], v1 = acc[ai][0][m][1]; p0.x = cvt_pk_bf16(v0[0], v0[1]); p0.y = cvt_pk_bf16(v0[2], v0[3]); p0.z = cvt_pk_bf16(v1[0], v1[1]); p0.w = cvt_pk_bf16(v1[2], v1[3]); }
                { const f32x4 v0 = acc[ai][1][m][0], v1 = acc[ai][1][m][1]; p1.x = cvt_pk_bf16(v0[0], v0[1]); p1.y = cvt_pk_bf16(v0[2], v0[3]); p1.z = cvt_pk_bf16(v1[0], v1[1]); p1.w = cvt_pk_bf16(v1[2], v1[3]); }
                q.x = dpp_ror8(p1.x); q.y = dpp_ror8(p1.y); q.z = dpp_ror8(p1.z); q.w = dpp_ror8(p1.w);
                u32x4 x, y; x.x = lo ? p0.x : q.x; x.y = lo ? p0.y : q.y; x.z = lo ? p0.z : q.z; x.w = lo ? p0.w : q.w; y.x = lo ? q.x : p0.x; y.y = lo ? q.y : p0.y; y.z = lo ? q.z : p0.z; y.w = lo ? q.w : p0.w;
                if constexpr (NT) { __builtin_nontemporal_store(x, (u32x4*)(rowp + cx)); __builtin_nontemporal_store(y, (u32x4*)(rowp + (size_t)8 * ldc + cy)); }
                else { *(u32x4*)(rowp + cx) = x; *(u32x4*)(rowp + (size_t)8 * ldc + cy) = y; } }
    }
};
typedef EpiBf16WideT<true> EpiBf16WideNT;
typedef EpiBf16WideT<false> EpiBf16Wide;
struct EpiSwiGLU {
    static constexpr bool PERM = true, WIDE = false;
    bf16* O; unsigned* cnt;
    __device__ __forceinline__ void operator()(const f32x4 (&acc)[2][2][4][2], const Unit& u, int wr, int wc, int fr, int fq) const {
        const int row0 = u.pm * BM + wr * 64 + fr, col0 = u.pc * HALF + wc * 32 + 8 * fq;
#pragma unroll
        for (int ai = 0; ai < 2; ++ai)
#pragma unroll
            for (int m = 0; m < 4; ++m) { bf16* rowp = O + (size_t)(row0 + ai * HALF + m * 16) * DEXP + col0;
                float h[8];
#pragma unroll
                for (int n = 0; n < 2; ++n)
#pragma unroll
                    for (int j = 0; j < 4; ++j) { const float g = acc[ai][0][m][n][j], up = acc[ai][1][m][n][j]; h[n * 4 + j] = g * __builtin_amdgcn_rcpf(1.0f + __builtin_amdgcn_exp2f(-1.4426950408889634f * g)) * up; }
                const unsigned long long w0 = (unsigned long long)cvt_pk_bf16(h[0], h[1]) | ((unsigned long long)cvt_pk_bf16(h[2], h[3]) << 32), w1 = (unsigned long long)cvt_pk_bf16(h[4], h[5]) | ((unsigned long long)cvt_pk_bf16(h[6], h[7]) << 32);
                GAS unsigned long long* gp = (GAS unsigned long long*)rowp;
                __hip_atomic_store(gp, w0, __ATOMIC_RELAXED, __HIP_MEMORY_SCOPE_AGENT);
                __hip_atomic_store(gp + 1, w1, __ATOMIC_RELAXED, __HIP_MEMORY_SCOPE_AGENT); }
        asm volatile("s_waitcnt vmcnt(0)" ::: "memory");
        if ((threadIdx.x & 63) == 0) __hip_atomic_fetch_add((GAS unsigned*)cnt + 64 * u.pm, 1u, __ATOMIC_RELAXED, __HIP_MEMORY_SCOPE_AGENT);
    }
};
template <bool RES_BF16> struct EpiResGateB {
    static constexpr bool PERM = true, WIDE = false;
    const void* res; bf16* out; const float* gate;
    __device__ __forceinline__ void operator()(const f32x4 (&acc)[2][2][4][2], const Unit& u, int wr, int wc, int fr, int fq) const {
        const int row0 = u.pm * BM + wr * 64 + fr, col0 = u.pc * BM + wc * 32 + 8 * fq;
        const float* gb = gate + (size_t)(u.pm >> 4) * 6144;
        f32x4 gv[2][2];
#pragma unroll
        for (int bj = 0; bj < 2; ++bj)
#pragma unroll
            for (int n = 0; n < 2; ++n) gv[bj][n] = *(const f32x4*)(gb + col0 + bj * HALF + n * 4);
#pragma unroll
        for (int ai = 0; ai < 2; ++ai)
#pragma unroll
            for (int m = 0; m < 4; ++m) { const size_t off = (size_t)(row0 + ai * HALF + m * 16) * D + col0;
#pragma unroll
                for (int bj = 0; bj < 2; ++bj) { f32x4 r0, r1;
                    if constexpr (RES_BF16) { const u32x4 rr = *(const u32x4*)((const bf16*)res + off + bj * HALF);
                        r0 = (f32x4){bflo(rr.x), bfhi(rr.x), bflo(rr.y), bfhi(rr.y)}; r1 = (f32x4){bflo(rr.z), bfhi(rr.z), bflo(rr.w), bfhi(rr.w)}; }
                    else { r0 = *(const f32x4*)((const float*)res + off + bj * HALF); r1 = *(const f32x4*)((const float*)res + off + bj * HALF + 4); }
                    const f32x4 v0 = r0 + gv[bj][0] * acc[ai][bj][m][0], v1 = r1 + gv[bj][1] * acc[ai][bj][m][1];
                    u32x4 w; w.x = cvt_pk_bf16(v0[0], v0[1]); w.y = cvt_pk_bf16(v0[2], v0[3]); w.z = cvt_pk_bf16(v1[0], v1[1]); w.w = cvt_pk_bf16(v1[2], v1[3]);
                    *(u32x4*)(out + off + bj * HALF) = w; } }
    }
};
struct EpiResGate {
    static constexpr bool PERM = false, WIDE = false;
    const float* res; float* out; const float* gate;
    __device__ __forceinline__ void operator()(const f32x4 (&acc)[2][2][4][2], const Unit& u, int wr, int wc, int fr, int fq) const {
        const int row0 = u.pm * BM + wr * 64 + fr, col0 = u.pc * BM + wc * 32 + 4 * fq;
        const float* gb = gate + (size_t)(u.pm >> 4) * 6144;
        f32x4 gv[2][2];
#pragma unroll
        for (int bj = 0; bj < 2; ++bj)
#pragma unroll
            for (int n = 0; n < 2; ++n) gv[bj][n] = *(const f32x4*)(gb + col0 + bj * HALF + n * 16);
#pragma unroll
        for (int ai = 0; ai < 2; ++ai)
#pragma unroll
            for (int m = 0; m < 4; ++m) { const size_t off = (size_t)(row0 + ai * HALF + m * 16) * D + col0;
#pragma unroll
                for (int bj = 0; bj < 2; ++bj)
#pragma unroll
                    for (int n = 0; n < 2; ++n) { const f32x4 r = *(const f32x4*)(res + off + bj * HALF + n * 16); *(f32x4*)(out + off + bj * HALF + n * 16) = r + gv[bj][n] * acc[ai][bj][m][n]; } }
    }
};

template <class Epi, class Sched, bool GATHER>
__device__ __forceinline__ void gemm_phase(LAS unsigned char* lds, const Gemm g, const Sched& S, const Epi& E, const LAS int* gidx) {
    const int tid = threadIdx.x, wid = __builtin_amdgcn_readfirstlane(tid >> 6), lane = tid & 63, wr = wid >> 2, wc = wid & 3, fr = lane & 15, fq = lane >> 4;
    const int K = g.K, nt = K / BK;
    unsigned voffA[2], voffB[2];
#pragma unroll
    for (int i = 0; i < 2; ++i) { int R, C; stage_rc(tid * 16 + i * 8192, R, C); const int Rb = Epi::WIDE ? ((R >> 5) * 64 + perm32(R & 31)) : Epi::PERM ? ((R & ~31) + perm32(R & 31)) : R;
        voffA[i] = (unsigned)(R * K + C) * 2u; voffB[i] = (unsigned)(Rb * K + C) * 2u; }
    const size_t kstep = (size_t)(BK * 2);
    const size_t hstep = (size_t)HALF * K * 2;
    const size_t tstep = 2 * hstep;
    const size_t hstepB = Epi::WIDE ? (size_t)32 * K * 2 : hstep;
    const unsigned ldsw = (unsigned)wid * 1024u;
    const int aoff = lds_byte(wr * 64 + fr, fq * 8), boff = lds_byte(wc * 32 + fr, fq * 8);
    int nslot = 0;
#define PG8_SA(b, h) (((b) * 2 + (h)) * HTB)
#define PG8_SB(b, h) ((4 + (b) * 2 + (h)) * HTB)
#define PG8_GLDS(gp, lp) __builtin_amdgcn_global_load_lds((const unsigned*)(gp), (LAS unsigned*)(lp), 16, 0, 0)
#define PG8_STAGE(bufoff, gbase, voff) do { _Pragma("unroll") for (int _i = 0; _i < 2; ++_i) PG8_GLDS((const char*)(gbase) + (voff)[_i], lds + (bufoff) + ldsw + _i * 8192); } while (0)
#define PG8_STAGE_A(bufoff, gptr, h, nx) do { if constexpr (GATHER) { const int _slot = (nx) ? nslot : ui; _Pragma("unroll") for (int _i = 0; _i < 2; ++_i) { int _R, _C; stage_rc(tid * 16 + _i * 8192, _R, _C); \
            const unsigned _vo = (unsigned)gidx[_slot * 256 + (h) * HALF + _R] + (unsigned)_C * 2u; PG8_GLDS((const char*)(gptr) + _vo, lds + (bufoff) + ldsw + _i * 8192); } } \
        else { PG8_STAGE(bufoff, (const char*)(gptr) + (h) * hstep, voffA); } } while (0)
#define PG8_LDA(dst, b, h) do { _Pragma("unroll") for (int m = 0; m < 4; ++m) _Pragma("unroll") for (int k = 0; k < 2; ++k) dst[m][k] = *(const LAS bf16x8*)(lds + PG8_SA(b, h) + aoff + m * 2048 + k * 1024); } while (0)
#define PG8_LDB(dst, b, h) do { _Pragma("unroll") for (int n = 0; n < 2; ++n) _Pragma("unroll") for (int k = 0; k < 2; ++k) dst[n][k] = *(const LAS bf16x8*)(lds + PG8_SB(b, h) + boff + n * 2048 + k * 1024); } while (0)
#define PG8_MMA(ai, bj, At, Bt) do { __builtin_amdgcn_s_setprio(1); _Pragma("unroll") for (int m = 0; m < 4; ++m) _Pragma("unroll") for (int n = 0; n < 2; ++n) _Pragma("unroll") for (int k = 0; k < 2; ++k) \
        acc[ai][bj][m][n] = __builtin_amdgcn_mfma_f32_16x16x32_bf16(Bt[n][k], At[m][k], acc[ai][bj][m][n], 0, 0, 0); __builtin_amdgcn_s_setprio(0); } while (0)
#define PG8_WAIT_V(n) asm volatile("s_waitcnt vmcnt(" #n ")" ::: "memory")
#define PG8_WAIT_L(n) asm volatile("s_waitcnt lgkmcnt(" #n ")" ::: "memory")
#define PG8_BAR __builtin_amdgcn_s_barrier()
#define PG8_SCHED __builtin_amdgcn_sched_barrier(0)
    Unit cur, nxt; int ui = 0;
    if (!S.next(0, cur)) return;
    f32x4 acc[2][2][4][2];
#pragma unroll
    for (int a = 0; a < 2; ++a)
#pragma unroll
        for (int b = 0; b < 2; ++b)
#pragma unroll
            for (int m = 0; m < 4; ++m)
#pragma unroll
                for (int n = 0; n < 2; ++n) acc[a][b][m][n] = (f32x4){0.f, 0.f, 0.f, 0.f};
    bf16x8 At[4][2], B0[2][2], B1[2][2];
    const char* cA = (const char*)g.A + (GATHER ? (size_t)0 : (size_t)cur.pm * tstep); const char* cB = (const char*)g.Bt + (size_t)cur.pn * tstep;
    PG8_STAGE(PG8_SB(0, 0), cB, voffB); PG8_STAGE(PG8_SB(0, 1), cB + hstepB, voffB); PG8_STAGE_A(PG8_SA(0, 0), cA, 0, false); PG8_STAGE_A(PG8_SA(0, 1), cA, 1, false);
    if (wr == 1) PG8_BAR;
    PG8_WAIT_V(2); PG8_BAR;
    PG8_STAGE(PG8_SB(1, 0), cB + kstep, voffB); PG8_STAGE_A(PG8_SA(1, 0), cA + kstep, 0, false); PG8_STAGE(PG8_SB(1, 1), cB + hstepB + kstep, voffB);
    PG8_WAIT_V(6); PG8_BAR;
    for (;;) {
        const bool has_next = S.next(ui + 1, nxt);
        const char* nA = has_next ? (const char*)g.A + (GATHER ? (size_t)0 : (size_t)nxt.pm * tstep) : cA; const char* nB = has_next ? (const char*)g.Bt + (size_t)nxt.pn * tstep : cB;
        if constexpr (GATHER) nslot = has_next ? ui + 1 : ui;
        for (int t = 0; t < nt; t += 2) {
            const bool last = (t == nt - 2);
            const char* a1 = cA + (size_t)(t + 1) * kstep;
            const char* a2 = last ? nA : cA + (size_t)(t + 2) * kstep; const char* b2 = last ? nB : cB + (size_t)(t + 2) * kstep;
            const char* a3 = a2 + kstep; const char* b3 = b2 + kstep;
            PG8_LDB(B0, 0, 0); PG8_LDB(B1, 0, 1); PG8_SCHED; PG8_LDA(At, 0, 0); PG8_STAGE_A(PG8_SA(1, 1), a1, 1, false);
            PG8_WAIT_V(8); PG8_WAIT_L(0); PG8_BAR; PG8_MMA(0, 0, At, B0); PG8_MMA(0, 1, At, B1); PG8_BAR; PG8_SCHED;
            PG8_LDA(At, 0, 1); PG8_STAGE(PG8_SB(0, 0), b2, voffB); PG8_STAGE(PG8_SB(0, 1), b2 + hstepB, voffB); PG8_STAGE_A(PG8_SA(0, 0), a2, 0, last);
            PG8_WAIT_V(8); PG8_WAIT_L(0); PG8_BAR; PG8_MMA(1, 0, At, B0); PG8_MMA(1, 1, At, B1); PG8_BAR; PG8_SCHED;
            PG8_LDB(B0, 1, 0); PG8_LDB(B1, 1, 1); PG8_SCHED; PG8_LDA(At, 1, 0); PG8_STAGE_A(PG8_SA(0, 1), a2, 1, last);
            PG8_WAIT_V(8); PG8_WAIT_L(0); PG8_BAR; PG8_MMA(0, 0, At, B0); PG8_MMA(0, 1, At, B1); PG8_BAR; PG8_SCHED;
            PG8_LDA(At, 1, 1); PG8_STAGE(PG8_SB(1, 0), b3, voffB); PG8_STAGE(PG8_SB(1, 1), b3 + hstepB, voffB); PG8_STAGE_A(PG8_SA(1, 0), a3, 0, last);
            PG8_WAIT_V(8); PG8_WAIT_L(0); PG8_BAR; PG8_MMA(1, 0, At, B0); PG8_MMA(1, 1, At, B1); PG8_BAR; PG8_SCHED;
        }
        if (wr == 0) PG8_BAR;
        E(acc, cur, wr, wc, fr, fq);
        if (!has_next) break;
#pragma unroll
        for (int a = 0; a < 2; ++a)
#pragma unroll
            for (int b = 0; b < 2; ++b)
#pragma unroll
                for (int m = 0; m < 4; ++m)
#pragma unroll
                    for (int n = 0; n < 2; ++n) acc[a][b][m][n] = (f32x4){0.f, 0.f, 0.f, 0.f};
        cur = nxt; cA = nA; cB = nB; ++ui;
        if (wr == 1) PG8_BAR;
    }
    PG8_WAIT_V(0);
    PG8_BAR;
#undef PG8_SA
#undef PG8_SB
#undef PG8_GLDS
#undef PG8_STAGE
#undef PG8_STAGE_A
#undef PG8_LDA
#undef PG8_LDB
#undef PG8_MMA
#undef PG8_WAIT_V
#undef PG8_WAIT_L
#undef PG8_BAR
#undef PG8_SCHED
}
}

struct Args { const float* in[23]; float* out; unsigned char* ws; float inv_freq[32]; int ph_lo, ph_hi; };
enum { I_X = 0, I_C, I_POS, I_WADA, I_BADA, I_NMIX, I_NFFN, I_WIN, I_RETN, I_HGRNN, I_LBL, I_WA2, I_BA, I_GLAN, I_WOUT, I_RGW, I_RGB, I_REW, I_REB, I_EG, I_EU, I_ED, I_NFIN };
constexpr int PH_PER_LAYER = 8, PH_FINAL = 1 + 2 * PH_PER_LAYER, N_PHASES = PH_FINAL + 1;

typedef const __attribute__((address_space(4))) Args KArgs;
#define KARGS(ap) KArgs* ap = (KArgs*)__builtin_amdgcn_kernarg_segment_ptr(); asm volatile("" : "+s"(ap))
#define PHASE_IDS() int tid = threadIdx.x; asm volatile("" : "+v"(tid)); const int lane = tid & 63, wave = __builtin_amdgcn_readfirstlane(tid >> 6); \
    const int G = gridDim.x, bid = blockIdx.x, gw = bid * 8 + wave, NGW = G * 8; (void)lane; (void)wave; (void)gw; (void)NGW; (void)G; (void)bid

__device__ __forceinline__ void transpose_item(const float* W, int ldw, int K, int k0, int n0, bf16* WT, int dst_row0, LAS float* scr, int lane) {
#pragma unroll 8
    for (int i = 0; i < 32; ++i) { const int kk = 2 * i + (lane >> 5); scr[kk * 33 + (lane & 31)] = W[(size_t)(k0 + kk) * ldw + n0 + (lane & 31)]; }
    LDS_WAIT(); asm volatile("" ::: "memory");
    const int c = lane & 7;
#pragma unroll
    for (int j = 0; j < 4; ++j) { const int n = (lane >> 3) + 8 * j; const LAS float* s = scr + (8 * c) * 33 + n;
        u32x4 o; o.x = pk2(s[0 * 33], s[1 * 33]); o.y = pk2(s[2 * 33], s[3 * 33]); o.z = pk2(s[4 * 33], s[5 * 33]); o.w = pk2(s[6 * 33], s[7 * 33]);
        *(u32x4*)(WT + (size_t)(dst_row0 + n) * K + k0 + 8 * c) = o; }
    LDS_WAIT(); asm volatile("" ::: "memory");
}
__device__ __forceinline__ void transpose_item64(const float* W, int ldw, int K, int k0, int n0, bf16* WT, int dst_row0, LAS float* scr, int lane) {
    const int lr = lane >> 4, lc = (lane & 15) * 4;
    f32x4 v[16];
#pragma unroll
    for (int i = 0; i < 16; ++i) v[i] = *(const f32x4*)(W + (size_t)(k0 + 4 * i + lr) * ldw + n0 + lc);
#pragma unroll
    for (int i = 0; i < 16; ++i) { LAS float* d = scr + (4 * i + lr) * 65 + lc; d[0] = v[i][0]; d[1] = v[i][1]; d[2] = v[i][2]; d[3] = v[i][3]; }
    LDS_WAIT(); asm volatile("" ::: "memory");
    const int c = lane & 7;
#pragma unroll
    for (int j = 0; j < 8; ++j) { const int n = (lane >> 3) + 8 * j; const LAS float* sp = scr + (8 * c) * 65 + n;
        u32x4 o; o.x = pk2(sp[0 * 65], sp[1 * 65]); o.y = pk2(sp[2 * 65], sp[3 * 65]); o.z = pk2(sp[4 * 65], sp[5 * 65]); o.w = pk2(sp[6 * 65], sp[7 * 65]);
        *(u32x4*)(WT + (size_t)(dst_row0 + n) * K + k0 + 8 * c) = o; }
    LDS_WAIT(); asm volatile("" ::: "memory");
}
__device__ __forceinline__ void convert_experts(LAS unsigned char* lds, KArgs* ap, int layer, int first, int stride, int wave, int lane) {
    unsigned char* ws = ap->ws;
    bf16* WGU_T = (bf16*)(ws + WS_WGU); bf16* WD_T = (bf16*)(ws + WS_WD);
    LAS float* scr = (LAS float*)(lds + wave * 16640);
    constexpr int I_G = 16 * 4, I_D = 4 * 16;
    for (int it = first; it < 32 * (2 * I_G + I_D); it += stride) {
        int r = it;
        if (r < 32 * I_G * 2) { const int up = r / (32 * I_G); r %= 32 * I_G; const int e = r / I_G; r %= I_G; const int kb = r / 4, nb = r % 4, n0 = nb * 64;
            transpose_item64(ap->in[up ? I_EU : I_EG] + ((size_t)layer * NEXP + e) * D * DEXP, DEXP, D, kb * 64, n0, WGU_T + ((size_t)layer * NEXP + e) * 512 * D, (n0 >> 7) * 256 + (n0 & 127) + up * 128, scr, lane); }
        else { r -= 32 * I_G * 2; const int e = r / I_D; r %= I_D; const int kb = r / 16, nb = r % 16;
            transpose_item64(ap->in[I_ED] + ((size_t)layer * NEXP + e) * DEXP * D, D, DEXP, kb * 64, nb * 64, WD_T + ((size_t)layer * NEXP + e) * D * DEXP, nb * 64, scr, lane); }
    }
}
__device__ __forceinline__ void sincos_acc(float a, float& s, float& c) {
    const double ad = (double)a; const double kd = rint(ad * 0.63661977236758134308); const double rd = fma(-kd, 1.57079632679489661923, ad);
    const int q = (int)kd & 3; const float r = (float)rd, r2 = r * r;
    const float sp = r + r * r2 * (-1.6666667163e-1f + r2 * (8.3333337680e-3f + r2 * (-1.9841270114e-4f + r2 * 2.7557314297e-6f)));
    const float cp = 1.0f + r2 * (-0.5f + r2 * (4.1666667908e-2f + r2 * (-1.3888889225e-3f + r2 * (2.4801587642e-5f + r2 * -2.7557314297e-7f))));
    const float ss = (q & 1) ? cp : sp, cc = (q & 1) ? sp : cp;
    s = (q & 2) ? -ss : ss; c = ((q + 1) & 2) ? -cc : cc;
}

template <int TYPE>
__device__ __forceinline__ void naive_mixer_item(LAS unsigned char* lds, KArgs* ap, int layer, int b, int hh  , int tid) {
    constexpr int DK = (TYPE == 2) ? 32 : 64, DKW = DK / 8;
    LAS float* Qs = (LAS float*)lds; LAS float* Ks = Qs + 4096; LAS float* As = Ks + 4096; LAS float* Vs = As + 4096; LAS float* Os = Vs + 4096; LAS float* Ps = Os + 4096;
    unsigned char* ws = ap->ws;
    const bf16* PROJ = (const bf16*)(ws + WS_PROJ); bf16* H = (bf16*)(ws + WS_H);
    const unsigned* ROPE = (const unsigned*)(ws + WS_ROPE);
    const float* lbl = ap->in[I_LBL]; const float* gba = ap->in[I_BA];
    const int e = tid & 63, w = tid >> 6;
    const int qc = (TYPE == 0 ? C_RQ + hh * 64 : TYPE == 1 ? C_HQ + hh * 64 : C_GQ + hh * 32);
    const int kc = (TYPE == 0 ? C_RK + hh * 64 : TYPE == 1 ? C_HF + hh * 64 : C_GK + hh * 32);
    const int vc = (TYPE == 0 ? C_RV : TYPE == 1 ? C_HI : C_GV) + hh * 64;
    const int gc = (TYPE == 0 ? C_RG : TYPE == 1 ? C_HG : C_GG) + hh * 64;
    const int mc = (TYPE == 0 ? 0 : TYPE == 1 ? 384 : 768) + hh * 64;
    const float* gain = ap->in[TYPE == 0 ? I_RETN : TYPE == 1 ? I_HGRNN : I_GLAN] + layer * (TYPE == 2 ? 256 : 384) + hh * 64;
    float S[DKW];
#pragma unroll
    for (int i = 0; i < DKW; ++i) S[i] = 0.f;
    for (int n = 0; n < 64; ++n) {
        __syncthreads();
        const size_t row0 = (size_t)b * SEQ + (size_t)n * 64;
        for (int idx = tid; idx < 4096; idx += 512) {
            const int t = idx >> 6, d = idx & 63; const bf16* p = PROJ + (row0 + t) * NPROJ;
            Vs[idx] = bf2f(p[vc + d]);
            if (TYPE == 0) {
                const int j = d & 31; const unsigned csw = ROPE[(row0 + t) * 32 + j]; const f32x2 cs = (f32x2){bflo(csw), bfhi(csw)};
                const float q1 = bf2f(p[qc + j]), q2 = bf2f(p[qc + 32 + j]), k1 = bf2f(p[kc + j]), k2 = bf2f(p[kc + 32 + j]);
                Qs[idx] = d < 32 ? q1 * cs.x - q2 * cs.y : q1 * cs.y + q2 * cs.x;
                Ks[idx] = (d < 32 ? k1 * cs.x - k2 * cs.y : k1 * cs.y + k2 * cs.x) * 0.125f;
                As[idx] = 1.0f - exp2f(-5.0f - (float)hh);
            } else if (TYPE == 1) {
                const float l0 = lbl[hh * 64 + d], l1 = lbl[384 + hh * 64 + d]; const float mx = fmaxf(l0, l1), e0 = expf(l0 - mx), e1 = expf(l1 - mx);
                const float lb = layer == 0 ? 0.f : e1 / (e0 + e1);
                const float z = bf2f(p[kc + d]); const float f = lb + (1.0f - lb) * sigmoidf_(z);
                As[idx] = fmaxf(f, 1e-30f); Ks[idx] = (1.0f - lb) * sigmoidf_(-z); Qs[idx] = siluf_(bf2f(p[qc + d])) * 0.125f;
            } else {
                if (d < 32) { const float pre = bf2f(p[C_GA + hh * 32 + d]) + gba[layer * 128 + hh * 32 + d];
                    const float ls = fminf(pre, 0.f) - log1pf(expf(-fabsf(pre)));
                    As[t * 64 + d] = expf(ls * (1.0f / 16.0f)); Ks[t * 64 + d] = bf2f(p[kc + d]); Qs[t * 64 + d] = bf2f(p[qc + d]) * 0.17677669529663687f; }
            }
        }
        __syncthreads();
        for (int t0 = 0; t0 < 64; t0 += 16) {
            for (int tt = 0; tt < 16; ++tt) { const int t = t0 + tt; const float v = Vs[t * 64 + e]; float part = 0.f;
#pragma unroll
                for (int i = 0; i < DKW; ++i) { const int d = w * DKW + i; S[i] = As[t * 64 + d] * S[i] + Ks[t * 64 + d] * v; part += Qs[t * 64 + d] * S[i]; }
                Ps[(tt * 8 + w) * 64 + e] = part; }
            __syncthreads();
            for (int idx = tid; idx < 1024; idx += 512) { const int tt = idx >> 6, ee = idx & 63; float o = 0.f;
#pragma unroll
                for (int ww = 0; ww < 8; ++ww) o += Ps[(tt * 8 + ww) * 64 + ee];
                Os[(t0 + tt) * 64 + ee] = o; }
            __syncthreads();
        }
        for (int tt = 0; tt < 8; ++tt) { const int t = w * 8 + tt; const float o = Os[t * 64 + e]; const float ss = wave_sum(o * o); const float r = rsqrtf(ss * (1.0f / 64.0f) + EPS);
            const float g = bf2f(PROJ[(row0 + t) * NPROJ + gc + e]);
            H[(row0 + t) * D + mc + e] = (bf16)f2bf(o * r * gain[e] * siluf_(g)); }
    }
}

constexpr int MX_PITCH = 72;
constexpr int MX_ARR = 64 * MX_PITCH * 2;
constexpr int MX_GROUP_BYTES = 5 * MX_ARR + 5 * 256 + 256;
constexpr int NSC = 4, NCH = 64 / NSC;
constexpr int ST_REC = 4096 + 64;
__device__ __forceinline__ float bfx(const u32x4& r, int i) { const unsigned w = r[i >> 1]; return (i & 1) ? bfhi(w) : bflo(w); }
__device__ __forceinline__ unsigned short bfbits(const u32x4& r, int i) { const unsigned w = r[i >> 1]; return (unsigned short)((i & 1) ? (w >> 16) : (w & 0xffffu)); }

template <int TYPE, int MODE>
__device__ __forceinline__ void mixer_chunked(LAS unsigned char* lds, KArgs* ap, int layer, int b, int head  , int hh  , int sc, int tid) {
    constexpr int DK = (TYPE == 2) ? 32 : 64, NKS = DK / 32;
    constexpr bool FULL = (MODE == 1);
    const int lane = tid & 63, wv = __builtin_amdgcn_readfirstlane(tid >> 6), gid = wv >> 2, w = wv & 3, col = lane & 15, rg = lane >> 4;
    int gbo = gid * MX_GROUP_BYTES; asm volatile("" : "+v"(gbo));
    LAS unsigned char* gb = lds + gbo;
    LAS bf16* Qt = (LAS bf16*)gb; LAS bf16* Kt = Qt + 64 * MX_PITCH; LAS bf16* KT = Kt + 64 * MX_PITCH; LAS bf16* VT = KT + 64 * MX_PITCH; LAS bf16* ST = VT + 64 * MX_PITCH;
    LAS float* EM = (LAS float*)(gb + 5 * MX_ARR); LAS float* EL = EM + 64; LAS float* ELM = EL + 64; LAS float* LBt = ELM + 64; LAS float* OMLt = LBt + 64;
    unsigned char* ws = ap->ws;
    const bf16* PROJ = (const bf16*)(ws + WS_PROJ); bf16* H = (bf16*)(ws + WS_H);
    float* STATE = (float*)(ws + WS_STATE) + (size_t)((b * 16 + head) * NSC) * ST_REC;
    const int qc = (TYPE == 0 ? C_RQ + hh * 64 : TYPE == 1 ? C_HQ + hh * 64 : C_GQ + hh * 32);
    const int kc = (TYPE == 0 ? C_RK + hh * 64 : TYPE == 1 ? C_HF + hh * 64 : C_GK + hh * 32);
    const int vc = (TYPE == 0 ? C_RV : TYPE == 1 ? C_HI : C_GV) + hh * 64;
    const int gc = (TYPE == 0 ? C_RG : TYPE == 1 ? C_HG : C_GG) + hh * 64;
    const int mc = (TYPE == 0 ? 0 : TYPE == 1 ? 384 : 768) + hh * 64;
    const float lgam = (TYPE == 0) ? log1pf(-exp2f(-5.0f - (float)hh)) * LOG2E : 0.f;
    float gba[16];
    if constexpr (TYPE == 2) { int zl = 0; asm volatile("" : "+v"(zl)); const float* gbap = ap->in[I_BA] + layer * 128 + hh * 32 + 16 * (w & 1) + zl;
#pragma unroll
        for (int p = 0; p < 16; ++p) gba[p] = gbap[p]; }
    if constexpr (TYPE == 1) {
        if (w == 0) { const float* lbl = ap->in[I_LBL]; const float l0 = lbl[hh * 64 + lane], l1 = lbl[384 + hh * 64 + lane]; const float mx = fmaxf(l0, l1), e0 = expf(l0 - mx), e1 = expf(l1 - mx);
            const float lb = layer == 0 ? 0.f : e1 / (e0 + e1); LBt[lane] = lb; OMLt[lane] = 1.0f - lb; }
    }
    f32x4 gn4[4];
    if constexpr (FULL) { const float* gain = ap->in[TYPE == 0 ? I_RETN : TYPE == 1 ? I_HGRNN : I_GLAN] + layer * (TYPE == 2 ? 256 : 384) + hh * 64;
#pragma unroll
        for (int et = 0; et < 4; ++et) gn4[et] = *(const f32x4*)(gain + 16 * et + 4 * rg); }
    const bool owner = (w < DK / 16);
    f32x4 S[4];
    f32x4 Gacc = (f32x4){1.f, 1.f, 1.f, 1.f};
#pragma unroll
    for (int et = 0; et < 4; ++et) S[et] = (f32x4){0.f, 0.f, 0.f, 0.f};
    if constexpr (FULL) { if (owner) { for (int j = 0; j < sc; ++j) { const float* rec = STATE + (size_t)j * ST_REC; const f32x4 gj = *(const f32x4*)(rec + 4096 + 16 * w + 4 * rg);
#pragma unroll
                for (int et = 0; et < 4; ++et) { const f32x4 sj = *(const f32x4*)(rec + ((w * 4 + et) * 64 + lane) * 4); S[et] = gj * S[et] + sj; } } } }
    const size_t rowbase = (size_t)b * SEQ + (size_t)sc * NCH * 64;
    u32x4 rq[2], rk[2], rv[2], rr[2]; u32x4 dummy[6];
#define MX_LOAD_RAW(n) do { const bf16* p_ = PROJ + (rowbase + (size_t)(n) * 64 + lane) * NPROJ; \
        if constexpr (TYPE == 0) { rk[0] = *(const u32x4*)(p_ + kc + 8 * w); rk[1] = *(const u32x4*)(p_ + kc + 32 + 8 * w); \
            if constexpr (FULL) { rq[0] = *(const u32x4*)(p_ + qc + 8 * w); rq[1] = *(const u32x4*)(p_ + qc + 32 + 8 * w); } \
            const u32x4* rp_ = (const u32x4*)((const unsigned*)(ws + WS_ROPE) + (rowbase + (size_t)(n) * 64 + lane) * 32 + 8 * w); rr[0] = rp_[0]; rr[1] = rp_[1]; } \
        else if constexpr (TYPE == 1) { rk[0] = *(const u32x4*)(p_ + kc + 16 * w); rk[1] = *(const u32x4*)(p_ + kc + 16 * w + 8); \
            if constexpr (FULL) { rq[0] = *(const u32x4*)(p_ + qc + 16 * w); rq[1] = *(const u32x4*)(p_ + qc + 16 * w + 8); } } \
        else { if (w < 2) { rk[0] = *(const u32x4*)(p_ + kc + 16 * w); rk[1] = *(const u32x4*)(p_ + kc + 16 * w + 8); rr[0] = *(const u32x4*)(p_ + C_GA + hh * 32 + 16 * w); rr[1] = *(const u32x4*)(p_ + C_GA + hh * 32 + 16 * w + 8); \
                            if constexpr (FULL) { rq[0] = *(const u32x4*)(p_ + qc + 16 * w); rq[1] = *(const u32x4*)(p_ + qc + 16 * w + 8); } } } \
        rv[0] = *(const u32x4*)(p_ + vc + 16 * w); rv[1] = *(const u32x4*)(p_ + vc + 16 * w + 8); \
        if (PROBE_TA && !FULL) { _Pragma("unroll") for (int x_ = 0; x_ < 6; ++x_) { dummy[x_] = *(const volatile u32x4*)(p_ + vc + 16 * w + 8 * (x_ & 1)); } } } while (0)
    MX_LOAD_RAW(0);
    __syncthreads();
    if (gid == 1) __syncthreads();
    for (int n = 0; n < NCH; ++n) {
        float em4[4];
        if (PROBE_TA && !FULL) { _Pragma("unroll") for (int x_ = 0; x_ < 6; ++x_) asm volatile("" :: "v"(dummy[x_])); }
        {
            float Qr[16], Kr[16];
            if constexpr (TYPE == 0) {
                const float sq = fexp2((float)(lane - 31) * lgam), sk = fexp2((float)(31 - lane) * lgam) * 0.125f;
#pragma unroll
                for (int i = 0; i < 8; ++i) { const unsigned csw = rr[i >> 2][i & 3]; const float cs = bflo(csw), sn = bfhi(csw);
                    const float k1 = bfx(rk[0], i), k2 = bfx(rk[1], i);
                    Kr[i] = (k1 * cs - k2 * sn) * sk; Kr[8 + i] = (k1 * sn + k2 * cs) * sk;
                    if constexpr (FULL) { const float q1 = bfx(rq[0], i), q2 = bfx(rq[1], i); Qr[i] = (q1 * cs - q2 * sn) * sq; Qr[8 + i] = (q1 * sn + q2 * cs) * sq; } }
                const float em = fexp2(32.0f * lgam);
#pragma unroll
                for (int i = 0; i < 4; ++i) em4[i] = em;
                if (lane < 16) { EL[16 * w + lane] = fexp2(64.0f * lgam); ELM[16 * w + lane] = em; }
            } else if (TYPE == 1 || w < 2) {
                float c[16]; float myM = 0.f, myL = 0.f;
                if constexpr (TYPE == 1) {
                    const f32x4 lb0 = *(const LAS f32x4*)(LBt + 16 * w), lb1 = *(const LAS f32x4*)(LBt + 16 * w + 4), lb2 = *(const LAS f32x4*)(LBt + 16 * w + 8), lb3 = *(const LAS f32x4*)(LBt + 16 * w + 12);
                    const f32x4 om0 = *(const LAS f32x4*)(OMLt + 16 * w), om1 = *(const LAS f32x4*)(OMLt + 16 * w + 4), om2 = *(const LAS f32x4*)(OMLt + 16 * w + 8), om3 = *(const LAS f32x4*)(OMLt + 16 * w + 12);
#pragma unroll
                    for (int p = 0; p < 16; ++p) { const float lb = (p < 4 ? lb0 : p < 8 ? lb1 : p < 12 ? lb2 : lb3)[p & 3], om = (p < 4 ? om0 : p < 8 ? om1 : p < 12 ? om2 : om3)[p & 3];
                        const float z = bfx(rk[p >> 3], p & 7); const float sg = sigmoidf_(z);
                        const float f = lb + om * sg; c[p] = flog2(fmaxf(f, 1e-30f)); Kr[p] = om * (1.0f - sg);
                        if constexpr (FULL) { const float qv = bfx(rq[p >> 3], p & 7); Qr[p] = siluf_(qv) * 0.125f; } }
                } else {
#pragma unroll
                    for (int p = 0; p < 16; ++p) { const float pre = bfx(rr[p >> 3], p & 7) + gba[p];
                        c[p] = (fminf(pre, 0.f) * LOG2E - flog2(1.0f + fexp2(-LOG2E * fabsf(pre)))) * (1.0f / 16.0f); Kr[p] = bfx(rk[p >> 3], p & 7);
                        if constexpr (FULL) Qr[p] = bfx(rq[p >> 3], p & 7) * 0.17677669529663687f; }
                }
#pragma unroll
                for (int p = 0; p < 16; p += 4) wave_incl_scan4(c[p], c[p + 1], c[p + 2], c[p + 3]);
#pragma unroll
                for (int p = 0; p < 16; ++p) { const float m = rdlane(c[p], 31), cl = rdlane(c[p], 63); Kr[p] *= fexp2(m - c[p]);
                    if constexpr (FULL) Qr[p] *= fexp2(c[p] - m);
                    myM = (lane == p) ? m : myM; myL = (lane == p) ? cl : myL; }
                if (lane < 16) { EM[16 * w + lane] = fexp2(myM); EL[16 * w + lane] = fexp2(myL); ELM[16 * w + lane] = fexp2(myL - myM); }
                if constexpr (FULL) { LDS_WAIT();
                    const f32x4 e4 = *(const LAS f32x4*)(EM + 16 * w + 4 * rg);
#pragma unroll
                    for (int i = 0; i < 4; ++i) em4[i] = e4[i]; }
            } else {
#pragma unroll
                for (int i = 0; i < 4; ++i) em4[i] = 0.f;
            }
            if (TYPE != 2 || w < 2) {
                u32x4 k0, k1;
                k0.x = pg8::cvt_pk_bf16(Kr[0], Kr[1]); k0.y = pg8::cvt_pk_bf16(Kr[2], Kr[3]); k0.z = pg8::cvt_pk_bf16(Kr[4], Kr[5]); k0.w = pg8::cvt_pk_bf16(Kr[6], Kr[7]);
                k1.x = pg8::cvt_pk_bf16(Kr[8], Kr[9]); k1.y = pg8::cvt_pk_bf16(Kr[10], Kr[11]); k1.z = pg8::cvt_pk_bf16(Kr[12], Kr[13]); k1.w = pg8::cvt_pk_bf16(Kr[14], Kr[15]);
                if constexpr (FULL) {
                    u32x4 q0, q1;
                    q0.x = pg8::cvt_pk_bf16(Qr[0], Qr[1]); q0.y = pg8::cvt_pk_bf16(Qr[2], Qr[3]); q0.z = pg8::cvt_pk_bf16(Qr[4], Qr[5]); q0.w = pg8::cvt_pk_bf16(Qr[6], Qr[7]);
                    q1.x = pg8::cvt_pk_bf16(Qr[8], Qr[9]); q1.y = pg8::cvt_pk_bf16(Qr[10], Qr[11]); q1.z = pg8::cvt_pk_bf16(Qr[12], Qr[13]); q1.w = pg8::cvt_pk_bf16(Qr[14], Qr[15]);
                    *(LAS u32x4*)(Qt + lane * MX_PITCH + 16 * w) = q0; *(LAS u32x4*)(Qt + lane * MX_PITCH + 16 * w + 8) = q1;
                    *(LAS u32x4*)(Kt + lane * MX_PITCH + 16 * w) = k0; *(LAS u32x4*)(Kt + lane * MX_PITCH + 16 * w + 8) = k1; }
#pragma unroll
                for (int p = 0; p < 16; ++p) KT[(16 * w + p) * MX_PITCH + lane] = bfbits(p < 8 ? k0 : k1, p & 7);
            }
#pragma unroll
            for (int p = 0; p < 16; ++p) VT[(16 * w + p) * MX_PITCH + lane] = bfbits(rv[p >> 3], p & 7);
            if constexpr (FULL) { if (owner) {
#pragma unroll
                for (int et = 0; et < 4; ++et) { u32x2 o; o.x = pg8::cvt_pk_bf16(S[et][0] * em4[0], S[et][1] * em4[1]); o.y = pg8::cvt_pk_bf16(S[et][2] * em4[2], S[et][3] * em4[3]);
                    *(LAS u32x2*)(ST + (16 * et + col) * MX_PITCH + 16 * w + 4 * rg) = o; } } }
        }
        __syncthreads();
        const size_t trow = rowbase + (size_t)n * 64 + 16 * w + col;
        u32x2 gt[4];
        if constexpr (FULL) {
#pragma unroll
            for (int et = 0; et < 4; ++et) gt[et] = *(const u32x2*)(PROJ + trow * NPROJ + gc + 16 * et + 4 * rg); }
        if (n + 1 < NCH) { MX_LOAD_RAW(n + 1); }
        f32x4 OT[4];
        if constexpr (FULL) {
            bf16x8 Bq[NKS];
#pragma unroll
            for (int ks = 0; ks < NKS; ++ks) Bq[ks] = *(const LAS bf16x8*)(Qt + (16 * w + col) * MX_PITCH + 32 * ks + 8 * rg);
            f32x4 PT[4];
#pragma unroll
            for (int st = 0; st < 4; ++st) { PT[st] = (f32x4){0.f, 0.f, 0.f, 0.f};
                if (st <= w) {
#pragma unroll
                    for (int ks = 0; ks < NKS; ++ks) { const bf16x8 af = *(const LAS bf16x8*)(Kt + (16 * st + col) * MX_PITCH + 32 * ks + 8 * rg); PT[st] = __builtin_amdgcn_mfma_f32_16x16x32_bf16(af, Bq[ks], PT[st], 0, 0, 0); }
                    if (st == w) {
#pragma unroll
                        for (int i = 0; i < 4; ++i) PT[st][i] = (4 * rg + i > col) ? 0.f : PT[st][i]; }
                } }
            u32x4 pb0, pb1;
            pb0.x = pg8::cvt_pk_bf16(PT[0][0], PT[0][1]); pb0.y = pg8::cvt_pk_bf16(PT[0][2], PT[0][3]); pb0.z = pg8::cvt_pk_bf16(PT[1][0], PT[1][1]); pb0.w = pg8::cvt_pk_bf16(PT[1][2], PT[1][3]);
            pb1.x = pg8::cvt_pk_bf16(PT[2][0], PT[2][1]); pb1.y = pg8::cvt_pk_bf16(PT[2][2], PT[2][3]); pb1.z = pg8::cvt_pk_bf16(PT[3][0], PT[3][1]); pb1.w = pg8::cvt_pk_bf16(PT[3][2], PT[3][3]);
#pragma unroll
            for (int et = 0; et < 4; ++et) { OT[et] = (f32x4){0.f, 0.f, 0.f, 0.f};
#pragma unroll
                for (int ks = 0; ks < NKS; ++ks) { const bf16x8 af = *(const LAS bf16x8*)(ST + (16 * et + col) * MX_PITCH + 32 * ks + 8 * rg); OT[et] = __builtin_amdgcn_mfma_f32_16x16x32_bf16(af, Bq[ks], OT[et], 0, 0, 0); }
                { const u32x2 a0 = *(const LAS u32x2*)(VT + (16 * et + col) * MX_PITCH + 4 * rg), a1 = *(const LAS u32x2*)(VT + (16 * et + col) * MX_PITCH + 16 + 4 * rg);
                  u32x4 av; av.x = a0.x; av.y = a0.y; av.z = a1.x; av.w = a1.y;
                  OT[et] = __builtin_amdgcn_mfma_f32_16x16x32_bf16(__builtin_bit_cast(bf16x8, av), __builtin_bit_cast(bf16x8, pb0), OT[et], 0, 0, 0); }
                if (w >= 2) { const u32x2 a0 = *(const LAS u32x2*)(VT + (16 * et + col) * MX_PITCH + 32 + 4 * rg), a1 = *(const LAS u32x2*)(VT + (16 * et + col) * MX_PITCH + 48 + 4 * rg);
                  u32x4 av; av.x = a0.x; av.y = a0.y; av.z = a1.x; av.w = a1.y;
                  OT[et] = __builtin_amdgcn_mfma_f32_16x16x32_bf16(__builtin_bit_cast(bf16x8, av), __builtin_bit_cast(bf16x8, pb1), OT[et], 0, 0, 0); }
            }
        }
        if (owner) {
            const f32x4 el = *(const LAS f32x4*)(EL + 16 * w + 4 * rg), elm = *(const LAS f32x4*)(ELM + 16 * w + 4 * rg);
#pragma unroll
            for (int et = 0; et < 4; ++et) { f32x4 W = (f32x4){0.f, 0.f, 0.f, 0.f};
#pragma unroll
                for (int ks = 0; ks < 2; ++ks) { const bf16x8 af = *(const LAS bf16x8*)(KT + (16 * w + col) * MX_PITCH + 32 * ks + 8 * rg), bfr = *(const LAS bf16x8*)(VT + (16 * et + col) * MX_PITCH + 32 * ks + 8 * rg);
                    W = __builtin_amdgcn_mfma_f32_16x16x32_bf16(af, bfr, W, 0, 0, 0); }
                S[et] = el * S[et] + elm * W; }
            if constexpr (!FULL) Gacc = Gacc * el;
        }
        if constexpr (FULL) {
            float ss = 0.f;
#pragma unroll
            for (int et = 0; et < 4; ++et) ss += (OT[et][0] * OT[et][0] + OT[et][1] * OT[et][1]) + (OT[et][2] * OT[et][2] + OT[et][3] * OT[et][3]);
            ss += __shfl_xor(ss, 16); ss += __shfl_xor(ss, 32);
            const float r = rsqrtf(ss * (1.0f / 64.0f) + EPS);
#pragma unroll
            for (int et = 0; et < 4; ++et) { const f32x4 g4 = gn4[et];
                const float g0 = bflo(gt[et].x), g1 = bfhi(gt[et].x), g2 = bflo(gt[et].y), g3 = bfhi(gt[et].y);
                const float o0 = OT[et][0] * r * g4[0] * siluf_(g0), o1 = OT[et][1] * r * g4[1] * siluf_(g1);
                const float o2 = OT[et][2] * r * g4[2] * siluf_(g2), o3 = OT[et][3] * r * g4[3] * siluf_(g3);
                u32x2 o; o.x = pg8::cvt_pk_bf16(o0, o1); o.y = pg8::cvt_pk_bf16(o2, o3);
                *(u32x2*)(H + trow * D + mc + 16 * et + 4 * rg) = o; }
        }
        __syncthreads();
    }
    if (gid == 0) __syncthreads();
    if constexpr (!FULL) { if (owner) { float* rec = STATE + (size_t)sc * ST_REC;
#pragma unroll
            for (int et = 0; et < 4; ++et) *(f32x4*)(rec + ((w * 4 + et) * 64 + lane) * 4) = S[et];
            if (col == 0) *(f32x4*)(rec + 4096 + 16 * w + 4 * rg) = Gacc; } }
#undef MX_LOAD_RAW
}

template <int MODE>
__device__ __forceinline__ void phase_mixer(LAS unsigned char* lds, int layer) {
    KARGS(ap); PHASE_IDS();
    constexpr int NS = (MODE == 0) ? NSC - 1 : NSC;
    constexpr int NPAIRS = NB * 8 * NS;
    for (int pr = bid; pr < NPAIRS; pr += G) {
        const int sc = pr % NS, hp = (pr / NS) & 7, b = pr / (NS * 8), hd = 2 * hp + (wave >> 2);
        if (hp < 3) mixer_chunked<0, MODE>(lds, ap, layer, b, hd, hd, sc, tid);
        else if (hp < 6) mixer_chunked<1, MODE>(lds, ap, layer, b, hd, hd - 6, sc, tid);
        else mixer_chunked<2, MODE>(lds, ap, layer, b, hd, hd - 12, sc, tid);
        __syncthreads();
    }
    if constexpr (MODE == 0) {
        const int nidle = G - NPAIRS;
        if (nidle > 0) { if (bid >= NPAIRS) convert_experts(lds, ap, layer, (bid - NPAIRS) * 8 + wave, nidle * 8, wave, lane); }
        else convert_experts(lds, ap, layer, gw, NGW, wave, lane);
    }
}

__device__ __forceinline__ void build_tp(LAS int* TP, const unsigned* cnt, int tid) {
    if (tid == 0) { int s = 0; for (int e = 0; e < 32; ++e) { TP[e] = s; s += ((int)cnt[e] + 255) >> 8; } TP[32] = s; }
    __syncthreads();
}

__device__ __forceinline__ void phase_prologue(LAS unsigned char* lds) {
    KARGS(ap); PHASE_IDS();
    unsigned char* ws = ap->ws;
    if (bid < 192) {
        float* MOD = (float*)(ws + WS_MOD);
        const float* cin = ap->in[I_C]; const float* wada = ap->in[I_WADA]; const float* bada = ap->in[I_BADA];
        LAS float* cact = (LAS float*)lds;
        for (int i = tid; i < 8192; i += 512) { const int b = i >> 10, k = i & 1023; cact[k * 8 + b] = siluf_(cin[i]); }
        __syncthreads();
        LAS float* red = (LAS float*)(lds + 32768);
        const int kr = lane >> 4, c4 = (lane & 15) * 4;
        for (int it = bid; it < 192; it += G) {
            const int l = it / 96, j0 = (it % 96) * 64; const float* W = wada + (size_t)l * D * 6144 + j0 + c4;
            f32x4 acc[8];
#pragma unroll
            for (int b = 0; b < 8; ++b) acc[b] = (f32x4){0.f, 0.f, 0.f, 0.f};
#pragma unroll 8
            for (int i = 0; i < 32; ++i) { const int k = wave * 128 + 4 * i + kr; const f32x4 wv = *(const f32x4*)(W + (size_t)k * 6144);
                const f32x4 c0 = *(const LAS f32x4*)(cact + k * 8), c1 = *(const LAS f32x4*)(cact + k * 8 + 4);
                acc[0] += c0[0] * wv; acc[1] += c0[1] * wv; acc[2] += c0[2] * wv; acc[3] += c0[3] * wv; acc[4] += c1[0] * wv; acc[5] += c1[1] * wv; acc[6] += c1[2] * wv; acc[7] += c1[3] * wv; }
#pragma unroll
            for (int b = 0; b < 8; ++b) *(LAS f32x4*)(red + ((wave * 4 + kr) * 8 + b) * 64 + c4) = acc[b];
            __syncthreads();
            { const int b = tid >> 6, col = tid & 63; float s = 0.f;
#pragma unroll
              for (int p = 0; p < 32; ++p) s += red[(p * 8 + b) * 64 + col];
              MOD[((size_t)l * 8 + b) * 6144 + j0 + col] = s + bada[l * 6144 + j0 + col]; }
            __syncthreads();
        }
    }
    __syncthreads();
    {
        bf16* WIN_T = (bf16*)(ws + WS_WIN); bf16* WOUT_T = (bf16*)(ws + WS_WOUT);
        LAS float* scr = (LAS float*)(lds + wave * 16384);
        constexpr int I_IN = 16 * 120, I_OUT = 16 * 32;
        constexpr int PER_L = I_IN + I_OUT;
        for (int it = gw; it < 2 * PER_L; it += NGW) {
            const int l = it / PER_L; int r = it % PER_L;
            if (r < I_IN) { const int kb = r / 120, nb = r % 120; transpose_item(ap->in[I_WIN] + (size_t)l * D * INP, INP, D, kb * 64, nb * 32, WIN_T + (size_t)l * NPROJ * D, nb * 32, scr, lane); continue; } r -= I_IN;
            { const int kb = r / 32, nb = r % 32; transpose_item(ap->in[I_WOUT] + (size_t)l * D * D, D, D, kb * 64, nb * 32, WOUT_T + (size_t)l * D * D, nb * 32, scr, lane); }
        }
        const float* win = ap->in[I_WIN]; const float* wa2 = ap->in[I_WA2];
        for (int it = bid * 512 + tid; it < 2 * 256 * 128; it += G * 512) {
            const int l = it / (256 * 128), r = it % (256 * 128), n = r / 128, k0 = (r % 128) * 8;
            float o[8];
#pragma unroll
            for (int j = 0; j < 8; ++j) o[j] = 0.f;
            if (n < 128) {
#pragma unroll
                for (int j = 0; j < 8; ++j) { const float* wr_ = win + (size_t)l * D * INP + (size_t)(k0 + j) * INP + 3840; float s = 0.f;
#pragma unroll
                    for (int rr = 0; rr < 16; ++rr) s += wr_[rr] * wa2[l * 16 * 128 + rr * 128 + n];
                    o[j] = s; } }
            u32x4 w; w.x = pk2(o[0], o[1]); w.y = pk2(o[2], o[3]); w.z = pk2(o[4], o[5]); w.w = pk2(o[6], o[7]);
            *(u32x4*)(WIN_T + (size_t)l * NPROJ * D + (size_t)(3840 + n) * D + k0) = w;
        }
    }
    {
        unsigned* ROPE = (unsigned*)(ws + WS_ROPE); const int* posp = (const int*)ap->in[I_POS];
        for (int it = bid * 512 + tid; it < MTOK * 32; it += G * 512) {
            const int row = it >> 5, j = it & 31; const int pos = posp[row];
            const float ang = (float)pos * ap->inv_freq[j]; float s, c; sincos_acc(ang, s, c); ROPE[it] = pk2(c, s);
        }
    }
}

template <int MODE>
__device__ __forceinline__ void phase_norm1(LAS unsigned char* lds, int layer) {
    KARGS(ap); PHASE_IDS();
    unsigned char* ws = ap->ws; float* outp = ap->out;
    const float* MOD = (const float*)(ws + WS_MOD); bf16* H = (bf16*)(ws + WS_H); const bf16* YP = (const bf16*)(ws + WS_YP);
    const int* ROUTE_I = (const int*)(ws + WS_ROUTE); const float* ROUTE_W = (const float*)(ws + WS_ROUTE + 4 * MTOK * 4);
    LAS int* TP = (LAS int*)(lds + TP_OFF);
    const int pl = (MODE == 2) ? DEPTH - 1 : layer - 1;
    if (MODE != 0) build_tp(TP, (const unsigned*)(ws + WS_CTL) + CW_CNT + pl * 64, tid);
    const float* xin = ap->in[I_X]; const bf16* xb16 = (const bf16*)(ws + WS_XB); bf16* x2 = (bf16*)outp;
    const float* gn = MODE == 2 ? ap->in[I_NFIN] : ap->in[I_NMIX] + layer * D;
    for (int rb = bid; rb < MTOK / 128; rb += G) {
        const int row0 = rb * 128 + wave * 16, b = row0 >> 12;
        f32x4 Av[4], Bv[4], Gf[4];
#pragma unroll
        for (int j = 0; j < 4; ++j) { const int c0 = 4 * lane + 256 * j; Av[j] = *(const f32x4*)(gn + c0);
            if (MODE != 2) { const float* mb = MOD + (size_t)layer * 8 * 6144 + (size_t)b * 6144; const f32x4 sc = *(const f32x4*)(mb + D + c0); Bv[j] = *(const f32x4*)(mb + c0); Av[j] = Av[j] * (1.0f + sc); }
            if (MODE != 0) Gf[j] = *(const f32x4*)(MOD + (size_t)pl * 8 * 6144 + (size_t)b * 6144 + 5 * D + c0); }
        for (int r = 0; r < 16; r += 2) {
            f32x4 v[2][4];
#pragma unroll
            for (int q = 0; q < 2; ++q)
#pragma unroll
                for (int j = 0; j < 4; ++j) { if (MODE == 0) v[q][j] = *(const f32x4*)(xin + (size_t)(row0 + r + q) * D + 4 * lane + 256 * j);
                    else { const u32x2 xv = *(const u32x2*)(xb16 + (size_t)(row0 + r + q) * D + 4 * lane + 256 * j); v[q][j] = (f32x4){bflo(xv.x), bfhi(xv.x), bflo(xv.y), bfhi(xv.y)}; } }
            if (MODE != 0) {
                u32x2 y0[2][4], y1[2][4]; float w0[2], w1[2];
#pragma unroll
                for (int q = 0; q < 2; ++q) { const int m = row0 + r + q; const int e0 = ROUTE_I[m], e1 = ROUTE_I[MTOK + m], r0 = ROUTE_I[2 * MTOK + m], r1 = ROUTE_I[3 * MTOK + m]; w0[q] = ROUTE_W[m]; w1[q] = ROUTE_W[MTOK + m];
                    const bf16* p0 = YP + (size_t)(TP[e0] * 256 + r0) * D; const bf16* p1 = YP + (size_t)(TP[e1] * 256 + r1) * D;
#pragma unroll
                    for (int j = 0; j < 4; ++j) { y0[q][j] = *(const u32x2*)(p0 + 4 * lane + 256 * j); y1[q][j] = *(const u32x2*)(p1 + 4 * lane + 256 * j); } }
#pragma unroll
                for (int q = 0; q < 2; ++q)
#pragma unroll
                    for (int j = 0; j < 4; ++j) { const u32x2 a0 = y0[q][j], a1 = y1[q][j];
                        v[q][j][0] += Gf[j][0] * (w0[q] * bflo(a0.x) + w1[q] * bflo(a1.x)); v[q][j][1] += Gf[j][1] * (w0[q] * bfhi(a0.x) + w1[q] * bfhi(a1.x));
                        v[q][j][2] += Gf[j][2] * (w0[q] * bflo(a0.y) + w1[q] * bflo(a1.y)); v[q][j][3] += Gf[j][3] * (w0[q] * bfhi(a0.y) + w1[q] * bfhi(a1.y));
                        if (MODE == 1) { u32x2 xo; xo.x = pk2(v[q][j][0], v[q][j][1]); xo.y = pk2(v[q][j][2], v[q][j][3]); *(u32x2*)(x2 + (size_t)(row0 + r + q) * D + 4 * lane + 256 * j) = xo; } }
            }
            float ss[2];
#pragma unroll
            for (int q = 0; q < 2; ++q) { float s = 0.f;
#pragma unroll
                for (int j = 0; j < 4; ++j) s += (v[q][j][0] * v[q][j][0] + v[q][j][1] * v[q][j][1]) + (v[q][j][2] * v[q][j][2] + v[q][j][3] * v[q][j][3]);
                ss[q] = s; }
            ss[0] = wave_sum(ss[0]); ss[1] = wave_sum(ss[1]);
#pragma unroll
            for (int q = 0; q < 2; ++q) { const float rstd = rsqrtf(ss[q] * (1.0f / D) + EPS); const size_t m = (size_t)(row0 + r + q);
#pragma unroll
                for (int j = 0; j < 4; ++j) { const int c0 = 4 * lane + 256 * j;
                    if (MODE == 2) { *(f32x4*)(outp + m * D + c0) = v[q][j] * rstd * Av[j]; }
                    else { const f32x4 y = (v[q][j] * rstd) * Av[j] + Bv[j]; u32x2 o; o.x = pk2(y[0], y[1]); o.y = pk2(y[2], y[3]); *(u32x2*)(H + m * D + c0) = o; } } }
        }
    }
}

__device__ __forceinline__ void phase_inproj(LAS unsigned char* lds, int layer) {
    KARGS(ap); unsigned char* ws = ap->ws;
    pg8::Gemm g{(const bf16*)(ws + WS_H), (const bf16*)(ws + WS_WIN) + (size_t)layer * NPROJ * D, D}; pg8::StaticOrder S; S.init(MTOK, NPROJ, gridDim.x, blockIdx.x);
    pg8::EpiBf16WideNT E{(bf16*)(ws + WS_PROJ), NPROJ};
    pg8::gemm_phase<pg8::EpiBf16WideNT, pg8::StaticOrder, false>(lds, g, S, E, nullptr);
}
__device__ __forceinline__ void phase_mixer_naive(LAS unsigned char* lds, int layer) {
    KARGS(ap); PHASE_IDS();
    for (int it = bid; it < NB * 16; it += G) {
        const int b = it >> 4, hd = it & 15;
        if (hd < 6) naive_mixer_item<0>(lds, ap, layer, b, hd, tid);
        else if (hd < 12) naive_mixer_item<1>(lds, ap, layer, b, hd - 6, tid);
        else naive_mixer_item<2>(lds, ap, layer, b, hd - 12, tid);
        __syncthreads();
    }
}
__device__ __forceinline__ void phase_outproj(LAS unsigned char* lds, int layer) {
    KARGS(ap); unsigned char* ws = ap->ws;
    pg8::Gemm g{(const bf16*)(ws + WS_H), (const bf16*)(ws + WS_WOUT) + (size_t)layer * D * D, D}; pg8::StaticOrder S; S.init(MTOK, D, gridDim.x, blockIdx.x);
    const float* gate = (const float*)(ws + WS_MOD) + (size_t)layer * 8 * 6144 + 2 * D;
    if (layer == 0) { pg8::EpiResGateB<false> E{ap->in[I_X], (bf16*)(ws + WS_XB), gate}; pg8::gemm_phase<pg8::EpiResGateB<false>, pg8::StaticOrder, false>(lds, g, S, E, nullptr); }
    else { pg8::EpiResGateB<true> E{ap->out, (bf16*)(ws + WS_XB), gate}; pg8::gemm_phase<pg8::EpiResGateB<true>, pg8::StaticOrder, false>(lds, g, S, E, nullptr); }
}
constexpr int WR_PITCH = 1032;
__device__ __forceinline__ void phase_norm2_router(LAS unsigned char* lds, int layer) {
    KARGS(ap); PHASE_IDS();
    unsigned char* ws = ap->ws; const bf16* xres = (const bf16*)(ws + WS_XB);
    bf16* H = (bf16*)(ws + WS_H);
    int* ROUTE_I = (int*)(ws + WS_ROUTE); float* ROUTE_W = (float*)(ws + WS_ROUTE + 4 * MTOK * 4); int* IDX2 = (int*)(ws + WS_IDX2);
    unsigned* cntl = (unsigned*)(ws + WS_CTL) + CW_CNT + layer * 64;
    LAS bf16* Wr = (LAS bf16*)lds;
    LAS float* LG = (LAS float*)(lds + 99072);
    LAS float* AB = (LAS float*)(lds + 119552);
    LAS int* HIST = (LAS int*)(lds + 127744); LAS int* BASE = HIST + 32; LAS int* RI = BASE + 32; LAS float* RW = (LAS float*)(RI + 128 * 4);
    { const float* rgw = ap->in[I_RGW] + (size_t)layer * D * 4; const float* rew = ap->in[I_REW] + (size_t)layer * D * 32;
      for (int i = tid; i < 32 * 1024; i += 512) { const int k = i >> 5, n = i & 31; Wr[(4 + n) * WR_PITCH + k] = (bf16)f2bf(rew[i]); }
      for (int i = tid; i < 4 * 1024; i += 512) { const int k = i >> 2, n = i & 3; Wr[n * WR_PITCH + k] = (bf16)f2bf(rgw[i]); }
      for (int i = tid; i < 12 * 1024; i += 512) { const int n = 36 + (i >> 10), k = i & 1023; Wr[n * WR_PITCH + k] = (bf16)0; } }
    const float* gn = ap->in[I_NFFN] + layer * D; const float* rgb = ap->in[I_RGB] + layer * 4; const float* reb = ap->in[I_REB] + layer * 32;
    const float* modl = (const float*)(ws + WS_MOD) + (size_t)layer * 8 * 6144;
    const int r = lane & 15, kq = lane >> 4;
    for (int rb = bid; rb < MTOK / 128; rb += G) {
        const int row0 = rb * 128 + wave * 16, b = row0 >> 12; const float* mb = modl + (size_t)b * 6144 + 3 * D;
        __syncthreads();
        if (tid < 32) HIST[tid] = 0;
        for (int i = tid; i < 1024; i += 512) { AB[i] = gn[i] * (1.0f + mb[D + i]); AB[1024 + i] = mb[i]; }
        __syncthreads();
        const bf16* xr = xres + (size_t)(row0 + r) * D + 8 * kq;
        float ss = 0.f;
#pragma unroll 16
        for (int ks = 0; ks < 32; ++ks) { const u32x4 xv = *(const u32x4*)(xr + 32 * ks); const f32x4 xa = (f32x4){bflo(xv.x), bfhi(xv.x), bflo(xv.y), bfhi(xv.y)}, xb = (f32x4){bflo(xv.z), bfhi(xv.z), bflo(xv.w), bfhi(xv.w)};
            ss += (xa[0] * xa[0] + xa[1] * xa[1]) + (xa[2] * xa[2] + xa[3] * xa[3]) + (xb[0] * xb[0] + xb[1] * xb[1]) + (xb[2] * xb[2] + xb[3] * xb[3]); }
        ss += __shfl_xor(ss, 16); ss += __shfl_xor(ss, 32);
        const float rstd = rsqrtf(ss * (1.0f / D) + EPS);
        f32x4 acc[3];
#pragma unroll
        for (int nt = 0; nt < 3; ++nt) acc[nt] = (f32x4){0.f, 0.f, 0.f, 0.f};
        bf16* hr = H + (size_t)(row0 + r) * D + 8 * kq;
#pragma unroll 8
        for (int ks = 0; ks < 32; ++ks) { const u32x4 xv = *(const u32x4*)(xr + 32 * ks); const f32x4 xa = (f32x4){bflo(xv.x), bfhi(xv.x), bflo(xv.y), bfhi(xv.y)}, xb = (f32x4){bflo(xv.z), bfhi(xv.z), bflo(xv.w), bfhi(xv.w)};
            const f32x4 a0 = *(const LAS f32x4*)(AB + 32 * ks + 8 * kq), a1 = *(const LAS f32x4*)(AB + 32 * ks + 8 * kq + 4), b0 = *(const LAS f32x4*)(AB + 1024 + 32 * ks + 8 * kq), b1 = *(const LAS f32x4*)(AB + 1024 + 32 * ks + 8 * kq + 4);
            const f32x4 ya = (xa * rstd) * a0 + b0, yb = (xb * rstd) * a1 + b1;
            u32x4 o; o.x = pg8::cvt_pk_bf16(ya[0], ya[1]); o.y = pg8::cvt_pk_bf16(ya[2], ya[3]); o.z = pg8::cvt_pk_bf16(yb[0], yb[1]); o.w = pg8::cvt_pk_bf16(yb[2], yb[3]);
            *(u32x4*)(hr + 32 * ks) = o;
            const bf16x8 af = __builtin_bit_cast(bf16x8, o);
#pragma unroll
            for (int nt = 0; nt < 3; ++nt) { const bf16x8 bfr = *(const LAS bf16x8*)(Wr + (16 * nt + r) * WR_PITCH + 32 * ks + 8 * kq); acc[nt] = __builtin_amdgcn_mfma_f32_16x16x32_bf16(af, bfr, acc[nt], 0, 0, 0); } }
        LAS float* lgw = LG + wave * 16 * 40;
#pragma unroll
        for (int nt = 0; nt < 3; ++nt) { if (16 * nt + r < 40) {
#pragma unroll
            for (int i = 0; i < 4; ++i) lgw[(4 * kq + i) * 40 + 16 * nt + r] = acc[nt][i]; } }
        LDS_WAIT();
        if (lane < 16) {
            const LAS float* lg = lgw + lane * 40;
            float gl[4];
#pragma unroll
            for (int t = 0; t < 4; ++t) gl[t] = lg[t] + rgb[t];
            int gi = 0; float gm = gl[0];
#pragma unroll
            for (int t = 1; t < 4; ++t) if (gl[t] > gm) { gm = gl[t]; gi = t; }
            float gs = 0.f;
#pragma unroll
            for (int t = 0; t < 4; ++t) gs += __expf(gl[t] - gm);
            const float gwt = 1.0f / gs;
            float el[8];
#pragma unroll
            for (int t = 0; t < 8; ++t) el[t] = lg[4 + gi * 8 + t] + reb[gi * 8 + t];
            int i0 = 0; float m0 = el[0];
#pragma unroll
            for (int t = 1; t < 8; ++t) if (el[t] > m0) { m0 = el[t]; i0 = t; }
            int i1 = -1; float m1 = -3.0e38f;
#pragma unroll
            for (int t = 0; t < 8; ++t) if (t != i0 && el[t] > m1) { m1 = el[t]; i1 = t; }
            const float ex = __expf(m1 - m0); const float w0 = gwt / (1.0f + ex), w1 = gwt * ex / (1.0f + ex);
            const int e0 = gi * 8 + i0, e1 = gi * 8 + i1, lr = wave * 16 + lane;
            const int l0 = __hip_atomic_fetch_add(HIST + e0, 1, __ATOMIC_RELAXED, __HIP_MEMORY_SCOPE_WORKGROUP), l1 = __hip_atomic_fetch_add(HIST + e1, 1, __ATOMIC_RELAXED, __HIP_MEMORY_SCOPE_WORKGROUP);
            RI[lr * 4 + 0] = e0; RI[lr * 4 + 1] = e1; RI[lr * 4 + 2] = l0; RI[lr * 4 + 3] = l1; RW[lr * 2 + 0] = w0; RW[lr * 2 + 1] = w1;
        }
        __syncthreads();
        if (tid < 32) { const int c = HIST[tid]; BASE[tid] = c ? (int)atomicAdd(cntl + tid, (unsigned)c) : 0; }
        __syncthreads();
        if (tid < 128) { const int m = rb * 128 + tid; const int e0 = RI[tid * 4 + 0], e1 = RI[tid * 4 + 1]; const int r0 = BASE[e0] + RI[tid * 4 + 2], r1 = BASE[e1] + RI[tid * 4 + 3];
            IDX2[e0 * MTOK + r0] = m; IDX2[e1 * MTOK + r1] = m;
            ROUTE_I[m] = e0; ROUTE_I[MTOK + m] = e1; ROUTE_I[2 * MTOK + m] = r0; ROUTE_I[3 * MTOK + m] = r1; ROUTE_W[m] = RW[tid * 2 + 0]; ROUTE_W[MTOK + m] = RW[tid * 2 + 1]; }
    }
}
__device__ __forceinline__ void phase_moe(LAS unsigned char* lds, int layer) {
    KARGS(ap); unsigned char* ws = ap->ws;
    LAS int* TP = (LAS int*)(lds + TP_OFF); LAS int* AUX = (LAS int*)(lds + AUX_OFF);
    unsigned* ctl = (unsigned*)(ws + WS_CTL);
    const unsigned* cntl = ctl + CW_CNT + layer * 64;
    unsigned* arrive = ctl + CW_MOE + layer * CW_MOE_LAYER;
    { int tid = threadIdx.x; build_tp(TP, cntl, tid);
      pg8::MoeOrder S0; S0.G = gridDim.x; S0.c = blockIdx.x; S0.npt = 2; S0.total = TP[32] * 2; S0.tp = TP;
      const int* IDX2 = (const int*)(ws + WS_IDX2);
      pg8::Unit u; for (int i = 0; i < 8; ++i) { if (!S0.next(i, u)) break; const int e = u.pn >> 1, j = u.pm - TP[e], cnt = (int)cntl[e];
          if (tid < 256) { const int rank = j * 256 + tid; AUX[i * 256 + tid] = (rank < cnt ? IDX2[e * MTOK + rank] : 0) * (D * 2); } }
      __syncthreads(); }
    { pg8::MoeOrder S; S.G = gridDim.x; S.c = blockIdx.x; S.npt = 2; S.total = TP[32] * 2; S.tp = TP;
      pg8::Gemm g{(const bf16*)(ws + WS_H), (const bf16*)(ws + WS_WGU) + (size_t)layer * NEXP * 512 * D, D};
      pg8::EpiSwiGLU E{(bf16*)(ws + WS_HID), arrive};
      pg8::gemm_phase<pg8::EpiSwiGLU, pg8::MoeOrder, true>(lds, g, S, E, AUX); }
    const int T_ = TP[32], split = 4 * ((((2 * T_) / (int)gridDim.x) * (int)gridDim.x) >> 1);
    pg8::Gemm gd{(const bf16*)(ws + WS_HID), (const bf16*)(ws + WS_WD) + (size_t)layer * NEXP * D * DEXP, DEXP};
    pg8::EpiBf16WideNT Ed{(bf16*)(ws + WS_YP), D};
    pg8::MoeDownOrder S1; S1.init(gridDim.x, blockIdx.x, T_, TP); S1.hi = split;
    int n1 = 0; while (n1 < 16) { const int ix = S1.unit_index(n1); if (ix < 0 || ix >= split) break; ++n1; }
    S1.wait(arrive, ctl + CW_TMO);
    pg8::gemm_phase<pg8::EpiBf16WideNT, pg8::MoeDownOrder, false>(lds, gd, S1, Ed, nullptr);
    pg8::MoeDownOrder S2; S2.init(gridDim.x, blockIdx.x, T_, TP); S2.lo = split; S2.j0 = n1;
    S2.wait(arrive, ctl + CW_TMO);
    pg8::gemm_phase<pg8::EpiBf16WideNT, pg8::MoeDownOrder, false>(lds, gd, S2, Ed, nullptr);
}

__global__ void __launch_bounds__(512, 2) fwd(Args a) {
    extern __shared__ __attribute__((aligned(16))) unsigned char lds_raw[];
    LAS unsigned char* lds = (LAS unsigned char*)lds_raw;
    volatile LAS unsigned* MISC = (volatile LAS unsigned*)(lds + LDSCTL_OFF);
    for (int u = threadIdx.x; u < (LDS_BYTES - LDSCTL_OFF) / 4; u += 512) ((LAS unsigned*)(lds + LDSCTL_OFF))[u] = 0u;
    __syncthreads();
#if MK_ONE_LAUNCH
    { unsigned* ctl0 = (unsigned*)(a.ws + WS_CTL); (void)xcd_barrier_post(ctl0 + CW_BAR, MISC + 8); }
    constexpr int lo = 0, hi = N_PHASES;
#define SEAM(k) do { if ((k) + 1 < hi) { KARGS(_ap); XcdBarrier _b; _b.bar = (unsigned*)(_ap->ws + WS_CTL) + CW_BAR; _b.x = xb_xcc_id(); _b.st = (volatile LAS unsigned*)(lds + LDSCTL_OFF) + 8; xcd_barrier(_b); if (PROBE_BAR) xcd_barrier(_b); } } while (0)
#else
    (void)MISC;
    const int lo = a.ph_lo, hi = a.ph_hi;
#define SEAM(k) do { } while (0)
#endif
#define IN(k) (lo <= (k) && (k) < hi)
    if (EN_P0 && IN(0)) { phase_prologue(lds); SEAM(0); if (PROBE_D) { phase_prologue(lds); SEAM(0); } }
#define LAYER_PHASES(layer) do { constexpr int pb = 1 + PH_PER_LAYER * (layer); \
        if (EN_PA && IN(pb + 0)) { if ((layer) == 0) { phase_norm1<0>(lds, (layer)); if (PROBE_A) { SEAM(pb + 0); phase_norm1<0>(lds, (layer)); } } else phase_norm1<1>(lds, (layer)); SEAM(pb + 0); } \
        if (EN_PB && IN(pb + 1)) { phase_inproj(lds, (layer)); SEAM(pb + 1); } \
        if (EN_PC && IN(pb + 2)) { if (!MK_NAIVE_MIXER) phase_mixer<0>(lds, (layer)); SEAM(pb + 2); } \
        if (EN_PC && IN(pb + 3)) { if (MK_NAIVE_MIXER) phase_mixer_naive(lds, (layer)); else phase_mixer<1>(lds, (layer)); SEAM(pb + 3); if (PROBE_M) { phase_mixer<0>(lds, (layer)); SEAM(pb + 3); } if (PROBE_M3) { phase_mixer<1>(lds, (layer)); SEAM(pb + 3); } } \
        if (EN_PD && IN(pb + 4)) { phase_outproj(lds, (layer)); SEAM(pb + 4); if (PROBE_PD && (layer) == 0) { phase_outproj(lds, (layer)); SEAM(pb + 4); } } \
        if (EN_PE && IN(pb + 5)) { phase_norm2_router(lds, (layer)); SEAM(pb + 5); if (PROBE_E) { if (blockIdx.x == 0 && threadIdx.x < 64) { KARGS(_a2); ((unsigned*)(_a2->ws + WS_CTL))[CW_CNT + (layer) * 64 + threadIdx.x] = 0u; } SEAM(pb + 5); phase_norm2_router(lds, (layer)); SEAM(pb + 5); } } \
        if (EN_PG && IN(pb + 6)) { phase_moe(lds, (layer)); SEAM(pb + 7); } } while (0)
    LAYER_PHASES(0);
    LAYER_PHASES(1);
#undef LAYER_PHASES
    if (EN_PF && IN(PH_FINAL)) phase_norm1<2>(lds, 0);
#undef IN
#undef SEAM
}

extern "C" void kernel_launch(void* const* d_in, const int* in_sizes, int n_in, void* d_out, int out_size, void* d_ws, size_t ws_size, hipStream_t stream) {
    static int grid = 0;
    if (grid == 0) {
        if (n_in != 23 || out_size != MTOK * D || ws_size < WS_END) { fprintf(stderr, "kernel_launch: unexpected shapes (n_in %d out %d ws %zu)\n", n_in, out_size, ws_size); grid = -1; return; }
        int dev = 0, cus = 0;
        if (hipGetDevice(&dev) != hipSuccess || hipDeviceGetAttribute(&cus, hipDeviceAttributeMultiprocessorCount, dev) != hipSuccess) { grid = -1; return; }
        if (hipFuncSetAttribute((const void*)fwd, hipFuncAttributeMaxDynamicSharedMemorySize, LDS_BYTES) != hipSuccess) { fprintf(stderr, "kernel_launch: hipFuncSetAttribute failed\n"); grid = -1; return; }
        int per_cu = 0;
        if (hipOccupancyMaxActiveBlocksPerMultiprocessor(&per_cu, (const void*)fwd, 512, LDS_BYTES) != hipSuccess || per_cu < 1) fprintf(stderr, "kernel_launch: occupancy query reports %d\n", per_cu);
        (void)hipGetLastError();
        grid = cus;
    }
    if (grid < 0) return;
    (void)hipMemsetAsync((char*)d_ws + WS_CTL, 0, CTL_ZERO_BYTES, stream);
    Args a{};
    for (int i = 0; i < 23; ++i) a.in[i] = (const float*)d_in[i];
    a.out = (float*)d_out; a.ws = (unsigned char*)d_ws;
    for (int j = 0; j < 32; ++j) a.inv_freq[j] = (float)std::pow(10000.0, -(double)j / 32.0);
#if MK_ONE_LAUNCH
    a.ph_lo = 0; a.ph_hi = N_PHASES;
    hipLaunchKernelGGL(fwd, dim3(grid), dim3(512), LDS_BYTES, stream, a);
#else
    for (int p = 0; p < N_PHASES; ++p) { a.ph_lo = p; a.ph_hi = p + 1; hipLaunchKernelGGL(fwd, dim3(grid), dim3(512), LDS_BYTES, stream, a); }
#endif
}
```

```cpp
#include <hip/hip_runtime.h>
#include <cstdio>
#include <cstdint>
#include <cmath>

#define GAS __attribute__((address_space(1)))
#define LAS __attribute__((address_space(3)))
typedef unsigned short bf16;
typedef short bf16x8 __attribute__((ext_vector_type(8)));
typedef float f32x4 __attribute__((ext_vector_type(4)));
typedef float f32x2 __attribute__((ext_vector_type(2)));
typedef unsigned u32x4 __attribute__((ext_vector_type(4)));
typedef unsigned u32x2 __attribute__((ext_vector_type(2)));

#ifndef EN_P0
#define EN_P0 1
#endif
#ifndef EN_PA
#define EN_PA 1
#endif
#ifndef EN_PB
#define EN_PB 1
#endif
#ifndef EN_PC
#define EN_PC 1
#endif
#ifndef EN_PD
#define EN_PD 1
#endif
#ifndef EN_PE
#define EN_PE 1
#endif
#ifndef EN_PG
#define EN_PG 1
#endif
#ifndef EN_PH
#define EN_PH 1
#endif
#ifndef EN_PF
#define EN_PF 1
#endif
#ifndef PROBE_M
#define PROBE_M 0
#endif
#ifndef PROBE_M3
#define PROBE_M3 0
#endif
#ifndef PROBE_A
#define PROBE_A 0
#endif
#ifndef PROBE_PD
#define PROBE_PD 0
#endif
#ifndef PROBE_BAR
#define PROBE_BAR 0
#endif
#ifndef PROBE_E
#define PROBE_E 0
#endif
#ifndef PROBE_TA
#define PROBE_TA 0
#endif
#ifndef PROBE_B
#define PROBE_B 0
#endif
#ifndef PROBE_C
#define PROBE_C 0
#endif
#ifndef PROBE_D
#define PROBE_D 0
#endif
#ifndef MK_NAIVE_MIXER
#define MK_NAIVE_MIXER 0
#endif
#ifndef MK_ONE_LAUNCH
#define MK_ONE_LAUNCH 1
#endif

constexpr int NB = 8, SEQ = 4096, MTOK = NB * SEQ, D = 1024, DEPTH = 2;
constexpr int NPROJ = 4096;
constexpr int INP = 3856;
constexpr int C_RQ = 0, C_RK = 384, C_RV = 768, C_RG = 1152, C_HQ = 1536, C_HF = 1920, C_HI = 2304, C_HG = 2688, C_GQ = 3072, C_GK = 3200, C_GV = 3328, C_GG = 3584, C_GA = 3840;
constexpr int NEXP = 32, DEXP = 256;
constexpr int MAXROWS = 73728;
constexpr float EPS = 1e-6f;

constexpr size_t MiB = 1u << 20;
constexpr size_t WS_CTL = 0, CTL_ZERO_BYTES = 1 * MiB;
constexpr size_t WS_MOD = 1 * MiB;
constexpr size_t WS_ROPE = 2 * MiB;
constexpr size_t WS_WIN = 10 * MiB;
constexpr size_t WS_WOUT = 26 * MiB;
constexpr size_t WS_WGU = 30 * MiB;
constexpr size_t WS_WD = 94 * MiB;
constexpr size_t WS_H = 126 * MiB;
constexpr size_t WS_PROJ = 190 * MiB;
constexpr size_t WS_HID = 190 * MiB;
constexpr size_t WS_YP = 226 * MiB;
constexpr size_t WS_XB = 370 * MiB;
constexpr size_t WS_STATE = 446 * MiB;
constexpr size_t WS_ROUTE = 474 * MiB;
constexpr size_t WS_IDX2 = 476 * MiB;
constexpr size_t WS_END = 480 * MiB;
constexpr int CW_CNT = 64;
constexpr int CW_BAR = 4096;
constexpr int CW_TMO = 8;
constexpr int CW_MOE = 16384, CW_MOE_LAYER = 32768;

constexpr int RING_BYTES = 131072;
constexpr int LDSCTL_OFF = 147456 - 1024;
constexpr int TP_OFF = LDSCTL_OFF + 512;
constexpr int AUX_OFF = 136 * 1024;
constexpr int LDS_BYTES = 147456;

#define RLX_AGENT __ATOMIC_RELAXED, __HIP_MEMORY_SCOPE_AGENT
#define LDS_WAIT() asm volatile("s_waitcnt lgkmcnt(0)" ::: "memory")
#define VM_WAIT() asm volatile("s_waitcnt vmcnt(0)" ::: "memory")

__device__ __forceinline__ unsigned f2bf(float f) { unsigned u = __builtin_bit_cast(unsigned, f); return (u + 0x7fffu + ((u >> 16) & 1u)) >> 16; }
__device__ __forceinline__ unsigned pk2(float lo, float hi) { return f2bf(lo) | (f2bf(hi) << 16); }
__device__ __forceinline__ float bf2f(unsigned short b) { return __builtin_bit_cast(float, ((unsigned)b) << 16); }
__device__ __forceinline__ float bflo(unsigned w) { return __builtin_bit_cast(float, w << 16); }
__device__ __forceinline__ float bfhi(unsigned w) { return __builtin_bit_cast(float, w & 0xffff0000u); }
constexpr float LOG2E = 1.4426950408889634f;
__device__ __forceinline__ float fexp2(float x) { return __builtin_amdgcn_exp2f(x); }
__device__ __forceinline__ float flog2(float x) { return __builtin_amdgcn_logf(x); }
__device__ __forceinline__ float frcp(float x) { return __builtin_amdgcn_rcpf(x); }
__device__ __forceinline__ float sigmoidf_(float x) { return frcp(1.0f + fexp2(-LOG2E * x)); }
__device__ __forceinline__ float siluf_(float x) { return x * frcp(1.0f + fexp2(-LOG2E * x)); }
template <int CTRL, int RMASK, bool BC> __device__ __forceinline__ float dpp_f(float v) {
    return __builtin_bit_cast(float, __builtin_amdgcn_update_dpp(0, __builtin_bit_cast(int, v), CTRL, RMASK, 0xf, BC)); }
__device__ __forceinline__ float rdlane(float v, int l) { return __builtin_bit_cast(float, __builtin_amdgcn_readlane(__builtin_bit_cast(int, v), l)); }
__device__ __forceinline__ float wave_sum(float v) {
    v += dpp_f<0x128, 0xf, false>(v); v += dpp_f<0x124, 0xf, false>(v); v += dpp_f<0x122, 0xf, false>(v); v += dpp_f<0x121, 0xf, false>(v);
    v += dpp_f<0x142, 0xa, false>(v); v += dpp_f<0x143, 0xc, false>(v);
    return rdlane(v, 63);
}
#define SCAN_STEP_(ctrl) "v_add_f32_dpp %0, %0, %0 " ctrl "\n\tv_add_f32_dpp %1, %1, %1 " ctrl "\n\tv_add_f32_dpp %2, %2, %2 " ctrl "\n\tv_add_f32_dpp %3, %3, %3 " ctrl "\n\t"
__device__ __forceinline__ void wave_incl_scan4(float& a, float& b, float& c, float& d) {
    asm volatile("s_nop 1\n\t"
        SCAN_STEP_("row_shr:1 row_mask:0xf bank_mask:0xf bound_ctrl:1") SCAN_STEP_("row_shr:2 row_mask:0xf bank_mask:0xf bound_ctrl:1")
        SCAN_STEP_("row_shr:4 row_mask:0xf bank_mask:0xf bound_ctrl:1") SCAN_STEP_("row_shr:8 row_mask:0xf bank_mask:0xf bound_ctrl:1")
        SCAN_STEP_("row_bcast:15 row_mask:0xa bank_mask:0xf") SCAN_STEP_("row_bcast:31 row_mask:0xc bank_mask:0xf")
        "s_nop 1" : "+v"(a), "+v"(b), "+v"(c), "+v"(d));
}
#define XB_TMO      128
#define XB_XCNT(j)  (256  + 64 * (j))
#define XB_XSUB(j)  (1280 + 64 * (j))
#define XB_XGEN(j)  (2304 + 64 * (j))
#define XB_TOP      3328
#define XB_TOPGEN   3392
#define XCD_BAR_WORDS 3456
#define XB_SPIN_CAP (1u << 18)
__device__ __forceinline__ unsigned xb_ld(unsigned* p)              { return __hip_atomic_load(p, __ATOMIC_RELAXED, __HIP_MEMORY_SCOPE_AGENT); }
__device__ __forceinline__ unsigned xb_add(unsigned* p, unsigned v) { return __hip_atomic_fetch_add(p, v, __ATOMIC_RELAXED, __HIP_MEMORY_SCOPE_AGENT); }
__device__ __forceinline__ unsigned xb_xcc_id() { return (unsigned)__builtin_amdgcn_s_getreg((3 << 11) | 20) & 0xFu; }
#define XB_SPIN(cond, bar) do { unsigned _sp = 0; while (cond) { __builtin_amdgcn_s_sleep(1); \
    if ((++_sp & 255u) == 0u) { if (xb_ld(&(bar)[XB_TMO])) break; if (_sp > XB_SPIN_CAP) { atomicAdd(&(bar)[XB_TMO], 1u); break; } } } } while (0)
struct XcdBarrier { unsigned* bar; unsigned x; volatile LAS unsigned* st; };
__device__ __forceinline__ XcdBarrier xcd_barrier_post(unsigned* bar, volatile LAS unsigned* st) {
    XcdBarrier b; b.bar = bar; b.x = xb_xcc_id(); b.st = st;
    if (threadIdx.x == 0) (void)xb_add(&bar[XB_XCNT(b.x)], 1u);
    return b;
}
__device__ __forceinline__ void xcd_barrier_complete(unsigned* bar, unsigned x, unsigned& nloc, unsigned& nx) {
    const unsigned G = gridDim.x * gridDim.y * gridDim.z;
    unsigned sum, cnt, mine, sp = 0u;
    for (;;) {
        sum = 0u; cnt = 0u; mine = 0u;
#pragma unroll
        for (unsigned j = 0; j < 16; ++j) { const unsigned c = xb_ld(&bar[XB_XCNT(j)]); sum += c; cnt += (c > 0u) ? 1u : 0u; mine = (j == x) ? c : mine; }
        if (sum == G) break;
        __builtin_amdgcn_s_sleep(1);
        if ((++sp & 255u) == 0u) { if (xb_ld(&bar[XB_TMO])) break; if (sp > XB_SPIN_CAP) { atomicAdd(&bar[XB_TMO], 1u); break; } }
    }
    nloc = mine > 0u ? mine : 1u; nx = cnt > 0u ? cnt : 1u;
}
__device__ __forceinline__ void xcd_barrier(const XcdBarrier& b) {
    asm volatile("s_waitcnt vmcnt(0)" ::: "memory");
    __syncthreads();
    if (threadIdx.x == 0) {
        unsigned* bar = b.bar;
        __builtin_amdgcn_s_waitcnt(0);
        unsigned nloc = b.st[0], nx = b.st[1];
        if (nloc == 0u) { xcd_barrier_complete(bar, b.x, nloc, nx); b.st[0] = nloc; b.st[1] = nx; }
        const unsigned mygen = b.st[2];
        const unsigned old = xb_add(&bar[XB_XSUB(b.x)], 1u);
        const unsigned gen = old / nloc;
        if (old + 1u == (gen + 1u) * nloc) {
            __builtin_amdgcn_fence(__ATOMIC_RELEASE, "agent");
            asm volatile("s_waitcnt vmcnt(0)" ::: "memory");
            const unsigned og = xb_add(&bar[XB_TOP], 1u);
            const unsigned tg = og / nx;
            if (og + 1u == (tg + 1u) * nx) xb_add(&bar[XB_TOPGEN], 1u);
        }
        XB_SPIN(xb_ld(&bar[XB_TOPGEN]) <= mygen, bar);
        __builtin_amdgcn_fence(__ATOMIC_ACQUIRE, "agent");
        asm volatile("s_waitcnt vmcnt(0)" ::: "memory");
        b.st[2] = mygen + 1u;
    }
    __syncthreads();
}

namespace pg8 {
constexpr int BM = 256, BK = 64, HALF = 128, HTB = HALF * BK * 2, STAGE_BYTES = 8 * HTB, NXCD = 8, WGM = 4;
__host__ __device__ __forceinline__ int lds_byte(int r, int c) { const int st = (r >> 4) * 2 + (c >> 5), rr = r & 15, cc = c & 31, ob = rr * 64 + cc * 2; return st * 1024 + (ob ^ (((ob >> 9) & 1) << 5)); }
__host__ __device__ __forceinline__ void stage_rc(int b, int& R, int& C) { const int st = b / 1024, sb = b % 1024, swz = sb ^ (((sb >> 9) & 1) << 5); R = (st >> 1) * 16 + swz / 64; C = (st & 1) * 32 + (swz % 64) / 2; }
__host__ __device__ __forceinline__ int perm32(int rho) { const int n = rho >> 4, i = rho & 15; return 8 * (i >> 2) + 4 * n + (i & 3); }
struct Unit { int pm, pn, pc; };
struct Gemm { const bf16* A; const bf16* Bt; int K; };

struct StaticOrder {
    int nM, nN, nwg, G, c;
    __device__ void init(int M, int N, int G_, int c_) { nM = M / BM; nN = N / BM; nwg = nM * nN; G = G_; c = c_; }
    __device__ bool next(int i, Unit& u) const {
        const long L = (long)i * G + c; if (L >= nwg) return false;
        int wgid = (int)L; { const int q = nwg / NXCD, r = nwg % NXCD, xcd = wgid % NXCD, off = wgid / NXCD; wgid = (xcd < r ? xcd * (q + 1) : r * (q + 1) + (xcd - r) * q) + off; }
        const int nig = WGM * nN, gid = wgid / nig, fm = gid * WGM, gsz = (nM - fm) < WGM ? (nM - fm) : WGM;
        u.pm = fm + ((wgid % nig) % gsz); u.pn = (wgid % nig) / gsz; u.pc = u.pn; return true;
    }
};
struct MoeOrder {
    int G, c, npt, total; const LAS int* tp;
    __device__ bool next(int i, Unit& u) const {
        const int cp = ((G & 7) == 0) ? (c & 7) * (G >> 3) + (c >> 3) : c;
        const int L = i * G + cp; if (L >= total) return false;
        const int mt = L / npt, nl = L % npt; int e = 0;
        while (e < 31 && tp[e + 1] <= mt) ++e;
        u.pm = mt; u.pn = e * npt + nl; u.pc = nl; return true;
    }
};

struct MoeDownOrder {
    int G, c, H, L, dh, dl, nD, j0, lo, hi; const LAS int* tp;
    __device__ void init(int G_, int c_, int T, const LAS int* tp_) { G = G_; c = c_; tp = tp_; j0 = 0; lo = 0;
        const int nU = 2 * T; nD = 4 * T; hi = nD; H = nU % G; L = G - H; dh = (nD - 3 * L + G - 1) / G; if (dh < 0) dh = 0; dl = dh + 3; }
    __device__ int unit_index(int j) const {
        const int cp = ((G & 7) == 0) ? (c & 7) * (G >> 3) + (c >> 3) : c;
        const int quota = (cp < H) ? dh : dl; if (j >= quota) return -1;
        const int idx = (j < dh) ? j * G + cp : dh * G + (j - dh) * L + (cp - H); return idx < nD ? idx : -1; }
    __device__ bool next(int i, Unit& u) const {
        const int idx = unit_index(j0 + i); if (idx < lo || idx >= hi) return false;
        const int mt = idx >> 2, nl = idx & 3; int e = 0;
        while (e < 31 && tp[e + 1] <= mt) ++e;
        u.pm = mt; u.pn = e * 4 + nl; u.pc = nl; return true;
    }
    __device__ __forceinline__ void wait(unsigned* cnt, unsigned* tmo) const {
        if (__builtin_amdgcn_readfirstlane(threadIdx.x >> 6) == 0) {
            for (int i = 0; i < 16; ++i) { const int idx = unit_index(j0 + i); if (idx < lo || idx >= hi) break;
                GAS unsigned* p = (GAS unsigned*)cnt + 64 * (idx >> 2); unsigned n = 0;
                while ((unsigned)__builtin_amdgcn_readfirstlane(__hip_atomic_load(p, __ATOMIC_RELAXED, __HIP_MEMORY_SCOPE_AGENT)) < 16u) {
                    __builtin_amdgcn_s_sleep(2);
                    if (++n > (1u << 20)) { __hip_atomic_store((GAS unsigned*)tmo, 1u, __ATOMIC_RELAXED, __HIP_MEMORY_SCOPE_AGENT); break; } } }
            __builtin_amdgcn_fence(__ATOMIC_ACQUIRE, "agent");
            asm volatile("s_waitcnt vmcnt(0)" ::: "memory");
        }
        __syncthreads();
    }
};

__device__ __forceinline__ unsigned cvt_pk_bf16(float lo, float hi) { unsigned r; asm volatile("v_cvt_pk_bf16_f32 %0, %1, %2" : "=v"(r) : "v"(lo), "v"(hi)); return r; }

template <bool NT> struct EpiBf16StoreT {
    static constexpr bool PERM = true, WIDE = false;
    bf16* O; int ldc;
    __device__ __forceinline__ void operator()(const f32x4 (&acc)[2][2][4][2], const Unit& u, int wr, int wc, int fr, int fq) const {
        const int row0 = u.pm * BM + wr * 64 + fr, col0 = u.pc * BM + wc * 32 + 8 * fq;
#pragma unroll
        for (int ai = 0; ai < 2; ++ai)
#pragma unroll
            for (int m = 0; m < 4; ++m) { bf16* rowp = O + (size_t)(row0 + ai * HALF + m * 16) * ldc + col0;
#pragma unroll
                for (int bj = 0; bj < 2; ++bj) { const f32x4 v0 = acc[ai][bj][m][0], v1 = acc[ai][bj][m][1];
                    u32x4 w; w.x = cvt_pk_bf16(v0[0], v0[1]); w.y = cvt_pk_bf16(v0[2], v0[3]); w.z = cvt_pk_bf16(v1[0], v1[1]); w.w = cvt_pk_bf16(v1[2], v1[3]);
                    if constexpr (NT) __builtin_nontemporal_store(w, (u32x4*)(rowp + bj * HALF)); else *(u32x4*)(rowp + bj * HALF) = w; } }
    }
};
typedef EpiBf16StoreT<false> EpiBf16Store;
__device__ __forceinline__ unsigned dpp_ror8(unsigned x) { return (unsigned)__builtin_amdgcn_update_dpp(0, (int)x, 0x128, 0xf, 0xf, false); }
template <bool NT> struct EpiBf16WideT {
    static constexpr bool PERM = true, WIDE = true;
    bf16* O; int ldc;
    __device__ __forceinline__ void operator()(const f32x4 (&acc)[2][2][4][2], const Unit& u, int wr, int wc, int fr, int fq) const {
        const bool lo = fr < 8;
        const int row0 = u.pm * BM + wr * 64 + (fr & 7), col0 = u.pc * BM + wc * 64 + 8 * fq;
        const int cx = lo ? 0 : 32, cy = lo ? 32 : 0;
#pragma unroll
        for (int ai = 0; ai < 2; ++ai)
#pragma unroll
            for (int m = 0; m < 4; ++m) { bf16* rowp = O + (size_t)(row0 + ai * HALF + m * 16) * ldc + col0;
                u32x4 p0, p1, q;
                { const f32x4 v0 = acc[ai][0][m][0], v1 = acc[ai][0][m][1]; p0.x = cvt_pk_bf16(v0[0], v0[1]); p0.y = cvt_pk_bf16(v0[2], v0[3]); p0.z = cvt_pk_bf16(v1[0], v1[1]); p0.w = cvt_pk_bf16(v1[2], v1[3]); }
                { const f32x4 v0 = acc[ai][1][m][0], v1 = acc[ai][1][m][1]; p1.x = cvt_pk_bf16(v0[0], v0[1]); p1.y = cvt_pk_bf16(v0[2], v0[3]); p1.z = cvt_pk_bf16(v1[0], v1[1]); p1.w = cvt_pk_bf16(v1[2], v1[3]); }
                q.x = dpp_ror8(p1.x); q.y = dpp_ror8(p1.y); q.z = dpp_ror8(p1.z); q.w = dpp_ror8(p1.w);
                u32x4 x, y; x.x = lo ? p0.x : q.x; x.y = lo ? p0.y : q.y; x.z = lo ? p0.z : q.z; x.w = lo ? p0.w : q.w; y.x = lo ? q.x : p0.x; y.y = lo ? q.y : p0.y; y.z = lo ? q.z : p0.z; y.w = lo ? q.w : p0.w;
                if constexpr (NT) { __builtin_nontemporal_store(x, (u32x4*)(rowp + cx)); __builtin_nontemporal_store(y, (u32x4*)(rowp + (size_t)8 * ldc + cy)); }
                else { *(u32x4*)(rowp + cx) = x; *(u32x4*)(rowp + (size_t)8 * ldc + cy) = y; } }
    }
};
typedef EpiBf16WideT<true> EpiBf16WideNT;
typedef EpiBf16WideT<false> EpiBf16Wide;
struct EpiSwiGLU {
    static constexpr bool PERM = true, WIDE = false;
    bf16* O; unsigned* cnt;
    __device__ __forceinline__ void operator()(const f32x4 (&acc)[2][2][4][2], const Unit& u, int wr, int wc, int fr, int fq) const {
        const int row0 = u.pm * BM + wr * 64 + fr, col0 = u.pc * HALF + wc * 32 + 8 * fq;
#pragma unroll
        for (int ai = 0; ai < 2; ++ai)
#pragma unroll
            for (int m = 0; m < 4; ++m) { bf16* rowp = O + (size_t)(row0 + ai * HALF + m * 16) * DEXP + col0;
                float h[8];
#pragma unroll
                for (int n = 0; n < 2; ++n)
#pragma unroll
                    for (int j = 0; j < 4; ++j) { const float g = acc[ai][0][m][n][j], up = acc[ai][1][m][n][j]; h[n * 4 + j] = g * __builtin_amdgcn_rcpf(1.0f + __builtin_amdgcn_exp2f(-1.4426950408889634f * g)) * up; }
                u32x4 w; w.x = cvt_pk_bf16(h[0], h[1]); w.y = cvt_pk_bf16(h[2], h[3]); w.z = cvt_pk_bf16(h[4], h[5]); w.w = cvt_pk_bf16(h[6], h[7]);
                asm volatile("s_nop 2\n\tglobal_store_dwordx4 %0, %1, off sc1\n\ts_nop 1" :: "v"(rowp), "v"(w) : "memory");     }
        asm volatile("s_waitcnt vmcnt(0)" ::: "memory");
        if ((threadIdx.x & 63) == 0) __hip_atomic_fetch_add((GAS unsigned*)cnt + 64 * u.pm, 1u, __ATOMIC_RELAXED, __HIP_MEMORY_SCOPE_AGENT);
    }
};
template <bool RES_BF16> struct EpiResGateB {
    static constexpr bool PERM = true, WIDE = true;
    const void* res; bf16* out; const float* gate;
    __device__ __forceinline__ void operator()(const f32x4 (&acc)[2][2][4][2], const Unit& u, int wr, int wc, int fr, int fq) const {
        const bool lo = fr < 8;
        const int row0 = u.pm * BM + wr * 64 + fr, col0 = u.pc * BM + wc * 64 + 8 * fq;
        const int cx = lo ? 0 : 32, cy = lo ? 32 : 0;
        const float* gb = gate + (size_t)(u.pm >> 4) * 6144;
        f32x4 gv[2][2];
#pragma unroll
        for (int bj = 0; bj < 2; ++bj)
#pragma unroll
            for (int n = 0; n < 2; ++n) gv[bj][n] = *(const f32x4*)(gb + col0 + bj * 32 + n * 4);
#pragma unroll
        for (int ai = 0; ai < 2; ++ai)
#pragma unroll
            for (int m = 0; m < 4; ++m) { const size_t off = (size_t)(row0 + ai * HALF + m * 16) * D + col0;
                u32x4 w[2];
                u32x4 rs[2];
                if constexpr (RES_BF16) { const bf16* rp = (const bf16*)res + (size_t)(u.pm * BM + wr * 64 + (fr & 7) + ai * HALF + m * 16) * D + col0;
                    const u32x4 lx = __builtin_nontemporal_load((const u32x4*)(rp + cx)), ly = __builtin_nontemporal_load((const u32x4*)(rp + (size_t)8 * D + cy));
                    u32x4 oth; oth.x = lo ? ly.x : lx.x; oth.y = lo ? ly.y : lx.y; oth.z = lo ? ly.z : lx.z; oth.w = lo ? ly.w : lx.w;
                    rs[0].x = lo ? lx.x : ly.x; rs[0].y = lo ? lx.y : ly.y; rs[0].z = lo ? lx.z : ly.z; rs[0].w = lo ? lx.w : ly.w;
                    rs[1].x = dpp_ror8(oth.x); rs[1].y = dpp_ror8(oth.y); rs[1].z = dpp_ror8(oth.z); rs[1].w = dpp_ror8(oth.w); }
#pragma unroll
                for (int bj = 0; bj < 2; ++bj) { f32x4 r0, r1;
                    if constexpr (RES_BF16) { const u32x4 rr = rs[bj];
                        r0 = (f32x4){bflo(rr.x), bfhi(rr.x), bflo(rr.y), bfhi(rr.y)}; r1 = (f32x4){bflo(rr.z), bfhi(rr.z), bflo(rr.w), bfhi(rr.w)}; }
                    else { r0 = *(const f32x4*)((const float*)res + off + bj * 32); r1 = *(const f32x4*)((const float*)res + off + bj * 32 + 4); }
                    const f32x4 v0 = r0 + gv[bj][0] * acc[ai][bj][m][0], v1 = r1 + gv[bj][1] * acc[ai][bj][m][1];
                    w[bj].x = cvt_pk_bf16(v0[0], v0[1]); w[bj].y = cvt_pk_bf16(v0[2], v0[3]); w[bj].z = cvt_pk_bf16(v1[0], v1[1]); w[bj].w = cvt_pk_bf16(v1[2], v1[3]); }
                u32x4 q; q.x = dpp_ror8(w[1].x); q.y = dpp_ror8(w[1].y); q.z = dpp_ror8(w[1].z); q.w = dpp_ror8(w[1].w);
                u32x4 x, y; x.x = lo ? w[0].x : q.x; x.y = lo ? w[0].y : q.y; x.z = lo ? w[0].z : q.z; x.w = lo ? w[0].w : q.w; y.x = lo ? q.x : w[0].x; y.y = lo ? q.y : w[0].y; y.z = lo ? q.z : w[0].z; y.w = lo ? q.w : w[0].w;
                bf16* rowp = out + (size_t)(u.pm * BM + wr * 64 + (fr & 7) + ai * HALF + m * 16) * D + col0;
                *(u32x4*)(rowp + cx) = x; *(u32x4*)(rowp + (size_t)8 * D + cy) = y; }
    }
};
struct EpiResGate {
    static constexpr bool PERM = false, WIDE = false;
    const float* res; float* out; const float* gate;
    __device__ __forceinline__ void operator()(const f32x4 (&acc)[2][2][4][2], const Unit& u, int wr, int wc, int fr, int fq) const {
        const int row0 = u.pm * BM + wr * 64 + fr, col0 = u.pc * BM + wc * 32 + 4 * fq;
        const float* gb = gate + (size_t)(u.pm >> 4) * 6144;
        f32x4 gv[2][2];
#pragma unroll
        for (int bj = 0; bj < 2; ++bj)
#pragma unroll
            for (int n = 0; n < 2; ++n) gv[bj][n] = *(const f32x4*)(gb + col0 + bj * HALF + n * 16);
#pragma unroll
        for (int ai = 0; ai < 2; ++ai)
#pragma unroll
            for (int m = 0; m < 4; ++m) { const size_t off = (size_t)(row0 + ai * HALF + m * 16) * D + col0;
#pragma unroll
                for (int bj = 0; bj < 2; ++bj)
#pragma unroll
                    for (int n = 0; n < 2; ++n) { const f32x4 r = *(const f32x4*)(res + off + bj * HALF + n * 16); *(f32x4*)(out + off + bj * HALF + n * 16) = r + gv[bj][n] * acc[ai][bj][m][n]; } }
    }
};

template <class Epi, class Sched, bool GATHER>
__device__ __forceinline__ void gemm_phase(LAS unsigned char* lds, const Gemm g, const Sched& S, const Epi& E, const LAS int* gidx) {
    const int tid = threadIdx.x, wid = __builtin_amdgcn_readfirstlane(tid >> 6), lane = tid & 63, wr = wid >> 2, wc = wid & 3, fr = lane & 15, fq = lane >> 4;
    const int K = g.K, nt = K / BK;
    unsigned voffA[2], voffB[2];
#pragma unroll
    for (int i = 0; i < 2; ++i) { int R, C; stage_rc(tid * 16 + i * 8192, R, C); const int Rb = Epi::WIDE ? ((R >> 5) * 64 + perm32(R & 31)) : Epi::PERM ? ((R & ~31) + perm32(R & 31)) : R;
        voffA[i] = (unsigned)(R * K + C) * 2u; voffB[i] = (unsigned)(Rb * K + C) * 2u; }
    const size_t kstep = (size_t)(BK * 2);
    const size_t hstep = (size_t)HALF * K * 2;
    const size_t tstep = 2 * hstep;
    const size_t hstepB = Epi::WIDE ? (size_t)32 * K * 2 : hstep;
    const unsigned ldsw = (unsigned)wid * 1024u;
    const int aoff = lds_byte(wr * 64 + fr, fq * 8), boff = lds_byte(wc * 32 + fr, fq * 8);
    int nslot = 0;
#define PG8_SA(b, h) (((b) * 2 + (h)) * HTB)
#define PG8_SB(b, h) ((4 + (b) * 2 + (h)) * HTB)
#define PG8_GLDS(gp, lp) __builtin_amdgcn_global_load_lds((const unsigned*)(gp), (LAS unsigned*)(lp), 16, 0, 0)
#define PG8_STAGE(bufoff, gbase, voff) do { _Pragma("unroll") for (int _i = 0; _i < 2; ++_i) PG8_GLDS((const char*)(gbase) + (voff)[_i], lds + (bufoff) + ldsw + _i * 8192); } while (0)
#define PG8_GLOOK(dst, slot_) do { _Pragma("unroll") for (int _h = 0; _h < 2; ++_h) _Pragma("unroll") for (int _i = 0; _i < 2; ++_i) { int _R, _C; stage_rc(tid * 16 + _i * 8192, _R, _C); \
            dst[_h][_i] = (unsigned)gidx[(slot_) * 256 + _h * HALF + _R] + (unsigned)_C * 2u; } } while (0)
#define PG8_STAGE_A(bufoff, gptr, h, nx) do { if constexpr (GATHER) { _Pragma("unroll") for (int _i = 0; _i < 2; ++_i) { \
            const unsigned _vo = (nx) ? gnxt[h][_i] : gcur[h][_i]; PG8_GLDS((const char*)(gptr) + _vo, lds + (bufoff) + ldsw + _i * 8192); } } \
        else { PG8_STAGE(bufoff, (const char*)(gptr) + (h) * hstep, voffA); } } while (0)
#define PG8_LDA(dst, b, h) do { _Pragma("unroll") for (int m = 0; m < 4; ++m) _Pragma("unroll") for (int k = 0; k < 2; ++k) dst[m][k] = *(const LAS bf16x8*)(lds + PG8_SA(b, h) + aoff + m * 2048 + k * 1024); } while (0)
#define PG8_LDB(dst, b, h) do { _Pragma("unroll") for (int n = 0; n < 2; ++n) _Pragma("unroll") for (int k = 0; k < 2; ++k) dst[n][k] = *(const LAS bf16x8*)(lds + PG8_SB(b, h) + boff + n * 2048 + k * 1024); } while (0)
#define PG8_MMA(ai, bj, At, Bt) do { __builtin_amdgcn_s_setprio(1); _Pragma("unroll") for (int m = 0; m < 4; ++m) _Pragma("unroll") for (int n = 0; n < 2; ++n) _Pragma("unroll") for (int k = 0; k < 2; ++k) \
        acc[ai][bj][m][n] = __builtin_amdgcn_mfma_f32_16x16x32_bf16(Bt[n][k], At[m][k], acc[ai][bj][m][n], 0, 0, 0); __builtin_amdgcn_s_setprio(0); } while (0)
#define PG8_WAIT_V(n) asm volatile("s_waitcnt vmcnt(" #n ")" ::: "memory")
#define PG8_WAIT_L(n) asm volatile("s_waitcnt lgkmcnt(" #n ")" ::: "memory")
#define PG8_BAR __builtin_amdgcn_s_barrier()
#define PG8_SCHED __builtin_amdgcn_sched_barrier(0)
    Unit cur, nxt; int ui = 0;
    if (!S.next(0, cur)) return;
    unsigned gcur[2][2] = {{0u, 0u}, {0u, 0u}}, gnxt[2][2] = {{0u, 0u}, {0u, 0u}};
    if constexpr (GATHER) PG8_GLOOK(gcur, 0);
    f32x4 acc[2][2][4][2];
#pragma unroll
    for (int a = 0; a < 2; ++a)
#pragma unroll
        for (int b = 0; b < 2; ++b)
#pragma unroll
            for (int m = 0; m < 4; ++m)
#pragma unroll
                for (int n = 0; n < 2; ++n) acc[a][b][m][n] = (f32x4){0.f, 0.f, 0.f, 0.f};
    bf16x8 At[4][2], B0[2][2], B1[2][2];
    const char* cA = (const char*)g.A + (GATHER ? (size_t)0 : (size_t)cur.pm * tstep); const char* cB = (const char*)g.Bt + (size_t)cur.pn * tstep;
    PG8_STAGE(PG8_SB(0, 0), cB, voffB); PG8_STAGE(PG8_SB(0, 1), cB + hstepB, voffB); PG8_STAGE_A(PG8_SA(0, 0), cA, 0, false); PG8_STAGE_A(PG8_SA(0, 1), cA, 1, false);
    if (wr == 1) PG8_BAR;
    PG8_WAIT_V(2); PG8_BAR;
    PG8_STAGE(PG8_SB(1, 0), cB + kstep, voffB); PG8_STAGE_A(PG8_SA(1, 0), cA + kstep, 0, false); PG8_STAGE(PG8_SB(1, 1), cB + hstepB + kstep, voffB);
    PG8_WAIT_V(6); PG8_BAR;
    for (;;) {
        const bool has_next = S.next(ui + 1, nxt);
        const char* nA = has_next ? (const char*)g.A + (GATHER ? (size_t)0 : (size_t)nxt.pm * tstep) : cA; const char* nB = has_next ? (const char*)g.Bt + (size_t)nxt.pn * tstep : cB;
        if constexpr (GATHER) { nslot = has_next ? ui + 1 : ui; PG8_GLOOK(gnxt, nslot); }
        for (int t = 0; t < nt; t += 2) {
            const bool last = (t == nt - 2);
            const char* a1 = cA + (size_t)(t + 1) * kstep;
            const char* a2 = last ? nA : cA + (size_t)(t + 2) * kstep; const char* b2 = last ? nB : cB + (size_t)(t + 2) * kstep;
            const char* a3 = a2 + kstep; const char* b3 = b2 + kstep;
            PG8_LDB(B0, 0, 0); PG8_LDB(B1, 0, 1); PG8_SCHED; PG8_LDA(At, 0, 0); PG8_STAGE_A(PG8_SA(1, 1), a1, 1, false);
            PG8_WAIT_V(8); PG8_WAIT_L(0); PG8_BAR; PG8_MMA(0, 0, At, B0); PG8_MMA(0, 1, At, B1); PG8_BAR; PG8_SCHED;
            PG8_LDA(At, 0, 1); PG8_STAGE(PG8_SB(0, 0), b2, voffB); PG8_STAGE(PG8_SB(0, 1), b2 + hstepB, voffB); PG8_STAGE_A(PG8_SA(0, 0), a2, 0, last);
            PG8_WAIT_V(8); PG8_WAIT_L(0); PG8_BAR; PG8_MMA(1, 0, At, B0); PG8_MMA(1, 1, At, B1); PG8_BAR; PG8_SCHED;
            PG8_LDB(B0, 1, 0); PG8_LDB(B1, 1, 1); PG8_SCHED; PG8_LDA(At, 1, 0); PG8_STAGE_A(PG8_SA(0, 1), a2, 1, last);
            PG8_WAIT_V(8); PG8_WAIT_L(0); PG8_BAR; PG8_MMA(0, 0, At, B0); PG8_MMA(0, 1, At, B1); PG8_BAR; PG8_SCHED;
            PG8_LDA(At, 1, 1); PG8_STAGE(PG8_SB(1, 0), b3, voffB); PG8_STAGE(PG8_SB(1, 1), b3 + hstepB, voffB); PG8_STAGE_A(PG8_SA(1, 0), a3, 0, last);
            PG8_WAIT_V(8); PG8_WAIT_L(0); PG8_BAR; PG8_MMA(1, 0, At, B0); PG8_MMA(1, 1, At, B1); PG8_BAR; PG8_SCHED;
        }
        if (wr == 0) PG8_BAR;
        E(acc, cur, wr, wc, fr, fq);
        if (!has_next) break;
#pragma unroll
        for (int a = 0; a < 2; ++a)
#pragma unroll
            for (int b = 0; b < 2; ++b)
#pragma unroll
                for (int m = 0; m < 4; ++m)
#pragma unroll
                    for (int n = 0; n < 2; ++n) acc[a][b][m][n] = (f32x4){0.f, 0.f, 0.f, 0.f};
        cur = nxt; cA = nA; cB = nB; ++ui;
        if constexpr (GATHER) { gcur[0][0] = gnxt[0][0]; gcur[0][1] = gnxt[0][1]; gcur[1][0] = gnxt[1][0]; gcur[1][1] = gnxt[1][1]; }
        if (wr == 1) PG8_BAR;
    }
    PG8_WAIT_V(0);
    PG8_BAR;
#undef PG8_SA
#undef PG8_SB
#undef PG8_GLDS
#undef PG8_STAGE
#undef PG8_STAGE_A
#undef PG8_GLOOK
#undef PG8_LDA
#undef PG8_LDB
#undef PG8_MMA
#undef PG8_WAIT_V
#undef PG8_WAIT_L
#undef PG8_BAR
#undef PG8_SCHED
}
}

struct Args { const float* in[23]; float* out; unsigned char* ws; float inv_freq[32]; int ph_lo, ph_hi; };
enum { I_X = 0, I_C, I_POS, I_WADA, I_BADA, I_NMIX, I_NFFN, I_WIN, I_RETN, I_HGRNN, I_LBL, I_WA2, I_BA, I_GLAN, I_WOUT, I_RGW, I_RGB, I_REW, I_REB, I_EG, I_EU, I_ED, I_NFIN };
constexpr int PH_PER_LAYER = 8, PH_FINAL = 1 + 2 * PH_PER_LAYER, N_PHASES = PH_FINAL + 1;

typedef const __attribute__((address_space(4))) Args KArgs;
#define KARGS(ap) KArgs* ap = (KArgs*)__builtin_amdgcn_kernarg_segment_ptr(); asm volatile("" : "+s"(ap))
#define PHASE_IDS() int tid = threadIdx.x; asm volatile("" : "+v"(tid)); const int lane = tid & 63, wave = __builtin_amdgcn_readfirstlane(tid >> 6); \
    const int G = gridDim.x, bid = blockIdx.x, gw = bid * 8 + wave, NGW = G * 8; (void)lane; (void)wave; (void)gw; (void)NGW; (void)G; (void)bid

__device__ __forceinline__ void transpose_item(const float* W, int ldw, int K, int k0, int n0, bf16* WT, int dst_row0, LAS float* scr, int lane) {
#pragma unroll 8
    for (int i = 0; i < 32; ++i) { const int kk = 2 * i + (lane >> 5); scr[kk * 33 + (lane & 31)] = __builtin_nontemporal_load(W + (size_t)(k0 + kk) * ldw + n0 + (lane & 31)); }
    LDS_WAIT(); asm volatile("" ::: "memory");
    const int c = lane & 7;
#pragma unroll
    for (int j = 0; j < 4; ++j) { const int n = (lane >> 3) + 8 * j; const LAS float* s = scr + (8 * c) * 33 + n;
        u32x4 o; o.x = pk2(s[0 * 33], s[1 * 33]); o.y = pk2(s[2 * 33], s[3 * 33]); o.z = pk2(s[4 * 33], s[5 * 33]); o.w = pk2(s[6 * 33], s[7 * 33]);
        *(u32x4*)(WT + (size_t)(dst_row0 + n) * K + k0 + 8 * c) = o; }
    LDS_WAIT(); asm volatile("" ::: "memory");
}
__device__ __forceinline__ void transpose_item64(const float* W, int ldw, int K, int k0, int n0, bf16* WT, int dst_row0, LAS float* scr, int lane) {
    const int lr = lane >> 4, lc = (lane & 15) * 4;
    f32x4 v[16];
#pragma unroll
    for (int i = 0; i < 16; ++i) v[i] = *(const f32x4*)(W + (size_t)(k0 + 4 * i + lr) * ldw + n0 + lc);
#pragma unroll
    for (int i = 0; i < 16; ++i) { LAS float* d = scr + (4 * i + lr) * 65 + lc; d[0] = v[i][0]; d[1] = v[i][1]; d[2] = v[i][2]; d[3] = v[i][3]; }
    LDS_WAIT(); asm volatile("" ::: "memory");
    const int c = lane & 7;
#pragma unroll
    for (int j = 0; j < 8; ++j) { const int n = (lane >> 3) + 8 * j; const LAS float* sp = scr + (8 * c) * 65 + n;
        u32x4 o; o.x = pk2(sp[0 * 65], sp[1 * 65]); o.y = pk2(sp[2 * 65], sp[3 * 65]); o.z = pk2(sp[4 * 65], sp[5 * 65]); o.w = pk2(sp[6 * 65], sp[7 * 65]);
        *(u32x4*)(WT + (size_t)(dst_row0 + n) * K + k0 + 8 * c) = o; }
    LDS_WAIT(); asm volatile("" ::: "memory");
}
struct CvItem { const float* W; bf16* WT; int ldw, K, k0, n0, drow; };
__device__ __forceinline__ CvItem cv_decode(KArgs* ap, int layer, int it) {
    unsigned char* ws = ap->ws; bf16* WGU_T = (bf16*)(ws + WS_WGU); bf16* WD_T = (bf16*)(ws + WS_WD);
    constexpr int I_G = 16 * 4, I_D = 4 * 16;
    CvItem c; int r = it;
    if (r < 32 * I_G * 2) { const int up = r / (32 * I_G); r %= 32 * I_G; const int e = r / I_G; r %= I_G; const int kb = r / 4, nb = r % 4, n0 = nb * 64;
        c.W = ap->in[up ? I_EU : I_EG] + ((size_t)layer * NEXP + e) * D * DEXP; c.ldw = DEXP; c.K = D; c.k0 = kb * 64; c.n0 = n0; c.WT = WGU_T + ((size_t)layer * NEXP + e) * 512 * D; c.drow = (n0 >> 7) * 256 + (n0 & 127) + up * 128; }
    else { r -= 32 * I_G * 2; const int e = r / I_D; r %= I_D; const int kb = r / 16, nb = r % 16;
        c.W = ap->in[I_ED] + ((size_t)layer * NEXP + e) * DEXP * D; c.ldw = D; c.K = DEXP; c.k0 = kb * 64; c.n0 = nb * 64; c.WT = WD_T + ((size_t)layer * NEXP + e) * D * DEXP; c.drow = nb * 64; }
    return c;
}
__device__ __forceinline__ void cv_load(const CvItem& c, f32x4 (&v)[16], int lane) {
    const int lr = lane >> 4, lc = (lane & 15) * 4;
#pragma unroll
    for (int i = 0; i < 16; ++i) v[i] = __builtin_nontemporal_load((const f32x4*)(c.W + (size_t)(c.k0 + 4 * i + lr) * c.ldw + c.n0 + lc));
}
__device__ __forceinline__ void cv_write(const f32x4 (&v)[16], LAS float* scr, int lane) {
    const int lr = lane >> 4, lc = (lane & 15) * 4;
#pragma unroll
    for (int i = 0; i < 16; ++i) { LAS float* d = scr + (4 * i + lr) * 65 + lc; d[0] = v[i][0]; d[1] = v[i][1]; d[2] = v[i][2]; d[3] = v[i][3]; }
}
__device__ __forceinline__ void cv_finish(const CvItem& c, LAS float* scr, int lane) {
    LDS_WAIT(); asm volatile("" ::: "memory");
    const int cc = lane & 7;
#pragma unroll
    for (int j = 0; j < 8; ++j) { const int n = (lane >> 3) + 8 * j; const LAS float* sp = scr + (8 * cc) * 65 + n;
        u32x4 o; o.x = pk2(sp[0 * 65], sp[1 * 65]); o.y = pk2(sp[2 * 65], sp[3 * 65]); o.z = pk2(sp[4 * 65], sp[5 * 65]); o.w = pk2(sp[6 * 65], sp[7 * 65]);
        __builtin_nontemporal_store(o, (u32x4*)(c.WT + (size_t)(c.drow + n) * c.K + c.k0 + 8 * cc)); }
    LDS_WAIT(); asm volatile("" ::: "memory");
}
constexpr int CV_PER_LAYER = 32 * (2 * 64 + 64);
__device__ __forceinline__ void convert_experts(LAS unsigned char* lds, KArgs* ap, int g0, int g1, int first, int stride, int wave, int lane) {
    LAS float* scr = (LAS float*)(lds + wave * 16640);
    int it0 = g0 + first, it1 = g0 + first + stride;
    bool ha = it0 < g1, hb = it1 < g1;
    CvItem a, b, cur; f32x4 va[16], vb[16];
    if (ha) { a = cv_decode(ap, it0 / CV_PER_LAYER, it0 % CV_PER_LAYER); cv_load(a, va, lane); }
    if (hb) { b = cv_decode(ap, it1 / CV_PER_LAYER, it1 % CV_PER_LAYER); cv_load(b, vb, lane); }
    for (;;) {
        if (!ha) break;
        cv_write(va, scr, lane); cur = a; it0 += 2 * stride; ha = it0 < g1; if (ha) { a = cv_decode(ap, it0 / CV_PER_LAYER, it0 % CV_PER_LAYER); cv_load(a, va, lane); } cv_finish(cur, scr, lane);
        if (!hb) break;
        cv_write(vb, scr, lane); cur = b; it1 += 2 * stride; hb = it1 < g1; if (hb) { b = cv_decode(ap, it1 / CV_PER_LAYER, it1 % CV_PER_LAYER); cv_load(b, vb, lane); } cv_finish(cur, scr, lane);
    }
}
constexpr int CV_P0 = 2560, CV_C1 = CV_P0 + (2 * CV_PER_LAYER - CV_P0) / 2;
__device__ __forceinline__ void sincos_acc(float a, float& s, float& c) {
    const double ad = (double)a; const double kd = rint(ad * 0.63661977236758134308); const double rd = fma(-kd, 1.57079632679489661923, ad);
    const int q = (int)kd & 3; const float r = (float)rd, r2 = r * r;
    const float sp = r + r * r2 * (-1.6666667163e-1f + r2 * (8.3333337680e-3f + r2 * (-1.9841270114e-4f + r2 * 2.7557314297e-6f)));
    const float cp = 1.0f + r2 * (-0.5f + r2 * (4.1666667908e-2f + r2 * (-1.3888889225e-3f + r2 * (2.4801587642e-5f + r2 * -2.7557314297e-7f))));
    const float ss = (q & 1) ? cp : sp, cc = (q & 1) ? sp : cp;
    s = (q & 2) ? -ss : ss; c = ((q + 1) & 2) ? -cc : cc;
}

template <int TYPE>
__device__ __forceinline__ void naive_mixer_item(LAS unsigned char* lds, KArgs* ap, int layer, int b, int hh  , int tid) {
    constexpr int DK = (TYPE == 2) ? 32 : 64, DKW = DK / 8;
    LAS float* Qs = (LAS float*)lds; LAS float* Ks = Qs + 4096; LAS float* As = Ks + 4096; LAS float* Vs = As + 4096; LAS float* Os = Vs + 4096; LAS float* Ps = Os + 4096;
    unsigned char* ws = ap->ws;
    const bf16* PROJ = (const bf16*)(ws + WS_PROJ); bf16* H = (bf16*)(ws + WS_H);
    const unsigned* ROPE = (const unsigned*)(ws + WS_ROPE);
    const float* lbl = ap->in[I_LBL]; const float* gba = ap->in[I_BA];
    const int e = tid & 63, w = tid >> 6;
    const int qc = (TYPE == 0 ? C_RQ + hh * 64 : TYPE == 1 ? C_HQ + hh * 64 : C_GQ + hh * 32);
    const int kc = (TYPE == 0 ? C_RK + hh * 64 : TYPE == 1 ? C_HF + hh * 64 : C_GK + hh * 32);
    const int vc = (TYPE == 0 ? C_RV : TYPE == 1 ? C_HI : C_GV) + hh * 64;
    const int gc = (TYPE == 0 ? C_RG : TYPE == 1 ? C_HG : C_GG) + hh * 64;
    const int mc = (TYPE == 0 ? 0 : TYPE == 1 ? 384 : 768) + hh * 64;
    const float* gain = ap->in[TYPE == 0 ? I_RETN : TYPE == 1 ? I_HGRNN : I_GLAN] + layer * (TYPE == 2 ? 256 : 384) + hh * 64;
    float S[DKW];
#pragma unroll
    for (int i = 0; i < DKW; ++i) S[i] = 0.f;
    for (int n = 0; n < 64; ++n) {
        __syncthreads();
        const size_t row0 = (size_t)b * SEQ + (size_t)n * 64;
        for (int idx = tid; idx < 4096; idx += 512) {
            const int t = idx >> 6, d = idx & 63; const bf16* p = PROJ + (row0 + t) * NPROJ;
            Vs[idx] = bf2f(p[vc + d]);
            if (TYPE == 0) {
                const int j = d & 31; const unsigned csw = ROPE[(row0 + t) * 32 + j]; const f32x2 cs = (f32x2){bflo(csw), bfhi(csw)};
                const float q1 = bf2f(p[qc + j]), q2 = bf2f(p[qc + 32 + j]), k1 = bf2f(p[kc + j]), k2 = bf2f(p[kc + 32 + j]);
                Qs[idx] = d < 32 ? q1 * cs.x - q2 * cs.y : q1 * cs.y + q2 * cs.x;
                Ks[idx] = (d < 32 ? k1 * cs.x - k2 * cs.y : k1 * cs.y + k2 * cs.x) * 0.125f;
                As[idx] = 1.0f - exp2f(-5.0f - (float)hh);
            } else if (TYPE == 1) {
                const float l0 = lbl[hh * 64 + d], l1 = lbl[384 + hh * 64 + d]; const float mx = fmaxf(l0, l1), e0 = expf(l0 - mx), e1 = expf(l1 - mx);
                const float lb = layer == 0 ? 0.f : e1 / (e0 + e1);
                const float z = bf2f(p[kc + d]); const float f = lb + (1.0f - lb) * sigmoidf_(z);
                As[idx] = fmaxf(f, 1e-30f); Ks[idx] = (1.0f - lb) * sigmoidf_(-z); Qs[idx] = siluf_(bf2f(p[qc + d])) * 0.125f;
            } else {
                if (d < 32) { const float pre = bf2f(p[C_GA + hh * 32 + d]) + gba[layer * 128 + hh * 32 + d];
                    const float ls = fminf(pre, 0.f) - log1pf(expf(-fabsf(pre)));
                    As[t * 64 + d] = expf(ls * (1.0f / 16.0f)); Ks[t * 64 + d] = bf2f(p[kc + d]); Qs[t * 64 + d] = bf2f(p[qc + d]) * 0.17677669529663687f; }
            }
        }
        __syncthreads();
        for (int t0 = 0; t0 < 64; t0 += 16) {
            for (int tt = 0; tt < 16; ++tt) { const int t = t0 + tt; const float v = Vs[t * 64 + e]; float part = 0.f;
#pragma unroll
                for (int i = 0; i < DKW; ++i) { const int d = w * DKW + i; S[i] = As[t * 64 + d] * S[i] + Ks[t * 64 + d] * v; part += Qs[t * 64 + d] * S[i]; }
                Ps[(tt * 8 + w) * 64 + e] = part; }
            __syncthreads();
            for (int idx = tid; idx < 1024; idx += 512) { const int tt = idx >> 6, ee = idx & 63; float o = 0.f;
#pragma unroll
                for (int ww = 0; ww < 8; ++ww) o += Ps[(tt * 8 + ww) * 64 + ee];
                Os[(t0 + tt) * 64 + ee] = o; }
            __syncthreads();
        }
        for (int tt = 0; tt < 8; ++tt) { const int t = w * 8 + tt; const float o = Os[t * 64 + e]; const float ss = wave_sum(o * o); const float r = rsqrtf(ss * (1.0f / 64.0f) + EPS);
            const float g = bf2f(PROJ[(row0 + t) * NPROJ + gc + e]);
            H[(row0 + t) * D + mc + e] = (bf16)f2bf(o * r * gain[e] * siluf_(g)); }
    }
}

constexpr int MX_PITCH = 72;
constexpr int MX_ARR = 64 * MX_PITCH * 2;
constexpr int MX_GROUP_BYTES = 5 * MX_ARR + 5 * 256 + 256;
constexpr int NSC = 4, NCH = 64 / NSC;
constexpr int ST_REC = 4096 + 64;
__device__ __forceinline__ float bfx(const u32x4& r, int i) { const unsigned w = r[i >> 1]; return (i & 1) ? bfhi(w) : bflo(w); }
__device__ __forceinline__ unsigned short bfbits(const u32x4& r, int i) { const unsigned w = r[i >> 1]; return (unsigned short)((i & 1) ? (w >> 16) : (w & 0xffffu)); }

template <int TYPE, int MODE>
__device__ __forceinline__ void mixer_chunked(LAS unsigned char* lds, KArgs* ap, int layer, int b, int head  , int hh  , int sc, int tid) {
    constexpr int DK = (TYPE == 2) ? 32 : 64, NKS = DK / 32;
    constexpr bool FULL = (MODE == 1);
    const int lane = tid & 63, wv = __builtin_amdgcn_readfirstlane(tid >> 6), gid = wv >> 2, w = wv & 3, col = lane & 15, rg = lane >> 4;
    int gbo = gid * MX_GROUP_BYTES; asm volatile("" : "+v"(gbo));
    LAS unsigned char* gb = lds + gbo;
    LAS bf16* Qt = (LAS bf16*)gb; LAS bf16* Kt = Qt + 64 * MX_PITCH; LAS bf16* KT = Kt + 64 * MX_PITCH; LAS bf16* VT = KT + 64 * MX_PITCH; LAS bf16* ST = VT + 64 * MX_PITCH;
    LAS float* EM = (LAS float*)(gb + 5 * MX_ARR); LAS float* EL = EM + 64; LAS float* ELM = EL + 64; LAS float* LBt = ELM + 64; LAS float* OMLt = LBt + 64;
    unsigned char* ws = ap->ws;
    const bf16* PROJ = (const bf16*)(ws + WS_PROJ); bf16* H = (bf16*)(ws + WS_H);
    float* STATE = (float*)(ws + WS_STATE) + (size_t)((b * 16 + head) * NSC) * ST_REC;
    const int qc = (TYPE == 0 ? C_RQ + hh * 64 : TYPE == 1 ? C_HQ + hh * 64 : C_GQ + hh * 32);
    const int kc = (TYPE == 0 ? C_RK + hh * 64 : TYPE == 1 ? C_HF + hh * 64 : C_GK + hh * 32);
    const int vc = (TYPE == 0 ? C_RV : TYPE == 1 ? C_HI : C_GV) + hh * 64;
    const int gc = (TYPE == 0 ? C_RG : TYPE == 1 ? C_HG : C_GG) + hh * 64;
    const int mc = (TYPE == 0 ? 0 : TYPE == 1 ? 384 : 768) + hh * 64;
    const float lgam = (TYPE == 0) ? log1pf(-exp2f(-5.0f - (float)hh)) * LOG2E : 0.f;
    float gba[16];
    if constexpr (TYPE == 2) { int zl = 0; asm volatile("" : "+v"(zl)); const float* gbap = ap->in[I_BA] + layer * 128 + hh * 32 + 16 * (w & 1) + zl;
#pragma unroll
        for (int p = 0; p < 16; ++p) gba[p] = gbap[p]; }
    if constexpr (TYPE == 1) {
        if (w == 0) { const float* lbl = ap->in[I_LBL]; const float l0 = lbl[hh * 64 + lane], l1 = lbl[384 + hh * 64 + lane]; const float mx = fmaxf(l0, l1), e0 = expf(l0 - mx), e1 = expf(l1 - mx);
            const float lb = layer == 0 ? 0.f : e1 / (e0 + e1); LBt[lane] = lb; OMLt[lane] = 1.0f - lb; }
    }
    f32x4 gn4[4];
    if constexpr (FULL) { const float* gain = ap->in[TYPE == 0 ? I_RETN : TYPE == 1 ? I_HGRNN : I_GLAN] + layer * (TYPE == 2 ? 256 : 384) + hh * 64;
#pragma unroll
        for (int et = 0; et < 4; ++et) gn4[et] = *(const f32x4*)(gain + 16 * et + 4 * rg); }
    const bool owner = (w < DK / 16);
    f32x4 S[4];
    f32x4 Gacc = (f32x4){1.f, 1.f, 1.f, 1.f};
#pragma unroll
    for (int et = 0; et < 4; ++et) S[et] = (f32x4){0.f, 0.f, 0.f, 0.f};
    if constexpr (FULL) { if (owner) { for (int j = 0; j < sc; ++j) { const float* rec = STATE + (size_t)j * ST_REC; const f32x4 gj = *(const f32x4*)(rec + 4096 + 16 * w + 4 * rg);
#pragma unroll
                for (int et = 0; et < 4; ++et) { const f32x4 sj = *(const f32x4*)(rec + ((w * 4 + et) * 64 + lane) * 4); S[et] = gj * S[et] + sj; } } } }
    const size_t rowbase = (size_t)b * SEQ + (size_t)sc * NCH * 64;
    u32x4 rq[2], rk[2], rv[2], rr[2]; u32x4 dummy[6];
#define MX_LOAD_RAW(n) do { const bf16* p_ = PROJ + (rowbase + (size_t)(n) * 64 + lane) * NPROJ; \
        if constexpr (TYPE == 0) { rk[0] = *(const u32x4*)(p_ + kc + 8 * w); rk[1] = *(const u32x4*)(p_ + kc + 32 + 8 * w); \
            if constexpr (FULL) { rq[0] = *(const u32x4*)(p_ + qc + 8 * w); rq[1] = *(const u32x4*)(p_ + qc + 32 + 8 * w); } \
            const u32x4* rp_ = (const u32x4*)((const unsigned*)(ws + WS_ROPE) + (rowbase + (size_t)(n) * 64 + lane) * 32 + 8 * w); rr[0] = rp_[0]; rr[1] = rp_[1]; } \
        else if constexpr (TYPE == 1) { rk[0] = *(const u32x4*)(p_ + kc + 16 * w); rk[1] = *(const u32x4*)(p_ + kc + 16 * w + 8); \
            if constexpr (FULL) { rq[0] = *(const u32x4*)(p_ + qc + 16 * w); rq[1] = *(const u32x4*)(p_ + qc + 16 * w + 8); } } \
        else { if (w < 2) { rk[0] = *(const u32x4*)(p_ + kc + 16 * w); rk[1] = *(const u32x4*)(p_ + kc + 16 * w + 8); rr[0] = *(const u32x4*)(p_ + C_GA + hh * 32 + 16 * w); rr[1] = *(const u32x4*)(p_ + C_GA + hh * 32 + 16 * w + 8); \
                            if constexpr (FULL) { rq[0] = *(const u32x4*)(p_ + qc + 16 * w); rq[1] = *(const u32x4*)(p_ + qc + 16 * w + 8); } } } \
        rv[0] = *(const u32x4*)(p_ + vc + 16 * w); rv[1] = *(const u32x4*)(p_ + vc + 16 * w + 8); \
        if (PROBE_TA && !FULL) { _Pragma("unroll") for (int x_ = 0; x_ < 6; ++x_) { dummy[x_] = *(const volatile u32x4*)(p_ + vc + 16 * w + 8 * (x_ & 1)); } } } while (0)
    MX_LOAD_RAW(0);
    __syncthreads();
    if (gid == 1) __syncthreads();
    for (int n = 0; n < NCH; ++n) {
        float em4[4];
        if (PROBE_TA && !FULL) { _Pragma("unroll") for (int x_ = 0; x_ < 6; ++x_) asm volatile("" :: "v"(dummy[x_])); }
        {
            float Qr[16], Kr[16];
            if constexpr (TYPE == 0) {
                const float sq = fexp2((float)(lane - 31) * lgam), sk = fexp2((float)(31 - lane) * lgam) * 0.125f;
#pragma unroll
                for (int i = 0; i < 8; ++i) { const unsigned csw = rr[i >> 2][i & 3]; const float cs = bflo(csw), sn = bfhi(csw);
                    const float k1 = bfx(rk[0], i), k2 = bfx(rk[1], i);
                    Kr[i] = (k1 * cs - k2 * sn) * sk; Kr[8 + i] = (k1 * sn + k2 * cs) * sk;
                    if constexpr (FULL) { const float q1 = bfx(rq[0], i), q2 = bfx(rq[1], i); Qr[i] = (q1 * cs - q2 * sn) * sq; Qr[8 + i] = (q1 * sn + q2 * cs) * sq; } }
                const float em = fexp2(32.0f * lgam);
#pragma unroll
                for (int i = 0; i < 4; ++i) em4[i] = em;
                if (lane < 16) { EL[16 * w + lane] = fexp2(64.0f * lgam); ELM[16 * w + lane] = em; }
            } else if (TYPE == 1 || w < 2) {
                float c[16]; float myM = 0.f, myL = 0.f;
                if constexpr (TYPE == 1) {
                    const f32x4 lb0 = *(const LAS f32x4*)(LBt + 16 * w), lb1 = *(const LAS f32x4*)(LBt + 16 * w + 4), lb2 = *(const LAS f32x4*)(LBt + 16 * w + 8), lb3 = *(const LAS f32x4*)(LBt + 16 * w + 12);
                    const f32x4 om0 = *(const LAS f32x4*)(OMLt + 16 * w), om1 = *(const LAS f32x4*)(OMLt + 16 * w + 4), om2 = *(const LAS f32x4*)(OMLt + 16 * w + 8), om3 = *(const LAS f32x4*)(OMLt + 16 * w + 12);
#pragma unroll
                    for (int p = 0; p < 16; ++p) { const float lb = (p < 4 ? lb0 : p < 8 ? lb1 : p < 12 ? lb2 : lb3)[p & 3], om = (p < 4 ? om0 : p < 8 ? om1 : p < 12 ? om2 : om3)[p & 3];
                        const float z = bfx(rk[p >> 3], p & 7); const float sg = sigmoidf_(z);
                        const float f = lb + om * sg; c[p] = flog2(fmaxf(f, 1e-30f)); Kr[p] = om * (1.0f - sg);
                        if constexpr (FULL) { const float qv = bfx(rq[p >> 3], p & 7); Qr[p] = siluf_(qv) * 0.125f; } }
                } else {
#pragma unroll
                    for (int p = 0; p < 16; ++p) { const float pre = bfx(rr[p >> 3], p & 7) + gba[p];
                        c[p] = (fminf(pre, 0.f) * LOG2E - flog2(1.0f + fexp2(-LOG2E * fabsf(pre)))) * (1.0f / 16.0f); Kr[p] = bfx(rk[p >> 3], p & 7);
                        if constexpr (FULL) Qr[p] = bfx(rq[p >> 3], p & 7) * 0.17677669529663687f; }
                }
#pragma unroll
                for (int p = 0; p < 16; p += 4) wave_incl_scan4(c[p], c[p + 1], c[p + 2], c[p + 3]);
#pragma unroll
                for (int p = 0; p < 16; ++p) { const float m = rdlane(c[p], 31), cl = rdlane(c[p], 63); Kr[p] *= fexp2(m - c[p]);
                    if constexpr (FULL) Qr[p] *= fexp2(c[p] - m);
                    myM = (lane == p) ? m : myM; myL = (lane == p) ? cl : myL; }
                if (lane < 16) { EM[16 * w + lane] = fexp2(myM); EL[16 * w + lane] = fexp2(myL); ELM[16 * w + lane] = fexp2(myL - myM); }
                if constexpr (FULL) { LDS_WAIT();
                    const f32x4 e4 = *(const LAS f32x4*)(EM + 16 * w + 4 * rg);
#pragma unroll
                    for (int i = 0; i < 4; ++i) em4[i] = e4[i]; }
            } else {
#pragma unroll
                for (int i = 0; i < 4; ++i) em4[i] = 0.f;
            }
            if (TYPE != 2 || w < 2) {
                u32x4 k0, k1;
                k0.x = pg8::cvt_pk_bf16(Kr[0], Kr[1]); k0.y = pg8::cvt_pk_bf16(Kr[2], Kr[3]); k0.z = pg8::cvt_pk_bf16(Kr[4], Kr[5]); k0.w = pg8::cvt_pk_bf16(Kr[6], Kr[7]);
                k1.x = pg8::cvt_pk_bf16(Kr[8], Kr[9]); k1.y = pg8::cvt_pk_bf16(Kr[10], Kr[11]); k1.z = pg8::cvt_pk_bf16(Kr[12], Kr[13]); k1.w = pg8::cvt_pk_bf16(Kr[14], Kr[15]);
                if constexpr (FULL) {
                    u32x4 q0, q1;
                    q0.x = pg8::cvt_pk_bf16(Qr[0], Qr[1]); q0.y = pg8::cvt_pk_bf16(Qr[2], Qr[3]); q0.z = pg8::cvt_pk_bf16(Qr[4], Qr[5]); q0.w = pg8::cvt_pk_bf16(Qr[6], Qr[7]);
                    q1.x = pg8::cvt_pk_bf16(Qr[8], Qr[9]); q1.y = pg8::cvt_pk_bf16(Qr[10], Qr[11]); q1.z = pg8::cvt_pk_bf16(Qr[12], Qr[13]); q1.w = pg8::cvt_pk_bf16(Qr[14], Qr[15]);
                    *(LAS u32x4*)(Qt + lane * MX_PITCH + 16 * w) = q0; *(LAS u32x4*)(Qt + lane * MX_PITCH + 16 * w + 8) = q1;
                    *(LAS u32x4*)(Kt + lane * MX_PITCH + 16 * w) = k0; *(LAS u32x4*)(Kt + lane * MX_PITCH + 16 * w + 8) = k1; }
#pragma unroll
                for (int p = 0; p < 16; ++p) KT[(16 * w + p) * MX_PITCH + lane] = bfbits(p < 8 ? k0 : k1, p & 7);
            }
#pragma unroll
            for (int p = 0; p < 16; ++p) VT[(16 * w + p) * MX_PITCH + lane] = bfbits(rv[p >> 3], p & 7);
            if constexpr (FULL) { if (owner) {
#pragma unroll
                for (int et = 0; et < 4; ++et) { u32x2 o; o.x = pg8::cvt_pk_bf16(S[et][0] * em4[0], S[et][1] * em4[1]); o.y = pg8::cvt_pk_bf16(S[et][2] * em4[2], S[et][3] * em4[3]);
                    *(LAS u32x2*)(ST + (16 * et + col) * MX_PITCH + 16 * w + 4 * rg) = o; } } }
        }
        __syncthreads();
        const size_t trow = rowbase + (size_t)n * 64 + 16 * w + col;
        u32x2 gt[4];
        if constexpr (FULL) {
#pragma unroll
            for (int et = 0; et < 4; ++et) gt[et] = *(const u32x2*)(PROJ + trow * NPROJ + gc + 16 * et + 4 * rg); }
        if (n + 1 < NCH) { MX_LOAD_RAW(n + 1); }
        f32x4 OT[4];
        if constexpr (FULL) {
            bf16x8 Bq[NKS];
#pragma unroll
            for (int ks = 0; ks < NKS; ++ks) Bq[ks] = *(const LAS bf16x8*)(Qt + (16 * w + col) * MX_PITCH + 32 * ks + 8 * rg);
            f32x4 PT[4];
#pragma unroll
            for (int st = 0; st < 4; ++st) { PT[st] = (f32x4){0.f, 0.f, 0.f, 0.f};
                if (st <= w) {
#pragma unroll
                    for (int ks = 0; ks < NKS; ++ks) { const bf16x8 af = *(const LAS bf16x8*)(Kt + (16 * st + col) * MX_PITCH + 32 * ks + 8 * rg); PT[st] = __builtin_amdgcn_mfma_f32_16x16x32_bf16(af, Bq[ks], PT[st], 0, 0, 0); }
                    if (st == w) {
#pragma unroll
                        for (int i = 0; i < 4; ++i) PT[st][i] = (4 * rg + i > col) ? 0.f : PT[st][i]; }
                } }
            u32x4 pb0, pb1;
            pb0.x = pg8::cvt_pk_bf16(PT[0][0], PT[0][1]); pb0.y = pg8::cvt_pk_bf16(PT[0][2], PT[0][3]); pb0.z = pg8::cvt_pk_bf16(PT[1][0], PT[1][1]); pb0.w = pg8::cvt_pk_bf16(PT[1][2], PT[1][3]);
            pb1.x = pg8::cvt_pk_bf16(PT[2][0], PT[2][1]); pb1.y = pg8::cvt_pk_bf16(PT[2][2], PT[2][3]); pb1.z = pg8::cvt_pk_bf16(PT[3][0], PT[3][1]); pb1.w = pg8::cvt_pk_bf16(PT[3][2], PT[3][3]);
#pragma unroll
            for (int et = 0; et < 4; ++et) { OT[et] = (f32x4){0.f, 0.f, 0.f, 0.f};
#pragma unroll
                for (int ks = 0; ks < NKS; ++ks) { const bf16x8 af = *(const LAS bf16x8*)(ST + (16 * et + col) * MX_PITCH + 32 * ks + 8 * rg); OT[et] = __builtin_amdgcn_mfma_f32_16x16x32_bf16(af, Bq[ks], OT[et], 0, 0, 0); }
                { const u32x2 a0 = *(const LAS u32x2*)(VT + (16 * et + col) * MX_PITCH + 4 * rg), a1 = *(const LAS u32x2*)(VT + (16 * et + col) * MX_PITCH + 16 + 4 * rg);
                  u32x4 av; av.x = a0.x; av.y = a0.y; av.z = a1.x; av.w = a1.y;
                  OT[et] = __builtin_amdgcn_mfma_f32_16x16x32_bf16(__builtin_bit_cast(bf16x8, av), __builtin_bit_cast(bf16x8, pb0), OT[et], 0, 0, 0); }
                if (w >= 2) { const u32x2 a0 = *(const LAS u32x2*)(VT + (16 * et + col) * MX_PITCH + 32 + 4 * rg), a1 = *(const LAS u32x2*)(VT + (16 * et + col) * MX_PITCH + 48 + 4 * rg);
                  u32x4 av; av.x = a0.x; av.y = a0.y; av.z = a1.x; av.w = a1.y;
                  OT[et] = __builtin_amdgcn_mfma_f32_16x16x32_bf16(__builtin_bit_cast(bf16x8, av), __builtin_bit_cast(bf16x8, pb1), OT[et], 0, 0, 0); }
            }
        }
        if (owner) {
            const f32x4 el = *(const LAS f32x4*)(EL + 16 * w + 4 * rg), elm = *(const LAS f32x4*)(ELM + 16 * w + 4 * rg);
#pragma unroll
            for (int et = 0; et < 4; ++et) { f32x4 W = (f32x4){0.f, 0.f, 0.f, 0.f};
#pragma unroll
                for (int ks = 0; ks < 2; ++ks) { const bf16x8 af = *(const LAS bf16x8*)(KT + (16 * w + col) * MX_PITCH + 32 * ks + 8 * rg), bfr = *(const LAS bf16x8*)(VT + (16 * et + col) * MX_PITCH + 32 * ks + 8 * rg);
                    W = __builtin_amdgcn_mfma_f32_16x16x32_bf16(af, bfr, W, 0, 0, 0); }
                S[et] = el * S[et] + elm * W; }
            if constexpr (!FULL) Gacc = Gacc * el;
        }
        if constexpr (FULL) {
            float ss = 0.f;
#pragma unroll
            for (int et = 0; et < 4; ++et) ss += (OT[et][0] * OT[et][0] + OT[et][1] * OT[et][1]) + (OT[et][2] * OT[et][2] + OT[et][3] * OT[et][3]);
            ss += __shfl_xor(ss, 16); ss += __shfl_xor(ss, 32);
            const float r = rsqrtf(ss * (1.0f / 64.0f) + EPS);
#pragma unroll
            for (int et = 0; et < 4; ++et) { const f32x4 g4 = gn4[et];
                const float g0 = bflo(gt[et].x), g1 = bfhi(gt[et].x), g2 = bflo(gt[et].y), g3 = bfhi(gt[et].y);
                const float o0 = OT[et][0] * r * g4[0] * siluf_(g0), o1 = OT[et][1] * r * g4[1] * siluf_(g1);
                const float o2 = OT[et][2] * r * g4[2] * siluf_(g2), o3 = OT[et][3] * r * g4[3] * siluf_(g3);
                u32x2 o; o.x = pg8::cvt_pk_bf16(o0, o1); o.y = pg8::cvt_pk_bf16(o2, o3);
                *(u32x2*)(H + trow * D + mc + 16 * et + 4 * rg) = o; }
        }
        __syncthreads();
    }
    if (gid == 0) __syncthreads();
    if constexpr (!FULL) { if (owner) { float* rec = STATE + (size_t)sc * ST_REC;
#pragma unroll
            for (int et = 0; et < 4; ++et) *(f32x4*)(rec + ((w * 4 + et) * 64 + lane) * 4) = S[et];
            if (col == 0) *(f32x4*)(rec + 4096 + 16 * w + 4 * rg) = Gacc; } }
#undef MX_LOAD_RAW
}

template <int MODE>
__device__ __forceinline__ void phase_mixer(LAS unsigned char* lds, int layer) {
    KARGS(ap); PHASE_IDS();
    constexpr int NS = (MODE == 0) ? NSC - 1 : NSC;
    constexpr int NPAIRS = NB * 8 * NS;
    for (int pr = bid; pr < NPAIRS; pr += G) {
        const int sc = pr % NS, hp = (pr / NS) & 7, b = pr / (NS * 8);
        const int hd = __builtin_amdgcn_readfirstlane((int)((0xf543bead9c827160ull >> (4 * (2 * hp + (wave >> 2)))) & 15ull));
        if (hd < 6) mixer_chunked<0, MODE>(lds, ap, layer, b, hd, hd, sc, tid);
        else if (hd < 12) mixer_chunked<1, MODE>(lds, ap, layer, b, hd, hd - 6, sc, tid);
        else mixer_chunked<2, MODE>(lds, ap, layer, b, hd, hd - 12, sc, tid);
        __syncthreads();
    }
    if constexpr (MODE == 0) {
        const int nidle = G - NPAIRS;
        const int p0 = (G > 192) ? CV_P0 : 0, c1 = (G > 192) ? CV_C1 : CV_PER_LAYER;
        const int g0 = layer == 0 ? p0 : c1, g1 = layer == 0 ? c1 : 2 * CV_PER_LAYER;
        if (nidle > 0) { if (bid >= NPAIRS) convert_experts(lds, ap, g0, g1, (bid - NPAIRS) * 8 + wave, nidle * 8, wave, lane); }
        else convert_experts(lds, ap, g0, g1, gw, NGW, wave, lane);
    }
}

__device__ __forceinline__ void build_tp(LAS int* TP, const unsigned* cnt, int tid) {
    if (tid == 0) { int s = 0; for (int e = 0; e < 32; ++e) { TP[e] = s; s += ((int)cnt[e] + 255) >> 8; } TP[32] = s; }
    __syncthreads();
}

__device__ __forceinline__ void phase_prologue(LAS unsigned char* lds) {
    KARGS(ap); PHASE_IDS();
    unsigned char* ws = ap->ws;
    if (bid < 192) {
        float* MOD = (float*)(ws + WS_MOD);
        const float* cin = ap->in[I_C]; const float* wada = ap->in[I_WADA]; const float* bada = ap->in[I_BADA];
        LAS float* cact = (LAS float*)lds;
        for (int i = tid; i < 8192; i += 512) { const int b = i >> 10, k = i & 1023; cact[k * 8 + b] = siluf_(cin[i]); }
        __syncthreads();
        LAS float* red = (LAS float*)(lds + 32768);
        const int kr = lane >> 4, c4 = (lane & 15) * 4;
        for (int it = bid; it < 192; it += G) {
            const int l = it / 96, j0 = (it % 96) * 64; const float* W = wada + (size_t)l * D * 6144 + j0 + c4;
            f32x4 acc[8];
#pragma unroll
            for (int b = 0; b < 8; ++b) acc[b] = (f32x4){0.f, 0.f, 0.f, 0.f};
#pragma unroll 8
            for (int i = 0; i < 32; ++i) { const int k = wave * 128 + 4 * i + kr; const f32x4 wv = __builtin_nontemporal_load((const f32x4*)(W + (size_t)k * 6144));
                const f32x4 c0 = *(const LAS f32x4*)(cact + k * 8), c1 = *(const LAS f32x4*)(cact + k * 8 + 4);
                acc[0] += c0[0] * wv; acc[1] += c0[1] * wv; acc[2] += c0[2] * wv; acc[3] += c0[3] * wv; acc[4] += c1[0] * wv; acc[5] += c1[1] * wv; acc[6] += c1[2] * wv; acc[7] += c1[3] * wv; }
#pragma unroll
            for (int b = 0; b < 8; ++b) *(LAS f32x4*)(red + ((wave * 4 + kr) * 8 + b) * 64 + c4) = acc[b];
            __syncthreads();
            { const int b = tid >> 6, col = tid & 63; float s = 0.f;
#pragma unroll
              for (int p = 0; p < 32; ++p) s += red[(p * 8 + b) * 64 + col];
              MOD[((size_t)l * 8 + b) * 6144 + j0 + col] = s + bada[l * 6144 + j0 + col]; }
            __syncthreads();
        }
    }
    else convert_experts(lds, ap, 0, CV_P0, (bid - 192) * 8 + wave, (G - 192) * 8, wave, lane);
    __syncthreads();
    {
        bf16* WIN_T = (bf16*)(ws + WS_WIN); bf16* WOUT_T = (bf16*)(ws + WS_WOUT);
        LAS float* scr = (LAS float*)(lds + wave * 16384);
        constexpr int I_IN = 16 * 120, I_OUT = 16 * 32;
        constexpr int PER_L = I_IN + I_OUT;
        for (int it = gw; it < 2 * PER_L; it += NGW) {
            const int l = it / PER_L; int r = it % PER_L;
            if (r < I_IN) { const int kb = r / 120, nb = r % 120; transpose_item(ap->in[I_WIN] + (size_t)l * D * INP, INP, D, kb * 64, nb * 32, WIN_T + (size_t)l * NPROJ * D, nb * 32, scr, lane); continue; } r -= I_IN;
            { const int kb = r / 32, nb = r % 32; transpose_item(ap->in[I_WOUT] + (size_t)l * D * D, D, D, kb * 64, nb * 32, WOUT_T + (size_t)l * D * D, nb * 32, scr, lane); }
        }
        const float* win = ap->in[I_WIN]; const float* wa2 = ap->in[I_WA2];
        for (int it = bid * 512 + tid; it < 2 * 256 * 128; it += G * 512) {
            const int l = it / (256 * 128), r = it % (256 * 128), n = r / 128, k0 = (r % 128) * 8;
            float o[8];
#pragma unroll
            for (int j = 0; j < 8; ++j) o[j] = 0.f;
            if (n < 128) {
#pragma unroll
                for (int j = 0; j < 8; ++j) { const float* wr_ = win + (size_t)l * D * INP + (size_t)(k0 + j) * INP + 3840; float s = 0.f;
#pragma unroll
                    for (int rr = 0; rr < 16; ++rr) s += wr_[rr] * wa2[l * 16 * 128 + rr * 128 + n];
                    o[j] = s; } }
            u32x4 w; w.x = pk2(o[0], o[1]); w.y = pk2(o[2], o[3]); w.z = pk2(o[4], o[5]); w.w = pk2(o[6], o[7]);
            *(u32x4*)(WIN_T + (size_t)l * NPROJ * D + (size_t)(3840 + n) * D + k0) = w;
        }
    }
    {
        unsigned* ROPE = (unsigned*)(ws + WS_ROPE); const int* posp = (const int*)ap->in[I_POS];
        for (int it = bid * 512 + tid; it < MTOK * 32; it += G * 512) {
            const int row = it >> 5, j = it & 31; const int pos = posp[row];
            const float ang = (float)pos * ap->inv_freq[j]; float s, c; sincos_acc(ang, s, c); ROPE[it] = pk2(c, s);
        }
    }
}

template <int MODE>
__device__ __forceinline__ void phase_norm1(LAS unsigned char* lds, int layer) {
    KARGS(ap); PHASE_IDS();
    unsigned char* ws = ap->ws; float* outp = ap->out;
    const float* MOD = (const float*)(ws + WS_MOD); bf16* H = (bf16*)(ws + WS_H); const bf16* YP = (const bf16*)(ws + WS_YP);
    const int* ROUTE_I = (const int*)(ws + WS_ROUTE); const float* ROUTE_W = (const float*)(ws + WS_ROUTE + 4 * MTOK * 4);
    LAS int* TP = (LAS int*)(lds + TP_OFF);
    const int pl = (MODE == 2) ? DEPTH - 1 : layer - 1;
    if (MODE != 0) build_tp(TP, (const unsigned*)(ws + WS_CTL) + CW_CNT + pl * 64, tid);
    const float* xin = ap->in[I_X]; const bf16* xb16 = (const bf16*)(ws + WS_XB); bf16* x2 = (bf16*)outp;
    const float* gn = MODE == 2 ? ap->in[I_NFIN] : ap->in[I_NMIX] + layer * D;
    for (int rb = bid; rb < MTOK / 128; rb += G) {
        const int row0 = rb * 128 + wave * 16, b = row0 >> 12;
        f32x4 Av[4], Bv[4], Gf[4];
#pragma unroll
        for (int j = 0; j < 4; ++j) { const int c0 = 4 * lane + 256 * j; Av[j] = *(const f32x4*)(gn + c0);
            if (MODE != 2) { const float* mb = MOD + (size_t)layer * 8 * 6144 + (size_t)b * 6144; const f32x4 sc = *(const f32x4*)(mb + D + c0); Bv[j] = *(const f32x4*)(mb + c0); Av[j] = Av[j] * (1.0f + sc); }
            if (MODE != 0) Gf[j] = *(const f32x4*)(MOD + (size_t)pl * 8 * 6144 + (size_t)b * 6144 + 5 * D + c0); }
        for (int r = 0; r < 16; r += 2) {
            f32x4 v[2][4];
#pragma unroll
            for (int q = 0; q < 2; ++q)
#pragma unroll
                for (int j = 0; j < 4; ++j) { if (MODE == 0) v[q][j] = __builtin_nontemporal_load((const f32x4*)(xin + (size_t)(row0 + r + q) * D + 4 * lane + 256 * j));
                    else { const u32x2 xv = __builtin_nontemporal_load((const u32x2*)(xb16 + (size_t)(row0 + r + q) * D + 4 * lane + 256 * j)); v[q][j] = (f32x4){bflo(xv.x), bfhi(xv.x), bflo(xv.y), bfhi(xv.y)}; } }
            if (MODE != 0) {
                u32x2 y0[2][4], y1[2][4]; float w0[2], w1[2];
#pragma unroll
                for (int q = 0; q < 2; ++q) { const int m = row0 + r + q; const int e0 = ROUTE_I[m], e1 = ROUTE_I[MTOK + m], r0 = ROUTE_I[2 * MTOK + m], r1 = ROUTE_I[3 * MTOK + m]; w0[q] = ROUTE_W[m]; w1[q] = ROUTE_W[MTOK + m];
                    const bf16* p0 = YP + (size_t)(TP[e0] * 256 + r0) * D; const bf16* p1 = YP + (size_t)(TP[e1] * 256 + r1) * D;
#pragma unroll
                    for (int j = 0; j < 4; ++j) { y0[q][j] = __builtin_nontemporal_load((const u32x2*)(p0 + 4 * lane + 256 * j)); y1[q][j] = __builtin_nontemporal_load((const u32x2*)(p1 + 4 * lane + 256 * j)); } }
#pragma unroll
                for (int q = 0; q < 2; ++q)
#pragma unroll
                    for (int j = 0; j < 4; ++j) { const u32x2 a0 = y0[q][j], a1 = y1[q][j];
                        v[q][j][0] += Gf[j][0] * (w0[q] * bflo(a0.x) + w1[q] * bflo(a1.x)); v[q][j][1] += Gf[j][1] * (w0[q] * bfhi(a0.x) + w1[q] * bfhi(a1.x));
                        v[q][j][2] += Gf[j][2] * (w0[q] * bflo(a0.y) + w1[q] * bflo(a1.y)); v[q][j][3] += Gf[j][3] * (w0[q] * bfhi(a0.y) + w1[q] * bfhi(a1.y));
                        if (MODE == 1) { u32x2 xo; xo.x = pk2(v[q][j][0], v[q][j][1]); xo.y = pk2(v[q][j][2], v[q][j][3]); *(u32x2*)(x2 + (size_t)(row0 + r + q) * D + 4 * lane + 256 * j) = xo; } }
            }
            float ss[2];
#pragma unroll
            for (int q = 0; q < 2; ++q) { float s = 0.f;
#pragma unroll
                for (int j = 0; j < 4; ++j) s += (v[q][j][0] * v[q][j][0] + v[q][j][1] * v[q][j][1]) + (v[q][j][2] * v[q][j][2] + v[q][j][3] * v[q][j][3]);
                ss[q] = s; }
            ss[0] = wave_sum(ss[0]); ss[1] = wave_sum(ss[1]);
#pragma unroll
            for (int q = 0; q < 2; ++q) { const float rstd = rsqrtf(ss[q] * (1.0f / D) + EPS); const size_t m = (size_t)(row0 + r + q);
#pragma unroll
                for (int j = 0; j < 4; ++j) { const int c0 = 4 * lane + 256 * j;
                    if (MODE == 2) { *(f32x4*)(outp + m * D + c0) = v[q][j] * rstd * Av[j]; }
                    else { const f32x4 y = (v[q][j] * rstd) * Av[j] + Bv[j]; u32x2 o; o.x = pk2(y[0], y[1]); o.y = pk2(y[2], y[3]); *(u32x2*)(H + m * D + c0) = o; } } }
        }
    }
}

__device__ __forceinline__ void phase_inproj(LAS unsigned char* lds, int layer) {
    KARGS(ap); unsigned char* ws = ap->ws;
    pg8::Gemm g{(const bf16*)(ws + WS_H), (const bf16*)(ws + WS_WIN) + (size_t)layer * NPROJ * D, D}; pg8::StaticOrder S; S.init(MTOK, NPROJ, gridDim.x, blockIdx.x);
    pg8::EpiBf16WideNT E{(bf16*)(ws + WS_PROJ), NPROJ};
    pg8::gemm_phase<pg8::EpiBf16WideNT, pg8::StaticOrder, false>(lds, g, S, E, nullptr);
}
__device__ __forceinline__ void phase_mixer_naive(LAS unsigned char* lds, int layer) {
    KARGS(ap); PHASE_IDS();
    for (int it = bid; it < NB * 16; it += G) {
        const int b = it >> 4, hd = it & 15;
        if (hd < 6) naive_mixer_item<0>(lds, ap, layer, b, hd, tid);
        else if (hd < 12) naive_mixer_item<1>(lds, ap, layer, b, hd - 6, tid);
        else naive_mixer_item<2>(lds, ap, layer, b, hd - 12, tid);
        __syncthreads();
    }
}
__device__ __forceinline__ void phase_outproj(LAS unsigned char* lds, int layer) {
    KARGS(ap); unsigned char* ws = ap->ws;
    pg8::Gemm g{(const bf16*)(ws + WS_H), (const bf16*)(ws + WS_WOUT) + (size_t)layer * D * D, D}; pg8::StaticOrder S; S.init(MTOK, D, gridDim.x, blockIdx.x);
    const float* gate = (const float*)(ws + WS_MOD) + (size_t)layer * 8 * 6144 + 2 * D;
    if (layer == 0) { pg8::EpiResGateB<false> E{ap->in[I_X], (bf16*)(ws + WS_XB), gate}; pg8::gemm_phase<pg8::EpiResGateB<false>, pg8::StaticOrder, false>(lds, g, S, E, nullptr); }
    else { pg8::EpiResGateB<true> E{ap->out, (bf16*)(ws + WS_XB), gate}; pg8::gemm_phase<pg8::EpiResGateB<true>, pg8::StaticOrder, false>(lds, g, S, E, nullptr); }
}
constexpr int WR_PITCH = 1032;
__device__ __forceinline__ void phase_norm2_router(LAS unsigned char* lds, int layer) {
    KARGS(ap); PHASE_IDS();
    unsigned char* ws = ap->ws; const bf16* xres = (const bf16*)(ws + WS_XB);
    bf16* H = (bf16*)(ws + WS_H);
    int* ROUTE_I = (int*)(ws + WS_ROUTE); float* ROUTE_W = (float*)(ws + WS_ROUTE + 4 * MTOK * 4); int* IDX2 = (int*)(ws + WS_IDX2);
    unsigned* cntl = (unsigned*)(ws + WS_CTL) + CW_CNT + layer * 64;
    LAS bf16* Wr = (LAS bf16*)lds;
    LAS float* LG = (LAS float*)(lds + 99072);
    LAS float* AB = (LAS float*)(lds + 119552);
    LAS int* HIST = (LAS int*)(lds + 127744); LAS int* BASE = HIST + 32; LAS int* RI = BASE + 32; LAS float* RW = (LAS float*)(RI + 128 * 4);
    { const float* rgw = ap->in[I_RGW] + (size_t)layer * D * 4; const float* rew = ap->in[I_REW] + (size_t)layer * D * 32;
      for (int i = tid; i < 32 * 1024; i += 512) { const int k = i >> 5, n = i & 31; Wr[(4 + n) * WR_PITCH + k] = (bf16)f2bf(rew[i]); }
      for (int i = tid; i < 4 * 1024; i += 512) { const int k = i >> 2, n = i & 3; Wr[n * WR_PITCH + k] = (bf16)f2bf(rgw[i]); }
      for (int i = tid; i < 12 * 1024; i += 512) { const int n = 36 + (i >> 10), k = i & 1023; Wr[n * WR_PITCH + k] = (bf16)0; } }
    const float* gn = ap->in[I_NFFN] + layer * D; const float* rgb = ap->in[I_RGB] + layer * 4; const float* reb = ap->in[I_REB] + layer * 32;
    const float* modl = (const float*)(ws + WS_MOD) + (size_t)layer * 8 * 6144;
    const int r = lane & 15, kq = lane >> 4;
    for (int rb = bid; rb < MTOK / 128; rb += G) {
        const int row0 = rb * 128 + wave * 16, b = row0 >> 12; const float* mb = modl + (size_t)b * 6144 + 3 * D;
        __syncthreads();
        if (tid < 32) HIST[tid] = 0;
        for (int i = tid; i < 1024; i += 512) { AB[i] = gn[i] * (1.0f + mb[D + i]); AB[1024 + i] = mb[i]; }
        __syncthreads();
        const bf16* xr = xres + (size_t)(row0 + r) * D + 8 * kq;
        float ss = 0.f;
#pragma unroll 16
        for (int ks = 0; ks < 32; ++ks) { const u32x4 xv = *(const u32x4*)(xr + 32 * ks); const f32x4 xa = (f32x4){bflo(xv.x), bfhi(xv.x), bflo(xv.y), bfhi(xv.y)}, xb = (f32x4){bflo(xv.z), bfhi(xv.z), bflo(xv.w), bfhi(xv.w)};
            ss += (xa[0] * xa[0] + xa[1] * xa[1]) + (xa[2] * xa[2] + xa[3] * xa[3]) + (xb[0] * xb[0] + xb[1] * xb[1]) + (xb[2] * xb[2] + xb[3] * xb[3]); }
        ss += __shfl_xor(ss, 16); ss += __shfl_xor(ss, 32);
        const float rstd = rsqrtf(ss * (1.0f / D) + EPS);
        f32x4 acc[3];
#pragma unroll
        for (int nt = 0; nt < 3; ++nt) acc[nt] = (f32x4){0.f, 0.f, 0.f, 0.f};
        bf16* hr = H + (size_t)(row0 + r) * D + 8 * kq;
#pragma unroll 8
        for (int ks = 0; ks < 32; ++ks) { const u32x4 xv = *(const u32x4*)(xr + 32 * ks); const f32x4 xa = (f32x4){bflo(xv.x), bfhi(xv.x), bflo(xv.y), bfhi(xv.y)}, xb = (f32x4){bflo(xv.z), bfhi(xv.z), bflo(xv.w), bfhi(xv.w)};
            const f32x4 a0 = *(const LAS f32x4*)(AB + 32 * ks + 8 * kq), a1 = *(const LAS f32x4*)(AB + 32 * ks + 8 * kq + 4), b0 = *(const LAS f32x4*)(AB + 1024 + 32 * ks + 8 * kq), b1 = *(const LAS f32x4*)(AB + 1024 + 32 * ks + 8 * kq + 4);
            const f32x4 ya = (xa * rstd) * a0 + b0, yb = (xb * rstd) * a1 + b1;
            u32x4 o; o.x = pg8::cvt_pk_bf16(ya[0], ya[1]); o.y = pg8::cvt_pk_bf16(ya[2], ya[3]); o.z = pg8::cvt_pk_bf16(yb[0], yb[1]); o.w = pg8::cvt_pk_bf16(yb[2], yb[3]);
            *(u32x4*)(hr + 32 * ks) = o;
            const bf16x8 af = __builtin_bit_cast(bf16x8, o);
#pragma unroll
            for (int nt = 0; nt < 3; ++nt) { const bf16x8 bfr = *(const LAS bf16x8*)(Wr + (16 * nt + r) * WR_PITCH + 32 * ks + 8 * kq); acc[nt] = __builtin_amdgcn_mfma_f32_16x16x32_bf16(af, bfr, acc[nt], 0, 0, 0); } }
        LAS float* lgw = LG + wave * 16 * 40;
#pragma unroll
        for (int nt = 0; nt < 3; ++nt) { if (16 * nt + r < 40) {
#pragma unroll
            for (int i = 0; i < 4; ++i) lgw[(4 * kq + i) * 40 + 16 * nt + r] = acc[nt][i]; } }
        LDS_WAIT();
        if (lane < 16) {
            const LAS float* lg = lgw + lane * 40;
            float gl[4];
#pragma unroll
            for (int t = 0; t < 4; ++t) gl[t] = lg[t] + rgb[t];
            int gi = 0; float gm = gl[0];
#pragma unroll
            for (int t = 1; t < 4; ++t) if (gl[t] > gm) { gm = gl[t]; gi = t; }
            float gs = 0.f;
#pragma unroll
            for (int t = 0; t < 4; ++t) gs += __expf(gl[t] - gm);
            const float gwt = 1.0f / gs;
            float el[8];
#pragma unroll
            for (int t = 0; t < 8; ++t) el[t] = lg[4 + gi * 8 + t] + reb[gi * 8 + t];
            int i0 = 0; float m0 = el[0];
#pragma unroll
            for (int t = 1; t < 8; ++t) if (el[t] > m0) { m0 = el[t]; i0 = t; }
            int i1 = -1; float m1 = -3.0e38f;
#pragma unroll
            for (int t = 0; t < 8; ++t) if (t != i0 && el[t] > m1) { m1 = el[t]; i1 = t; }
            const float ex = __expf(m1 - m0); const float w0 = gwt / (1.0f + ex), w1 = gwt * ex / (1.0f + ex);
            const int e0 = gi * 8 + i0, e1 = gi * 8 + i1, lr = wave * 16 + lane;
            const int l0 = __hip_atomic_fetch_add(HIST + e0, 1, __ATOMIC_RELAXED, __HIP_MEMORY_SCOPE_WORKGROUP), l1 = __hip_atomic_fetch_add(HIST + e1, 1, __ATOMIC_RELAXED, __HIP_MEMORY_SCOPE_WORKGROUP);
            RI[lr * 4 + 0] = e0; RI[lr * 4 + 1] = e1; RI[lr * 4 + 2] = l0; RI[lr * 4 + 3] = l1; RW[lr * 2 + 0] = w0; RW[lr * 2 + 1] = w1;
        }
        __syncthreads();
        if (tid < 32) { const int c = HIST[tid]; BASE[tid] = c ? (int)atomicAdd(cntl + tid, (unsigned)c) : 0; }
        __syncthreads();
        if (tid < 128) { const int m = rb * 128 + tid; const int e0 = RI[tid * 4 + 0], e1 = RI[tid * 4 + 1]; const int r0 = BASE[e0] + RI[tid * 4 + 2], r1 = BASE[e1] + RI[tid * 4 + 3];
            IDX2[e0 * MTOK + r0] = m; IDX2[e1 * MTOK + r1] = m;
            ROUTE_I[m] = e0; ROUTE_I[MTOK + m] = e1; ROUTE_I[2 * MTOK + m] = r0; ROUTE_I[3 * MTOK + m] = r1; ROUTE_W[m] = RW[tid * 2 + 0]; ROUTE_W[MTOK + m] = RW[tid * 2 + 1]; }
    }
}
__device__ __forceinline__ void phase_moe(LAS unsigned char* lds, int layer) {
    KARGS(ap); unsigned char* ws = ap->ws;
    LAS int* TP = (LAS int*)(lds + TP_OFF); LAS int* AUX = (LAS int*)(lds + AUX_OFF);
    unsigned* ctl = (unsigned*)(ws + WS_CTL);
    const unsigned* cntl = ctl + CW_CNT + layer * 64;
    unsigned* arrive = ctl + CW_MOE + layer * CW_MOE_LAYER;
    { int tid = threadIdx.x; build_tp(TP, cntl, tid);
      pg8::MoeOrder S0; S0.G = gridDim.x; S0.c = blockIdx.x; S0.npt = 2; S0.total = TP[32] * 2; S0.tp = TP;
      const int* IDX2 = (const int*)(ws + WS_IDX2);
      pg8::Unit u; for (int i = 0; i < 8; ++i) { if (!S0.next(i, u)) break; const int e = u.pn >> 1, j = u.pm - TP[e], cnt = (int)cntl[e];
          if (tid < 256) { const int rank = j * 256 + tid; AUX[i * 256 + tid] = (rank < cnt ? IDX2[e * MTOK + rank] : 0) * (D * 2); } }
      __syncthreads(); }
    { pg8::MoeOrder S; S.G = gridDim.x; S.c = blockIdx.x; S.npt = 2; S.total = TP[32] * 2; S.tp = TP;
      pg8::Gemm g{(const bf16*)(ws + WS_H), (const bf16*)(ws + WS_WGU) + (size_t)layer * NEXP * 512 * D, D};
      pg8::EpiSwiGLU E{(bf16*)(ws + WS_HID), arrive};
      pg8::gemm_phase<pg8::EpiSwiGLU, pg8::MoeOrder, true>(lds, g, S, E, AUX); }
    const int T_ = TP[32], split = 4 * ((((2 * T_) / (int)gridDim.x) * (int)gridDim.x) >> 1);
    pg8::Gemm gd{(const bf16*)(ws + WS_HID), (const bf16*)(ws + WS_WD) + (size_t)layer * NEXP * D * DEXP, DEXP};
    pg8::EpiBf16WideNT Ed{(bf16*)(ws + WS_YP), D};
    pg8::MoeDownOrder S1; S1.init(gridDim.x, blockIdx.x, T_, TP); S1.hi = split;
    int n1 = 0; while (n1 < 16) { const int ix = S1.unit_index(n1); if (ix < 0 || ix >= split) break; ++n1; }
    S1.wait(arrive, ctl + CW_TMO);
    pg8::gemm_phase<pg8::EpiBf16WideNT, pg8::MoeDownOrder, false>(lds, gd, S1, Ed, nullptr);
    pg8::MoeDownOrder S2; S2.init(gridDim.x, blockIdx.x, T_, TP); S2.lo = split; S2.j0 = n1;
    S2.wait(arrive, ctl + CW_TMO);
    pg8::gemm_phase<pg8::EpiBf16WideNT, pg8::MoeDownOrder, false>(lds, gd, S2, Ed, nullptr);
}

__global__ void __launch_bounds__(512, 2) fwd(Args a) {
    extern __shared__ __attribute__((aligned(16))) unsigned char lds_raw[];
    LAS unsigned char* lds = (LAS unsigned char*)lds_raw;
    volatile LAS unsigned* MISC = (volatile LAS unsigned*)(lds + LDSCTL_OFF);
    for (int u = threadIdx.x; u < (LDS_BYTES - LDSCTL_OFF) / 4; u += 512) ((LAS unsigned*)(lds + LDSCTL_OFF))[u] = 0u;
    __syncthreads();
#if MK_ONE_LAUNCH
    { unsigned* ctl0 = (unsigned*)(a.ws + WS_CTL); (void)xcd_barrier_post(ctl0 + CW_BAR, MISC + 8); }
    constexpr int lo = 0, hi = N_PHASES;
#define SEAM(k) do { if ((k) + 1 < hi) { KARGS(_ap); XcdBarrier _b; _b.bar = (unsigned*)(_ap->ws + WS_CTL) + CW_BAR; _b.x = xb_xcc_id(); _b.st = (volatile LAS unsigned*)(lds + LDSCTL_OFF) + 8; xcd_barrier(_b); if (PROBE_BAR) xcd_barrier(_b); } } while (0)
#else
    (void)MISC;
    const int lo = a.ph_lo, hi = a.ph_hi;
#define SEAM(k) do { } while (0)
#endif
#define IN(k) (lo <= (k) && (k) < hi)
    if (EN_P0 && IN(0)) { phase_prologue(lds); SEAM(0); if (PROBE_D) { phase_prologue(lds); SEAM(0); } }
#define LAYER_PHASES(layer) do { constexpr int pb = 1 + PH_PER_LAYER * (layer); \
        if (EN_PA && IN(pb + 0)) { if ((layer) == 0) { phase_norm1<0>(lds, (layer)); if (PROBE_A) { SEAM(pb + 0); phase_norm1<0>(lds, (layer)); } } else phase_norm1<1>(lds, (layer)); SEAM(pb + 0); } \
        if (EN_PB && IN(pb + 1)) { phase_inproj(lds, (layer)); SEAM(pb + 1); } \
        if (EN_PC && IN(pb + 2)) { if (!MK_NAIVE_MIXER) phase_mixer<0>(lds, (layer)); SEAM(pb + 2); } \
        if (EN_PC && IN(pb + 3)) { if (MK_NAIVE_MIXER) phase_mixer_naive(lds, (layer)); else phase_mixer<1>(lds, (layer)); SEAM(pb + 3); if (PROBE_M) { phase_mixer<0>(lds, (layer)); SEAM(pb + 3); } if (PROBE_M3) { phase_mixer<1>(lds, (layer)); SEAM(pb + 3); } } \
        if (EN_PD && IN(pb + 4)) { phase_outproj(lds, (layer)); SEAM(pb + 4); if (PROBE_PD && (layer) == 0) { phase_outproj(lds, (layer)); SEAM(pb + 4); } } \
        if (EN_PE && IN(pb + 5)) { phase_norm2_router(lds, (layer)); SEAM(pb + 5); if (PROBE_E) { if (blockIdx.x == 0 && threadIdx.x < 64) { KARGS(_a2); ((unsigned*)(_a2->ws + WS_CTL))[CW_CNT + (layer) * 64 + threadIdx.x] = 0u; } SEAM(pb + 5); phase_norm2_router(lds, (layer)); SEAM(pb + 5); } } \
        if (EN_PG && IN(pb + 6)) { phase_moe(lds, (layer)); SEAM(pb + 7); } } while (0)
    LAYER_PHASES(0);
    LAYER_PHASES(1);
#undef LAYER_PHASES
    if (EN_PF && IN(PH_FINAL)) phase_norm1<2>(lds, 0);
#undef IN
#undef SEAM
}

extern "C" void kernel_launch(void* const* d_in, const int* in_sizes, int n_in, void* d_out, int out_size, void* d_ws, size_t ws_size, hipStream_t stream) {
    static int grid = 0;
    if (grid == 0) {
        if (n_in != 23 || out_size != MTOK * D || ws_size < WS_END) { fprintf(stderr, "kernel_launch: unexpected shapes (n_in %d out %d ws %zu)\n", n_in, out_size, ws_size); grid = -1; return; }
        int dev = 0, cus = 0;
        if (hipGetDevice(&dev) != hipSuccess || hipDeviceGetAttribute(&cus, hipDeviceAttributeMultiprocessorCount, dev) != hipSuccess) { grid = -1; return; }
        if (hipFuncSetAttribute((const void*)fwd, hipFuncAttributeMaxDynamicSharedMemorySize, LDS_BYTES) != hipSuccess) { fprintf(stderr, "kernel_launch: hipFuncSetAttribute failed\n"); grid = -1; return; }
        int per_cu = 0;
        if (hipOccupancyMaxActiveBlocksPerMultiprocessor(&per_cu, (const void*)fwd, 512, LDS_BYTES) != hipSuccess || per_cu < 1) fprintf(stderr, "kernel_launch: occupancy query reports %d\n", per_cu);
        (void)hipGetLastError();
        grid = cus;
    }
    if (grid < 0) return;
    (void)hipMemsetAsync((char*)d_ws + WS_CTL, 0, CTL_ZERO_BYTES, stream);
    Args a{};
    for (int i = 0; i < 23; ++i) a.in[i] = (const float*)d_in[i];
    a.out = (float*)d_out; a.ws = (unsigned char*)d_ws;
    for (int j = 0; j < 32; ++j) a.inv_freq[j] = (float)std::pow(10000.0, -(double)j / 32.0);
#if MK_ONE_LAUNCH
    a.ph_lo = 0; a.ph_hi = N_PHASES;
    hipLaunchKernelGGL(fwd, dim3(grid), dim3(512), LDS_BYTES, stream, a);
#else
    for (int p = 0; p < N_PHASES; ++p) { a.ph_lo = p; a.ph_hi = p + 1; hipLaunchKernelGGL(fwd, dim3(grid), dim3(512), LDS_BYTES, stream, a); }
#endif
}
```
